# Optimizing an MI355X kernel written in HIP

```python
import math
import jax, jax.numpy as jnp
from jax import lax
import numpy as np

D_MODEL = 1024
BATCH = 4
SEQ = 4096
DEPTH = 4

GRID_W = 64
CTX_LEN = 256
HEAD_DIM = 128
FNET_GROUPS = 4
FNET_GROUP_DIM = 64
FNET_WIDTH = FNET_GROUPS * FNET_GROUP_DIM
GQA_Q_HEADS = 6
GQA_KV_HEADS = 2
GQA_GROUP = GQA_Q_HEADS // GQA_KV_HEADS
AB_IN_WIDTH = FNET_WIDTH + (GQA_Q_HEADS + 2 * GQA_KV_HEADS) * HEAD_DIM
AB_OUT_WIDTH = FNET_WIDTH + GQA_Q_HEADS * HEAD_DIM
ROPE_THETA = 10000.0
Q_BLOCK = 128
NA_HEADS = 8
NA_WIDTH = NA_HEADS * HEAD_DIM
NA_KH = 8
NA_KW = 16
NA_ROWS_PER_BLOCK = Q_BLOCK // GRID_W
NEG_INF = -1e30
N_EXPERTS = 64
TOP_K = 8
EXPERT_DIM = 256
SHARED_DIM = 256
ROUTE_SCALE = 2.5
MOE_BLOCK = 128
DN_ALPHA = (2 * DEPTH) ** 0.25
DN_BETA = (8 * DEPTH) ** -0.25
N_EVEN = (DEPTH + 1) // 2
N_ODD = DEPTH // 2
LN_EPS = 1e-6
RMS_EPS = 1e-6

kernel_name = "hybrid_fourier_gqa_natten_moe_deepnorm"


def layer_norm(x, g, b):
    xf = x.astype(jnp.float32)
    mu = xf.mean(-1, keepdims=True)
    xc = xf - mu
    var = (xc * xc).mean(-1, keepdims=True)
    return (xc * lax.rsqrt(var + LN_EPS) * g + b).astype(x.dtype)


def rms_norm(x, g):
    xf = x.astype(jnp.float32)
    return (xf * lax.rsqrt((xf * xf).mean(-1, keepdims=True) + RMS_EPS) * g).astype(x.dtype)


def axial_rope(x):
    n_tok = x.shape[1]
    t = jnp.arange(n_tok)
    half = HEAD_DIM // 2
    nf = half // 2
    inv = ROPE_THETA ** (-(2.0 / half) * jnp.arange(nf, dtype=jnp.float32))

    def rot(v, pos):
        ang = pos.astype(jnp.float32)[:, None] * inv
        cos = jnp.cos(ang)[:, None, :]
        sin = jnp.sin(ang)[:, None, :]
        v1, v2 = v[..., :nf], v[..., nf:]
        return jnp.concatenate([v1 * cos - v2 * sin, v1 * sin + v2 * cos], axis=-1)

    xf = x.astype(jnp.float32)
    out = jnp.concatenate([rot(xf[..., :half], t // GRID_W), rot(xf[..., half:], t % GRID_W)], axis=-1)
    return out.astype(x.dtype)


def gqa_attend(q, k, v):
    s = jnp.einsum("bqkgd,bnkd->bkgqn", q, k).astype(jnp.float32) * HEAD_DIM ** -0.5
    p = jax.nn.softmax(s, axis=-1).astype(v.dtype)
    return jnp.einsum("bkgqn,bnkd->bqkgd", p, v)


def fourier_mix(f, w_fnet):
    bsz, n_tok, _ = f.shape
    fg = f.reshape(bsz, n_tok, FNET_GROUPS, FNET_GROUP_DIM).astype(jnp.float32)
    fr = jnp.fft.fft2(fg, axes=(1, 3), norm="ortho").real.astype(f.dtype)
    return jnp.einsum("blgc,gcd->blgd", fr, w_fnet).reshape(bsz, n_tok, FNET_WIDTH)


def mixer_ab(h_lat, h_ctx, w_in, w_fnet, q_gain, k_gain, w_out, want_ctx):
    bsz, n_lat, _ = h_lat.shape
    n_ctx = h_ctx.shape[1]
    nq = GQA_Q_HEADS * HEAD_DIM
    nkv = GQA_KV_HEADS * HEAD_DIM
    cuts = [FNET_WIDTH, FNET_WIDTH + nq, FNET_WIDTH + nq + nkv]
    f, q, k, v = jnp.split(h_lat @ w_in, cuts, axis=-1)
    q = axial_rope(rms_norm(q.reshape(bsz, n_lat, GQA_Q_HEADS, HEAD_DIM), q_gain))
    k = axial_rope(rms_norm(k.reshape(bsz, n_lat, GQA_KV_HEADS, HEAD_DIM), k_gain))
    v = v.reshape(bsz, n_lat, GQA_KV_HEADS, HEAD_DIM)
    if want_ctx:
        fc, qc, kc, vc = jnp.split(h_ctx @ w_in, cuts, axis=-1)
    else:
        kc, vc = jnp.split(h_ctx @ w_in[:, cuts[1]:], [nkv], axis=-1)
    kc = rms_norm(kc.reshape(bsz, n_ctx, GQA_KV_HEADS, HEAD_DIM), k_gain)
    vc = vc.reshape(bsz, n_ctx, GQA_KV_HEADS, HEAD_DIM)
    k_all = jnp.concatenate([k, kc], axis=1)
    v_all = jnp.concatenate([v, vc], axis=1)
    nb = n_lat // Q_BLOCK
    qb = q.reshape(bsz, nb, Q_BLOCK, GQA_KV_HEADS, GQA_GROUP, HEAD_DIM).swapaxes(0, 1)
    o = lax.map(lambda qi: gqa_attend(qi, k_all, v_all), qb)
    o = o.swapaxes(0, 1).reshape(bsz, n_lat, nq)
    y_lat = jnp.concatenate([fourier_mix(f, w_fnet), o], axis=-1) @ w_out
    if not want_ctx:
        return y_lat, None
    qc = rms_norm(qc.reshape(bsz, n_ctx, GQA_Q_HEADS, HEAD_DIM), q_gain)
    qc = qc.reshape(bsz, n_ctx, GQA_KV_HEADS, GQA_GROUP, HEAD_DIM)
    oc = gqa_attend(qc, kc, vc).reshape(bsz, n_ctx, nq)
    y_ctx = jnp.concatenate([fourier_mix(fc, w_fnet), oc], axis=-1) @ w_out
    return y_lat, y_ctx


def mixer_na(h_lat, h_ctx, w_in, rpb, w_out, want_ctx):
    bsz, n_lat, _ = h_lat.shape
    n_ctx = h_ctx.shape[1]
    rows = n_lat // GRID_W
    kh = min(NA_KH, rows)
    kw = min(NA_KW, GRID_W)
    qr = NA_ROWS_PER_BLOCK
    nbr = min(qr + kh - 1, rows)
    nblk = rows // qr
    scale = HEAD_DIM ** -0.5
    q, k, v = jnp.split(h_lat @ w_in, 3, axis=-1)
    if want_ctx:
        qc, kc, vc = jnp.split(h_ctx @ w_in, 3, axis=-1)
    else:
        kc, vc = jnp.split(h_ctx @ w_in[:, NA_WIDTH:], 2, axis=-1)
    kc = kc.reshape(bsz, n_ctx, NA_HEADS, HEAD_DIM)
    vc = vc.reshape(bsz, n_ctx, NA_HEADS, HEAD_DIM)
    k_grid = k.reshape(bsz, rows, GRID_W, NA_HEADS, HEAD_DIM)
    v_grid = v.reshape(bsz, rows, GRID_W, NA_HEADS, HEAD_DIM)
    q_blocks = q.reshape(bsz, nblk, qr * GRID_W, NA_HEADS, HEAD_DIM).swapaxes(0, 1)
    col = jnp.arange(GRID_W)
    col_start = jnp.clip(col - kw // 2, 0, GRID_W - kw)
    in_col = (col[None, :] >= col_start[:, None]) & (col[None, :] < col_start[:, None] + kw)
    dc = jnp.clip(col[None, :] - col[:, None] + NA_KW - 1, 0, 2 * NA_KW - 2)

    def block(args):
        i, qi = args
        qrow = i * qr + jnp.arange(qr)
        rstart = jnp.clip(qrow - kh // 2, 0, rows - kh)
        bs = jnp.minimum(rstart[0], rows - nbr)
        krow = bs + jnp.arange(nbr)
        kb = lax.dynamic_slice_in_dim(k_grid, bs, nbr, axis=1).reshape(bsz, nbr * GRID_W, NA_HEADS, HEAD_DIM)
        vb = lax.dynamic_slice_in_dim(v_grid, bs, nbr, axis=1).reshape(bsz, nbr * GRID_W, NA_HEADS, HEAD_DIM)
        in_row = (krow[None, :] >= rstart[:, None]) & (krow[None, :] < rstart[:, None] + kh)
        dr = jnp.clip(krow[None, :] - qrow[:, None] + NA_KH - 1, 0, 2 * NA_KH - 2)
        mask = (in_row[:, None, :, None] & in_col[None, :, None, :]).reshape(qr * GRID_W, nbr * GRID_W)
        bias = rpb[:, dr[:, None, :, None], dc[None, :, None, :]].reshape(NA_HEADS, qr * GRID_W, nbr * GRID_W)
        s_loc = jnp.einsum("bqhd,bnhd->bhqn", qi, kb).astype(jnp.float32) * scale + bias.astype(jnp.float32)
        s_loc = jnp.where(mask, s_loc, NEG_INF)
        s_ctx = jnp.einsum("bqhd,bnhd->bhqn", qi, kc).astype(jnp.float32) * scale
        p = jax.nn.softmax(jnp.concatenate([s_loc, s_ctx], axis=-1), axis=-1).astype(vb.dtype)
        n_loc = nbr * GRID_W
        return (jnp.einsum("bhqn,bnhd->bqhd", p[..., :n_loc], vb)
                + jnp.einsum("bhqn,bnhd->bqhd", p[..., n_loc:], vc))

    o = lax.map(block, (jnp.arange(nblk), q_blocks))
    y_lat = o.swapaxes(0, 1).reshape(bsz, n_lat, NA_WIDTH) @ w_out
    if not want_ctx:
        return y_lat, None
    qc = qc.reshape(bsz, n_ctx, NA_HEADS, 1, HEAD_DIM)
    oc = gqa_attend(qc, kc, vc).reshape(bsz, n_ctx, NA_WIDTH)
    return y_lat, oc @ w_out


def moe_ffn(h, w_router, e_bias, w_gate, w_up, w_down, s_gate, s_up, s_down):
    n_tok, d = h.shape
    scores = jax.nn.sigmoid((h @ w_router).astype(jnp.float32))
    _, idx = lax.top_k(scores + e_bias.astype(jnp.float32), TOP_K)
    wts = jnp.take_along_axis(scores, idx, axis=-1)
    wts = wts / wts.sum(-1, keepdims=True) * ROUTE_SCALE
    n_pairs = n_tok * TOP_K
    flat_e = idx.reshape(-1)
    order = jnp.argsort(flat_e)
    sorted_e = flat_e[order]
    sorted_tok = (order // TOP_K).astype(jnp.int32)
    sorted_w = wts.reshape(-1)[order]
    counts = jnp.bincount(flat_e, length=N_EXPERTS)
    padded = (counts + MOE_BLOCK - 1) // MOE_BLOCK * MOE_BLOCK
    pad_end = jnp.cumsum(padded)
    pad_start = pad_end - padded
    grp_start = jnp.cumsum(counts) - counts
    dest = pad_start[sorted_e] + jnp.arange(n_pairs) - grp_start[sorted_e]
    n_blocks = (n_pairs + N_EXPERTS * (MOE_BLOCK - 1)) // MOE_BLOCK + 1
    n_slots = n_blocks * MOE_BLOCK
    slot_tok = jnp.full((n_slots,), n_tok, jnp.int32).at[dest].set(sorted_tok)
    slot_w = jnp.zeros((n_slots,), jnp.float32).at[dest].set(sorted_w)
    block_e = jnp.minimum(jnp.searchsorted(pad_end, jnp.arange(n_blocks) * MOE_BLOCK, side="right"),
                          N_EXPERTS - 1)
    h_pad = jnp.concatenate([h, jnp.zeros((1, d), h.dtype)], axis=0)

    def expert_block(args):
        tok, e = args
        xb = h_pad[tok]
        a = jax.nn.silu(xb @ w_gate[e]) * (xb @ w_up[e])
        return a @ w_down[e]

    yb = lax.map(expert_block, (slot_tok.reshape(n_blocks, MOE_BLOCK), block_e))
    y = yb.reshape(n_slots, d) * slot_w[:, None].astype(h.dtype)
    routed = jnp.zeros((n_tok + 1, d), h.dtype).at[slot_tok].add(y)[:n_tok]
    shared = (jax.nn.silu(h @ s_gate) * (h @ s_up)) @ s_down
    return routed + shared


def setup_inputs(seed: int = 0) -> dict:
    key = jax.random.key(seed)
    ks = iter(jax.random.split(key, 32))
    D = D_MODEL

    def nrm(shape, scale):
        return jax.random.normal(next(ks), shape, jnp.float32) * scale

    return {
        "x": nrm((BATCH, SEQ, D), 1.0),
        "c": nrm((BATCH, D), 1.0),
        "ctx": nrm((BATCH, CTX_LEN, D), 1.0),
        "c_ctx": nrm((D,), 1.0),
        "w_mod": nrm((DEPTH, D, 6 * D), 0.5 * D ** -0.5),
        "b_mod": nrm((DEPTH, 6 * D), 0.02),
        "ln1_g": 1.0 + nrm((DEPTH, D), 0.05),
        "ln1_b": nrm((DEPTH, D), 0.02),
        "ln2_g": 1.0 + nrm((DEPTH, D), 0.05),
        "ln2_b": nrm((DEPTH, D), 0.02),
        "ab_w_in": nrm((N_EVEN, D, AB_IN_WIDTH), D ** -0.5),
        "ab_w_fnet": nrm((N_EVEN, FNET_GROUPS, FNET_GROUP_DIM, FNET_GROUP_DIM), FNET_GROUP_DIM ** -0.5),
        "ab_q_norm": 1.0 + nrm((N_EVEN, HEAD_DIM), 0.05),
        "ab_k_norm": 1.0 + nrm((N_EVEN, HEAD_DIM), 0.05),
        "ab_w_out": nrm((N_EVEN, AB_OUT_WIDTH, D), AB_OUT_WIDTH ** -0.5 * DN_BETA),
        "na_w_in": nrm((N_ODD, D, 3 * NA_WIDTH), D ** -0.5),
        "na_rpb": nrm((N_ODD, NA_HEADS, 2 * NA_KH - 1, 2 * NA_KW - 1), 0.5),
        "na_w_out": nrm((N_ODD, NA_WIDTH, D), NA_WIDTH ** -0.5 * DN_BETA),
        "moe_w_router": nrm((DEPTH, D, N_EXPERTS), D ** -0.5),
        "moe_bias": nrm((DEPTH, N_EXPERTS), 0.01),
        "moe_w_gate": nrm((DEPTH, N_EXPERTS, D, EXPERT_DIM), D ** -0.5),
        "moe_w_up": nrm((DEPTH, N_EXPERTS, D, EXPERT_DIM), D ** -0.5),
        "moe_w_down": nrm((DEPTH, N_EXPERTS, EXPERT_DIM, D), EXPERT_DIM ** -0.5 * DN_BETA),
        "sh_w_gate": nrm((DEPTH, D, SHARED_DIM), D ** -0.5),
        "sh_w_up": nrm((DEPTH, D, SHARED_DIM), D ** -0.5),
        "sh_w_down": nrm((DEPTH, SHARED_DIM, D), SHARED_DIM ** -0.5 * DN_BETA),
    }


def reference(x, c, ctx, c_ctx, w_mod, b_mod, ln1_g, ln1_b, ln2_g, ln2_b,
              ab_w_in, ab_w_fnet, ab_q_norm, ab_k_norm, ab_w_out,
              na_w_in, na_rpb, na_w_out,
              moe_w_router, moe_bias, moe_w_gate, moe_w_up, moe_w_down,
              sh_w_gate, sh_w_up, sh_w_down):
    bsz, n_lat, d = x.shape
    n_ctx = ctx.shape[1]
    for l in range(DEPTH):
        want_ctx = l < DEPTH - 1
        j = l // 2
        mod = jax.nn.silu(c) @ w_mod[l] + b_mod[l]
        mod_c = jax.nn.silu(c_ctx) @ w_mod[l] + b_mod[l]
        sh1, sc1, g1, sh2, sc2, g2 = jnp.split(mod[:, None, :], 6, axis=-1)
        csh1, csc1, cg1, csh2, csc2, cg2 = jnp.split(mod_c, 6, axis=-1)
        h = x * (1.0 + sc1) + sh1
        hc = ctx * (1.0 + csc1) + csh1
        if l % 2 == 0:
            y, yc = mixer_ab(h, hc, ab_w_in[j], ab_w_fnet[j], ab_q_norm[j], ab_k_norm[j], ab_w_out[j], want_ctx)
        else:
            y, yc = mixer_na(h, hc, na_w_in[j], na_rpb[j], na_w_out[j], want_ctx)
        x = layer_norm(DN_ALPHA * x + g1 * y, ln1_g[l], ln1_b[l])
        h2 = (x * (1.0 + sc2) + sh2).reshape(bsz * n_lat, d)
        moe_args = (moe_w_router[l], moe_bias[l], moe_w_gate[l], moe_w_up[l], moe_w_down[l],
                    sh_w_gate[l], sh_w_up[l], sh_w_down[l])
        if want_ctx:
            ctx = layer_norm(DN_ALPHA * ctx + cg1 * yc, ln1_g[l], ln1_b[l])
            hc2 = (ctx * (1.0 + csc2) + csh2).reshape(bsz * n_ctx, d)
            ff = moe_ffn(jnp.concatenate([h2, hc2], axis=0), *moe_args)
            ff_lat = ff[:bsz * n_lat].reshape(bsz, n_lat, d)
            ff_ctx = ff[bsz * n_lat:].reshape(bsz, n_ctx, d)
            ctx = layer_norm(DN_ALPHA * ctx + cg2 * ff_ctx, ln2_g[l], ln2_b[l])
        else:
            ff_lat = moe_ffn(h2, *moe_args).reshape(bsz, n_lat, d)
        x = layer_norm(DN_ALPHA * x + g2 * ff_lat, ln2_g[l], ln2_b[l])
    return x
```

```cpp
#include <hip/hip_runtime.h>
#include <cstdio>
#include <cstdint>
#include <cstring>

#define LAS __attribute__((address_space(3)))
#define GAS __attribute__((address_space(1)))
typedef unsigned short bf16_t;
typedef short bf16x8 __attribute__((ext_vector_type(8)));
typedef short s16x4 __attribute__((ext_vector_type(4)));
typedef float f32x2 __attribute__((ext_vector_type(2)));
typedef float f32x4 __attribute__((ext_vector_type(4)));
typedef float f32x16 __attribute__((ext_vector_type(16)));
typedef unsigned u32x2 __attribute__((ext_vector_type(2)));
typedef unsigned u32x4 __attribute__((ext_vector_type(4)));

#ifndef MK_ONE_LAUNCH
#define MK_ONE_LAUNCH 0
#endif

constexpr int NB = 4, LSEQ = 4096, DM = 1024, NCTX = 256, DEPTH = 4;
constexpr int TLAT = NB * LSEQ, TCTX = NB * NCTX, TT = TLAT + TCTX;
constexpr int KVR = LSEQ + NCTX;
constexpr int NEXP = 64, TOPK = 8, EDIM = 256;
constexpr int NPAIR = TT * TOPK, NSLOT = NPAIR + TT;
constexpr float DN_ALPHA = 1.681792830507429f;
constexpr float LN_EPS = 1e-6f, RMS_EPS = 1e-6f, ROUTE_SCALE = 2.5f;
constexpr float ATT_SCALE = 0.088388347648318440f;

constexpr size_t al256(size_t x) { return (x + 255) / 256 * 256; }
constexpr size_t WS_CTL = 0, CTL_BYTES = 65536;
constexpr size_t WS_MOD = WS_CTL + CTL_BYTES;
constexpr size_t WS_GAINP = WS_MOD + al256((size_t)DEPTH * 5 * 6 * DM * 4);
constexpr size_t WS_ROPE = WS_GAINP + 2048;
constexpr size_t WS_WRHI = WS_ROPE + 16384;
constexpr size_t WS_WRLO = WS_WRHI + (size_t)DEPTH * 64 * DM * 2;
constexpr size_t WS_WF = WS_WRLO + (size_t)DEPTH * 64 * DM * 2;
constexpr size_t WS_WINE = WS_WF + (size_t)2 * 512 * DM * 2;
constexpr size_t WS_WINO = WS_WINE + (size_t)2 * 1280 * DM * 2;
constexpr size_t WS_WOUT = WS_WINO + (size_t)2 * 3072 * DM * 2;
constexpr size_t WS_WGU = WS_WOUT + (size_t)DEPTH * DM * DM * 2;
constexpr size_t WS_WD = WS_WGU + (size_t)DEPTH * 65 * 512 * DM * 2;
constexpr size_t WS_TW = WS_WD + (size_t)DEPTH * 65 * DM * 256 * 2;
constexpr size_t WS_TWC = WS_TW + (size_t)4096 * 8192 * 2;
constexpr size_t WS_XS = WS_TWC + (size_t)256 * 512 * 2;
constexpr size_t WS_H = WS_XS + (size_t)TT * DM * 4;
constexpr size_t WS_TKE = WS_H + (size_t)TT * DM * 2;
constexpr size_t WS_TKW = WS_TKE + (size_t)NPAIR * 4;
constexpr size_t WS_TKP = WS_TKW + (size_t)NPAIR * 4;
constexpr size_t WS_LIST = WS_TKP + (size_t)NPAIR * 4;
constexpr size_t WS_ACT = WS_LIST + (size_t)(NEXP + 1) * TT * 4;
constexpr size_t WS_YB = WS_ACT + (size_t)(NSLOT + 256) * EDIM * 2;
constexpr size_t WS_QB = WS_YB;
constexpr size_t WS_KB = WS_QB + (size_t)TT * DM * 2;
constexpr size_t WS_VB = WS_KB + (size_t)NB * KVR * DM * 2;
constexpr size_t WS_O = WS_VB + (size_t)NB * KVR * DM * 2;
constexpr size_t WS_Y = WS_O + (size_t)TT * DM * 2;
constexpr size_t WS_ZT = WS_Y + (size_t)TT * DM * 2;
constexpr size_t WS_ZCT = WS_ZT + (size_t)1024 * 8192 * 2;
constexpr size_t WS_OVL_END = WS_ZCT + (size_t)1024 * 512 * 2;
constexpr size_t WS_END = WS_YB + (size_t)NSLOT * DM * 2;
static_assert(WS_OVL_END <= WS_END, "overlay fits in YB");
static_assert(WS_END <= (size_t)1 << 30, "workspace must fit 1 GiB");
constexpr int CW_TMO = 0, CW_CNT = 64  , CW_BAR = 1024;

constexpr int LDS_BYTES = 147456;
constexpr int LDS_STAGE = 0;
constexpr int LDS_EPI = 131072;
constexpr int LDS_RIDX = 139264;
constexpr int LDS_TAB = 141312;
constexpr int LDS_MISC = 147456 - 256;

__device__ __forceinline__ unsigned cvt_pk_bf16(float lo, float hi) { unsigned r; asm volatile("v_cvt_pk_bf16_f32 %0, %1, %2" : "=v"(r) : "v"(lo), "v"(hi)); return r; }
__device__ __forceinline__ float bf_lo(unsigned u) { return __uint_as_float(u << 16); }
__device__ __forceinline__ float bf_hi(unsigned u) { return __uint_as_float(u & 0xffff0000u); }
__device__ __forceinline__ float wave_sum(float v) {
#pragma unroll
    for (int o = 1; o < 64; o <<= 1) v += __shfl_xor(v, o);
    return v;
}
__device__ __forceinline__ float wave_max(float v) {
#pragma unroll
    for (int o = 1; o < 64; o <<= 1) v = fmaxf(v, __shfl_xor(v, o));
    return v;
}
#define LDS_WAIT() asm volatile("s_waitcnt lgkmcnt(0)" ::: "memory")
#define VM_WAIT() asm volatile("s_waitcnt vmcnt(0)" ::: "memory")

__device__ __forceinline__ int opaque_tid() { int t = threadIdx.x; asm volatile("" : "+v"(t)); return t; }
namespace pg8 {
constexpr int BM = 256, BK = 64, HALF = 128, HTB = HALF * BK * 2  , STAGE_BYTES = 8 * HTB;

__host__ __device__ __forceinline__ int lds_byte(int r, int c) { const int st = (r >> 4) * 2 + (c >> 5), rr = r & 15, cc = c & 31, ob = rr * 64 + cc * 2; return st * 1024 + (ob ^ (((ob >> 9) & 1) << 5)); }
__host__ __device__ __forceinline__ void stage_rc(int b, int& R, int& C) { const int st = b / 1024, sb = b % 1024, swz = sb ^ (((sb >> 9) & 1) << 5); R = (st >> 1) * 16 + swz / 64; C = (st & 1) * 32 + (swz % 64) / 2; }
__host__ __device__ __forceinline__ int perm32(int rho) { const int n = rho >> 4, i = rho & 15; return 8 * (i >> 2) + 4 * n + (i & 3); }

struct Unit { const char* A; const char* B; char* C; const int* rows; int ldc, nvalid, x0, x1; };

struct EpiStore {
    __device__ __forceinline__ void operator()(const f32x4 (&acc)[2][2][4][2], const Unit& u) const {
        const int tid = opaque_tid(), wid = tid >> 6, lane = tid & 63, wr = wid >> 2, wc = wid & 3, fr = lane & 15, fq = lane >> 4;
        const int row0 = wr * 64 + fr, col0 = wc * 32 + 8 * fq;
#pragma unroll
        for (int ai = 0; ai < 2; ++ai)
#pragma unroll
            for (int m = 0; m < 4; ++m) {
                const int r = row0 + ai * HALF + m * 16;
                if (r < u.nvalid) {
                    bf16_t* rowp = (bf16_t*)u.C + (size_t)r * u.ldc + col0;
#pragma unroll
                    for (int bj = 0; bj < 2; ++bj) { const f32x4 v0 = acc[ai][bj][m][0], v1 = acc[ai][bj][m][1];
                        u32x4 w; w.x = cvt_pk_bf16(v0[0], v0[1]); w.y = cvt_pk_bf16(v0[2], v0[3]); w.z = cvt_pk_bf16(v1[0], v1[1]); w.w = cvt_pk_bf16(v1[2], v1[3]);
                        *(u32x4*)(rowp + bj * HALF) = w; }
                }
            }
    }
};
struct EpiSwiGLU {
    __device__ __forceinline__ void operator()(const f32x4 (&acc)[2][2][4][2], const Unit& u) const {
        const int tid = opaque_tid(), wid = tid >> 6, lane = tid & 63, wr = wid >> 2, wc = wid & 3, fr = lane & 15, fq = lane >> 4;
        const int row0 = wr * 64 + fr, col0 = wc * 32 + 8 * fq;
#pragma unroll
        for (int ai = 0; ai < 2; ++ai)
#pragma unroll
            for (int m = 0; m < 4; ++m) {
                const int r = row0 + ai * HALF + m * 16;
                if (r < u.nvalid) {
                    float o[8];
#pragma unroll
                    for (int n = 0; n < 2; ++n)
#pragma unroll
                        for (int j = 0; j < 4; ++j) { const float g = acc[ai][0][m][n][j], up = acc[ai][1][m][n][j];
                            o[n * 4 + j] = g * __builtin_amdgcn_rcpf(1.0f + __builtin_amdgcn_exp2f(-1.4426950408889634f * g)) * up; }
                    u32x4 w; w.x = cvt_pk_bf16(o[0], o[1]); w.y = cvt_pk_bf16(o[2], o[3]); w.z = cvt_pk_bf16(o[4], o[5]); w.w = cvt_pk_bf16(o[6], o[7]);
                    *(u32x4*)((bf16_t*)u.C + (size_t)r * u.ldc + col0) = w;
                }
            }
    }
};
struct EpiQKVE {
    LAS float* P;
    const float* gainp;
    const f32x2* rope;
    __device__ __forceinline__ void operator()(const f32x4 (&acc)[2][2][4][2], const Unit& u) const {
        const int tid = opaque_tid(), wid = tid >> 6, lane = tid & 63, wr = wid >> 2, wc = wid & 3, fr = lane & 15, fq = lane >> 4;
        const int row0 = wr * 64 + fr, col0 = wc * 32 + 8 * fq;
        if (u.x0 == 2) {
#pragma unroll
            for (int ai = 0; ai < 2; ++ai)
#pragma unroll
                for (int m = 0; m < 4; ++m) { bf16_t* rowp = (bf16_t*)u.C + (size_t)(row0 + ai * HALF + m * 16) * u.ldc + col0;
#pragma unroll
                    for (int bj = 0; bj < 2; ++bj) { const f32x4 v0 = acc[ai][bj][m][0], v1 = acc[ai][bj][m][1];
                        u32x4 w; w.x = cvt_pk_bf16(v0[0], v0[1]); w.y = cvt_pk_bf16(v0[2], v0[3]); w.z = cvt_pk_bf16(v1[0], v1[1]); w.w = cvt_pk_bf16(v1[2], v1[3]);
                        *(u32x4*)(rowp + bj * HALF) = w; } }
            asm volatile("" ::: "memory"); __builtin_amdgcn_s_barrier(); asm volatile("" ::: "memory");
            return;
        }
#pragma unroll
        for (int ai = 0; ai < 2; ++ai)
#pragma unroll
            for (int m = 0; m < 4; ++m)
#pragma unroll
                for (int bj = 0; bj < 2; ++bj) { const f32x4 a = acc[ai][bj][m][0], b = acc[ai][bj][m][1];
                    float s = (a[0] * a[0] + a[1] * a[1]) + (a[2] * a[2] + a[3] * a[3]) + (b[0] * b[0] + b[1] * b[1]) + (b[2] * b[2] + b[3] * b[3]);
                    s += __shfl_xor(s, 16); s += __shfl_xor(s, 32);
                    if (fq == 0) P[(bj * 256 + row0 + ai * HALF + m * 16) * 4 + wc] = s; }
        asm volatile("s_waitcnt lgkmcnt(0)" ::: "memory"); __builtin_amdgcn_s_barrier(); asm volatile("" ::: "memory");
        const f32x4 g0 = *(const f32x4*)(gainp + u.x0 * 128 + col0), g1 = *(const f32x4*)(gainp + u.x0 * 128 + col0 + 4);
        const int half = wc >> 1, fi = ((wc & 1) * 4 + fq) * 4;
#pragma unroll
        for (int ai = 0; ai < 2; ++ai)
#pragma unroll
            for (int m = 0; m < 4; ++m) {
                const int r = row0 + ai * HALF + m * 16;
                int pos = 0;
                if (u.x1 >= 0) { const int t = u.x1 + r; pos = half ? (t & 63) : (t >> 6); }
                const f32x4 cs0 = *(const f32x4*)(rope + pos * 32 + fi), cs1 = *(const f32x4*)(rope + pos * 32 + fi + 2);
                const float cc[4] = {cs0[0], cs0[2], cs1[0], cs1[2]}, ss[4] = {cs0[1], cs0[3], cs1[1], cs1[3]};
                bf16_t* rowp = (bf16_t*)u.C + (size_t)r * u.ldc + col0;
#pragma unroll
                for (int bj = 0; bj < 2; ++bj) {
                    const f32x4 pp = *(const LAS f32x4*)(P + (bj * 256 + r) * 4);
                    const float rs = __builtin_amdgcn_rsqf(((pp[0] + pp[1]) + (pp[2] + pp[3])) * (1.0f / 128.0f) + RMS_EPS);
                    float o1[4], o2[4];
#pragma unroll
                    for (int j = 0; j < 4; ++j) { const float v1 = acc[ai][bj][m][0][j] * rs * g0[j], v2 = acc[ai][bj][m][1][j] * rs * g1[j];
                        o1[j] = v1 * cc[j] - v2 * ss[j]; o2[j] = v1 * ss[j] + v2 * cc[j]; }
                    u32x4 w; w.x = cvt_pk_bf16(o1[0], o1[1]); w.y = cvt_pk_bf16(o1[2], o1[3]); w.z = cvt_pk_bf16(o2[0], o2[1]); w.w = cvt_pk_bf16(o2[2], o2[3]);
                    *(u32x4*)(rowp + bj * HALF) = w;
                }
            }
    }
};

template <class Epi, class Sched, bool GATHER>
__device__ __forceinline__ void gemm_phase(LAS unsigned char* lds, const int K_, Sched& S, const Epi& E) {
    const int K = K_;
    const int tid = opaque_tid(), wid = __builtin_amdgcn_readfirstlane(tid >> 6), lane = tid & 63, wr = wid >> 2, wc = wid & 3, fr = lane & 15, fq = lane >> 4;
    const int nt = K / BK;
    Unit cur, nxt; int ui = 0;
    if (!S.next(0, cur)) return;
    unsigned voffB[2], offA[2][2];
#pragma unroll
    for (int i = 0; i < 2; ++i) { int R, C; stage_rc(tid * 16 + i * 8192, R, C); const int Rb = (R & ~31) + perm32(R & 31);
        voffB[i] = (unsigned)(Rb * K + C) * 2u; }
    LAS int* ridx = (LAS int*)(lds + LDS_RIDX);
    if (GATHER) {
        if (tid < 256) ridx[tid] = (tid < cur.nvalid) ? cur.rows[tid] : 0;
        __syncthreads();
#pragma unroll
        for (int h = 0; h < 2; ++h)
#pragma unroll
            for (int i = 0; i < 2; ++i) { int R, C; stage_rc(tid * 16 + i * 8192, R, C); offA[h][i] = (unsigned)ridx[h * HALF + R] * (unsigned)(K * 2) + (unsigned)C * 2u; }
    } else {
#pragma unroll
        for (int h = 0; h < 2; ++h)
#pragma unroll
            for (int i = 0; i < 2; ++i) { int R, C; stage_rc(tid * 16 + i * 8192, R, C); offA[h][i] = (unsigned)((h * HALF + R) * K + C) * 2u; }
    }
    const size_t kstep = (size_t)(BK * 2);
    const size_t hstep = (size_t)HALF * K * 2;
    const unsigned ldsw = (unsigned)wid * 1024u;
    const int aoff = lds_byte(wr * 64 + fr, fq * 8), boff = lds_byte(wc * 32 + fr, fq * 8);
#define PG8_SA(b, h) (((b) * 2 + (h)) * HTB)
#define PG8_SB(b, h) ((4 + (b) * 2 + (h)) * HTB)
#define PG8_STAGE(bufoff, gbase, voff) do { _Pragma("unroll") for (int _i = 0; _i < 2; ++_i) \
        __builtin_amdgcn_global_load_lds((const unsigned*)((const char*)(gbase) + (voff)[_i]), (LAS unsigned*)(lds + (bufoff) + ldsw + _i * 8192), 16, 0, 0); } while (0)
#define PG8_LDA(dst, b, h) do { _Pragma("unroll") for (int m = 0; m < 4; ++m) _Pragma("unroll") for (int k = 0; k < 2; ++k) dst[m][k] = *(const LAS bf16x8*)(lds + PG8_SA(b, h) + aoff + m * 2048 + k * 1024); } while (0)
#define PG8_LDB(dst, b, h) do { _Pragma("unroll") for (int n = 0; n < 2; ++n) _Pragma("unroll") for (int k = 0; k < 2; ++k) dst[n][k] = *(const LAS bf16x8*)(lds + PG8_SB(b, h) + boff + n * 2048 + k * 1024); } while (0)
#define PG8_MMA(ai, bj, At, Bt) do { __builtin_amdgcn_s_setprio(1); _Pragma("unroll") for (int m = 0; m < 4; ++m) _Pragma("unroll") for (int n = 0; n < 2; ++n) _Pragma("unroll") for (int k = 0; k < 2; ++k) \
        acc[ai][bj][m][n] = __builtin_amdgcn_mfma_f32_16x16x32_bf16(Bt[n][k], At[m][k], acc[ai][bj][m][n], 0, 0, 0); __builtin_amdgcn_s_setprio(0); } while (0)
#define PG8_WAIT_V(n) asm volatile("s_waitcnt vmcnt(" #n ")" ::: "memory")
#define PG8_WAIT_L(n) asm volatile("s_waitcnt lgkmcnt(" #n ")" ::: "memory")
#define PG8_BAR __builtin_amdgcn_s_barrier()
#define PG8_SCHED __builtin_amdgcn_sched_barrier(0)
    f32x4 acc[2][2][4][2];
#pragma unroll
    for (int a = 0; a < 2; ++a)
#pragma unroll
        for (int b = 0; b < 2; ++b)
#pragma unroll
            for (int m = 0; m < 4; ++m)
#pragma unroll
                for (int n = 0; n < 2; ++n) acc[a][b][m][n] = (f32x4){0.f, 0.f, 0.f, 0.f};
    bf16x8 At[4][2], B0[2][2], B1[2][2];
    const char* cA = cur.A; const char* cB = cur.B;
    PG8_STAGE(PG8_SB(0, 0), cB, voffB); PG8_STAGE(PG8_SA(0, 0), cA, offA[0]); PG8_STAGE(PG8_SB(0, 1), cB + hstep, voffB); PG8_STAGE(PG8_SA(0, 1), cA, offA[1]);
    if (wr == 1) PG8_BAR;
    PG8_WAIT_V(4); PG8_BAR;
    PG8_STAGE(PG8_SB(1, 0), cB + kstep, voffB); PG8_STAGE(PG8_SA(1, 0), cA + kstep, offA[0]); PG8_STAGE(PG8_SB(1, 1), cB + hstep + kstep, voffB);
    PG8_WAIT_V(6); PG8_BAR;
    for (;;) {
        const bool has_next = S.next(ui + 1, nxt);
        const char* nA = has_next ? nxt.A : cA; const char* nB = has_next ? nxt.B : cB;
        if (GATHER && has_next && wid < 4)
            __builtin_amdgcn_global_load_lds((const unsigned*)(nxt.rows + wid * 64 + lane), (LAS unsigned*)(lds + LDS_RIDX + ((ui + 1) & 1) * 1024 + wid * 256), 4, 0, 0);
        for (int t = 0; t < nt; t += 2) {
            const bool last = (t == nt - 2);
            const char* a1 = cA + (size_t)(t + 1) * kstep;
            const char* a2 = last ? nA : cA + (size_t)(t + 2) * kstep; const char* b2 = last ? nB : cB + (size_t)(t + 2) * kstep;
            const char* a3 = a2 + kstep; const char* b3 = b2 + kstep;
            PG8_LDB(B0, 0, 0); PG8_SCHED; PG8_LDA(At, 0, 0); PG8_STAGE(PG8_SA(1, 1), a1, offA[1]);
            PG8_WAIT_L(8); PG8_BAR; PG8_WAIT_L(0); PG8_MMA(0, 0, At, B0); PG8_BAR; PG8_SCHED;
            if (GATHER && last && has_next) {
                LAS int* rn = ridx + ((ui + 1) & 1) * 256;
#pragma unroll
                for (int h = 0; h < 2; ++h)
#pragma unroll
                    for (int i = 0; i < 2; ++i) { int R, C; stage_rc(tid * 16 + i * 8192, R, C); const int rr = h * HALF + R; const int tok = (rr < nxt.nvalid) ? rn[rr] : 0; offA[h][i] = (unsigned)tok * (unsigned)(K * 2) + (unsigned)C * 2u; }
            }
            PG8_LDB(B1, 0, 1); PG8_STAGE(PG8_SB(0, 0), b2, voffB);
            PG8_BAR; PG8_WAIT_L(0); PG8_MMA(0, 1, At, B1); PG8_BAR;
            PG8_LDA(At, 0, 1); PG8_STAGE(PG8_SA(0, 0), a2, offA[0]);
            PG8_BAR; PG8_WAIT_L(0); PG8_MMA(1, 0, At, B0); PG8_BAR; PG8_SCHED;
            PG8_STAGE(PG8_SB(0, 1), b2 + hstep, voffB);
            PG8_WAIT_V(6); PG8_BAR; PG8_MMA(1, 1, At, B1); PG8_BAR;
            PG8_LDB(B0, 1, 0); PG8_SCHED; PG8_LDA(At, 1, 0); PG8_STAGE(PG8_SA(0, 1), a2, offA[1]);
            PG8_WAIT_L(8); PG8_BAR; PG8_WAIT_L(0); PG8_MMA(0, 0, At, B0); PG8_BAR; PG8_SCHED;
            PG8_LDB(B1, 1, 1); PG8_STAGE(PG8_SB(1, 0), b3, voffB);
            PG8_BAR; PG8_WAIT_L(0); PG8_MMA(0, 1, At, B1); PG8_BAR;
            PG8_LDA(At, 1, 1); PG8_STAGE(PG8_SA(1, 0), a3, offA[0]);
            PG8_BAR; PG8_WAIT_L(0); PG8_MMA(1, 0, At, B0); PG8_BAR; PG8_SCHED;
            PG8_STAGE(PG8_SB(1, 1), b3 + hstep, voffB);
            PG8_WAIT_V(6); PG8_BAR; PG8_MMA(1, 1, At, B1); PG8_BAR;
        }
        { Unit eu; S.next(ui, eu); E(acc, eu); }
        if (!has_next) break;
#pragma unroll
        for (int a = 0; a < 2; ++a)
#pragma unroll
            for (int b = 0; b < 2; ++b)
#pragma unroll
                for (int m = 0; m < 4; ++m)
#pragma unroll
                    for (int n = 0; n < 2; ++n) acc[a][b][m][n] = (f32x4){0.f, 0.f, 0.f, 0.f};
        cur = nxt; cA = nA; cB = nB; ++ui;
    }
    PG8_WAIT_V(0);
    if (wr == 0) PG8_BAR;
    PG8_BAR;
#undef PG8_SA
#undef PG8_SB
#undef PG8_STAGE
#undef PG8_LDA
#undef PG8_LDB
#undef PG8_MMA
#undef PG8_WAIT_V
#undef PG8_WAIT_L
#undef PG8_BAR
#undef PG8_SCHED
}
}

namespace att {
constexpr int D = 128, NW = 8, QBLK = 32, KVBLK = 64;
constexpr float SCALE = ATT_SCALE;
constexpr float THR = 8.f;
constexpr size_t SHM_V = KVBLK * D * 2, SHM_K = KVBLK * D * 2, SHM_ATTN = 2 * SHM_V + 2 * SHM_K + NW * 64 * 4;
constexpr int LDS_BIAS = 69632;
#define KSWZ(row, colB) ((row) * 256 + ((colB) ^ (((row) & 7) << 4)))
#define SBAR() __builtin_amdgcn_sched_barrier(0)
__device__ __forceinline__ int crow(int r, int hi) { return (r & 3) + 8 * (r >> 2) + 4 * hi; }

__device__ __forceinline__ void partialSM(f32x16& p0, f32x16& p1, float& m_reg, float& mn, float& alpha) {
  constexpr float C = SCALE * 1.4426950408889634f;
  float pmax = p0[0];
#pragma unroll
  for (int r = 1; r < 16; ++r) pmax = fmaxf(pmax, p0[r]);
#pragma unroll
  for (int r = 0; r < 16; ++r) pmax = fmaxf(pmax, p1[r]);
  { auto rr = __builtin_amdgcn_permlane32_swap(__float_as_uint(pmax), __float_as_uint(pmax), false, false);
    pmax = fmaxf(__uint_as_float(rr[0]), __uint_as_float(rr[1])); }
  if (__builtin_expect(__all(pmax - m_reg <= THR / SCALE), 1)) { mn = m_reg; alpha = 1.f; }
  else { mn = fmaxf(m_reg, pmax); alpha = __builtin_amdgcn_exp2f((m_reg - mn) * C); m_reg = mn; }
  float mnC = -mn * C;
#pragma unroll
  for (int r = 0; r < 16; ++r) p0[r] = fmaf(p0[r], C, mnC);
#pragma unroll
  for (int r = 0; r < 16; ++r) p1[r] = fmaf(p1[r], C, mnC);
#pragma unroll
  for (int r = 0; r < 16; ++r) p0[r] = __builtin_amdgcn_exp2f(p0[r]);
}
__device__ __forceinline__ void finishSM(f32x16& p0, f32x16& p1, float alpha, float& l_reg, bf16x8& pa0, bf16x8& pa1, bf16x8& pa2, bf16x8& pa3) {
#pragma unroll
  for (int r = 0; r < 16; ++r) p1[r] = __builtin_amdgcn_exp2f(p1[r]);
  float ps = 0;
#pragma unroll
  for (int r = 0; r < 16; ++r) ps += p0[r];
#pragma unroll
  for (int r = 0; r < 16; ++r) ps += p1[r];
  { auto rr = __builtin_amdgcn_permlane32_swap(__float_as_uint(ps), __float_as_uint(ps), false, false);
    ps = __uint_as_float(rr[0]) + __uint_as_float(rr[1]); }
  l_reg = l_reg * alpha + ps;
#define PK4(P, BASE, OUT) do { unsigned a0 = cvt_pk_bf16(P[BASE + 0], P[BASE + 1]), a1 = cvt_pk_bf16(P[BASE + 2], P[BASE + 3]);   \
    unsigned b0 = cvt_pk_bf16(P[BASE + 4], P[BASE + 5]), b1 = cvt_pk_bf16(P[BASE + 6], P[BASE + 7]);                              \
    auto r0 = __builtin_amdgcn_permlane32_swap(a0, b0, false, false); auto r1 = __builtin_amdgcn_permlane32_swap(a1, b1, false, false); \
    u32x4 w = {r0[0], r1[0], r0[1], r1[1]}; OUT = *reinterpret_cast<bf16x8*>(&w); } while (0)
  PK4(p0, 0, pa0); PK4(p0, 8, pa1); PK4(p1, 0, pa2); PK4(p1, 8, pa3);
#undef PK4
}
__device__ __forceinline__ void qkt(f32x16& p0, f32x16& p1, const char* Ks, const bf16x8* qr, int r32, int hi) {
  p0 = f32x16{}; p1 = f32x16{};
#pragma unroll
  for (int d0 = 0; d0 < 8; ++d0) { int cb = (d0 * 16 + hi * 8) * 2;
    bf16x8 b0 = *reinterpret_cast<const bf16x8*>(Ks + KSWZ(r32, cb));
    bf16x8 b1 = *reinterpret_cast<const bf16x8*>(Ks + KSWZ(32 + r32, cb));
    p0 = __builtin_amdgcn_mfma_f32_32x32x16_bf16(b0, qr[d0], p0, 0, 0, 0);
    p1 = __builtin_amdgcn_mfma_f32_32x32x16_bf16(b1, qr[d0], p1, 0, 0, 0); }
}
__device__ __forceinline__ int v_st(int k, int c) { const int kk = (k & ~0xC) | ((k & 4) << 1) | ((k & 8) >> 1); return ((kk >> 3) * 4 + (c >> 5)) * 512 + ((kk & 7) * 32 + (c & 31)) * 2; }
__device__ __forceinline__ int v_rd_base(int lane) { return ((lane & 3) << 3) | (((lane >> 2) & 3) << 6) | (((lane >> 4) & 1) << 5) | (((lane >> 5) & 1) << 8); }
constexpr int v_rd_off(int d0, int ks, int half) { return d0 * 512 + ks * 4096 + half * 2048; }
template <int OFF> __device__ __forceinline__ s16x4 tr_read(int vb) {
  s16x4 r; asm volatile("ds_read_b64_tr_b16 %0, %1 offset:%2" : "=&v"(r) : "v"(vb), "i"(OFF) : "memory"); return r;
}
template <int D0> __device__ __forceinline__ void pv_one(f32x16& od, int vb, bf16x8 pa0, bf16x8 pa1, bf16x8 pa2, bf16x8 pa3) {
  const s16x4 l0 = tr_read<v_rd_off(D0, 0, 0)>(vb), h0 = tr_read<v_rd_off(D0, 0, 1)>(vb), l1 = tr_read<v_rd_off(D0, 1, 0)>(vb), h1 = tr_read<v_rd_off(D0, 1, 1)>(vb);
  const s16x4 l2 = tr_read<v_rd_off(D0, 2, 0)>(vb), h2 = tr_read<v_rd_off(D0, 2, 1)>(vb), l3 = tr_read<v_rd_off(D0, 3, 0)>(vb), h3 = tr_read<v_rd_off(D0, 3, 1)>(vb);
  asm volatile("s_waitcnt lgkmcnt(0)" ::: "memory"); SBAR();
#define PK(L, H) (bf16x8){L[0], L[1], L[2], L[3], H[0], H[1], H[2], H[3]}
  od = __builtin_amdgcn_mfma_f32_32x32x16_bf16(pa0, PK(l0, h0), od, 0, 0, 0);
  od = __builtin_amdgcn_mfma_f32_32x32x16_bf16(pa1, PK(l1, h1), od, 0, 0, 0);
  od = __builtin_amdgcn_mfma_f32_32x32x16_bf16(pa2, PK(l2, h2), od, 0, 0, 0);
  od = __builtin_amdgcn_mfma_f32_32x32x16_bf16(pa3, PK(l3, h3), od, 0, 0, 0);
#undef PK
}
__device__ __forceinline__ void pv_d0(f32x16* o, int vb, bf16x8 pa0, bf16x8 pa1, bf16x8 pa2, bf16x8 pa3) {
  pv_one<0>(o[0], vb, pa0, pa1, pa2, pa3); pv_one<1>(o[1], vb, pa0, pa1, pa2, pa3); pv_one<2>(o[2], vb, pa0, pa1, pa2, pa3); pv_one<3>(o[3], vb, pa0, pa1, pa2, pa3);
}

template <bool NA, int ldq, int ldk, int ldo>
__device__ __forceinline__ void attn_body(const bf16_t* __restrict__ Qb, const bf16_t* __restrict__ Kh, const bf16_t* __restrict__ Vh,
                                          bf16_t* __restrict__ Ob, const int NT, const int nloc, const int bs, const int q0r, char* lds) {
  const int tid = opaque_tid(), wid = tid >> 6, lane = tid & 63, r32 = lane & 31, hi = lane >> 5;
  char* V_lds = lds; char* K_lds = lds + 2 * SHM_V;
  float* ws = (float*)(lds + 2 * SHM_V + 2 * SHM_K) + wid * 64; float* li_l = ws; float* al_l = ws + 32;
  float m_reg = -1e30f, l_reg = 0; f32x16 o[4] = {}; bf16x8 qr[8];
  const bf16_t* Qw = Qb + (wid * QBLK + r32) * ldq + hi * 8;
#pragma unroll
  for (int d0 = 0; d0 < 8; ++d0) qr[d0] = *reinterpret_cast<const bf16x8*>(Qw + d0 * 16);
  const int sr = tid >> 4, sc = (tid & 15) * 8, vst0 = v_st(sr, sc), vst1 = v_st(32 + sr, sc);
  const int vb0 = (int)(uintptr_t)V_lds + v_rd_base(lane);
  const unsigned kvo = (unsigned)(sr * ldk + sc) * 2u;
  const float* btab = (const float*)(lds + LDS_BIAS) + 64;
  struct { bf16x8 vs0, vs1, ks0, ks1; } sr_[2];
#define KOFF(j) (NA ? ((j) < nloc ? (bs + (j)) * 64 : LSEQ + ((j) - nloc) * 64) : (j) * 64)
#define SLOAD(i, k0) do { const unsigned _ko = (unsigned)((k0) * ldk * 2) + kvo; sr_[i].vs0 = *reinterpret_cast<const bf16x8*>((const char*)Vh + _ko); sr_[i].vs1 = *reinterpret_cast<const bf16x8*>((const char*)Vh + (_ko + 64u * ldk)); \
    sr_[i].ks0 = *reinterpret_cast<const bf16x8*>((const char*)Kh + _ko); sr_[i].ks1 = *reinterpret_cast<const bf16x8*>((const char*)Kh + (_ko + 64u * ldk)); } while (0)
#define SWRITE(b, i) do { int sr_w = sr, sc_w = sc, v0_w = vst0, v1_w = vst1; \
    if (NA) { const int t_ = opaque_tid(); sr_w = t_ >> 4; sc_w = (t_ & 15) * 8; v0_w = v_st(sr_w, sc_w); v1_w = v_st(32 + sr_w, sc_w); }     \
    *(bf16x8*)(V_lds + (b) * SHM_V + v0_w) = sr_[i].vs0;          \
    *(bf16x8*)(V_lds + (b) * SHM_V + v1_w) = sr_[i].vs1; int kc = sc_w * 2;               \
    *(bf16x8*)(K_lds + (b) * SHM_K + KSWZ(sr_w, kc)) = sr_[i].ks0;                       \
    *(bf16x8*)(K_lds + (b) * SHM_K + KSWZ(32 + sr_w, kc)) = sr_[i].ks1; } while (0)
#define SWAIT() asm volatile("s_waitcnt vmcnt(4)" ::: "memory")
#define RESC(a) do { if (__any((a) < 1.f)) { if (hi == 0) al_l[r32] = (a); asm volatile("s_waitcnt lgkmcnt(0)" ::: "memory"); \
    _Pragma("unroll") for (int d = 0; d < 4; ++d) _Pragma("unroll") for (int r = 0; r < 16; ++r) o[d][r] *= al_l[crow(r, hi)]; } } while (0)
#define NAMASK(P0, P1, j) do { if (NA && (j) < nloc) { const int kr = bs + (j); const int t_ = opaque_tid(); \
    const int qrow = q0r + __builtin_amdgcn_readfirstlane(t_ >> 7), qcol = ((t_ >> 6) & 1) * 32 + (t_ & 31), hi_ = (t_ >> 5) & 1; \
    const int rstart = min(max(qrow - 4, 0), 56), cstart = min(max(qcol - 8, 0), 48); \
    if (kr >= rstart && kr < rstart + 8) { const float* bp = btab + (kr - qrow + 7) * 31 + (4 * hi_ - qcol + 15); const int cs = cstart - 4 * hi_; \
      _Pragma("unroll") for (int r = 0; r < 16; ++r) { const int kc = (r & 3) + 8 * (r >> 2); \
        P0[r] = ((unsigned)(kc - cs) < 16u) ? P0[r] + bp[kc] : -1e30f; P1[r] = ((unsigned)(kc + 32 - cs) < 16u) ? P1[r] + bp[kc + 32] : -1e30f; } } \
    else { _Pragma("unroll") for (int r = 0; r < 16; ++r) { P0[r] = -1e30f; P1[r] = -1e30f; } } } } while (0)
  f32x16 pA0, pA1, pB0, pB1; float mnA, mnB, alA, alB; bf16x8 pa0, pa1, pa2, pa3;
  constexpr int SE = 0, SO = 1;
  SLOAD(SE, KOFF(0)); asm volatile("s_waitcnt vmcnt(0)" ::: "memory"); SWRITE(0, SE); __syncthreads();
  qkt(pA0, pA1, K_lds, qr, r32, hi); NAMASK(pA0, pA1, 0); partialSM(pA0, pA1, m_reg, mnA, alA);
  SLOAD(SO, KOFF(1)); if (2 < NT) SLOAD(SE, KOFF(2));
  SWAIT(); SWRITE(1, SO); __syncthreads();
  for (int j = 1; j + 1 < NT; j += 2) {
    SBAR(); qkt(pB0, pB1, K_lds + SHM_K, qr, r32, hi); NAMASK(pB0, pB1, j);
    finishSM(pA0, pA1, alA, l_reg, pa0, pa1, pa2, pa3); SBAR();
    SLOAD(SO, KOFF(j + 2)); SBAR();
    pv_d0(o, vb0, pa0, pa1, pa2, pa3); partialSM(pB0, pB1, m_reg, mnB, alB);
    __syncthreads(); SWAIT(); SWRITE(0, SE);
    RESC(alB); __syncthreads();
    SBAR(); qkt(pA0, pA1, K_lds, qr, r32, hi); NAMASK(pA0, pA1, j + 1);
    finishSM(pB0, pB1, alB, l_reg, pa0, pa1, pa2, pa3); SBAR();
    if (j + 3 < NT) SLOAD(SE, KOFF(j + 3)); SBAR();
    pv_d0(o, vb0 + (int)SHM_V, pa0, pa1, pa2, pa3); partialSM(pA0, pA1, m_reg, mnA, alA);
    __syncthreads(); SWAIT(); SWRITE(1, SO);
    RESC(alA); __syncthreads();
  }
  SBAR(); qkt(pB0, pB1, K_lds + SHM_K, qr, r32, hi); NAMASK(pB0, pB1, NT - 1);
  finishSM(pA0, pA1, alA, l_reg, pa0, pa1, pa2, pa3); SBAR();
  pv_d0(o, vb0, pa0, pa1, pa2, pa3); partialSM(pB0, pB1, m_reg, mnB, alB);
  __syncthreads(); RESC(alB);
  finishSM(pB0, pB1, alB, l_reg, pa0, pa1, pa2, pa3); SBAR();
  pv_d0(o, vb0 + (int)SHM_V, pa0, pa1, pa2, pa3);
  if (hi == 0) li_l[r32] = l_reg; asm volatile("s_waitcnt lgkmcnt(0)" ::: "memory");
  float rli[16];
#pragma unroll
  for (int r = 0; r < 16; ++r) rli[r] = __builtin_amdgcn_rcpf(li_l[crow(r, hi)]);
  bf16_t* Ow = Ob + (wid * QBLK) * ldo + r32;
#pragma unroll
  for (int r = 0; r < 16; ++r) { const int orow = crow(r, hi);
#pragma unroll
    for (int d0 = 0; d0 < 4; ++d0) { const unsigned pk = cvt_pk_bf16(o[d0][r] * rli[r], 0.f); Ow[orow * ldo + d0 * 32] = (bf16_t)(pk & 0xffffu); } }
  __syncthreads();
#undef KOFF
#undef SLOAD
#undef SWRITE
#undef SWAIT
#undef RESC
#undef NAMASK
}
#undef KSWZ
#undef SBAR
}

#define XB_TMO      128
#define XB_XCNT(j)  (256  + 64 * (j))
#define XB_XSUB(j)  (1280 + 64 * (j))
#define XB_XGEN(j)  (2304 + 64 * (j))
#define XB_TOP      3328
#define XB_TOPGEN   3392
#define XCD_BAR_WORDS 3456
#define XB_SPIN_CAP (1u << 22)
__device__ __forceinline__ unsigned xb_ld(unsigned* p)              { return __hip_atomic_load(p, __ATOMIC_RELAXED, __HIP_MEMORY_SCOPE_AGENT); }
__device__ __forceinline__ unsigned xb_add(unsigned* p, unsigned v) { return __hip_atomic_fetch_add(p, v, __ATOMIC_RELAXED, __HIP_MEMORY_SCOPE_AGENT); }
__device__ __forceinline__ unsigned xb_xcc_id() { return (unsigned)__builtin_amdgcn_s_getreg((3 << 11) | 20) & 0xFu; }
#define XB_SPIN(cond, bar) do { unsigned _sp = 0; while (cond) { __builtin_amdgcn_s_sleep(1); \
    if ((++_sp & 255u) == 0u) { if (xb_ld(&(bar)[XB_TMO])) break; if (_sp > XB_SPIN_CAP) { atomicAdd(&(bar)[XB_TMO], 1u); break; } } } } while (0)
struct XcdBarrier { unsigned* bar; unsigned x; volatile LAS unsigned* st; };
__device__ __forceinline__ XcdBarrier xcd_barrier_post(unsigned* bar, volatile LAS unsigned* st) {
    XcdBarrier b; b.bar = bar; b.x = xb_xcc_id(); b.st = st;
    if (threadIdx.x == 0) (void)xb_add(&bar[XB_XCNT(b.x)], 1u);
    return b;
}
__device__ __forceinline__ void xcd_barrier_complete(unsigned* bar, unsigned x, unsigned& nloc, unsigned& nx) {
    const unsigned G = gridDim.x * gridDim.y * gridDim.z;
    unsigned sum, cnt, mine, sp = 0u;
    for (;;) {
        sum = 0u; cnt = 0u; mine = 0u;
#pragma unroll
        for (unsigned j = 0; j < 16; ++j) { const unsigned c = xb_ld(&bar[XB_XCNT(j)]); sum += c; cnt += (c > 0u) ? 1u : 0u; mine = (j == x) ? c : mine; }
        if (sum == G) break;
        __builtin_amdgcn_s_sleep(1);
        if ((++sp & 255u) == 0u) { if (xb_ld(&bar[XB_TMO])) break; if (sp > XB_SPIN_CAP) { atomicAdd(&bar[XB_TMO], 1u); break; } }
    }
    nloc = mine > 0u ? mine : 1u; nx = cnt > 0u ? cnt : 1u;
}
__device__ __forceinline__ void xcd_barrier(const XcdBarrier& b) {
    asm volatile("s_waitcnt vmcnt(0)" ::: "memory");
    __syncthreads();
    if (threadIdx.x == 0) {
        unsigned* bar = b.bar;
        __builtin_amdgcn_s_waitcnt(0);
        unsigned nloc = b.st[0], nx = b.st[1];
        if (nloc == 0u) { xcd_barrier_complete(bar, b.x, nloc, nx); b.st[0] = nloc; b.st[1] = nx; }
        const unsigned old = xb_add(&bar[XB_XSUB(b.x)], 1u);
        const unsigned gen = old / nloc;
        if (old + 1u == (gen + 1u) * nloc) {
            __builtin_amdgcn_fence(__ATOMIC_RELEASE, "agent");
            asm volatile("s_waitcnt vmcnt(0)" ::: "memory");
            const unsigned og = xb_add(&bar[XB_TOP], 1u);
            const unsigned tg = og / nx;
            if (og + 1u == (tg + 1u) * nx) xb_add(&bar[XB_TOPGEN], 1u);
            else XB_SPIN(xb_ld(&bar[XB_TOPGEN]) == tg, bar);
            __builtin_amdgcn_fence(__ATOMIC_ACQUIRE, "agent");
            xb_add(&bar[XB_XGEN(b.x)], 1u);
            asm volatile("s_waitcnt vmcnt(0)" ::: "memory");
        } else {
            XB_SPIN(xb_ld(&bar[XB_XGEN(b.x)]) == gen, bar);
            __builtin_amdgcn_fence(__ATOMIC_ACQUIRE, "agent");
            asm volatile("s_waitcnt vmcnt(0)" ::: "memory");
        }
    }
    __syncthreads();
}

enum { I_X = 0, I_C, I_CTX, I_CCTX, I_WMOD, I_BMOD, I_LN1G, I_LN1B, I_LN2G, I_LN2B, I_ABWIN, I_ABWF, I_ABQN, I_ABKN, I_ABWOUT, I_NAWIN, I_NARPB, I_NAWOUT,
       I_WR, I_EBIAS, I_WG, I_WU, I_WDN, I_SG, I_SU, I_SD, N_IN };
struct Args { const float* in[N_IN]; float* out; unsigned char* ws; int ph_lo, ph_hi; };
struct KA {
    __device__ __forceinline__ const __attribute__((address_space(4))) char* base() const { const __attribute__((address_space(4))) char* p = (const __attribute__((address_space(4))) char*)__builtin_amdgcn_kernarg_segment_ptr(); asm volatile("" : "+s"(p)); return p; }
    __device__ __forceinline__ const float* in(int i) const { return *(const float* const __attribute__((address_space(4)))*)(base() + 8 * i); }
    __device__ __forceinline__ float* out() const { return *(float* const __attribute__((address_space(4)))*)(base() + 8 * N_IN); }
    __device__ __forceinline__ int ph_lo() const { return *(const int __attribute__((address_space(4)))*)(base() + 8 * N_IN + 16); }
    __device__ __forceinline__ int ph_hi() const { return *(const int __attribute__((address_space(4)))*)(base() + 8 * N_IN + 20); }
    __device__ __forceinline__ unsigned char* ws() const { return *(unsigned char* const __attribute__((address_space(4)))*)(base() + 8 * N_IN + 8); }
};

__device__ __forceinline__ int tok_batchrow(int m) { return m < TLAT ? (m >> 12) : 4; }

__host__ __device__ __forceinline__ int rope_phys(int d) { const int hf = d >> 6, dd = d & 63, i = dd & 31, second = dd >> 5; return hf * 64 + (i >> 2) * 8 + second * 4 + (i & 3); }

template <class RowMap>
__device__ __forceinline__ void transpose_item(const float* W, int ldw, int k0, int n0, bf16_t* WT, int K, const RowMap& drow, LAS float* scr, int lane) {
#pragma unroll 8
    for (int i = 0; i < 32; ++i) { const int kk = 2 * i + (lane >> 5); scr[kk * 33 + (lane & 31)] = W[(size_t)(k0 + kk) * ldw + n0 + (lane & 31)]; }
    LDS_WAIT(); asm volatile("" ::: "memory");
    const int c = lane & 7;
#pragma unroll
    for (int j = 0; j < 4; ++j) { const int n = (lane >> 3) + 8 * j; const LAS float* s = scr + (8 * c) * 33 + n;
        u32x4 o; o.x = cvt_pk_bf16(s[0 * 33], s[1 * 33]); o.y = cvt_pk_bf16(s[2 * 33], s[3 * 33]); o.z = cvt_pk_bf16(s[4 * 33], s[5 * 33]); o.w = cvt_pk_bf16(s[6 * 33], s[7 * 33]);
        *(u32x4*)(WT + (size_t)drow(n0 + n) * K + k0 + 8 * c) = o; }
    LDS_WAIT(); asm volatile("" ::: "memory");
}
struct RowId { __device__ __forceinline__ int operator()(int n) const { return n; } };
struct RowGU { int which; __device__ __forceinline__ int operator()(int n) const { return (n >> 7) * 256 + which * 128 + (n & 127); } };
struct RowINE { __device__ __forceinline__ int operator()(int n) const { const int c = n - 256; return c < 1024 ? (c & ~127) + rope_phys(c & 127) : c; } };

__device__ __forceinline__ void p0_convert_weights(const KA& a, LAS unsigned char* lds, int gw, int NGW, int wave, int lane) {
    LAS float* scr = (LAS float*)(lds + wave * 8704);
    unsigned char* ws = a.ws();
    constexpr int N_GU = DEPTH * 65 * 2 * 128, N_DN = DEPTH * 65 * 128, N_INE = 2 * 640, N_INO = 2 * 1536, N_OUT = DEPTH * 512;
    constexpr int NITEMS = N_GU + N_DN + N_INE + N_INO + N_OUT;
    for (int it = gw; it < NITEMS; it += NGW) {
        int r = it;
        if (r < N_GU) { const int mat = r >> 7, item = r & 127, which = mat & 1, le = mat >> 1, l = le / 65, e = le % 65;
            const float* src = (e < 64) ? a.in(which ? I_WU : I_WG) + ((size_t)(l * 64 + e) * DM * EDIM) : a.in(which ? I_SU : I_SG) + (size_t)l * DM * EDIM;
            bf16_t* dst = (bf16_t*)(ws + WS_WGU) + (size_t)(l * 65 + e) * 512 * DM;
            transpose_item(src, EDIM, 64 * (item >> 3), 32 * (item & 7), dst, DM, RowGU{which}, scr, lane); continue; } r -= N_GU;
        if (r < N_DN) { const int le = r >> 7, item = r & 127, l = le / 65, e = le % 65;
            const float* src = (e < 64) ? a.in(I_WDN) + ((size_t)(l * 64 + e) * EDIM * DM) : a.in(I_SD) + (size_t)l * EDIM * DM;
            bf16_t* dst = (bf16_t*)(ws + WS_WD) + (size_t)(l * 65 + e) * DM * EDIM;
            transpose_item(src, DM, 64 * (item >> 5), 32 * (item & 31), dst, EDIM, RowId{}, scr, lane); continue; } r -= N_DN;
        if (r < N_INE) { const int j = r / 640, item = r % 640;
            transpose_item(a.in(I_ABWIN) + (size_t)j * DM * 1536, 1536, 64 * (item / 40), 256 + 32 * (item % 40), (bf16_t*)(ws + WS_WINE) + (size_t)j * 1280 * DM, DM, RowINE{}, scr, lane); continue; } r -= N_INE;
        if (r < N_INO) { const int j = r / 1536, item = r % 1536;
            transpose_item(a.in(I_NAWIN) + (size_t)j * DM * 3072, 3072, 64 * (item / 96), 32 * (item % 96), (bf16_t*)(ws + WS_WINO) + (size_t)j * 3072 * DM, DM, RowId{}, scr, lane); continue; } r -= N_INO;
        { const int l = r >> 9, item = r & 511;
            const float* src = ((l & 1) ? a.in(I_NAWOUT) : a.in(I_ABWOUT)) + (size_t)(l >> 1) * DM * DM;
            transpose_item(src, DM, 64 * (item >> 5), 32 * (item & 31), (bf16_t*)(ws + WS_WOUT) + (size_t)l * DM * DM, DM, RowId{}, scr, lane); }
    }
}

__device__ __forceinline__ void p0_mod(const KA& a, LAS unsigned char* lds, int bid, int G, int tid, int wave, int lane) {
    LAS float* sl = (LAS float*)(lds + 69632);
    LAS float* part = (LAS float*)(lds + 69632 + 20480);
    for (int i = tid; i < 5 * DM; i += 512) { const int r = i >> 10, k = i & 1023; const float v = (r < 4) ? a.in(I_C)[r * DM + k] : a.in(I_CCTX)[k]; sl[i] = v / (1.0f + __expf(-v)); }
    __syncthreads();
    float* mod = (float*)(a.ws() + WS_MOD);
    for (int task = bid; task < DEPTH * 96; task += G) {
        const int l = task / 96, c0 = (task % 96) * 64;
        const float* w = a.in(I_WMOD) + (size_t)l * DM * 6144 + c0 + lane;
        float acc[5] = {0.f, 0.f, 0.f, 0.f, 0.f};
#pragma unroll 8
        for (int k = wave * 128; k < wave * 128 + 128; ++k) { const float wv = w[(size_t)k * 6144];
#pragma unroll
            for (int r = 0; r < 5; ++r) acc[r] += sl[r * DM + k] * wv; }
#pragma unroll
        for (int r = 0; r < 5; ++r) part[(wave * 5 + r) * 64 + lane] = acc[r];
        __syncthreads();
        if (tid < 320) { const int r = tid >> 6, c = tid & 63; float s = a.in(I_BMOD)[l * 6144 + c0 + c];
#pragma unroll
            for (int w8 = 0; w8 < 8; ++w8) s += part[(w8 * 5 + r) * 64 + c];
            mod[((size_t)l * 5 + r) * 6144 + c0 + c] = s; }
        __syncthreads();
    }
}

__device__ __forceinline__ void p0_fourier_fold(const KA& a, LAS unsigned char* lds, int task, int tid, int wave, int lane) {
    const int j = task >> 3, q = (task >> 2) & 1, g = task & 3;
    LAS float* M = (LAS float*)(lds + 100352);
    const float* Wf = a.in(I_ABWF) + (size_t)(j * 4 + g) * 64 * 64;
    __syncthreads();
    for (int i = tid; i < 4096; i += 512) { const int c = i >> 6, d = i & 63; float s = 0.f;
        for (int m = 0; m < 64; ++m) { const float ang = (float)((m * c) & 63) * (1.0f / 32.0f); s += (q ? sinpif(ang) : cospif(ang)) * Wf[m * 64 + d]; }
        M[i] = s; }
    __syncthreads();
    float mcol[64];
#pragma unroll
    for (int c = 0; c < 64; ++c) mcol[c] = M[c * 64 + lane];
    bf16_t* dst = (bf16_t*)(a.ws() + WS_WF) + ((size_t)j * 512 + q * 256 + g * 64 + lane) * DM;
    const float* win = a.in(I_ABWIN) + (size_t)j * DM * 1536 + g * 64 + lane;
    for (int k = wave * 128; k < wave * 128 + 128; ++k) {
        const float wv = win[(size_t)k * 1536]; float s = 0.f;
#pragma unroll
        for (int c = 0; c < 64; ++c) s += __int_as_float(__builtin_amdgcn_readlane(__float_as_int(wv), c)) * mcol[c];
        dst[k] = (bf16_t)(cvt_pk_bf16(s, 0.f) & 0xffffu);
    }
}

__device__ __forceinline__ void p0_tables(const KA& a, LAS unsigned char* lds, int gtid, int NGT, int tid) {
    LAS float* ctab = (LAS float*)(lds + 116736);
    for (int i = tid; i < 4096; i += 512) ctab[i] = cospif((float)i * (1.0f / 2048.0f));
    __syncthreads();
    bf16_t* TW = (bf16_t*)(a.ws() + WS_TW);
    for (int it = gtid; it < 4096 * 1024; it += NGT) {
        const int k = it >> 10, c8 = (it & 1023) * 8, n0 = c8 & 4095, sh = (c8 >> 12) ? 1024 : 0; const float sg = (c8 >> 12) ? (-1.0f / 512.0f) : (1.0f / 512.0f);
        float v[8];
#pragma unroll
        for (int j = 0; j < 8; ++j) v[j] = ctab[(k * (n0 + j) - sh) & 4095] * sg;
        u32x4 o; o.x = cvt_pk_bf16(v[0], v[1]); o.y = cvt_pk_bf16(v[2], v[3]); o.z = cvt_pk_bf16(v[4], v[5]); o.w = cvt_pk_bf16(v[6], v[7]);
        *(u32x4*)(TW + (size_t)k * 8192 + c8) = o;
    }
    bf16_t* TWC = (bf16_t*)(a.ws() + WS_TWC);
    for (int it = gtid; it < 256 * 64; it += NGT) {
        const int k = it >> 6, c8 = (it & 63) * 8, n0 = c8 & 255, sh = (c8 >> 8) ? 1024 : 0; const float sg = (c8 >> 8) ? (-1.0f / 128.0f) : (1.0f / 128.0f);
        float v[8];
#pragma unroll
        for (int j = 0; j < 8; ++j) v[j] = ctab[(((k * (n0 + j)) & 255) * 16 - sh) & 4095] * sg;
        u32x4 o; o.x = cvt_pk_bf16(v[0], v[1]); o.y = cvt_pk_bf16(v[2], v[3]); o.z = cvt_pk_bf16(v[4], v[5]); o.w = cvt_pk_bf16(v[6], v[7]);
        *(u32x4*)(TWC + (size_t)k * 512 + c8) = o;
    }
    bf16_t* WH = (bf16_t*)(a.ws() + WS_WRHI); bf16_t* WL = (bf16_t*)(a.ws() + WS_WRLO);
    for (int it = gtid; it < DEPTH * 64 * DM; it += NGT) {
        const int l = it >> 16, e = (it >> 10) & 63, k = it & 1023; const float w = a.in(I_WR)[((size_t)l * DM + k) * 64 + e];
        const unsigned h = cvt_pk_bf16(w, 0.f) & 0xffffu; const float r = w - __uint_as_float(h << 16);
        WH[it] = (bf16_t)h; WL[it] = (bf16_t)(cvt_pk_bf16(r, 0.f) & 0xffffu);
    }
    float* gp = (float*)(a.ws() + WS_GAINP);
    for (int it = gtid; it < 2 * 2 * 128; it += NGT) { const int j = it >> 8, qk = (it >> 7) & 1, d = it & 127; gp[(j * 2 + qk) * 128 + rope_phys(d)] = a.in(qk ? I_ABKN : I_ABQN)[j * 128 + d]; }
    f32x2* rp = (f32x2*)(a.ws() + WS_ROPE);
    for (int it = gtid; it < 64 * 32; it += NGT) { const int pos = it >> 5, i = it & 31; const float inv = exp2f(-(float)i * (13.287712379549449f / 32.0f));
        const float ang = (float)pos * inv; rp[it] = (f32x2){cosf(ang), sinf(ang)}; }
}

__device__ __forceinline__ const float* xrow_in(const KA& a, int l, int m) {
    if (l == 0) return m < TLAT ? a.in(I_X) + (size_t)m * DM : a.in(I_CTX) + (size_t)(m - TLAT) * DM;
    return (const float*)(a.ws() + WS_XS) + (size_t)m * DM;
}
__device__ __forceinline__ void p0b_modulate(const KA& a, int gw, int NGW, int lane) {
    const float* mod = (const float*)(a.ws() + WS_MOD);
    bf16_t* H = (bf16_t*)(a.ws() + WS_H);
    for (int m = gw; m < TT; m += NGW) {
        const f32x4* xr = (const f32x4*)xrow_in(a, 0, m) + lane; const float* md = mod + (size_t)tok_batchrow(m) * 6144;
        u32x2* o = (u32x2*)(H + (size_t)m * DM) + lane;
#pragma unroll
        for (int j = 0; j < 4; ++j) { const f32x4 x = xr[64 * j], sh = *((const f32x4*)md + lane + 64 * j), sc = *((const f32x4*)(md + DM) + lane + 64 * j);
            const f32x4 h = x * (sc + 1.0f) + sh; o[64 * j] = (u32x2){cvt_pk_bf16(h[0], h[1]), cvt_pk_bf16(h[2], h[3])}; }
    }
}

__device__ __forceinline__ void phase_ln1_router(const KA& a, LAS unsigned char* lds, int l, int bid, int tid, int wave, int lane) {
    constexpr int AST = 1032;
    LAS bf16_t* Ahi = (LAS bf16_t*)lds; LAS bf16_t* Alo = (LAS bf16_t*)(lds + 32 * AST * 2);
    LAS float* lg = (LAS float*)(lds + 2 * 32 * AST * 2);
    LAS int* hist = (LAS int*)(lds + 2 * 32 * AST * 2 + 8192);
    LAS int* pend = hist + 128;
    const float* mod = (const float*)(a.ws() + WS_MOD) + (size_t)l * 5 * 6144;
    const float* lng = a.in(I_LN1G) + l * DM; const float* lnb = a.in(I_LN1B) + l * DM;
    const bf16_t* Y = (const bf16_t*)(a.ws() + WS_Y);
    float* XS = (float*)(a.ws() + WS_XS); bf16_t* H = (bf16_t*)(a.ws() + WS_H);
    const bf16_t* WH = (const bf16_t*)(a.ws() + WS_WRHI) + (size_t)l * 64 * DM; const bf16_t* WL = (const bf16_t*)(a.ws() + WS_WRLO) + (size_t)l * 64 * DM;
    int* tke = (int*)(a.ws() + WS_TKE); float* tkw = (float*)(a.ws() + WS_TKW); int* tkp = (int*)(a.ws() + WS_TKP); int* list = (int*)(a.ws() + WS_LIST);
    unsigned* cnt = (unsigned*)(a.ws() + WS_CTL) + CW_CNT + l * 64;
    const float ebias = a.in(I_EBIAS)[l * 64 + lane];
    if (tid < 64) hist[tid] = 0;
    __syncthreads();
    const int tok0 = bid * 68;
    for (int st = 0; st < 3; ++st) {
        const int s0 = st * 32, ns = (st < 2) ? 32 : 4;
        for (int r = wave; r < 32; r += 8) {
            LAS u32x2* ah = (LAS u32x2*)(Ahi + r * AST) + lane; LAS u32x2* al = (LAS u32x2*)(Alo + r * AST) + lane;
            if (r < ns) {
                const int m = tok0 + s0 + r; const float* md = mod + (size_t)tok_batchrow(m) * 6144;
                const f32x4* xr = (const f32x4*)xrow_in(a, l, m) + lane; const u32x2* yr = (const u32x2*)(Y + (size_t)m * DM) + lane;
                f32x4 v[4]; float s = 0.f;
#pragma unroll
                for (int j = 0; j < 4; ++j) { const f32x4 x = xr[64 * j], g1 = *((const f32x4*)(md + 2 * DM) + lane + 64 * j); const u32x2 yy = yr[64 * j];
                    const f32x4 y = {bf_lo(yy.x), bf_hi(yy.x), bf_lo(yy.y), bf_hi(yy.y)};
                    v[j] = x * DN_ALPHA + g1 * y; s += (v[j][0] + v[j][1]) + (v[j][2] + v[j][3]); }
                const float mean = wave_sum(s) * (1.0f / DM); float s2 = 0.f;
#pragma unroll
                for (int j = 0; j < 4; ++j) { v[j] = v[j] - mean; s2 += (v[j][0] * v[j][0] + v[j][1] * v[j][1]) + (v[j][2] * v[j][2] + v[j][3] * v[j][3]); }
                const float rstd = __builtin_amdgcn_rsqf(wave_sum(s2) * (1.0f / DM) + LN_EPS);
                f32x4* xo = (f32x4*)(XS + (size_t)m * DM) + lane; u32x2* ho = (u32x2*)(H + (size_t)m * DM) + lane;
#pragma unroll
                for (int j = 0; j < 4; ++j) { const f32x4 g = *((const f32x4*)lng + lane + 64 * j), bb = *((const f32x4*)lnb + lane + 64 * j);
                    const f32x4 x1 = v[j] * rstd * g + bb; xo[64 * j] = x1;
                    const f32x4 sh2 = *((const f32x4*)(md + 3 * DM) + lane + 64 * j), sc2 = *((const f32x4*)(md + 4 * DM) + lane + 64 * j);
                    const f32x4 h = x1 * (sc2 + 1.0f) + sh2;
                    const unsigned h01 = cvt_pk_bf16(h[0], h[1]), h23 = cvt_pk_bf16(h[2], h[3]);
                    ho[64 * j] = (u32x2){h01, h23}; ah[64 * j] = (u32x2){h01, h23};
                    al[64 * j] = (u32x2){cvt_pk_bf16(h[0] - bf_lo(h01), h[1] - bf_hi(h01)), cvt_pk_bf16(h[2] - bf_lo(h23), h[3] - bf_hi(h23))}; }
            } else {
#pragma unroll
                for (int j = 0; j < 4; ++j) { ah[64 * j] = (u32x2){0u, 0u}; al[64 * j] = (u32x2){0u, 0u}; }
            }
        }
        __syncthreads();
        {
            const int mt = wave >> 2, ntile = wave & 3, fr = lane & 15, fq = lane >> 4;
            const LAS bf16_t* pah = Ahi + (mt * 16 + fr) * AST + fq * 8; const LAS bf16_t* pal = Alo + (mt * 16 + fr) * AST + fq * 8;
            const bf16_t* pbh = WH + (size_t)(ntile * 16 + fr) * DM + fq * 8; const bf16_t* pbl = WL + (size_t)(ntile * 16 + fr) * DM + fq * 8;
            f32x4 acc = {0.f, 0.f, 0.f, 0.f};
#pragma unroll 4
            for (int ks = 0; ks < 32; ++ks) {
                const bf16x8 ahv = *(const LAS bf16x8*)(pah + ks * 32), alv = *(const LAS bf16x8*)(pal + ks * 32);
                const bf16x8 bhv = *(const bf16x8*)(pbh + ks * 32), blv = *(const bf16x8*)(pbl + ks * 32);
                acc = __builtin_amdgcn_mfma_f32_16x16x32_bf16(ahv, bhv, acc, 0, 0, 0);
                acc = __builtin_amdgcn_mfma_f32_16x16x32_bf16(ahv, blv, acc, 0, 0, 0);
                acc = __builtin_amdgcn_mfma_f32_16x16x32_bf16(alv, bhv, acc, 0, 0, 0);
            }
#pragma unroll
            for (int i = 0; i < 4; ++i) lg[(mt * 16 + fq * 4 + i) * 64 + ntile * 16 + fr] = acc[i];
        }
        __syncthreads();
        for (int r = wave; r < ns; r += 8) {
            const int m = tok0 + s0 + r;
            const float score = 1.0f / (1.0f + __expf(-lg[r * 64 + lane]));
            float sel = score + ebias; unsigned long long taken = 0ull;
#pragma unroll 1
            for (int k = 0; k < TOPK; ++k) { const float mx = wave_max(sel); const unsigned long long bal = __ballot(sel == mx); const int win = __ffsll((long long)bal) - 1;
                taken |= 1ull << win; if (lane == win) sel = -3.0e38f; }
            const bool mine = (taken >> lane) & 1ull;
            const float wsum = wave_sum(mine ? score : 0.f);
            if (mine) { const int k = __popcll(taken & ((1ull << lane) - 1ull)); const int lr = __hip_atomic_fetch_add(&hist[lane], 1, __ATOMIC_RELAXED, __HIP_MEMORY_SCOPE_WORKGROUP);
                tke[m * 8 + k] = lane; tkw[m * 8 + k] = score / wsum * ROUTE_SCALE; pend[(s0 + r) * 8 + k] = (lane << 16) | lr; }
        }
        __syncthreads();
    }
    if (tid < 64) hist[64 + tid] = (int)atomicAdd(&cnt[tid], (unsigned)hist[tid]);
    __syncthreads();
    for (int i = tid; i < 68 * 8; i += 512) { const int pe = pend[i], e = pe >> 16, p = hist[64 + e] + (pe & 0xffff); const int m = tok0 + (i >> 3);
        tkp[m * 8 + (i & 7)] = p; list[(size_t)e * TT + p] = m; }
}

__device__ __forceinline__ void phase_combine_ln2(const KA& a, LAS unsigned char* lds, int l, int gw, int NGW, int tid, int lane) {
    LAS int* rst = (LAS int*)(lds + LDS_TAB) + 66;
    const float* mod = (const float*)(a.ws() + WS_MOD) + (size_t)l * 5 * 6144;
    const float* lng = a.in(I_LN2G) + l * DM; const float* lnb = a.in(I_LN2B) + l * DM;
    const bf16_t* YB = (const bf16_t*)(a.ws() + WS_YB);
    float* XS = (float*)(a.ws() + WS_XS); bf16_t* H = (bf16_t*)(a.ws() + WS_H);
    const int* tke = (const int*)(a.ws() + WS_TKE); const float* tkw = (const float*)(a.ws() + WS_TKW); const int* tkp = (const int*)(a.ws() + WS_TKP);
    const int mend = (l == DEPTH - 1) ? TLAT : TT;
    for (int m = gw; m < mend; m += NGW) {
        const float* md = mod + (size_t)tok_batchrow(m) * 6144;
        int slot = 0; float w = 1.0f;
        if (lane < 8) { slot = rst[tke[m * 8 + lane]] + tkp[m * 8 + lane]; w = tkw[m * 8 + lane]; }
        if (lane == 8) slot = rst[64] + m;
        f32x4 ff[4];
#pragma unroll
        for (int j = 0; j < 4; ++j) ff[j] = (f32x4){0.f, 0.f, 0.f, 0.f};
#pragma unroll
        for (int k = 0; k < 9; ++k) { const int sk = __builtin_amdgcn_readlane(slot, k); const float wk = __int_as_float(__builtin_amdgcn_readlane(__float_as_int(w), k));
            const u32x2* yr = (const u32x2*)(YB + (size_t)sk * DM) + lane;
#pragma unroll
            for (int j = 0; j < 4; ++j) { const u32x2 yy = yr[64 * j]; ff[j] += (f32x4){bf_lo(yy.x), bf_hi(yy.x), bf_lo(yy.y), bf_hi(yy.y)} * wk; } }
        f32x4* xio = (f32x4*)(XS + (size_t)m * DM) + lane;
        f32x4 v[4]; float s = 0.f;
#pragma unroll
        for (int j = 0; j < 4; ++j) { const f32x4 g2 = *((const f32x4*)(md + 5 * DM) + lane + 64 * j);
            v[j] = xio[64 * j] * DN_ALPHA + g2 * ff[j]; s += (v[j][0] + v[j][1]) + (v[j][2] + v[j][3]); }
        const float mean = wave_sum(s) * (1.0f / DM); float s2 = 0.f;
#pragma unroll
        for (int j = 0; j < 4; ++j) { v[j] = v[j] - mean; s2 += (v[j][0] * v[j][0] + v[j][1] * v[j][1]) + (v[j][2] * v[j][2] + v[j][3] * v[j][3]); }
        const float rstd = __builtin_amdgcn_rsqf(wave_sum(s2) * (1.0f / DM) + LN_EPS);
        if (l == DEPTH - 1) {
            f32x4* oo = (f32x4*)(a.out() + (size_t)m * DM) + lane;
#pragma unroll
            for (int j = 0; j < 4; ++j) { const f32x4 g = *((const f32x4*)lng + lane + 64 * j), bb = *((const f32x4*)lnb + lane + 64 * j); oo[64 * j] = v[j] * rstd * g + bb; }
        } else {
            const float* mdn = md + 5 * 6144;
            u32x2* ho = (u32x2*)(H + (size_t)m * DM) + lane;
#pragma unroll
            for (int j = 0; j < 4; ++j) { const f32x4 g = *((const f32x4*)lng + lane + 64 * j), bb = *((const f32x4*)lnb + lane + 64 * j);
                const f32x4 x2 = v[j] * rstd * g + bb; xio[64 * j] = x2;
                const f32x4 sh = *((const f32x4*)mdn + lane + 64 * j), sc = *((const f32x4*)(mdn + DM) + lane + 64 * j);
                const f32x4 h = x2 * (sc + 1.0f) + sh; ho[64 * j] = (u32x2){cvt_pk_bf16(h[0], h[1]), cvt_pk_bf16(h[2], h[3])}; }
        }
    }
}

__device__ __forceinline__ void build_expert_tables(const KA& a, LAS unsigned char* lds, int l, int tid) {
    LAS int* tst = (LAS int*)(lds + LDS_TAB); LAS int* rst = tst + 66; LAS int* cn = rst + 66;
    __syncthreads();
    if (tid < 64) {
        const unsigned* cnt = (const unsigned*)(a.ws() + WS_CTL) + CW_CNT + l * 64;
        const int c = (int)__hip_atomic_load(cnt + tid, __ATOMIC_RELAXED, __HIP_MEMORY_SCOPE_AGENT);
        int t = (c + 255) >> 8, r = c;
#pragma unroll
        for (int o = 1; o < 64; o <<= 1) { const int t2 = __shfl_up(t, o), r2 = __shfl_up(r, o); if (tid >= o) { t += t2; r += r2; } }
        tst[tid] = t - ((c + 255) >> 8); rst[tid] = r - c; cn[tid] = c;
        if (tid == 63) { tst[64] = t; rst[64] = r; cn[64] = TT; tst[65] = t + (TT >> 8); rst[65] = r + TT; }
    }
    __syncthreads();
}

struct Seg {
    int i0, c, G, first, n;
    __device__ __forceinline__ void init(int first_, int n_, int c_, int G_) { first = first_; n = n_; c = c_; G = G_; i0 = (first_ <= c_) ? 0 : (first_ - c_ + G_ - 1) / G_; }
    __device__ __forceinline__ int idx(int i) const { const int L = (i0 + i) * G + c - first; return L < n ? L : -1; }
};
__device__ __forceinline__ int kv_row0(int pm) { return pm < 64 ? (pm >> 4) * KVR + (pm & 15) * 256 : (pm - 64) * KVR + LSEQ; }

struct SchedQKVE { Seg s; unsigned char* ws; int j;
    __device__ __forceinline__ bool next(int i, pg8::Unit& u) { const int L = s.idx(i); if (L < 0) return false; const int pm = L % 68, pn = L / 68;
        u.A = (const char*)(ws + WS_H) + (size_t)pm * 256 * 2048; u.B = (const char*)(ws + WS_WINE) + ((size_t)j * 1280 + pn * 256) * 2048; u.rows = nullptr; u.nvalid = 256;
        u.x1 = pm < 64 ? (pm & 15) * 256 : -1;
        if (pn < 3) { u.C = (char*)(ws + WS_QB) + ((size_t)pm * 256 * 768 + pn * 256) * 2; u.ldc = 768; u.x0 = 0; }
        else { u.C = (char*)(ws + (pn == 3 ? WS_KB : WS_VB)) + (size_t)kv_row0(pm) * 256 * 2; u.ldc = 256; u.x0 = pn - 2; }
        return true; } };
struct SchedFP { Seg s; unsigned char* ws; int j;
    __device__ __forceinline__ bool next(int i, pg8::Unit& u) { const int L = s.idx(i); if (L < 0) return false; u.rows = nullptr; u.nvalid = 256; u.x0 = 0; u.x1 = 0;
        if (L < 128) { const int q = L >> 6, mt = L & 63, b = mt >> 4;
            u.A = (const char*)(ws + WS_WF) + ((size_t)j * 512 + q * 256) * 2048; u.B = (const char*)(ws + WS_H) + (size_t)mt * 256 * 2048;
            u.C = (char*)(ws + WS_ZT) + ((size_t)b * 256 * 8192 + q * 4096 + (mt & 15) * 256) * 2; u.ldc = 8192; }
        else { const int q = (L - 128) >> 2, b = (L - 128) & 3;
            u.A = (const char*)(ws + WS_WF) + ((size_t)j * 512 + q * 256) * 2048; u.B = (const char*)(ws + WS_H) + (size_t)(TLAT + b * 256) * 2048;
            u.C = (char*)(ws + WS_ZCT) + ((size_t)b * 256 * 512 + q * 256) * 2; u.ldc = 512; }
        return true; } };
struct SchedQKVO { Seg s; unsigned char* ws; int j;
    __device__ __forceinline__ bool next(int i, pg8::Unit& u) { const int L = s.idx(i); if (L < 0) return false; const int pm = L % 68, pn = L / 68;
        u.A = (const char*)(ws + WS_H) + (size_t)pm * 256 * 2048; u.B = (const char*)(ws + WS_WINO) + ((size_t)j * 3072 + pn * 256) * 2048; u.rows = nullptr; u.nvalid = 256; u.x0 = 0; u.x1 = 0; u.ldc = 1024;
        if (pn < 4) u.C = (char*)(ws + WS_QB) + ((size_t)pm * 256 * 1024 + pn * 256) * 2;
        else u.C = (char*)(ws + (pn < 8 ? WS_KB : WS_VB)) + ((size_t)kv_row0(pm) * 1024 + (pn & 3) * 256) * 2;
        return true; } };
struct SchedDFT { Seg s; unsigned char* ws;
    __device__ __forceinline__ bool next(int i, pg8::Unit& u) { const int L = s.idx(i); if (L < 0) return false; const int pm = L & 15, b = L >> 4;
        u.A = (const char*)(ws + WS_TW) + (size_t)pm * 256 * 16384; u.B = (const char*)(ws + WS_ZT) + (size_t)b * 256 * 16384;
        u.C = (char*)(ws + WS_O) + (size_t)(b * LSEQ + pm * 256) * 1024 * 2; u.ldc = 1024; u.rows = nullptr; u.nvalid = 256; u.x0 = 0; u.x1 = 0; return true; } };
struct SchedDFTC { Seg s; unsigned char* ws;
    __device__ __forceinline__ bool next(int i, pg8::Unit& u) { const int b = s.idx(i); if (b < 0) return false;
        u.A = (const char*)(ws + WS_TWC); u.B = (const char*)(ws + WS_ZCT) + (size_t)b * 256 * 1024;
        u.C = (char*)(ws + WS_O) + (size_t)(TLAT + b * 256) * 1024 * 2; u.ldc = 1024; u.rows = nullptr; u.nvalid = 256; u.x0 = 0; u.x1 = 0; return true; } };
struct SchedOUT { Seg s; unsigned char* ws; int l;
    __device__ __forceinline__ bool next(int i, pg8::Unit& u) { const int L = s.idx(i); if (L < 0) return false; const int pm = L % 68, pn = L / 68;
        u.A = (const char*)(ws + WS_O) + (size_t)pm * 256 * 2048; u.B = (const char*)(ws + WS_WOUT) + ((size_t)l * 1024 + pn * 256) * 2048;
        u.C = (char*)(ws + WS_Y) + ((size_t)pm * 256 * 1024 + pn * 256) * 2; u.ldc = 1024; u.rows = nullptr; u.nvalid = 256; u.x0 = 0; u.x1 = 0; return true; } };
struct SchedGU { Seg s; unsigned char* ws; int l; const LAS int* tab; int e;
    __device__ __forceinline__ bool next(int i, pg8::Unit& u) { const int L = s.idx(i); if (L < 0) return false; const int mtg = L >> 1, nt = L & 1;
        while (tab[e + 1] <= mtg) ++e;
        while (tab[e] > mtg) --e;
        const int mt = mtg - tab[e], r0 = tab[66 + e] + mt * 256;
        u.A = (const char*)(ws + WS_H); u.rows = (const int*)(ws + WS_LIST) + (size_t)e * TT + mt * 256; u.nvalid = min(256, tab[132 + e] - mt * 256);
        u.B = (const char*)(ws + WS_WGU) + ((size_t)(l * 65 + e) * 512 + nt * 256) * 2048;
        u.C = (char*)(ws + WS_ACT) + ((size_t)r0 * 256 + nt * 128) * 2; u.ldc = 256; u.x0 = 0; u.x1 = 0; return true; } };
struct SchedDN { Seg s; unsigned char* ws; int l; const LAS int* tab; int e;
    __device__ __forceinline__ bool next(int i, pg8::Unit& u) { const int L = s.idx(i); if (L < 0) return false; const int mtg = L >> 2, nt = L & 3;
        while (tab[e + 1] <= mtg) ++e;
        while (tab[e] > mtg) --e;
        const int mt = mtg - tab[e], r0 = tab[66 + e] + mt * 256;
        u.A = (const char*)(ws + WS_ACT) + (size_t)r0 * 512; u.rows = nullptr; u.nvalid = min(256, tab[132 + e] - mt * 256);
        u.B = (const char*)(ws + WS_WD) + ((size_t)(l * 65 + e) * 1024 + nt * 256) * 512;
        u.C = (char*)(ws + WS_YB) + ((size_t)r0 * 1024 + nt * 256) * 2; u.ldc = 1024; u.x0 = 0; u.x1 = 0; return true; } };

constexpr int NPHASE = 2 + 7 * DEPTH;
#ifndef PHMASK
#define PHMASK 0xFFFFF
#endif
#define SITE(b) if constexpr ((PHMASK >> (b)) & 1)
__global__ void __launch_bounds__(512, 2) fwd(Args args_) {
    extern __shared__ __attribute__((aligned(16))) unsigned char lds_raw[];
    LAS unsigned char* lds = (LAS unsigned char*)lds_raw;
    const int bid = blockIdx.x, G = gridDim.x;
#define tid (opaque_tid())
#define lane (opaque_tid() & 63)
#define wave (__builtin_amdgcn_readfirstlane(opaque_tid() >> 6))
    const KA a;
#define WSP (a.ws())
#define args a
    volatile LAS unsigned* MISC = (volatile LAS unsigned*)(lds + LDS_MISC);
    { const int t0 = threadIdx.x; if (t0 < 64) MISC[t0] = 0u; }
    __syncthreads();
#define lo (a.ph_lo())
#define hi (a.ph_hi())
    XcdBarrier bar; bar.bar = (unsigned*)(WSP + WS_CTL) + CW_BAR; bar.x = 0; bar.st = MISC + 8;
    if (hi - lo > 1) bar = xcd_barrier_post((unsigned*)(WSP + WS_CTL) + CW_BAR, MISC + 8);
#define IN(k) (lo <= (k) && (k) < hi)
#define SEAM(k) do { if (IN(k) && IN((k) + 1)) xcd_barrier(bar); } while (0)
    const int NGW = G * 8;
#define gw (bid * 8 + wave)

    if (IN(0)) SITE(0) {
        p0_mod(args, lds, bid, G, tid, wave, lane);
        for (int task = bid; task < 16; task += G) p0_fourier_fold(args, lds, task, tid, wave, lane);
        p0_tables(args, lds, bid * 512 + tid, G * 512, tid);
        { int* ident = (int*)(WSP + WS_LIST) + (size_t)NEXP * TT; for (int i = bid * 512 + tid; i < TT; i += G * 512) ident[i] = i; }
        p0_convert_weights(args, lds, gw, NGW, wave, lane);
    }
    SEAM(0);
    if (IN(1)) SITE(0) p0b_modulate(args, gw, NGW, lane);
    SEAM(1);

    for (int l = 0; l < DEPTH; ++l) {
        const int pb = 2 + 7 * l, j = l >> 1;
        if (IN(pb + 0)) {
            if ((l & 1) == 0) {
                SITE(1) { SchedQKVE S; S.s.init(0, 340, bid, G); S.ws = WSP; S.j = j;
                  pg8::EpiQKVE E; E.P = (LAS float*)(lds + LDS_EPI); E.gainp = (const float*)(WSP + WS_GAINP) + j * 256; E.rope = (const f32x2*)(WSP + WS_ROPE);
                  pg8::gemm_phase<pg8::EpiQKVE, SchedQKVE, false>(lds, 1024, S, E); }
                SITE(2) { SchedFP S; S.s.init(340, 136, bid, G); S.ws = WSP; S.j = j; pg8::EpiStore E;
                  pg8::gemm_phase<pg8::EpiStore, SchedFP, false>(lds, 1024, S, E); }
            } else SITE(3) {
                SchedQKVO S; S.s.init(0, 816, bid, G); S.ws = WSP; S.j = j; pg8::EpiStore E;
                pg8::gemm_phase<pg8::EpiStore, SchedQKVO, false>(lds, 1024, S, E);
            }
        }
        SEAM(pb + 0);
        if (IN(pb + 1)) {
            const bf16_t* QB = (const bf16_t*)(WSP + WS_QB); const bf16_t* KB = (const bf16_t*)(WSP + WS_KB); const bf16_t* VB = (const bf16_t*)(WSP + WS_VB); bf16_t* O = (bf16_t*)(WSP + WS_O);
            if ((l & 1) == 0) {
                SITE(4) { SchedDFT S; S.s.init(0, 64, bid, G); S.ws = WSP; pg8::EpiStore E; pg8::gemm_phase<pg8::EpiStore, SchedDFT, false>(lds, 8192, S, E); }
                SITE(5) { SchedDFTC S; S.s.init(28, 4, bid, G); S.ws = WSP; pg8::EpiStore E; pg8::gemm_phase<pg8::EpiStore, SchedDFTC, false>(lds, 512, S, E); }
                __syncthreads();
                SITE(6) {
                    int u = (bid < 24) ? bid : (bid >= 64 ? bid - 40 : 408);
                    while (u < 408) {
                        const bf16_t *q, *k, *v; bf16_t* o; int ntile;
                        if (u < 24) { const int b = u / 6, h = u % 6; q = QB + (TLAT + b * 256) * 768 + h * 128; k = KB + (b * KVR + LSEQ) * 256 + (h / 3) * 128; v = VB + (b * KVR + LSEQ) * 256 + (h / 3) * 128;
                            o = O + (TLAT + b * 256) * 1024 + 256 + h * 128; ntile = 4; u = 408; }
                        else { const int uu = u - 24, bk = uu / 48, x = uu % 48, b = bk >> 1, kvh = bk & 1, h = kvh * 3 + x / 16, qb = x & 15;
                            q = QB + (b * LSEQ + qb * 256) * 768 + h * 128; k = KB + b * KVR * 256 + kvh * 128; v = VB + b * KVR * 256 + kvh * 128;
                            o = O + (b * LSEQ + qb * 256) * 1024 + 256 + h * 128; ntile = 68; u += 192; }
                        att::attn_body<false, 768, 256, 1024>(q, k, v, o, ntile, 0, 0, 0, (char*)lds_raw);
                    }
                }
            } else {
                const float* rpb = a.in(I_NARPB) + (size_t)j * 8 * 465;
                LAS float* bt = (LAS float*)(lds + att::LDS_BIAS);
                SITE(7) for (int u = bid; u < 544; u += G) {
                    const bf16_t *q, *k, *v; bf16_t* o; int ntile, nloc, bs, q0r, h;
                    if (u < 512) { const int bh = u >> 4, blk = u & 15, b = bh >> 3; h = bh & 7; bs = min(max(4 * blk - 4, 0), 52); q0r = 4 * blk; ntile = 16; nloc = 12;
                        q = QB + (b * LSEQ + blk * 256) * 1024 + h * 128; k = KB + b * KVR * 1024 + h * 128; v = VB + b * KVR * 1024 + h * 128; o = O + (b * LSEQ + blk * 256) * 1024 + h * 128; }
                    else { const int b = (u - 512) >> 3; h = u & 7; bs = 0; q0r = 0; ntile = 4; nloc = 0;
                        q = QB + (TLAT + b * 256) * 1024 + h * 128; k = KB + b * KVR * 1024 + h * 128; v = VB + b * KVR * 1024 + h * 128; o = O + (TLAT + b * 256) * 1024 + h * 128; }
                    for (int i = tid; i < 465; i += 512) bt[64 + i] = rpb[h * 465 + i] * (1.0f / ATT_SCALE);
                    att::attn_body<true, 1024, 1024, 1024>(q, k, v, o, ntile, nloc, bs, q0r, (char*)lds_raw);
                }
            }
        }
        SEAM(pb + 1);
        if (IN(pb + 2)) SITE(9) { SchedOUT S; S.s.init(0, 272, bid, G); S.ws = WSP; S.l = l; pg8::EpiStore E; pg8::gemm_phase<pg8::EpiStore, SchedOUT, false>(lds, 1024, S, E); }
        SEAM(pb + 2);
        if (IN(pb + 3)) SITE(10) phase_ln1_router(args, lds, l, bid, tid, wave, lane);
        SEAM(pb + 3);
        if (IN(pb + 4)) SITE(11) { build_expert_tables(args, lds, l, tid);
            const LAS int* tab = (const LAS int*)(lds + LDS_TAB);
            SchedGU S; S.s.init(0, tab[65] * 2, bid, G); S.ws = WSP; S.l = l; S.tab = tab; S.e = 0; pg8::EpiSwiGLU E;
            pg8::gemm_phase<pg8::EpiSwiGLU, SchedGU, true>(lds, 1024, S, E); }
        SEAM(pb + 4);
        if (IN(pb + 5)) SITE(12) { build_expert_tables(args, lds, l, tid);
            const LAS int* tab = (const LAS int*)(lds + LDS_TAB);
            SchedDN S; S.s.init(0, tab[65] * 4, bid, G); S.ws = WSP; S.l = l; S.tab = tab; S.e = 0; pg8::EpiStore E;
            int k256 = 256; asm volatile("" : "+s"(k256));
            pg8::gemm_phase<pg8::EpiStore, SchedDN, false>(lds, k256, S, E); }
        SEAM(pb + 5);
        if (IN(pb + 6)) SITE(13) { build_expert_tables(args, lds, l, tid); phase_combine_ln2(args, lds, l, gw, NGW, tid, lane); }
        SEAM(pb + 6);
    }
#undef IN
#undef SEAM
#undef lo
#undef hi
#undef lane
#undef wave
#undef gw
#undef tid
#undef WSP
#undef args
}

extern "C" void kernel_launch(void* const* d_in, const int* in_sizes, int n_in, void* d_out, int out_size, void* d_ws, size_t ws_size, hipStream_t stream) {
    static int ok = 0;
    if (ok == 0) {
        if (n_in != N_IN || ws_size < WS_END) { fprintf(stderr, "kernel_launch: n_in %d (want %d), ws %zu (want >= %zu)\n", n_in, (int)N_IN, ws_size, (size_t)WS_END); return; }
        if (hipFuncSetAttribute((const void*)fwd, hipFuncAttributeMaxDynamicSharedMemorySize, LDS_BYTES) != hipSuccess) { fprintf(stderr, "kernel_launch: hipFuncSetAttribute failed\n"); return; }
        int per_cu = 0;
        if (hipOccupancyMaxActiveBlocksPerMultiprocessor(&per_cu, (const void*)fwd, 512, LDS_BYTES) != hipSuccess || per_cu < 1) fprintf(stderr, "kernel_launch: occupancy query reports %d\n", per_cu);
        ok = 1;
    }
    Args a;
    memset(&a, 0, sizeof(a));
    for (int i = 0; i < N_IN; ++i) a.in[i] = (const float*)d_in[i];
    a.out = (float*)d_out; a.ws = (unsigned char*)d_ws;
    hipMemsetAsync((char*)d_ws + WS_CTL, 0, CTL_BYTES, stream);
#if MK_ONE_LAUNCH
    a.ph_lo = 0; a.ph_hi = NPHASE;
    hipLaunchKernelGGL(fwd, dim3(256), dim3(512), LDS_BYTES, stream, a);
#else
    for (int p = 0; p < NPHASE; ++p) { a.ph_lo = p; a.ph_hi = p + 1; hipLaunchKernelGGL(fwd, dim3(256), dim3(512), LDS_BYTES, stream, a); }
#endif
    const hipError_t le = hipPeekAtLastError();
    if (le != hipSuccess) fprintf(stderr, "kernel_launch: launch failed: %s\n", hipGetErrorName(le));
}
```

```cpp
#include <hip/hip_runtime.h>
#include <cstdio>
#include <cstdint>
#include <cstring>

#define LAS __attribute__((address_space(3)))
#define GAS __attribute__((address_space(1)))
typedef unsigned short bf16_t;
typedef short bf16x8 __attribute__((ext_vector_type(8)));
typedef short s16x4 __attribute__((ext_vector_type(4)));
typedef float f32x2 __attribute__((ext_vector_type(2)));
typedef float f32x4 __attribute__((ext_vector_type(4)));
typedef float f32x16 __attribute__((ext_vector_type(16)));
typedef unsigned u32x2 __attribute__((ext_vector_type(2)));
typedef unsigned u32x4 __attribute__((ext_vector_type(4)));

#ifndef MK_ONE_LAUNCH
#define MK_ONE_LAUNCH 1
#endif

constexpr int NB = 4, LSEQ = 4096, DM = 1024, NCTX = 256, DEPTH = 4;
constexpr int TLAT = NB * LSEQ, TCTX = NB * NCTX, TT = TLAT + TCTX;
constexpr int KVR = LSEQ + NCTX;
constexpr int NEXP = 64, TOPK = 8, EDIM = 256;
constexpr int NPAIR = TT * TOPK, NSLOT = NPAIR + TT;
constexpr float DN_ALPHA = 1.681792830507429f;
constexpr float LN_EPS = 1e-6f, RMS_EPS = 1e-6f, ROUTE_SCALE = 2.5f;
constexpr float ATT_SCALE = 0.088388347648318440f;

constexpr size_t al256(size_t x) { return (x + 255) / 256 * 256; }
constexpr size_t WS_CTL = 0, CTL_BYTES = 65536;
constexpr size_t WS_MOD = WS_CTL + CTL_BYTES;
constexpr size_t WS_GAINP = WS_MOD + al256((size_t)DEPTH * 5 * 6 * DM * 4);
constexpr size_t WS_ROPE = WS_GAINP + 2048;
constexpr size_t WS_WRHI = WS_ROPE + 16384;
constexpr size_t WS_WRLO = WS_WRHI + (size_t)DEPTH * 64 * DM * 2;
constexpr size_t WS_WF = WS_WRLO + (size_t)DEPTH * 64 * DM * 2;
constexpr size_t WS_WINE = WS_WF + (size_t)2 * 512 * DM * 2;
constexpr size_t WS_WINO = WS_WINE + (size_t)2 * 1280 * DM * 2;
constexpr size_t WS_WOUT = WS_WINO + (size_t)2 * 3072 * DM * 2;
constexpr size_t WS_WGU = WS_WOUT + (size_t)DEPTH * DM * DM * 2;
constexpr size_t WS_WD = WS_WGU + (size_t)DEPTH * 65 * 512 * DM * 2;
constexpr size_t WS_TW = WS_WD + (size_t)DEPTH * 65 * DM * 256 * 2;
constexpr size_t WS_TWC = WS_TW + (size_t)4096 * 8192 * 2;
constexpr size_t WS_XS = WS_TWC + (size_t)256 * 512 * 2;
constexpr size_t WS_H = WS_XS + (size_t)TT * DM * 4;
constexpr size_t WS_TKE = WS_H + (size_t)TT * DM * 2;
constexpr size_t WS_TKW = WS_TKE + (size_t)NPAIR * 4;
constexpr size_t WS_TKP = WS_TKW + (size_t)NPAIR * 4;
constexpr size_t WS_LIST = WS_TKP + (size_t)NPAIR * 4;
constexpr size_t WS_ACT = WS_LIST + (size_t)(NEXP + 1) * TT * 4;
constexpr size_t WS_YB = WS_ACT + (size_t)(NSLOT + 256) * EDIM * 2;
constexpr size_t WS_QB = WS_YB;
constexpr size_t WS_KB = WS_QB + (size_t)TT * DM * 2;
constexpr size_t WS_VB = WS_KB + (size_t)NB * KVR * DM * 2;
constexpr size_t WS_O = WS_VB + (size_t)NB * KVR * DM * 2;
constexpr size_t WS_Y = WS_O + (size_t)TT * DM * 2;
constexpr size_t WS_ZT = WS_Y + (size_t)TT * DM * 2;
constexpr size_t WS_ZCT = WS_ZT + (size_t)1024 * 8192 * 2;
constexpr size_t WS_OVL_END = WS_ZCT + (size_t)1024 * 512 * 2;
constexpr size_t WS_END = WS_YB + (size_t)NSLOT * DM * 2;
static_assert(WS_OVL_END <= WS_END, "overlay fits in YB");
static_assert(WS_END <= (size_t)1 << 30, "workspace must fit 1 GiB");
constexpr int CW_TMO = 0, CW_CNT = 64  , CW_BAR = 1024;

constexpr int LDS_BYTES = 147456;
constexpr int LDS_STAGE = 0;
constexpr int LDS_EPI = 131072;
constexpr int LDS_RIDX = 139264;
constexpr int LDS_TAB = 141312;
constexpr int LDS_MISC = 147456 - 256;

__device__ __forceinline__ unsigned cvt_pk_bf16(float lo, float hi) { unsigned r; asm volatile("v_cvt_pk_bf16_f32 %0, %1, %2" : "=v"(r) : "v"(lo), "v"(hi)); return r; }
__device__ __forceinline__ float bf_lo(unsigned u) { return __uint_as_float(u << 16); }
__device__ __forceinline__ float bf_hi(unsigned u) { return __uint_as_float(u & 0xffff0000u); }
__device__ __forceinline__ float wave_sum(float v) {
#pragma unroll
    for (int o = 1; o < 64; o <<= 1) v += __shfl_xor(v, o);
    return v;
}
__device__ __forceinline__ float wave_max(float v) {
#pragma unroll
    for (int o = 1; o < 64; o <<= 1) v = fmaxf(v, __shfl_xor(v, o));
    return v;
}
#define LDS_WAIT() asm volatile("s_waitcnt lgkmcnt(0)" ::: "memory")
#define VM_WAIT() asm volatile("s_waitcnt vmcnt(0)" ::: "memory")

__device__ __forceinline__ int opaque_tid() { int t = threadIdx.x; asm volatile("" : "+v"(t)); return t; }
namespace pg8 {
constexpr int BM = 256, BK = 64, HALF = 128, HTB = HALF * BK * 2  , STAGE_BYTES = 8 * HTB;

__host__ __device__ __forceinline__ int lds_byte(int r, int c) { const int st = (r >> 4) * 2 + (c >> 5), rr = r & 15, cc = c & 31, ob = rr * 64 + cc * 2; return st * 1024 + (ob ^ (((ob >> 9) & 1) << 5)); }
__host__ __device__ __forceinline__ void stage_rc(int b, int& R, int& C) { const int st = b / 1024, sb = b % 1024, swz = sb ^ (((sb >> 9) & 1) << 5); R = (st >> 1) * 16 + swz / 64; C = (st & 1) * 32 + (swz % 64) / 2; }
__host__ __device__ __forceinline__ int perm32(int rho) { const int n = rho >> 4, i = rho & 15; return 8 * (i >> 2) + 4 * n + (i & 3); }

struct Unit { const char* A; const char* B; char* C; const int* rows; int ldc, nvalid, x0, x1; };

struct EpiStore {
    __device__ __forceinline__ void operator()(const f32x4 (&acc)[2][2][4][2], const Unit& u) const {
        const int tid = opaque_tid(), wid = tid >> 6, lane = tid & 63, wr = wid >> 2, wc = wid & 3, fr = lane & 15, fq = lane >> 4;
        const int row0 = wr * 64 + fr, col0 = wc * 32 + 8 * fq;
#pragma unroll
        for (int ai = 0; ai < 2; ++ai)
#pragma unroll
            for (int m = 0; m < 4; ++m) {
                const int r = row0 + ai * HALF + m * 16;
                if (r < u.nvalid) {
                    bf16_t* rowp = (bf16_t*)u.C + (size_t)r * u.ldc + col0;
#pragma unroll
                    for (int bj = 0; bj < 2; ++bj) { const f32x4 v0 = acc[ai][bj][m][0], v1 = acc[ai][bj][m][1];
                        u32x4 w; w.x = cvt_pk_bf16(v0[0], v0[1]); w.y = cvt_pk_bf16(v0[2], v0[3]); w.z = cvt_pk_bf16(v1[0], v1[1]); w.w = cvt_pk_bf16(v1[2], v1[3]);
                        *(u32x4*)(rowp + bj * HALF) = w; }
                }
            }
    }
};
struct EpiSwiGLU {
    __device__ __forceinline__ void operator()(const f32x4 (&acc)[2][2][4][2], const Unit& u) const {
        const int tid = opaque_tid(), wid = tid >> 6, lane = tid & 63, wr = wid >> 2, wc = wid & 3, fr = lane & 15, fq = lane >> 4;
        const int row0 = wr * 64 + fr, col0 = wc * 32 + 8 * fq;
#pragma unroll
        for (int ai = 0; ai < 2; ++ai)
#pragma unroll
            for (int m = 0; m < 4; ++m) {
                const int r = row0 + ai * HALF + m * 16;
                if (r < u.nvalid) {
                    float o[8];
#pragma unroll
                    for (int n = 0; n < 2; ++n)
#pragma unroll
                        for (int j = 0; j < 4; ++j) { const float g = acc[ai][0][m][n][j], up = acc[ai][1][m][n][j];
                            o[n * 4 + j] = g * __builtin_amdgcn_rcpf(1.0f + __builtin_amdgcn_exp2f(-1.4426950408889634f * g)) * up; }
                    u32x4 w; w.x = cvt_pk_bf16(o[0], o[1]); w.y = cvt_pk_bf16(o[2], o[3]); w.z = cvt_pk_bf16(o[4], o[5]); w.w = cvt_pk_bf16(o[6], o[7]);
                    *(u32x4*)((bf16_t*)u.C + (size_t)r * u.ldc + col0) = w;
                }
            }
    }
};
struct EpiQKVE {
    LAS float* P;
    const float* gainp;
    const f32x2* rope;
    __device__ __forceinline__ void operator()(const f32x4 (&acc)[2][2][4][2], const Unit& u) const {
        const int tid = opaque_tid(), wid = tid >> 6, lane = tid & 63, wr = wid >> 2, wc = wid & 3, fr = lane & 15, fq = lane >> 4;
        const int row0 = wr * 64 + fr, col0 = wc * 32 + 8 * fq;
        if (u.x0 == 2) {
#pragma unroll
            for (int ai = 0; ai < 2; ++ai)
#pragma unroll
                for (int m = 0; m < 4; ++m) { bf16_t* rowp = (bf16_t*)u.C + (size_t)(row0 + ai * HALF + m * 16) * u.ldc + col0;
#pragma unroll
                    for (int bj = 0; bj < 2; ++bj) { const f32x4 v0 = acc[ai][bj][m][0], v1 = acc[ai][bj][m][1];
                        u32x4 w; w.x = cvt_pk_bf16(v0[0], v0[1]); w.y = cvt_pk_bf16(v0[2], v0[3]); w.z = cvt_pk_bf16(v1[0], v1[1]); w.w = cvt_pk_bf16(v1[2], v1[3]);
                        *(u32x4*)(rowp + bj * HALF) = w; } }
            asm volatile("" ::: "memory"); __builtin_amdgcn_s_barrier(); asm volatile("" ::: "memory");
            return;
        }
#pragma unroll
        for (int ai = 0; ai < 2; ++ai)
#pragma unroll
            for (int m = 0; m < 4; ++m)
#pragma unroll
                for (int bj = 0; bj < 2; ++bj) { const f32x4 a = acc[ai][bj][m][0], b = acc[ai][bj][m][1];
                    float s = (a[0] * a[0] + a[1] * a[1]) + (a[2] * a[2] + a[3] * a[3]) + (b[0] * b[0] + b[1] * b[1]) + (b[2] * b[2] + b[3] * b[3]);
                    s += __shfl_xor(s, 16); s += __shfl_xor(s, 32);
                    if (fq == 0) P[(bj * 256 + row0 + ai * HALF + m * 16) * 4 + wc] = s; }
        asm volatile("s_waitcnt lgkmcnt(0)" ::: "memory"); __builtin_amdgcn_s_barrier(); asm volatile("" ::: "memory");
        const f32x4 g0 = *(const f32x4*)(gainp + u.x0 * 128 + col0), g1 = *(const f32x4*)(gainp + u.x0 * 128 + col0 + 4);
        const int half = wc >> 1, fi = ((wc & 1) * 4 + fq) * 4;
#pragma unroll
        for (int ai = 0; ai < 2; ++ai)
#pragma unroll
            for (int m = 0; m < 4; ++m) {
                const int r = row0 + ai * HALF + m * 16;
                int pos = 0;
                if (u.x1 >= 0) { const int t = u.x1 + r; pos = half ? (t & 63) : (t >> 6); }
                const f32x4 cs0 = *(const f32x4*)(rope + pos * 32 + fi), cs1 = *(const f32x4*)(rope + pos * 32 + fi + 2);
                const float cc[4] = {cs0[0], cs0[2], cs1[0], cs1[2]}, ss[4] = {cs0[1], cs0[3], cs1[1], cs1[3]};
                bf16_t* rowp = (bf16_t*)u.C + (size_t)r * u.ldc + col0;
#pragma unroll
                for (int bj = 0; bj < 2; ++bj) {
                    const f32x4 pp = *(const LAS f32x4*)(P + (bj * 256 + r) * 4);
                    const float rs = __builtin_amdgcn_rsqf(((pp[0] + pp[1]) + (pp[2] + pp[3])) * (1.0f / 128.0f) + RMS_EPS);
                    float o1[4], o2[4];
#pragma unroll
                    for (int j = 0; j < 4; ++j) { const float v1 = acc[ai][bj][m][0][j] * rs * g0[j], v2 = acc[ai][bj][m][1][j] * rs * g1[j];
                        o1[j] = v1 * cc[j] - v2 * ss[j]; o2[j] = v1 * ss[j] + v2 * cc[j]; }
                    u32x4 w; w.x = cvt_pk_bf16(o1[0], o1[1]); w.y = cvt_pk_bf16(o1[2], o1[3]); w.z = cvt_pk_bf16(o2[0], o2[1]); w.w = cvt_pk_bf16(o2[2], o2[3]);
                    *(u32x4*)(rowp + bj * HALF) = w;
                }
            }
    }
};

template <class Epi, class Sched, bool GATHER>
__device__ __forceinline__ void gemm_phase(LAS unsigned char* lds, const int K_, Sched& S, const Epi& E) {
    const int K = K_;
    const int tid = opaque_tid(), wid = __builtin_amdgcn_readfirstlane(tid >> 6), lane = tid & 63, wr = wid >> 2, wc = wid & 3, fr = lane & 15, fq = lane >> 4;
    const int nt = K / BK;
    Unit cur, nxt; int ui = 0;
    if (!S.next(0, cur)) return;
    unsigned voffB[2], offA[2][2];
#pragma unroll
    for (int i = 0; i < 2; ++i) { int R, C; stage_rc(tid * 16 + i * 8192, R, C); const int Rb = (R & ~31) + perm32(R & 31);
        voffB[i] = (unsigned)(Rb * K + C) * 2u; }
    LAS int* ridx = (LAS int*)(lds + LDS_RIDX);
    if (GATHER) {
        if (tid < 256) ridx[tid] = (tid < cur.nvalid) ? cur.rows[tid] : 0;
        __syncthreads();
#pragma unroll
        for (int h = 0; h < 2; ++h)
#pragma unroll
            for (int i = 0; i < 2; ++i) { int R, C; stage_rc(tid * 16 + i * 8192, R, C); offA[h][i] = (unsigned)ridx[h * HALF + R] * (unsigned)(K * 2) + (unsigned)C * 2u; }
    } else {
#pragma unroll
        for (int h = 0; h < 2; ++h)
#pragma unroll
            for (int i = 0; i < 2; ++i) { int R, C; stage_rc(tid * 16 + i * 8192, R, C); offA[h][i] = (unsigned)((h * HALF + R) * K + C) * 2u; }
    }
    const size_t kstep = (size_t)(BK * 2);
    const size_t hstep = (size_t)HALF * K * 2;
    const unsigned ldsw = (unsigned)wid * 1024u;
    const int aoff = lds_byte(wr * 64 + fr, fq * 8), boff = lds_byte(wc * 32 + fr, fq * 8);
#define PG8_SA(b, h) (((b) * 2 + (h)) * HTB)
#define PG8_SB(b, h) ((4 + (b) * 2 + (h)) * HTB)
#define PG8_STAGE(bufoff, gbase, voff) do { _Pragma("unroll") for (int _i = 0; _i < 2; ++_i) \
        __builtin_amdgcn_global_load_lds((const unsigned*)((const char*)(gbase) + (voff)[_i]), (LAS unsigned*)(lds + (bufoff) + ldsw + _i * 8192), 16, 0, 0); } while (0)
#define PG8_LDA(dst, b, h) do { _Pragma("unroll") for (int m = 0; m < 4; ++m) _Pragma("unroll") for (int k = 0; k < 2; ++k) dst[m][k] = *(const LAS bf16x8*)(lds + PG8_SA(b, h) + aoff + m * 2048 + k * 1024); } while (0)
#define PG8_LDB(dst, b, h) do { _Pragma("unroll") for (int n = 0; n < 2; ++n) _Pragma("unroll") for (int k = 0; k < 2; ++k) dst[n][k] = *(const LAS bf16x8*)(lds + PG8_SB(b, h) + boff + n * 2048 + k * 1024); } while (0)
#define PG8_MMA(ai, bj, At, Bt) do { __builtin_amdgcn_s_setprio(1); _Pragma("unroll") for (int m = 0; m < 4; ++m) _Pragma("unroll") for (int n = 0; n < 2; ++n) _Pragma("unroll") for (int k = 0; k < 2; ++k) \
        acc[ai][bj][m][n] = __builtin_amdgcn_mfma_f32_16x16x32_bf16(Bt[n][k], At[m][k], acc[ai][bj][m][n], 0, 0, 0); __builtin_amdgcn_s_setprio(0); } while (0)
#define PG8_WAIT_V(n) asm volatile("s_waitcnt vmcnt(" #n ")" ::: "memory")
#define PG8_WAIT_L(n) asm volatile("s_waitcnt lgkmcnt(" #n ")" ::: "memory")
#define PG8_BAR __builtin_amdgcn_s_barrier()
#define PG8_SCHED __builtin_amdgcn_sched_barrier(0)
    f32x4 acc[2][2][4][2];
#pragma unroll
    for (int a = 0; a < 2; ++a)
#pragma unroll
        for (int b = 0; b < 2; ++b)
#pragma unroll
            for (int m = 0; m < 4; ++m)
#pragma unroll
                for (int n = 0; n < 2; ++n) acc[a][b][m][n] = (f32x4){0.f, 0.f, 0.f, 0.f};
    bf16x8 At[4][2], B0[2][2], B1[2][2];
    const char* cA = cur.A; const char* cB = cur.B;
    PG8_STAGE(PG8_SB(0, 0), cB, voffB); PG8_STAGE(PG8_SA(0, 0), cA, offA[0]); PG8_STAGE(PG8_SB(0, 1), cB + hstep, voffB); PG8_STAGE(PG8_SA(0, 1), cA, offA[1]);
    if (wr == 1) PG8_BAR;
    PG8_WAIT_V(4); PG8_BAR;
    PG8_STAGE(PG8_SB(1, 0), cB + kstep, voffB); PG8_STAGE(PG8_SA(1, 0), cA + kstep, offA[0]); PG8_STAGE(PG8_SB(1, 1), cB + hstep + kstep, voffB);
    PG8_WAIT_V(6); PG8_BAR;
    for (;;) {
        const bool has_next = S.next(ui + 1, nxt);
        const char* nA = has_next ? nxt.A : cA; const char* nB = has_next ? nxt.B : cB;
        if (GATHER && has_next && wid < 4)
            __builtin_amdgcn_global_load_lds((const unsigned*)(nxt.rows + wid * 64 + lane), (LAS unsigned*)(lds + LDS_RIDX + ((ui + 1) & 1) * 1024 + wid * 256), 4, 0, 0);
        for (int t = 0; t < nt; t += 2) {
            const bool last = (t == nt - 2);
            const char* a1 = cA + (size_t)(t + 1) * kstep;
            const char* a2 = last ? nA : cA + (size_t)(t + 2) * kstep; const char* b2 = last ? nB : cB + (size_t)(t + 2) * kstep;
            const char* a3 = a2 + kstep; const char* b3 = b2 + kstep;
            PG8_LDB(B0, 0, 0); PG8_SCHED; PG8_LDA(At, 0, 0); PG8_STAGE(PG8_SA(1, 1), a1, offA[1]);
            PG8_WAIT_L(8); PG8_BAR; PG8_WAIT_L(0); PG8_MMA(0, 0, At, B0); PG8_BAR; PG8_SCHED;
            if (GATHER && last && has_next) {
                LAS int* rn = ridx + ((ui + 1) & 1) * 256;
#pragma unroll
                for (int h = 0; h < 2; ++h)
#pragma unroll
                    for (int i = 0; i < 2; ++i) { int R, C; stage_rc(tid * 16 + i * 8192, R, C); const int rr = h * HALF + R; const int tok = (rr < nxt.nvalid) ? rn[rr] : 0; offA[h][i] = (unsigned)tok * (unsigned)(K * 2) + (unsigned)C * 2u; }
            }
            PG8_LDB(B1, 0, 1); PG8_STAGE(PG8_SB(0, 0), b2, voffB);
            PG8_BAR; PG8_WAIT_L(0); PG8_MMA(0, 1, At, B1); PG8_BAR;
            PG8_LDA(At, 0, 1); PG8_STAGE(PG8_SA(0, 0), a2, offA[0]);
            PG8_BAR; PG8_WAIT_L(0); PG8_MMA(1, 0, At, B0); PG8_BAR; PG8_SCHED;
            PG8_STAGE(PG8_SB(0, 1), b2 + hstep, voffB);
            PG8_WAIT_V(6); PG8_BAR; PG8_MMA(1, 1, At, B1); PG8_BAR;
            PG8_LDB(B0, 1, 0); PG8_SCHED; PG8_LDA(At, 1, 0); PG8_STAGE(PG8_SA(0, 1), a2, offA[1]);
            PG8_WAIT_L(8); PG8_BAR; PG8_WAIT_L(0); PG8_MMA(0, 0, At, B0); PG8_BAR; PG8_SCHED;
            PG8_LDB(B1, 1, 1); PG8_STAGE(PG8_SB(1, 0), b3, voffB);
            PG8_BAR; PG8_WAIT_L(0); PG8_MMA(0, 1, At, B1); PG8_BAR;
            PG8_LDA(At, 1, 1); PG8_STAGE(PG8_SA(1, 0), a3, offA[0]);
            PG8_BAR; PG8_WAIT_L(0); PG8_MMA(1, 0, At, B0); PG8_BAR; PG8_SCHED;
            PG8_STAGE(PG8_SB(1, 1), b3 + hstep, voffB);
            PG8_WAIT_V(6); PG8_BAR; PG8_MMA(1, 1, At, B1); PG8_BAR;
        }
        { Unit eu; S.next(ui, eu); E(acc, eu); }
        if (!has_next) break;
#pragma unroll
        for (int a = 0; a < 2; ++a)
#pragma unroll
            for (int b = 0; b < 2; ++b)
#pragma unroll
                for (int m = 0; m < 4; ++m)
#pragma unroll
                    for (int n = 0; n < 2; ++n) acc[a][b][m][n] = (f32x4){0.f, 0.f, 0.f, 0.f};
        cur = nxt; cA = nA; cB = nB; ++ui;
    }
    PG8_WAIT_V(0);
    if (wr == 0) PG8_BAR;
    PG8_BAR;
#undef PG8_SA
#undef PG8_SB
#undef PG8_STAGE
#undef PG8_LDA
#undef PG8_LDB
#undef PG8_MMA
#undef PG8_WAIT_V
#undef PG8_WAIT_L
#undef PG8_BAR
#undef PG8_SCHED
}
}

namespace att {
constexpr int D = 128, NW = 8, QBLK = 32, KVBLK = 64;
constexpr float SCALE = ATT_SCALE;
constexpr float THR = 8.f;
constexpr size_t SHM_V = KVBLK * D * 2, SHM_K = KVBLK * D * 2, SHM_ATTN = 2 * SHM_V + 2 * SHM_K + NW * 64 * 4;
constexpr int LDS_BIAS = 69632;
#define KSWZ(row, colB) ((row) * 256 + ((colB) ^ (((row) & 7) << 4)))
#define SBAR() __builtin_amdgcn_sched_barrier(0)
__device__ __forceinline__ int crow(int r, int hi) { return (r & 3) + 8 * (r >> 2) + 4 * hi; }

__device__ __forceinline__ void partialSM(f32x16& p0, f32x16& p1, float& m_reg, float& mn, float& alpha) {
  constexpr float C = SCALE * 1.4426950408889634f;
  float pmax = p0[0];
#pragma unroll
  for (int r = 1; r < 16; ++r) pmax = fmaxf(pmax, p0[r]);
#pragma unroll
  for (int r = 0; r < 16; ++r) pmax = fmaxf(pmax, p1[r]);
  { auto rr = __builtin_amdgcn_permlane32_swap(__float_as_uint(pmax), __float_as_uint(pmax), false, false);
    pmax = fmaxf(__uint_as_float(rr[0]), __uint_as_float(rr[1])); }
  if (__builtin_expect(__all(pmax - m_reg <= THR / SCALE), 1)) { mn = m_reg; alpha = 1.f; }
  else { mn = fmaxf(m_reg, pmax); alpha = __builtin_amdgcn_exp2f((m_reg - mn) * C); m_reg = mn; }
  float mnC = -mn * C;
#pragma unroll
  for (int r = 0; r < 16; ++r) p0[r] = fmaf(p0[r], C, mnC);
#pragma unroll
  for (int r = 0; r < 16; ++r) p1[r] = fmaf(p1[r], C, mnC);
#pragma unroll
  for (int r = 0; r < 16; ++r) p0[r] = __builtin_amdgcn_exp2f(p0[r]);
}
__device__ __forceinline__ void finishSM(f32x16& p0, f32x16& p1, float alpha, float& l_reg, bf16x8& pa0, bf16x8& pa1, bf16x8& pa2, bf16x8& pa3) {
#pragma unroll
  for (int r = 0; r < 16; ++r) p1[r] = __builtin_amdgcn_exp2f(p1[r]);
  float ps = 0;
#pragma unroll
  for (int r = 0; r < 16; ++r) ps += p0[r];
#pragma unroll
  for (int r = 0; r < 16; ++r) ps += p1[r];
  { auto rr = __builtin_amdgcn_permlane32_swap(__float_as_uint(ps), __float_as_uint(ps), false, false);
    ps = __uint_as_float(rr[0]) + __uint_as_float(rr[1]); }
  l_reg = l_reg * alpha + ps;
#define PK4(P, BASE, OUT) do { unsigned a0 = cvt_pk_bf16(P[BASE + 0], P[BASE + 1]), a1 = cvt_pk_bf16(P[BASE + 2], P[BASE + 3]);   \
    unsigned b0 = cvt_pk_bf16(P[BASE + 4], P[BASE + 5]), b1 = cvt_pk_bf16(P[BASE + 6], P[BASE + 7]);                              \
    auto r0 = __builtin_amdgcn_permlane32_swap(a0, b0, false, false); auto r1 = __builtin_amdgcn_permlane32_swap(a1, b1, false, false); \
    u32x4 w = {r0[0], r1[0], r0[1], r1[1]}; OUT = *reinterpret_cast<bf16x8*>(&w); } while (0)
  PK4(p0, 0, pa0); PK4(p0, 8, pa1); PK4(p1, 0, pa2); PK4(p1, 8, pa3);
#undef PK4
}
__device__ __forceinline__ void qkt(f32x16& p0, f32x16& p1, const char* Ks, const bf16x8* qr, int r32, int hi) {
  p0 = f32x16{}; p1 = f32x16{};
#pragma unroll
  for (int d0 = 0; d0 < 8; ++d0) { int cb = (d0 * 16 + hi * 8) * 2;
    bf16x8 b0 = *reinterpret_cast<const bf16x8*>(Ks + KSWZ(r32, cb));
    bf16x8 b1 = *reinterpret_cast<const bf16x8*>(Ks + KSWZ(32 + r32, cb));
    p0 = __builtin_amdgcn_mfma_f32_32x32x16_bf16(b0, qr[d0], p0, 0, 0, 0);
    p1 = __builtin_amdgcn_mfma_f32_32x32x16_bf16(b1, qr[d0], p1, 0, 0, 0); }
}
__device__ __forceinline__ int v_st(int k, int c) { const int kk = (k & ~0xC) | ((k & 4) << 1) | ((k & 8) >> 1); return ((kk >> 3) * 4 + (c >> 5)) * 512 + ((kk & 7) * 32 + (c & 31)) * 2; }
__device__ __forceinline__ int v_rd_base(int lane) { return ((lane & 3) << 3) | (((lane >> 2) & 3) << 6) | (((lane >> 4) & 1) << 5) | (((lane >> 5) & 1) << 8); }
constexpr int v_rd_off(int d0, int ks, int half) { return d0 * 512 + ks * 4096 + half * 2048; }
template <int OFF> __device__ __forceinline__ s16x4 tr_read(int vb) {
  s16x4 r; asm volatile("ds_read_b64_tr_b16 %0, %1 offset:%2" : "=&v"(r) : "v"(vb), "i"(OFF) : "memory"); return r;
}
template <int D0> __device__ __forceinline__ void pv_one(f32x16& od, int vb, bf16x8 pa0, bf16x8 pa1, bf16x8 pa2, bf16x8 pa3) {
  const s16x4 l0 = tr_read<v_rd_off(D0, 0, 0)>(vb), h0 = tr_read<v_rd_off(D0, 0, 1)>(vb), l1 = tr_read<v_rd_off(D0, 1, 0)>(vb), h1 = tr_read<v_rd_off(D0, 1, 1)>(vb);
  const s16x4 l2 = tr_read<v_rd_off(D0, 2, 0)>(vb), h2 = tr_read<v_rd_off(D0, 2, 1)>(vb), l3 = tr_read<v_rd_off(D0, 3, 0)>(vb), h3 = tr_read<v_rd_off(D0, 3, 1)>(vb);
  asm volatile("s_waitcnt lgkmcnt(0)" ::: "memory"); SBAR();
#define PK(L, H) (bf16x8){L[0], L[1], L[2], L[3], H[0], H[1], H[2], H[3]}
  od = __builtin_amdgcn_mfma_f32_32x32x16_bf16(pa0, PK(l0, h0), od, 0, 0, 0);
  od = __builtin_amdgcn_mfma_f32_32x32x16_bf16(pa1, PK(l1, h1), od, 0, 0, 0);
  od = __builtin_amdgcn_mfma_f32_32x32x16_bf16(pa2, PK(l2, h2), od, 0, 0, 0);
  od = __builtin_amdgcn_mfma_f32_32x32x16_bf16(pa3, PK(l3, h3), od, 0, 0, 0);
#undef PK
}
__device__ __forceinline__ void pv_d0(f32x16* o, int vb, bf16x8 pa0, bf16x8 pa1, bf16x8 pa2, bf16x8 pa3) {
  pv_one<0>(o[0], vb, pa0, pa1, pa2, pa3); pv_one<1>(o[1], vb, pa0, pa1, pa2, pa3); pv_one<2>(o[2], vb, pa0, pa1, pa2, pa3); pv_one<3>(o[3], vb, pa0, pa1, pa2, pa3);
}

template <bool NA, int ldq, int ldk, int ldo>
__device__ __forceinline__ void attn_body(const bf16_t* __restrict__ Qb, const bf16_t* __restrict__ Kh, const bf16_t* __restrict__ Vh,
                                          bf16_t* __restrict__ Ob, const int NT, const int nloc, const int bs, const int q0r, char* lds) {
  const int tid = opaque_tid(), wid = tid >> 6, lane = tid & 63, r32 = lane & 31, hi = lane >> 5;
  char* V_lds = lds; char* K_lds = lds + 2 * SHM_V;
  float* ws = (float*)(lds + 2 * SHM_V + 2 * SHM_K) + wid * 64; float* li_l = ws; float* al_l = ws + 32;
  float m_reg = -1e30f, l_reg = 0; f32x16 o[4] = {}; bf16x8 qr[8];
  const bf16_t* Qw = Qb + (wid * QBLK + r32) * ldq + hi * 8;
#pragma unroll
  for (int d0 = 0; d0 < 8; ++d0) qr[d0] = *reinterpret_cast<const bf16x8*>(Qw + d0 * 16);
  const int sr = tid >> 4, sc = (tid & 15) * 8, vst0 = v_st(sr, sc), vst1 = v_st(32 + sr, sc);
  const int vb0 = (int)(uintptr_t)V_lds + v_rd_base(lane);
  const unsigned kvo = (unsigned)(sr * ldk + sc) * 2u;
  const float* btab = (const float*)(lds + LDS_BIAS) + 64;
  struct { bf16x8 vs0, vs1, ks0, ks1; } sr_[2];
#define KOFF(j) (NA ? ((j) < nloc ? (bs + (j)) * 64 : LSEQ + ((j) - nloc) * 64) : (j) * 64)
#define SLOAD(i, k0) do { const unsigned _ko = (unsigned)((k0) * ldk * 2) + kvo; sr_[i].vs0 = *reinterpret_cast<const bf16x8*>((const char*)Vh + _ko); sr_[i].vs1 = *reinterpret_cast<const bf16x8*>((const char*)Vh + (_ko + 64u * ldk)); \
    sr_[i].ks0 = *reinterpret_cast<const bf16x8*>((const char*)Kh + _ko); sr_[i].ks1 = *reinterpret_cast<const bf16x8*>((const char*)Kh + (_ko + 64u * ldk)); } while (0)
#define SWRITE(b, i) do { int sr_w = sr, sc_w = sc, v0_w = vst0, v1_w = vst1; \
    if (NA) { const int t_ = opaque_tid(); sr_w = t_ >> 4; sc_w = (t_ & 15) * 8; v0_w = v_st(sr_w, sc_w); v1_w = v_st(32 + sr_w, sc_w); }     \
    *(bf16x8*)(V_lds + (b) * SHM_V + v0_w) = sr_[i].vs0;          \
    *(bf16x8*)(V_lds + (b) * SHM_V + v1_w) = sr_[i].vs1; int kc = sc_w * 2;               \
    *(bf16x8*)(K_lds + (b) * SHM_K + KSWZ(sr_w, kc)) = sr_[i].ks0;                       \
    *(bf16x8*)(K_lds + (b) * SHM_K + KSWZ(32 + sr_w, kc)) = sr_[i].ks1; } while (0)
#define SWAIT() asm volatile("s_waitcnt vmcnt(4)" ::: "memory")
#define RESC(a) do { if (__any((a) < 1.f)) { if (hi == 0) al_l[r32] = (a); asm volatile("s_waitcnt lgkmcnt(0)" ::: "memory"); \
    _Pragma("unroll") for (int d = 0; d < 4; ++d) _Pragma("unroll") for (int r = 0; r < 16; ++r) o[d][r] *= al_l[crow(r, hi)]; } } while (0)
#define NAMASK(P0, P1, j) do { if (NA && (j) < nloc) { const int kr = bs + (j); const int t_ = opaque_tid(); \
    const int qrow = q0r + __builtin_amdgcn_readfirstlane(t_ >> 7), qcol = ((t_ >> 6) & 1) * 32 + (t_ & 31), hi_ = (t_ >> 5) & 1; \
    const int rstart = min(max(qrow - 4, 0), 56), cstart = min(max(qcol - 8, 0), 48); \
    if (kr >= rstart && kr < rstart + 8) { const float* bp = btab + (kr - qrow + 7) * 31 + (4 * hi_ - qcol + 15); const int cs = cstart - 4 * hi_; \
      _Pragma("unroll") for (int r = 0; r < 16; ++r) { const int kc = (r & 3) + 8 * (r >> 2); \
        P0[r] = ((unsigned)(kc - cs) < 16u) ? P0[r] + bp[kc] : -1e30f; P1[r] = ((unsigned)(kc + 32 - cs) < 16u) ? P1[r] + bp[kc + 32] : -1e30f; } } \
    else { _Pragma("unroll") for (int r = 0; r < 16; ++r) { P0[r] = -1e30f; P1[r] = -1e30f; } } } } while (0)
  f32x16 pA0, pA1, pB0, pB1; float mnA, mnB, alA, alB; bf16x8 pa0, pa1, pa2, pa3;
  constexpr int SE = 0, SO = 1;
  SLOAD(SE, KOFF(0)); asm volatile("s_waitcnt vmcnt(0)" ::: "memory"); SWRITE(0, SE); __syncthreads();
  qkt(pA0, pA1, K_lds, qr, r32, hi); NAMASK(pA0, pA1, 0); partialSM(pA0, pA1, m_reg, mnA, alA);
  SLOAD(SO, KOFF(1)); if (2 < NT) SLOAD(SE, KOFF(2));
  SWAIT(); SWRITE(1, SO); __syncthreads();
  for (int j = 1; j + 1 < NT; j += 2) {
    SBAR(); qkt(pB0, pB1, K_lds + SHM_K, qr, r32, hi); NAMASK(pB0, pB1, j);
    finishSM(pA0, pA1, alA, l_reg, pa0, pa1, pa2, pa3); SBAR();
    SLOAD(SO, KOFF(j + 2)); SBAR();
    pv_d0(o, vb0, pa0, pa1, pa2, pa3); partialSM(pB0, pB1, m_reg, mnB, alB);
    __syncthreads(); SWAIT(); SWRITE(0, SE);
    RESC(alB); __syncthreads();
    SBAR(); qkt(pA0, pA1, K_lds, qr, r32, hi); NAMASK(pA0, pA1, j + 1);
    finishSM(pB0, pB1, alB, l_reg, pa0, pa1, pa2, pa3); SBAR();
    if (j + 3 < NT) SLOAD(SE, KOFF(j + 3)); SBAR();
    pv_d0(o, vb0 + (int)SHM_V, pa0, pa1, pa2, pa3); partialSM(pA0, pA1, m_reg, mnA, alA);
    __syncthreads(); SWAIT(); SWRITE(1, SO);
    RESC(alA); __syncthreads();
  }
  SBAR(); qkt(pB0, pB1, K_lds + SHM_K, qr, r32, hi); NAMASK(pB0, pB1, NT - 1);
  finishSM(pA0, pA1, alA, l_reg, pa0, pa1, pa2, pa3); SBAR();
  pv_d0(o, vb0, pa0, pa1, pa2, pa3); partialSM(pB0, pB1, m_reg, mnB, alB);
  __syncthreads(); RESC(alB);
  finishSM(pB0, pB1, alB, l_reg, pa0, pa1, pa2, pa3); SBAR();
  pv_d0(o, vb0 + (int)SHM_V, pa0, pa1, pa2, pa3);
  if (hi == 0) li_l[r32] = l_reg; asm volatile("s_waitcnt lgkmcnt(0)" ::: "memory");
  float rli[16];
#pragma unroll
  for (int r = 0; r < 16; ++r) rli[r] = __builtin_amdgcn_rcpf(li_l[crow(r, hi)]);
  bf16_t* Ow = Ob + (wid * QBLK) * ldo + r32;
#pragma unroll
  for (int r = 0; r < 16; ++r) { const int orow = crow(r, hi);
#pragma unroll
    for (int d0 = 0; d0 < 4; ++d0) { const unsigned pk = cvt_pk_bf16(o[d0][r] * rli[r], 0.f); Ow[orow * ldo + d0 * 32] = (bf16_t)(pk & 0xffffu); } }
  __syncthreads();
#undef KOFF
#undef SLOAD
#undef SWRITE
#undef SWAIT
#undef RESC
#undef NAMASK
}
#undef KSWZ
#undef SBAR
}

#define XB_TMO      128
#define XB_XCNT(j)  (256  + 64 * (j))
#define XB_XSUB(j)  (1280 + 64 * (j))
#define XB_XGEN(j)  (2304 + 64 * (j))
#define XB_TOP      3328
#define XB_TOPGEN   3392
#define XCD_BAR_WORDS 3456
#define XB_SPIN_CAP (1u << 22)
__device__ __forceinline__ unsigned xb_ld(unsigned* p)              { return __hip_atomic_load(p, __ATOMIC_RELAXED, __HIP_MEMORY_SCOPE_AGENT); }
__device__ __forceinline__ unsigned xb_add(unsigned* p, unsigned v) { return __hip_atomic_fetch_add(p, v, __ATOMIC_RELAXED, __HIP_MEMORY_SCOPE_AGENT); }
__device__ __forceinline__ unsigned xb_xcc_id() { return (unsigned)__builtin_amdgcn_s_getreg((3 << 11) | 20) & 0xFu; }
#define XB_SPIN(cond, bar) do { unsigned _sp = 0; while (cond) { __builtin_amdgcn_s_sleep(1); \
    if ((++_sp & 255u) == 0u) { if (xb_ld(&(bar)[XB_TMO])) break; if (_sp > XB_SPIN_CAP) { atomicAdd(&(bar)[XB_TMO], 1u); break; } } } } while (0)
struct XcdBarrier { unsigned* bar; unsigned x; volatile LAS unsigned* st; };
__device__ __forceinline__ XcdBarrier xcd_barrier_post(unsigned* bar, volatile LAS unsigned* st) {
    XcdBarrier b; b.bar = bar; b.x = xb_xcc_id(); b.st = st;
    if (threadIdx.x == 0) (void)xb_add(&bar[XB_XCNT(b.x)], 1u);
    return b;
}
__device__ __forceinline__ void xcd_barrier_complete(unsigned* bar, unsigned x, unsigned& nloc, unsigned& nx) {
    const unsigned G = gridDim.x * gridDim.y * gridDim.z;
    unsigned sum, cnt, mine, sp = 0u;
    for (;;) {
        sum = 0u; cnt = 0u; mine = 0u;
#pragma unroll
        for (unsigned j = 0; j < 16; ++j) { const unsigned c = xb_ld(&bar[XB_XCNT(j)]); sum += c; cnt += (c > 0u) ? 1u : 0u; mine = (j == x) ? c : mine; }
        if (sum == G) break;
        __builtin_amdgcn_s_sleep(1);
        if ((++sp & 255u) == 0u) { if (xb_ld(&bar[XB_TMO])) break; if (sp > XB_SPIN_CAP) { atomicAdd(&bar[XB_TMO], 1u); break; } }
    }
    nloc = mine > 0u ? mine : 1u; nx = cnt > 0u ? cnt : 1u;
}
__device__ __forceinline__ void xcd_barrier(const XcdBarrier& b) {
    asm volatile("s_waitcnt vmcnt(0)" ::: "memory");
    __syncthreads();
    if (threadIdx.x == 0) {
        unsigned* bar = b.bar;
        __builtin_amdgcn_s_waitcnt(0);
        unsigned nloc = b.st[0], nx = b.st[1];
        if (nloc == 0u) { xcd_barrier_complete(bar, b.x, nloc, nx); b.st[0] = nloc; b.st[1] = nx; }
        const unsigned old = xb_add(&bar[XB_XSUB(b.x)], 1u);
        const unsigned gen = old / nloc;
        if (old + 1u == (gen + 1u) * nloc) {
            __builtin_amdgcn_fence(__ATOMIC_RELEASE, "agent");
            asm volatile("s_waitcnt vmcnt(0)" ::: "memory");
            const unsigned og = xb_add(&bar[XB_TOP], 1u);
            const unsigned tg = og / nx;
            if (og + 1u == (tg + 1u) * nx) xb_add(&bar[XB_TOPGEN], 1u);
            else XB_SPIN(xb_ld(&bar[XB_TOPGEN]) == tg, bar);
            __builtin_amdgcn_fence(__ATOMIC_ACQUIRE, "agent");
            xb_add(&bar[XB_XGEN(b.x)], 1u);
            asm volatile("s_waitcnt vmcnt(0)" ::: "memory");
        } else {
            XB_SPIN(xb_ld(&bar[XB_XGEN(b.x)]) == gen, bar);
            __builtin_amdgcn_fence(__ATOMIC_ACQUIRE, "agent");
            asm volatile("s_waitcnt vmcnt(0)" ::: "memory");
        }
    }
    __syncthreads();
}

enum { I_X = 0, I_C, I_CTX, I_CCTX, I_WMOD, I_BMOD, I_LN1G, I_LN1B, I_LN2G, I_LN2B, I_ABWIN, I_ABWF, I_ABQN, I_ABKN, I_ABWOUT, I_NAWIN, I_NARPB, I_NAWOUT,
       I_WR, I_EBIAS, I_WG, I_WU, I_WDN, I_SG, I_SU, I_SD, N_IN };
struct Args { const float* in[N_IN]; float* out; unsigned char* ws; int ph_lo, ph_hi; };
struct KA {
    __device__ __forceinline__ const __attribute__((address_space(4))) char* base() const { const __attribute__((address_space(4))) char* p = (const __attribute__((address_space(4))) char*)__builtin_amdgcn_kernarg_segment_ptr(); asm volatile("" : "+s"(p)); return p; }
    __device__ __forceinline__ const float* in(int i) const { return *(const float* const __attribute__((address_space(4)))*)(base() + 8 * i); }
    __device__ __forceinline__ float* out() const { return *(float* const __attribute__((address_space(4)))*)(base() + 8 * N_IN); }
    __device__ __forceinline__ int ph_lo() const { return *(const int __attribute__((address_space(4)))*)(base() + 8 * N_IN + 16); }
    __device__ __forceinline__ int ph_hi() const { return *(const int __attribute__((address_space(4)))*)(base() + 8 * N_IN + 20); }
    __device__ __forceinline__ unsigned char* ws() const { return *(unsigned char* const __attribute__((address_space(4)))*)(base() + 8 * N_IN + 8); }
};

__device__ __forceinline__ int tok_batchrow(int m) { return m < TLAT ? (m >> 12) : 4; }

__host__ __device__ __forceinline__ int rope_phys(int d) { const int hf = d >> 6, dd = d & 63, i = dd & 31, second = dd >> 5; return hf * 64 + (i >> 2) * 8 + second * 4 + (i & 3); }

template <class RowMap>
__device__ __forceinline__ void transpose_item(const float* W, int ldw, int k0, int n0, bf16_t* WT, int K, const RowMap& drow, LAS float* scr, int lane) {
#pragma unroll 8
    for (int i = 0; i < 32; ++i) { const int kk = 2 * i + (lane >> 5); scr[kk * 33 + (lane & 31)] = W[(size_t)(k0 + kk) * ldw + n0 + (lane & 31)]; }
    LDS_WAIT(); asm volatile("" ::: "memory");
    const int c = lane & 7;
#pragma unroll
    for (int j = 0; j < 4; ++j) { const int n = (lane >> 3) + 8 * j; const LAS float* s = scr + (8 * c) * 33 + n;
        u32x4 o; o.x = cvt_pk_bf16(s[0 * 33], s[1 * 33]); o.y = cvt_pk_bf16(s[2 * 33], s[3 * 33]); o.z = cvt_pk_bf16(s[4 * 33], s[5 * 33]); o.w = cvt_pk_bf16(s[6 * 33], s[7 * 33]);
        *(u32x4*)(WT + (size_t)drow(n0 + n) * K + k0 + 8 * c) = o; }
    LDS_WAIT(); asm volatile("" ::: "memory");
}
struct RowId { __device__ __forceinline__ int operator()(int n) const { return n; } };
struct RowGU { int which; __device__ __forceinline__ int operator()(int n) const { return (n >> 7) * 256 + which * 128 + (n & 127); } };
struct RowINE { __device__ __forceinline__ int operator()(int n) const { const int c = n - 256; return c < 1024 ? (c & ~127) + rope_phys(c & 127) : c; } };

__device__ __forceinline__ void p0_convert_weights(const KA& a, LAS unsigned char* lds, int gw, int NGW, int wave, int lane) {
    LAS float* scr = (LAS float*)(lds + wave * 8704);
    unsigned char* ws = a.ws();
    constexpr int N_GU = DEPTH * 65 * 2 * 128, N_DN = DEPTH * 65 * 128, N_INE = 2 * 640, N_INO = 2 * 1536, N_OUT = DEPTH * 512;
    constexpr int NITEMS = N_GU + N_DN + N_INE + N_INO + N_OUT;
    for (int it = gw; it < NITEMS; it += NGW) {
        int r = it;
        if (r < N_GU) { const int mat = r >> 7, item = r & 127, which = mat & 1, le = mat >> 1, l = le / 65, e = le % 65;
            const float* src = (e < 64) ? a.in(which ? I_WU : I_WG) + ((size_t)(l * 64 + e) * DM * EDIM) : a.in(which ? I_SU : I_SG) + (size_t)l * DM * EDIM;
            bf16_t* dst = (bf16_t*)(ws + WS_WGU) + (size_t)(l * 65 + e) * 512 * DM;
            transpose_item(src, EDIM, 64 * (item >> 3), 32 * (item & 7), dst, DM, RowGU{which}, scr, lane); continue; } r -= N_GU;
        if (r < N_DN) { const int le = r >> 7, item = r & 127, l = le / 65, e = le % 65;
            const float* src = (e < 64) ? a.in(I_WDN) + ((size_t)(l * 64 + e) * EDIM * DM) : a.in(I_SD) + (size_t)l * EDIM * DM;
            bf16_t* dst = (bf16_t*)(ws + WS_WD) + (size_t)(l * 65 + e) * DM * EDIM;
            transpose_item(src, DM, 64 * (item >> 5), 32 * (item & 31), dst, EDIM, RowId{}, scr, lane); continue; } r -= N_DN;
        if (r < N_INE) { const int j = r / 640, item = r % 640;
            transpose_item(a.in(I_ABWIN) + (size_t)j * DM * 1536, 1536, 64 * (item / 40), 256 + 32 * (item % 40), (bf16_t*)(ws + WS_WINE) + (size_t)j * 1280 * DM, DM, RowINE{}, scr, lane); continue; } r -= N_INE;
        if (r < N_INO) { const int j = r / 1536, item = r % 1536;
            transpose_item(a.in(I_NAWIN) + (size_t)j * DM * 3072, 3072, 64 * (item / 96), 32 * (item % 96), (bf16_t*)(ws + WS_WINO) + (size_t)j * 3072 * DM, DM, RowId{}, scr, lane); continue; } r -= N_INO;
        { const int l = r >> 9, item = r & 511;
            const float* src = ((l & 1) ? a.in(I_NAWOUT) : a.in(I_ABWOUT)) + (size_t)(l >> 1) * DM * DM;
            transpose_item(src, DM, 64 * (item >> 5), 32 * (item & 31), (bf16_t*)(ws + WS_WOUT) + (size_t)l * DM * DM, DM, RowId{}, scr, lane); }
    }
}

__device__ __forceinline__ void p0_mod(const KA& a, LAS unsigned char* lds, int bid, int G, int tid, int wave, int lane) {
    LAS float* sl = (LAS float*)(lds + 69632);
    LAS float* part = (LAS float*)(lds + 69632 + 20480);
    for (int i = tid; i < 5 * DM; i += 512) { const int r = i >> 10, k = i & 1023; const float v = (r < 4) ? a.in(I_C)[r * DM + k] : a.in(I_CCTX)[k]; sl[i] = v / (1.0f + __expf(-v)); }
    __syncthreads();
    float* mod = (float*)(a.ws() + WS_MOD);
    for (int task = bid; task < DEPTH * 96; task += G) {
        const int l = task / 96, c0 = (task % 96) * 64;
        const float* w = a.in(I_WMOD) + (size_t)l * DM * 6144 + c0 + lane;
        float acc[5] = {0.f, 0.f, 0.f, 0.f, 0.f};
#pragma unroll 8
        for (int k = wave * 128; k < wave * 128 + 128; ++k) { const float wv = w[(size_t)k * 6144];
#pragma unroll
            for (int r = 0; r < 5; ++r) acc[r] += sl[r * DM + k] * wv; }
#pragma unroll
        for (int r = 0; r < 5; ++r) part[(wave * 5 + r) * 64 + lane] = acc[r];
        __syncthreads();
        if (tid < 320) { const int r = tid >> 6, c = tid & 63; float s = a.in(I_BMOD)[l * 6144 + c0 + c];
#pragma unroll
            for (int w8 = 0; w8 < 8; ++w8) s += part[(w8 * 5 + r) * 64 + c];
            mod[((size_t)l * 5 + r) * 6144 + c0 + c] = s; }
        __syncthreads();
    }
}

__device__ __forceinline__ void p0_fourier_fold(const KA& a, LAS unsigned char* lds, int task, int tid, int wave, int lane) {
    const int j = task >> 3, q = (task >> 2) & 1, g = task & 3;
    LAS float* M = (LAS float*)(lds + 100352);
    const float* Wf = a.in(I_ABWF) + (size_t)(j * 4 + g) * 64 * 64;
    __syncthreads();
    for (int i = tid; i < 4096; i += 512) { const int c = i >> 6, d = i & 63; float s = 0.f;
        for (int m = 0; m < 64; ++m) { const float ang = (float)((m * c) & 63) * (1.0f / 32.0f); s += (q ? sinpif(ang) : cospif(ang)) * Wf[m * 64 + d]; }
        M[i] = s; }
    __syncthreads();
    float mcol[64];
#pragma unroll
    for (int c = 0; c < 64; ++c) mcol[c] = M[c * 64 + lane];
    bf16_t* dst = (bf16_t*)(a.ws() + WS_WF) + ((size_t)j * 512 + q * 256 + g * 64 + lane) * DM;
    const float* win = a.in(I_ABWIN) + (size_t)j * DM * 1536 + g * 64 + lane;
    for (int k = wave * 128; k < wave * 128 + 128; ++k) {
        const float wv = win[(size_t)k * 1536]; float s = 0.f;
#pragma unroll
        for (int c = 0; c < 64; ++c) s += __int_as_float(__builtin_amdgcn_readlane(__float_as_int(wv), c)) * mcol[c];
        dst[k] = (bf16_t)(cvt_pk_bf16(s, 0.f) & 0xffffu);
    }
}

__device__ __forceinline__ void p0_tables(const KA& a, LAS unsigned char* lds, int gtid, int NGT, int tid) {
    LAS float* ctab = (LAS float*)(lds + 116736);
    for (int i = tid; i < 4096; i += 512) ctab[i] = cospif((float)i * (1.0f / 2048.0f));
    __syncthreads();
    bf16_t* TW = (bf16_t*)(a.ws() + WS_TW);
    for (int it = gtid; it < 4096 * 1024; it += NGT) {
        const int k = it >> 10, c8 = (it & 1023) * 8, n0 = c8 & 4095, sh = (c8 >> 12) ? 1024 : 0; const float sg = (c8 >> 12) ? (-1.0f / 512.0f) : (1.0f / 512.0f);
        float v[8];
#pragma unroll
        for (int j = 0; j < 8; ++j) v[j] = ctab[(k * (n0 + j) - sh) & 4095] * sg;
        u32x4 o; o.x = cvt_pk_bf16(v[0], v[1]); o.y = cvt_pk_bf16(v[2], v[3]); o.z = cvt_pk_bf16(v[4], v[5]); o.w = cvt_pk_bf16(v[6], v[7]);
        *(u32x4*)(TW + (size_t)k * 8192 + c8) = o;
    }
    bf16_t* TWC = (bf16_t*)(a.ws() + WS_TWC);
    for (int it = gtid; it < 256 * 64; it += NGT) {
        const int k = it >> 6, c8 = (it & 63) * 8, n0 = c8 & 255, sh = (c8 >> 8) ? 1024 : 0; const float sg = (c8 >> 8) ? (-1.0f / 128.0f) : (1.0f / 128.0f);
        float v[8];
#pragma unroll
        for (int j = 0; j < 8; ++j) v[j] = ctab[(((k * (n0 + j)) & 255) * 16 - sh) & 4095] * sg;
        u32x4 o; o.x = cvt_pk_bf16(v[0], v[1]); o.y = cvt_pk_bf16(v[2], v[3]); o.z = cvt_pk_bf16(v[4], v[5]); o.w = cvt_pk_bf16(v[6], v[7]);
        *(u32x4*)(TWC + (size_t)k * 512 + c8) = o;
    }
    bf16_t* WH = (bf16_t*)(a.ws() + WS_WRHI); bf16_t* WL = (bf16_t*)(a.ws() + WS_WRLO);
    for (int it = gtid; it < DEPTH * 64 * DM; it += NGT) {
        const int l = it >> 16, e = (it >> 10) & 63, k = it & 1023; const float w = a.in(I_WR)[((size_t)l * DM + k) * 64 + e];
        const unsigned h = cvt_pk_bf16(w, 0.f) & 0xffffu; const float r = w - __uint_as_float(h << 16);
        WH[it] = (bf16_t)h; WL[it] = (bf16_t)(cvt_pk_bf16(r, 0.f) & 0xffffu);
    }
    float* gp = (float*)(a.ws() + WS_GAINP);
    for (int it = gtid; it < 2 * 2 * 128; it += NGT) { const int j = it >> 8, qk = (it >> 7) & 1, d = it & 127; gp[(j * 2 + qk) * 128 + rope_phys(d)] = a.in(qk ? I_ABKN : I_ABQN)[j * 128 + d]; }
    f32x2* rp = (f32x2*)(a.ws() + WS_ROPE);
    for (int it = gtid; it < 64 * 32; it += NGT) { const int pos = it >> 5, i = it & 31; const float inv = exp2f(-(float)i * (13.287712379549449f / 32.0f));
        const float ang = (float)pos * inv; rp[it] = (f32x2){cosf(ang), sinf(ang)}; }
}

__device__ __forceinline__ const float* xrow_in(const KA& a, int l, int m) {
    if (l == 0) return m < TLAT ? a.in(I_X) + (size_t)m * DM : a.in(I_CTX) + (size_t)(m - TLAT) * DM;
    return (const float*)(a.ws() + WS_XS) + (size_t)m * DM;
}
__device__ __forceinline__ void p0b_modulate(const KA& a, int gw, int NGW, int lane) {
    const float* mod = (const float*)(a.ws() + WS_MOD);
    bf16_t* H = (bf16_t*)(a.ws() + WS_H);
    for (int m = gw; m < TT; m += NGW) {
        const f32x4* xr = (const f32x4*)xrow_in(a, 0, m) + lane; const float* md = mod + (size_t)tok_batchrow(m) * 6144;
        u32x2* o = (u32x2*)(H + (size_t)m * DM) + lane;
#pragma unroll
        for (int j = 0; j < 4; ++j) { const f32x4 x = xr[64 * j], sh = *((const f32x4*)md + lane + 64 * j), sc = *((const f32x4*)(md + DM) + lane + 64 * j);
            const f32x4 h = x * (sc + 1.0f) + sh; o[64 * j] = (u32x2){cvt_pk_bf16(h[0], h[1]), cvt_pk_bf16(h[2], h[3])}; }
    }
}

__device__ __forceinline__ void phase_ln1_router(const KA& a, LAS unsigned char* lds, int l, int bid, int tid, int wave, int lane) {
    constexpr int AST = 1032;
    LAS bf16_t* Ahi = (LAS bf16_t*)lds; LAS bf16_t* Alo = (LAS bf16_t*)(lds + 32 * AST * 2);
    LAS float* lg = (LAS float*)(lds + 2 * 32 * AST * 2);
    LAS int* hist = (LAS int*)(lds + 2 * 32 * AST * 2 + 8192);
    LAS int* pend = hist + 128;
    const float* mod = (const float*)(a.ws() + WS_MOD) + (size_t)l * 5 * 6144;
    const float* lng = a.in(I_LN1G) + l * DM; const float* lnb = a.in(I_LN1B) + l * DM;
    const bf16_t* Y = (const bf16_t*)(a.ws() + WS_Y);
    float* XS = (float*)(a.ws() + WS_XS); bf16_t* H = (bf16_t*)(a.ws() + WS_H);
    const bf16_t* WH = (const bf16_t*)(a.ws() + WS_WRHI) + (size_t)l * 64 * DM; const bf16_t* WL = (const bf16_t*)(a.ws() + WS_WRLO) + (size_t)l * 64 * DM;
    int* tke = (int*)(a.ws() + WS_TKE); float* tkw = (float*)(a.ws() + WS_TKW); int* tkp = (int*)(a.ws() + WS_TKP); int* list = (int*)(a.ws() + WS_LIST);
    unsigned* cnt = (unsigned*)(a.ws() + WS_CTL) + CW_CNT + l * 64;
    const float ebias = a.in(I_EBIAS)[l * 64 + lane];
    if (tid < 64) hist[tid] = 0;
    __syncthreads();
    const int tok0 = bid * 68;
    for (int st = 0; st < 3; ++st) {
        const int s0 = st * 32, ns = (st < 2) ? 32 : 4;
        for (int r = wave; r < 32; r += 8) {
            LAS u32x2* ah = (LAS u32x2*)(Ahi + r * AST) + lane; LAS u32x2* al = (LAS u32x2*)(Alo + r * AST) + lane;
            if (r < ns) {
                const int m = tok0 + s0 + r; const float* md = mod + (size_t)tok_batchrow(m) * 6144;
                const f32x4* xr = (const f32x4*)xrow_in(a, l, m) + lane; const u32x2* yr = (const u32x2*)(Y + (size_t)m * DM) + lane;
                f32x4 v[4]; float s = 0.f;
#pragma unroll
                for (int j = 0; j < 4; ++j) { const f32x4 x = xr[64 * j], g1 = *((const f32x4*)(md + 2 * DM) + lane + 64 * j); const u32x2 yy = yr[64 * j];
                    const f32x4 y = {bf_lo(yy.x), bf_hi(yy.x), bf_lo(yy.y), bf_hi(yy.y)};
                    v[j] = x * DN_ALPHA + g1 * y; s += (v[j][0] + v[j][1]) + (v[j][2] + v[j][3]); }
                const float mean = wave_sum(s) * (1.0f / DM); float s2 = 0.f;
#pragma unroll
                for (int j = 0; j < 4; ++j) { v[j] = v[j] - mean; s2 += (v[j][0] * v[j][0] + v[j][1] * v[j][1]) + (v[j][2] * v[j][2] + v[j][3] * v[j][3]); }
                const float rstd = __builtin_amdgcn_rsqf(wave_sum(s2) * (1.0f / DM) + LN_EPS);
                f32x4* xo = (f32x4*)(XS + (size_t)m * DM) + lane; u32x2* ho = (u32x2*)(H + (size_t)m * DM) + lane;
#pragma unroll
                for (int j = 0; j < 4; ++j) { const f32x4 g = *((const f32x4*)lng + lane + 64 * j), bb = *((const f32x4*)lnb + lane + 64 * j);
                    const f32x4 x1 = v[j] * rstd * g + bb; xo[64 * j] = x1;
                    const f32x4 sh2 = *((const f32x4*)(md + 3 * DM) + lane + 64 * j), sc2 = *((const f32x4*)(md + 4 * DM) + lane + 64 * j);
                    const f32x4 h = x1 * (sc2 + 1.0f) + sh2;
                    const unsigned h01 = cvt_pk_bf16(h[0], h[1]), h23 = cvt_pk_bf16(h[2], h[3]);
                    ho[64 * j] = (u32x2){h01, h23}; ah[64 * j] = (u32x2){h01, h23};
                    al[64 * j] = (u32x2){cvt_pk_bf16(h[0] - bf_lo(h01), h[1] - bf_hi(h01)), cvt_pk_bf16(h[2] - bf_lo(h23), h[3] - bf_hi(h23))}; }
            } else {
#pragma unroll
                for (int j = 0; j < 4; ++j) { ah[64 * j] = (u32x2){0u, 0u}; al[64 * j] = (u32x2){0u, 0u}; }
            }
        }
        __syncthreads();
        {
            const int mt = wave >> 2, ntile = wave & 3, fr = lane & 15, fq = lane >> 4;
            const LAS bf16_t* pah = Ahi + (mt * 16 + fr) * AST + fq * 8; const LAS bf16_t* pal = Alo + (mt * 16 + fr) * AST + fq * 8;
            const bf16_t* pbh = WH + (size_t)(ntile * 16 + fr) * DM + fq * 8; const bf16_t* pbl = WL + (size_t)(ntile * 16 + fr) * DM + fq * 8;
            f32x4 acc = {0.f, 0.f, 0.f, 0.f};
#pragma unroll 4
            for (int ks = 0; ks < 32; ++ks) {
                const bf16x8 ahv = *(const LAS bf16x8*)(pah + ks * 32), alv = *(const LAS bf16x8*)(pal + ks * 32);
                const bf16x8 bhv = *(const bf16x8*)(pbh + ks * 32), blv = *(const bf16x8*)(pbl + ks * 32);
                acc = __builtin_amdgcn_mfma_f32_16x16x32_bf16(ahv, bhv, acc, 0, 0, 0);
                acc = __builtin_amdgcn_mfma_f32_16x16x32_bf16(ahv, blv, acc, 0, 0, 0);
                acc = __builtin_amdgcn_mfma_f32_16x16x32_bf16(alv, bhv, acc, 0, 0, 0);
            }
#pragma unroll
            for (int i = 0; i < 4; ++i) lg[(mt * 16 + fq * 4 + i) * 64 + ntile * 16 + fr] = acc[i];
        }
        __syncthreads();
        for (int r = wave; r < ns; r += 8) {
            const int m = tok0 + s0 + r;
            const float score = 1.0f / (1.0f + __expf(-lg[r * 64 + lane]));
            float sel = score + ebias; unsigned long long taken = 0ull;
#pragma unroll 1
            for (int k = 0; k < TOPK; ++k) { const float mx = wave_max(sel); const unsigned long long bal = __ballot(sel == mx); const int win = __ffsll((long long)bal) - 1;
                taken |= 1ull << win; if (lane == win) sel = -3.0e38f; }
            const bool mine = (taken >> lane) & 1ull;
            const float wsum = wave_sum(mine ? score : 0.f);
            if (mine) { const int k = __popcll(taken & ((1ull << lane) - 1ull)); const int lr = __hip_atomic_fetch_add(&hist[lane], 1, __ATOMIC_RELAXED, __HIP_MEMORY_SCOPE_WORKGROUP);
                tke[m * 8 + k] = lane; tkw[m * 8 + k] = score / wsum * ROUTE_SCALE; pend[(s0 + r) * 8 + k] = (lane << 16) | lr; }
        }
        __syncthreads();
    }
    if (tid < 64) hist[64 + tid] = (int)atomicAdd(&cnt[tid], (unsigned)hist[tid]);
    __syncthreads();
    for (int i = tid; i < 68 * 8; i += 512) { const int pe = pend[i], e = pe >> 16, p = hist[64 + e] + (pe & 0xffff); const int m = tok0 + (i >> 3);
        tkp[m * 8 + (i & 7)] = p; list[(size_t)e * TT + p] = m; }
}

__device__ __forceinline__ void phase_combine_ln2(const KA& a, LAS unsigned char* lds, int l, int gw, int NGW, int tid, int lane) {
    LAS int* rst = (LAS int*)(lds + LDS_TAB) + 66;
    const float* mod = (const float*)(a.ws() + WS_MOD) + (size_t)l * 5 * 6144;
    const float* lng = a.in(I_LN2G) + l * DM; const float* lnb = a.in(I_LN2B) + l * DM;
    const bf16_t* YB = (const bf16_t*)(a.ws() + WS_YB);
    float* XS = (float*)(a.ws() + WS_XS); bf16_t* H = (bf16_t*)(a.ws() + WS_H);
    const int* tke = (const int*)(a.ws() + WS_TKE); const float* tkw = (const float*)(a.ws() + WS_TKW); const int* tkp = (const int*)(a.ws() + WS_TKP);
    const int mend = (l == DEPTH - 1) ? TLAT : TT;
    for (int m = gw; m < mend; m += NGW) {
        const float* md = mod + (size_t)tok_batchrow(m) * 6144;
        int slot = 0; float w = 1.0f;
        if (lane < 8) { slot = rst[tke[m * 8 + lane]] + tkp[m * 8 + lane]; w = tkw[m * 8 + lane]; }
        if (lane == 8) slot = rst[64] + m;
        f32x4 ff[4];
#pragma unroll
        for (int j = 0; j < 4; ++j) ff[j] = (f32x4){0.f, 0.f, 0.f, 0.f};
#pragma unroll
        for (int k = 0; k < 9; ++k) { const int sk = __builtin_amdgcn_readlane(slot, k); const float wk = __int_as_float(__builtin_amdgcn_readlane(__float_as_int(w), k));
            const u32x2* yr = (const u32x2*)(YB + (size_t)sk * DM) + lane;
#pragma unroll
            for (int j = 0; j < 4; ++j) { const u32x2 yy = yr[64 * j]; ff[j] += (f32x4){bf_lo(yy.x), bf_hi(yy.x), bf_lo(yy.y), bf_hi(yy.y)} * wk; } }
        f32x4* xio = (f32x4*)(XS + (size_t)m * DM) + lane;
        f32x4 v[4]; float s = 0.f;
#pragma unroll
        for (int j = 0; j < 4; ++j) { const f32x4 g2 = *((const f32x4*)(md + 5 * DM) + lane + 64 * j);
            v[j] = xio[64 * j] * DN_ALPHA + g2 * ff[j]; s += (v[j][0] + v[j][1]) + (v[j][2] + v[j][3]); }
        const float mean = wave_sum(s) * (1.0f / DM); float s2 = 0.f;
#pragma unroll
        for (int j = 0; j < 4; ++j) { v[j] = v[j] - mean; s2 += (v[j][0] * v[j][0] + v[j][1] * v[j][1]) + (v[j][2] * v[j][2] + v[j][3] * v[j][3]); }
        const float rstd = __builtin_amdgcn_rsqf(wave_sum(s2) * (1.0f / DM) + LN_EPS);
        if (l == DEPTH - 1) {
            f32x4* oo = (f32x4*)(a.out() + (size_t)m * DM) + lane;
#pragma unroll
            for (int j = 0; j < 4; ++j) { const f32x4 g = *((const f32x4*)lng + lane + 64 * j), bb = *((const f32x4*)lnb + lane + 64 * j); oo[64 * j] = v[j] * rstd * g + bb; }
        } else {
            const float* mdn = md + 5 * 6144;
            u32x2* ho = (u32x2*)(H + (size_t)m * DM) + lane;
#pragma unroll
            for (int j = 0; j < 4; ++j) { const f32x4 g = *((const f32x4*)lng + lane + 64 * j), bb = *((const f32x4*)lnb + lane + 64 * j);
                const f32x4 x2 = v[j] * rstd * g + bb; xio[64 * j] = x2;
                const f32x4 sh = *((const f32x4*)mdn + lane + 64 * j), sc = *((const f32x4*)(mdn + DM) + lane + 64 * j);
                const f32x4 h = x2 * (sc + 1.0f) + sh; ho[64 * j] = (u32x2){cvt_pk_bf16(h[0], h[1]), cvt_pk_bf16(h[2], h[3])}; }
        }
    }
}

__device__ __forceinline__ void build_expert_tables(const KA& a, LAS unsigned char* lds, int l, int tid) {
    LAS int* tst = (LAS int*)(lds + LDS_TAB); LAS int* rst = tst + 66; LAS int* cn = rst + 66;
    __syncthreads();
    if (tid < 64) {
        const unsigned* cnt = (const unsigned*)(a.ws() + WS_CTL) + CW_CNT + l * 64;
        const int c = (int)__hip_atomic_load(cnt + tid, __ATOMIC_RELAXED, __HIP_MEMORY_SCOPE_AGENT);
        int t = (c + 255) >> 8, r = c;
#pragma unroll
        for (int o = 1; o < 64; o <<= 1) { const int t2 = __shfl_up(t, o), r2 = __shfl_up(r, o); if (tid >= o) { t += t2; r += r2; } }
        tst[tid] = t - ((c + 255) >> 8); rst[tid] = r - c; cn[tid] = c;
        if (tid == 63) { tst[64] = t; rst[64] = r; cn[64] = TT; tst[65] = t + (TT >> 8); rst[65] = r + TT; }
    }
    __syncthreads();
}

struct Seg {
    int i0, c, G, first, n;
    __device__ __forceinline__ void init(int first_, int n_, int c_, int G_) { first = first_; n = n_; c = c_; G = G_; i0 = (first_ <= c_) ? 0 : (first_ - c_ + G_ - 1) / G_; }
    __device__ __forceinline__ int idx(int i) const { const int L = (i0 + i) * G + c - first; return L < n ? L : -1; }
};
__device__ __forceinline__ int kv_row0(int pm) { return pm < 64 ? (pm >> 4) * KVR + (pm & 15) * 256 : (pm - 64) * KVR + LSEQ; }

struct SchedQKVE { Seg s; unsigned char* ws; int j;
    __device__ __forceinline__ bool next(int i, pg8::Unit& u) { const int L = s.idx(i); if (L < 0) return false; const int pm = L % 68, pn = L / 68;
        u.A = (const char*)(ws + WS_H) + (size_t)pm * 256 * 2048; u.B = (const char*)(ws + WS_WINE) + ((size_t)j * 1280 + pn * 256) * 2048; u.rows = nullptr; u.nvalid = 256;
        u.x1 = pm < 64 ? (pm & 15) * 256 : -1;
        if (pn < 3) { u.C = (char*)(ws + WS_QB) + ((size_t)pm * 256 * 768 + pn * 256) * 2; u.ldc = 768; u.x0 = 0; }
        else { u.C = (char*)(ws + (pn == 3 ? WS_KB : WS_VB)) + (size_t)kv_row0(pm) * 256 * 2; u.ldc = 256; u.x0 = pn - 2; }
        return true; } };
struct SchedFP { Seg s; unsigned char* ws; int j;
    __device__ __forceinline__ bool next(int i, pg8::Unit& u) { const int L = s.idx(i); if (L < 0) return false; u.rows = nullptr; u.nvalid = 256; u.x0 = 0; u.x1 = 0;
        if (L < 128) { const int q = L >> 6, mt = L & 63, b = mt >> 4;
            u.A = (const char*)(ws + WS_WF) + ((size_t)j * 512 + q * 256) * 2048; u.B = (const char*)(ws + WS_H) + (size_t)mt * 256 * 2048;
            u.C = (char*)(ws + WS_ZT) + ((size_t)b * 256 * 8192 + q * 4096 + (mt & 15) * 256) * 2; u.ldc = 8192; }
        else { const int q = (L - 128) >> 2, b = (L - 128) & 3;
            u.A = (const char*)(ws + WS_WF) + ((size_t)j * 512 + q * 256) * 2048; u.B = (const char*)(ws + WS_H) + (size_t)(TLAT + b * 256) * 2048;
            u.C = (char*)(ws + WS_ZCT) + ((size_t)b * 256 * 512 + q * 256) * 2; u.ldc = 512; }
        return true; } };
struct SchedQKVO { Seg s; unsigned char* ws; int j;
    __device__ __forceinline__ bool next(int i, pg8::Unit& u) { const int L = s.idx(i); if (L < 0) return false; const int pm = L % 68, pn = L / 68;
        u.A = (const char*)(ws + WS_H) + (size_t)pm * 256 * 2048; u.B = (const char*)(ws + WS_WINO) + ((size_t)j * 3072 + pn * 256) * 2048; u.rows = nullptr; u.nvalid = 256; u.x0 = 0; u.x1 = 0; u.ldc = 1024;
        if (pn < 4) u.C = (char*)(ws + WS_QB) + ((size_t)pm * 256 * 1024 + pn * 256) * 2;
        else u.C = (char*)(ws + (pn < 8 ? WS_KB : WS_VB)) + ((size_t)kv_row0(pm) * 1024 + (pn & 3) * 256) * 2;
        return true; } };
struct SchedDFT { Seg s; unsigned char* ws;
    __device__ __forceinline__ bool next(int i, pg8::Unit& u) { const int L = s.idx(i); if (L < 0) return false; const int pm = L & 15, b = L >> 4;
        u.A = (const char*)(ws + WS_TW) + (size_t)pm * 256 * 16384; u.B = (const char*)(ws + WS_ZT) + (size_t)b * 256 * 16384;
        u.C = (char*)(ws + WS_O) + (size_t)(b * LSEQ + pm * 256) * 1024 * 2; u.ldc = 1024; u.rows = nullptr; u.nvalid = 256; u.x0 = 0; u.x1 = 0; return true; } };
struct SchedDFTC { Seg s; unsigned char* ws;
    __device__ __forceinline__ bool next(int i, pg8::Unit& u) { const int b = s.idx(i); if (b < 0) return false;
        u.A = (const char*)(ws + WS_TWC); u.B = (const char*)(ws + WS_ZCT) + (size_t)b * 256 * 1024;
        u.C = (char*)(ws + WS_O) + (size_t)(TLAT + b * 256) * 1024 * 2; u.ldc = 1024; u.rows = nullptr; u.nvalid = 256; u.x0 = 0; u.x1 = 0; return true; } };
struct SchedOUT { Seg s; unsigned char* ws; int l;
    __device__ __forceinline__ bool next(int i, pg8::Unit& u) { const int L = s.idx(i); if (L < 0) return false; const int pm = L % 68, pn = L / 68;
        u.A = (const char*)(ws + WS_O) + (size_t)pm * 256 * 2048; u.B = (const char*)(ws + WS_WOUT) + ((size_t)l * 1024 + pn * 256) * 2048;
        u.C = (char*)(ws + WS_Y) + ((size_t)pm * 256 * 1024 + pn * 256) * 2; u.ldc = 1024; u.rows = nullptr; u.nvalid = 256; u.x0 = 0; u.x1 = 0; return true; } };
struct SchedGU { Seg s; unsigned char* ws; int l; const LAS int* tab; int e;
    __device__ __forceinline__ bool next(int i, pg8::Unit& u) { const int L = s.idx(i); if (L < 0) return false; const int mtg = L >> 1, nt = L & 1;
        while (tab[e + 1] <= mtg) ++e;
        while (tab[e] > mtg) --e;
        const int mt = mtg - tab[e], r0 = tab[66 + e] + mt * 256;
        u.A = (const char*)(ws + WS_H); u.rows = (const int*)(ws + WS_LIST) + (size_t)e * TT + mt * 256; u.nvalid = min(256, tab[132 + e] - mt * 256);
        u.B = (const char*)(ws + WS_WGU) + ((size_t)(l * 65 + e) * 512 + nt * 256) * 2048;
        u.C = (char*)(ws + WS_ACT) + ((size_t)r0 * 256 + nt * 128) * 2; u.ldc = 256; u.x0 = 0; u.x1 = 0; return true; } };
struct SchedDN { Seg s; unsigned char* ws; int l; const LAS int* tab; int e;
    __device__ __forceinline__ bool next(int i, pg8::Unit& u) { const int L = s.idx(i); if (L < 0) return false; const int mtg = L >> 2, nt = L & 3;
        while (tab[e + 1] <= mtg) ++e;
        while (tab[e] > mtg) --e;
        const int mt = mtg - tab[e], r0 = tab[66 + e] + mt * 256;
        u.A = (const char*)(ws + WS_ACT) + (size_t)r0 * 512; u.rows = nullptr; u.nvalid = min(256, tab[132 + e] - mt * 256);
        u.B = (const char*)(ws + WS_WD) + ((size_t)(l * 65 + e) * 1024 + nt * 256) * 512;
        u.C = (char*)(ws + WS_YB) + ((size_t)r0 * 1024 + nt * 256) * 2; u.ldc = 1024; u.x0 = 0; u.x1 = 0; return true; } };

constexpr int NPHASE = 2 + 7 * DEPTH;
#ifndef PHMASK
#define PHMASK 0xFFFFF
#endif
#define SITE(b) if constexpr ((PHMASK >> (b)) & 1)
__global__ void __launch_bounds__(512, 2) fwd(Args args_) {
    extern __shared__ __attribute__((aligned(16))) unsigned char lds_raw[];
    LAS unsigned char* lds = (LAS unsigned char*)lds_raw;
    const int bid = blockIdx.x, G = gridDim.x;
#define tid (opaque_tid())
#define lane (opaque_tid() & 63)
#define wave (__builtin_amdgcn_readfirstlane(opaque_tid() >> 6))
    const KA a;
#define WSP (a.ws())
#define args a
    volatile LAS unsigned* MISC = (volatile LAS unsigned*)(lds + LDS_MISC);
    { const int t0 = threadIdx.x; if (t0 < 64) MISC[t0] = 0u; }
    __syncthreads();
#define lo (a.ph_lo())
#define hi (a.ph_hi())
    XcdBarrier bar; bar.bar = (unsigned*)(WSP + WS_CTL) + CW_BAR; bar.x = 0; bar.st = MISC + 8;
    if (hi - lo > 1) bar = xcd_barrier_post((unsigned*)(WSP + WS_CTL) + CW_BAR, MISC + 8);
#define IN(k) (lo <= (k) && (k) < hi)
#define SEAM(k) do { if (IN(k) && IN((k) + 1)) xcd_barrier(bar); } while (0)
    const int NGW = G * 8;
#define gw (bid * 8 + wave)

    if (IN(0)) SITE(0) {
        p0_mod(args, lds, bid, G, tid, wave, lane);
        for (int task = bid; task < 16; task += G) p0_fourier_fold(args, lds, task, tid, wave, lane);
        p0_tables(args, lds, bid * 512 + tid, G * 512, tid);
        { int* ident = (int*)(WSP + WS_LIST) + (size_t)NEXP * TT; for (int i = bid * 512 + tid; i < TT; i += G * 512) ident[i] = i; }
        p0_convert_weights(args, lds, gw, NGW, wave, lane);
    }
    SEAM(0);
    if (IN(1)) SITE(0) p0b_modulate(args, gw, NGW, lane);
    SEAM(1);

    for (int l = 0; l < DEPTH; ++l) {
        const int pb = 2 + 7 * l, j = l >> 1;
        if (IN(pb + 0)) {
            if ((l & 1) == 0) {
                SITE(1) { SchedQKVE S; S.s.init(0, 340, bid, G); S.ws = WSP; S.j = j;
                  pg8::EpiQKVE E; E.P = (LAS float*)(lds + LDS_EPI); E.gainp = (const float*)(WSP + WS_GAINP) + j * 256; E.rope = (const f32x2*)(WSP + WS_ROPE);
                  pg8::gemm_phase<pg8::EpiQKVE, SchedQKVE, false>(lds, 1024, S, E); }
                SITE(2) { SchedFP S; S.s.init(340, 136, bid, G); S.ws = WSP; S.j = j; pg8::EpiStore E;
                  pg8::gemm_phase<pg8::EpiStore, SchedFP, false>(lds, 1024, S, E); }
            } else SITE(3) {
                SchedQKVO S; S.s.init(0, 816, bid, G); S.ws = WSP; S.j = j; pg8::EpiStore E;
                pg8::gemm_phase<pg8::EpiStore, SchedQKVO, false>(lds, 1024, S, E);
            }
        }
        SEAM(pb + 0);
        if (IN(pb + 1)) {
            const bf16_t* QB = (const bf16_t*)(WSP + WS_QB); const bf16_t* KB = (const bf16_t*)(WSP + WS_KB); const bf16_t* VB = (const bf16_t*)(WSP + WS_VB); bf16_t* O = (bf16_t*)(WSP + WS_O);
            if ((l & 1) == 0) {
                SITE(4) { SchedDFT S; S.s.init(0, 64, bid, G); S.ws = WSP; pg8::EpiStore E; pg8::gemm_phase<pg8::EpiStore, SchedDFT, false>(lds, 8192, S, E); }
                SITE(5) { SchedDFTC S; S.s.init(28, 4, bid, G); S.ws = WSP; pg8::EpiStore E; pg8::gemm_phase<pg8::EpiStore, SchedDFTC, false>(lds, 512, S, E); }
                __syncthreads();
                SITE(6) {
                    int u = (bid < 24) ? bid : (bid >= 64 ? bid - 40 : 408);
                    while (u < 408) {
                        const bf16_t *q, *k, *v; bf16_t* o; int ntile;
                        if (u < 24) { const int b = u / 6, h = u % 6; q = QB + (TLAT + b * 256) * 768 + h * 128; k = KB + (b * KVR + LSEQ) * 256 + (h / 3) * 128; v = VB + (b * KVR + LSEQ) * 256 + (h / 3) * 128;
                            o = O + (TLAT + b * 256) * 1024 + 256 + h * 128; ntile = 4; u = 408; }
                        else { const int uu = u - 24, bk = uu / 48, x = uu % 48, b = bk >> 1, kvh = bk & 1, h = kvh * 3 + x / 16, qb = x & 15;
                            q = QB + (b * LSEQ + qb * 256) * 768 + h * 128; k = KB + b * KVR * 256 + kvh * 128; v = VB + b * KVR * 256 + kvh * 128;
                            o = O + (b * LSEQ + qb * 256) * 1024 + 256 + h * 128; ntile = 68; u += 192; }
                        att::attn_body<false, 768, 256, 1024>(q, k, v, o, ntile, 0, 0, 0, (char*)lds_raw);
                    }
                }
            } else {
                const float* rpb = a.in(I_NARPB) + (size_t)j * 8 * 465;
                LAS float* bt = (LAS float*)(lds + att::LDS_BIAS);
                SITE(7) for (int u = bid; u < 544; u += G) {
                    const bf16_t *q, *k, *v; bf16_t* o; int ntile, nloc, bs, q0r, h;
                    if (u < 512) { const int bh = u >> 4, blk = u & 15, b = bh >> 3; h = bh & 7; bs = min(max(4 * blk - 4, 0), 52); q0r = 4 * blk; ntile = 16; nloc = 12;
                        q = QB + (b * LSEQ + blk * 256) * 1024 + h * 128; k = KB + b * KVR * 1024 + h * 128; v = VB + b * KVR * 1024 + h * 128; o = O + (b * LSEQ + blk * 256) * 1024 + h * 128; }
                    else { const int b = (u - 512) >> 3; h = u & 7; bs = 0; q0r = 0; ntile = 4; nloc = 0;
                        q = QB + (TLAT + b * 256) * 1024 + h * 128; k = KB + b * KVR * 1024 + h * 128; v = VB + b * KVR * 1024 + h * 128; o = O + (TLAT + b * 256) * 1024 + h * 128; }
                    for (int i = tid; i < 465; i += 512) bt[64 + i] = rpb[h * 465 + i] * (1.0f / ATT_SCALE);
                    att::attn_body<true, 1024, 1024, 1024>(q, k, v, o, ntile, nloc, bs, q0r, (char*)lds_raw);
                }
            }
        }
        SEAM(pb + 1);
        if (IN(pb + 2)) SITE(9) { SchedOUT S; S.s.init(0, 272, bid, G); S.ws = WSP; S.l = l; pg8::EpiStore E; pg8::gemm_phase<pg8::EpiStore, SchedOUT, false>(lds, 1024, S, E); }
        SEAM(pb + 2);
        if (IN(pb + 3)) SITE(10) phase_ln1_router(args, lds, l, bid, tid, wave, lane);
        SEAM(pb + 3);
        if (IN(pb + 4)) SITE(11) { build_expert_tables(args, lds, l, tid);
            const LAS int* tab = (const LAS int*)(lds + LDS_TAB);
            SchedGU S; S.s.init(0, tab[65] * 2, bid, G); S.ws = WSP; S.l = l; S.tab = tab; S.e = 0; pg8::EpiSwiGLU E;
            pg8::gemm_phase<pg8::EpiSwiGLU, SchedGU, true>(lds, 1024, S, E); }
        SEAM(pb + 4);
        if (IN(pb + 5)) SITE(12) { build_expert_tables(args, lds, l, tid);
            const LAS int* tab = (const LAS int*)(lds + LDS_TAB);
            SchedDN S; S.s.init(0, tab[65] * 4, bid, G); S.ws = WSP; S.l = l; S.tab = tab; S.e = 0; pg8::EpiStore E;
            int k256 = 256; asm volatile("" : "+s"(k256));
            pg8::gemm_phase<pg8::EpiStore, SchedDN, false>(lds, k256, S, E); }
        SEAM(pb + 5);
        if (IN(pb + 6)) SITE(13) { build_expert_tables(args, lds, l, tid); phase_combine_ln2(args, lds, l, gw, NGW, tid, lane); }
        SEAM(pb + 6);
    }
#undef IN
#undef SEAM
#undef lo
#undef hi
#undef lane
#undef wave
#undef gw
#undef tid
#undef WSP
#undef args
}

extern "C" void kernel_launch(void* const* d_in, const int* in_sizes, int n_in, void* d_out, int out_size, void* d_ws, size_t ws_size, hipStream_t stream) {
    static int ok = 0;
    if (ok == 0) {
        if (n_in != N_IN || ws_size < WS_END) { fprintf(stderr, "kernel_launch: n_in %d (want %d), ws %zu (want >= %zu)\n", n_in, (int)N_IN, ws_size, (size_t)WS_END); return; }
        if (hipFuncSetAttribute((const void*)fwd, hipFuncAttributeMaxDynamicSharedMemorySize, LDS_BYTES) != hipSuccess) { fprintf(stderr, "kernel_launch: hipFuncSetAttribute failed\n"); return; }
        int per_cu = 0;
        if (hipOccupancyMaxActiveBlocksPerMultiprocessor(&per_cu, (const void*)fwd, 512, LDS_BYTES) != hipSuccess || per_cu < 1) fprintf(stderr, "kernel_launch: occupancy query reports %d\n", per_cu);
        ok = 1;
    }
    Args a;
    memset(&a, 0, sizeof(a));
    for (int i = 0; i < N_IN; ++i) a.in[i] = (const float*)d_in[i];
    a.out = (float*)d_out; a.ws = (unsigned char*)d_ws;
    hipMemsetAsync((char*)d_ws + WS_CTL, 0, CTL_BYTES, stream);
#if MK_ONE_LAUNCH
    a.ph_lo = 0; a.ph_hi = NPHASE;
    hipLaunchKernelGGL(fwd, dim3(256), dim3(512), LDS_BYTES, stream, a);
#else
    for (int p = 0; p < NPHASE; ++p) { a.ph_lo = p; a.ph_hi = p + 1; hipLaunchKernelGGL(fwd, dim3(256), dim3(512), LDS_BYTES, stream, a); }
#endif
    const hipError_t le = hipPeekAtLastError();
    if (le != hipSuccess) fprintf(stderr, "kernel_launch: launch failed: %s\n", hipGetErrorName(le));
}
```

```cpp
#include <hip/hip_runtime.h>
#include <cstdio>
#include <cstdint>
#include <cstring>

#define LAS __attribute__((address_space(3)))
#define GAS __attribute__((address_space(1)))
typedef unsigned short bf16_t;
typedef short bf16x8 __attribute__((ext_vector_type(8)));
typedef short s16x4 __attribute__((ext_vector_type(4)));
typedef float f32x2 __attribute__((ext_vector_type(2)));
typedef float f32x4 __attribute__((ext_vector_type(4)));
typedef float f32x16 __attribute__((ext_vector_type(16)));
typedef unsigned u32x2 __attribute__((ext_vector_type(2)));
typedef unsigned u32x4 __attribute__((ext_vector_type(4)));

#ifndef MK_ONE_LAUNCH
#define MK_ONE_LAUNCH 1
#endif

constexpr int NB = 4, LSEQ = 4096, DM = 1024, NCTX = 256, DEPTH = 4;
constexpr int TLAT = NB * LSEQ, TCTX = NB * NCTX, TT = TLAT + TCTX;
constexpr int KVR = LSEQ + NCTX;
constexpr int NEXP = 64, TOPK = 8, EDIM = 256;
constexpr int NPAIR = TT * TOPK, NSLOT = NPAIR + TT;
constexpr float DN_ALPHA = 1.681792830507429f;
constexpr float LN_EPS = 1e-6f, RMS_EPS = 1e-6f, ROUTE_SCALE = 2.5f;
constexpr float ATT_SCALE = 0.088388347648318440f;

constexpr size_t al256(size_t x) { return (x + 255) / 256 * 256; }
constexpr size_t WS_CTL = 0, CTL_BYTES = 65536;
constexpr size_t WS_MOD = WS_CTL + CTL_BYTES;
constexpr size_t WS_GAINP = WS_MOD + al256((size_t)DEPTH * 5 * 6 * DM * 4);
constexpr size_t WS_ROPE = WS_GAINP + 2048;
constexpr size_t WS_WRHI = WS_ROPE + 16384;
constexpr size_t WS_WRLO = WS_WRHI + (size_t)DEPTH * 64 * DM * 2;
constexpr size_t WS_WF = WS_WRLO + (size_t)DEPTH * 64 * DM * 2;
constexpr size_t WS_WINE = WS_WF + (size_t)2 * 512 * DM * 2;
constexpr size_t WS_WINO = WS_WINE + (size_t)2 * 1280 * DM * 2;
constexpr size_t WS_WOUT = WS_WINO + (size_t)2 * 3072 * DM * 2;
constexpr size_t WS_WGU = WS_WOUT + (size_t)DEPTH * DM * DM * 2;
constexpr size_t WS_WD = WS_WGU + (size_t)DEPTH * 65 * 512 * DM * 2;
constexpr size_t WS_TW = WS_WD + (size_t)DEPTH * 65 * DM * 256 * 2;
constexpr size_t WS_TWC = WS_TW + (size_t)4096 * 8192 * 2;
constexpr size_t WS_XS = WS_TWC + (size_t)256 * 512 * 2;
constexpr size_t WS_H = WS_XS + (size_t)TT * DM * 4;
constexpr size_t WS_TKE = WS_H + (size_t)TT * DM * 2;
constexpr size_t WS_TKW = WS_TKE + (size_t)NPAIR * 4;
constexpr size_t WS_TKP = WS_TKW + (size_t)NPAIR * 4;
constexpr size_t WS_LIST = WS_TKP + (size_t)NPAIR * 4;
constexpr size_t WS_ACT = WS_LIST + (size_t)(NEXP + 1) * TT * 4;
constexpr size_t WS_YB = WS_ACT + (size_t)(NSLOT + 256) * EDIM * 2;
constexpr size_t WS_QB = WS_YB;
constexpr size_t WS_KB = WS_QB + (size_t)TT * DM * 2;
constexpr size_t WS_VB = WS_KB + (size_t)NB * KVR * DM * 2;
constexpr size_t WS_O = WS_VB + (size_t)NB * KVR * DM * 2;
constexpr size_t WS_Y = WS_O + (size_t)TT * DM * 2;
constexpr size_t WS_ZT = WS_Y + (size_t)TT * DM * 2;
constexpr size_t WS_ZCT = WS_ZT + (size_t)1024 * 8192 * 2;
constexpr size_t WS_OVL_END = WS_ZCT + (size_t)1024 * 512 * 2;
constexpr size_t WS_HL = WS_YB + (size_t)NSLOT * DM * 2;
constexpr size_t WS_END = WS_HL + (size_t)TT * DM * 2;
static_assert(WS_OVL_END <= WS_HL, "overlay fits in YB");
static_assert(WS_END <= (size_t)1 << 30, "workspace must fit 1 GiB");
constexpr int CW_TMO = 0, CW_CNT = 64  , CW_BAR = 1024;

constexpr int LDS_BYTES = 147456;
constexpr int LDS_STAGE = 0;
constexpr int LDS_EPI = 131072;
constexpr int LDS_RIDX = 139264;
constexpr int LDS_TAB = 141312;
constexpr int LDS_MISC = 147456 - 256;

__device__ __forceinline__ unsigned cvt_pk_bf16(float lo, float hi) { unsigned r; asm volatile("v_cvt_pk_bf16_f32 %0, %1, %2" : "=v"(r) : "v"(lo), "v"(hi)); return r; }
__device__ __forceinline__ float bf_lo(unsigned u) { return __uint_as_float(u << 16); }
__device__ __forceinline__ float bf_hi(unsigned u) { return __uint_as_float(u & 0xffff0000u); }
__device__ __forceinline__ float wave_sum(float v) {
#pragma unroll
    for (int o = 1; o < 64; o <<= 1) v += __shfl_xor(v, o);
    return v;
}
__device__ __forceinline__ float wave_max(float v) {
#pragma unroll
    for (int o = 1; o < 64; o <<= 1) v = fmaxf(v, __shfl_xor(v, o));
    return v;
}
#define LDS_WAIT() asm volatile("s_waitcnt lgkmcnt(0)" ::: "memory")
#define VM_WAIT() asm volatile("s_waitcnt vmcnt(0)" ::: "memory")

__device__ __forceinline__ int opaque_tid() { int t = threadIdx.x; asm volatile("" : "+v"(t)); return t; }
namespace pg8 {
constexpr int BM = 256, BK = 64, HALF = 128, HTB = HALF * BK * 2  , STAGE_BYTES = 8 * HTB;

__host__ __device__ __forceinline__ int lds_byte(int r, int c) { const int st = (r >> 4) * 2 + (c >> 5), rr = r & 15, cc = c & 31, ob = rr * 64 + cc * 2; return st * 1024 + (ob ^ (((ob >> 9) & 1) << 5)); }
__host__ __device__ __forceinline__ void stage_rc(int b, int& R, int& C) { const int st = b / 1024, sb = b % 1024, swz = sb ^ (((sb >> 9) & 1) << 5); R = (st >> 1) * 16 + swz / 64; C = (st & 1) * 32 + (swz % 64) / 2; }
__host__ __device__ __forceinline__ int perm32(int rho) { const int n = rho >> 4, i = rho & 15; return 8 * (i >> 2) + 4 * n + (i & 3); }

struct Unit { const char* A; const char* B; char* C; const int* rows; int ldc, nvalid, x0, x1; };

struct EpiStore {
    __device__ __forceinline__ void operator()(const f32x4 (&acc)[2][2][4][2], const Unit& u) const {
        const int tid = opaque_tid(), wid = tid >> 6, lane = tid & 63, wr = wid >> 2, wc = wid & 3, fr = lane & 15, fq = lane >> 4;
        const int row0 = wr * 64 + fr, col0 = wc * 32 + 8 * fq;
#pragma unroll
        for (int ai = 0; ai < 2; ++ai)
#pragma unroll
            for (int m = 0; m < 4; ++m) {
                const int r = row0 + ai * HALF + m * 16;
                if (r < u.nvalid) {
                    bf16_t* rowp = (bf16_t*)u.C + (size_t)r * u.ldc + col0;
#pragma unroll
                    for (int bj = 0; bj < 2; ++bj) { const f32x4 v0 = acc[ai][bj][m][0], v1 = acc[ai][bj][m][1];
                        u32x4 w; w.x = cvt_pk_bf16(v0[0], v0[1]); w.y = cvt_pk_bf16(v0[2], v0[3]); w.z = cvt_pk_bf16(v1[0], v1[1]); w.w = cvt_pk_bf16(v1[2], v1[3]);
                        *(u32x4*)(rowp + bj * HALF) = w; }
                }
            }
    }
};
constexpr float YB_SCALE = 32.0f;
struct EpiStoreF8 {
    __device__ __forceinline__ void operator()(const f32x4 (&acc)[2][2][4][2], const Unit& u) const {
        const int tid = opaque_tid(), wid = tid >> 6, lane = tid & 63, wr = wid >> 2, wc = wid & 3, fr = lane & 15, fq = lane >> 4;
        const int row0 = wr * 64 + fr, col0 = wc * 32 + 8 * fq;
#pragma unroll
        for (int ai = 0; ai < 2; ++ai)
#pragma unroll
            for (int m = 0; m < 4; ++m) {
                const int r = row0 + ai * HALF + m * 16;
                if (r < u.nvalid) {
                    unsigned char* rowp = (unsigned char*)u.C + (size_t)r * u.ldc + col0;
#pragma unroll
                    for (int bj = 0; bj < 2; ++bj) { const f32x4 v0 = acc[ai][bj][m][0] * YB_SCALE, v1 = acc[ai][bj][m][1] * YB_SCALE;
                        int w0 = 0, w1 = 0;
                        w0 = __builtin_amdgcn_cvt_pk_fp8_f32(v0[0], v0[1], w0, false); w0 = __builtin_amdgcn_cvt_pk_fp8_f32(v0[2], v0[3], w0, true);
                        w1 = __builtin_amdgcn_cvt_pk_fp8_f32(v1[0], v1[1], w1, false); w1 = __builtin_amdgcn_cvt_pk_fp8_f32(v1[2], v1[3], w1, true);
                        *(u32x2*)(rowp + bj * HALF) = (u32x2){(unsigned)w0, (unsigned)w1}; }
                }
            }
    }
};
struct EpiSwiGLU {
    __device__ __forceinline__ void operator()(const f32x4 (&acc)[2][2][4][2], const Unit& u) const {
        const int tid = opaque_tid(), wid = tid >> 6, lane = tid & 63, wr = wid >> 2, wc = wid & 3, fr = lane & 15, fq = lane >> 4;
        const int row0 = wr * 64 + fr, col0 = wc * 32 + 8 * fq;
#pragma unroll
        for (int ai = 0; ai < 2; ++ai)
#pragma unroll
            for (int m = 0; m < 4; ++m) {
                const int r = row0 + ai * HALF + m * 16;
                if (r < u.nvalid) {
                    float o[8];
#pragma unroll
                    for (int n = 0; n < 2; ++n)
#pragma unroll
                        for (int j = 0; j < 4; ++j) { const float g = acc[ai][0][m][n][j], up = acc[ai][1][m][n][j];
                            o[n * 4 + j] = g * __builtin_amdgcn_rcpf(1.0f + __builtin_amdgcn_exp2f(-1.4426950408889634f * g)) * up; }
                    u32x4 w; w.x = cvt_pk_bf16(o[0], o[1]); w.y = cvt_pk_bf16(o[2], o[3]); w.z = cvt_pk_bf16(o[4], o[5]); w.w = cvt_pk_bf16(o[6], o[7]);
                    *(u32x4*)((bf16_t*)u.C + (size_t)r * u.ldc + col0) = w;
                }
            }
    }
};
struct EpiQKVE {
    LAS float* P;
    const float* gainp;
    const f32x2* rope;
    __device__ __forceinline__ void operator()(const f32x4 (&acc)[2][2][4][2], const Unit& u) const {
        const int tid = opaque_tid(), wid = tid >> 6, lane = tid & 63, wr = wid >> 2, wc = wid & 3, fr = lane & 15, fq = lane >> 4;
        const int row0 = wr * 64 + fr, col0 = wc * 32 + 8 * fq;
        if (u.x0 == 2) {
#pragma unroll
            for (int ai = 0; ai < 2; ++ai)
#pragma unroll
                for (int m = 0; m < 4; ++m) { bf16_t* rowp = (bf16_t*)u.C + (size_t)(row0 + ai * HALF + m * 16) * u.ldc + col0;
#pragma unroll
                    for (int bj = 0; bj < 2; ++bj) { const f32x4 v0 = acc[ai][bj][m][0], v1 = acc[ai][bj][m][1];
                        u32x4 w; w.x = cvt_pk_bf16(v0[0], v0[1]); w.y = cvt_pk_bf16(v0[2], v0[3]); w.z = cvt_pk_bf16(v1[0], v1[1]); w.w = cvt_pk_bf16(v1[2], v1[3]);
                        *(u32x4*)(rowp + bj * HALF) = w; } }
            asm volatile("" ::: "memory"); __builtin_amdgcn_s_barrier(); asm volatile("" ::: "memory");
            return;
        }
#pragma unroll
        for (int ai = 0; ai < 2; ++ai)
#pragma unroll
            for (int m = 0; m < 4; ++m)
#pragma unroll
                for (int bj = 0; bj < 2; ++bj) { const f32x4 a = acc[ai][bj][m][0], b = acc[ai][bj][m][1];
                    float s = (a[0] * a[0] + a[1] * a[1]) + (a[2] * a[2] + a[3] * a[3]) + (b[0] * b[0] + b[1] * b[1]) + (b[2] * b[2] + b[3] * b[3]);
                    s += __shfl_xor(s, 16); s += __shfl_xor(s, 32);
                    if (fq == 0) P[(bj * 256 + row0 + ai * HALF + m * 16) * 4 + wc] = s; }
        asm volatile("s_waitcnt lgkmcnt(0)" ::: "memory"); __builtin_amdgcn_s_barrier(); asm volatile("" ::: "memory");
        const f32x4 g0 = *(const f32x4*)(gainp + u.x0 * 128 + col0), g1 = *(const f32x4*)(gainp + u.x0 * 128 + col0 + 4);
        const int half = wc >> 1, fi = ((wc & 1) * 4 + fq) * 4;
#pragma unroll
        for (int ai = 0; ai < 2; ++ai)
#pragma unroll
            for (int m = 0; m < 4; ++m) {
                const int r = row0 + ai * HALF + m * 16;
                int pos = 0;
                if (u.x1 >= 0) { const int t = u.x1 + r; pos = half ? (t & 63) : (t >> 6); }
                const f32x4 cs0 = *(const f32x4*)(rope + pos * 32 + fi), cs1 = *(const f32x4*)(rope + pos * 32 + fi + 2);
                const float cc[4] = {cs0[0], cs0[2], cs1[0], cs1[2]}, ss[4] = {cs0[1], cs0[3], cs1[1], cs1[3]};
                bf16_t* rowp = (bf16_t*)u.C + (size_t)r * u.ldc + col0;
#pragma unroll
                for (int bj = 0; bj < 2; ++bj) {
                    const f32x4 pp = *(const LAS f32x4*)(P + (bj * 256 + r) * 4);
                    const float rs = __builtin_amdgcn_rsqf(((pp[0] + pp[1]) + (pp[2] + pp[3])) * (1.0f / 128.0f) + RMS_EPS);
                    float o1[4], o2[4];
#pragma unroll
                    for (int j = 0; j < 4; ++j) { const float v1 = acc[ai][bj][m][0][j] * rs * g0[j], v2 = acc[ai][bj][m][1][j] * rs * g1[j];
                        o1[j] = v1 * cc[j] - v2 * ss[j]; o2[j] = v1 * ss[j] + v2 * cc[j]; }
                    u32x4 w; w.x = cvt_pk_bf16(o1[0], o1[1]); w.y = cvt_pk_bf16(o1[2], o1[3]); w.z = cvt_pk_bf16(o2[0], o2[1]); w.w = cvt_pk_bf16(o2[2], o2[3]);
                    *(u32x4*)(rowp + bj * HALF) = w;
                }
            }
    }
};

template <class Epi, class Sched, bool GATHER>
__device__ __forceinline__ void gemm_phase(LAS unsigned char* lds, const int K_, Sched& S, const Epi& E) {
    const int K = K_;
    const int tid = opaque_tid(), wid = __builtin_amdgcn_readfirstlane(tid >> 6), lane = tid & 63, wr = wid >> 2, wc = wid & 3, fr = lane & 15, fq = lane >> 4;
    const int nt = K / BK;
    Unit cur, nxt; int ui = 0;
    if (!S.next(0, cur)) return;
    unsigned voffB[2], offA[2][2];
#pragma unroll
    for (int i = 0; i < 2; ++i) { int R, C; stage_rc(tid * 16 + i * 8192, R, C); const int Rb = (R & ~31) + perm32(R & 31);
        voffB[i] = (unsigned)(Rb * K + C) * 2u; }
    LAS int* ridx = (LAS int*)(lds + LDS_RIDX);
    if (GATHER) {
        if (tid < 256) ridx[tid] = (tid < cur.nvalid) ? cur.rows[tid] : 0;
        __syncthreads();
#pragma unroll
        for (int h = 0; h < 2; ++h)
#pragma unroll
            for (int i = 0; i < 2; ++i) { int R, C; stage_rc(tid * 16 + i * 8192, R, C); offA[h][i] = (unsigned)ridx[h * HALF + R] * (unsigned)(K * 2) + (unsigned)C * 2u; }
    } else {
#pragma unroll
        for (int h = 0; h < 2; ++h)
#pragma unroll
            for (int i = 0; i < 2; ++i) { int R, C; stage_rc(tid * 16 + i * 8192, R, C); offA[h][i] = (unsigned)((h * HALF + R) * K + C) * 2u; }
    }
    const size_t kstep = (size_t)(BK * 2);
    const size_t hstep = (size_t)HALF * K * 2;
    const unsigned ldsw = (unsigned)wid * 1024u;
    const int aoff = lds_byte(wr * 64 + fr, fq * 8), boff = lds_byte(wc * 32 + fr, fq * 8);
#define PG8_SA(b, h) (((b) * 2 + (h)) * HTB)
#define PG8_SB(b, h) ((4 + (b) * 2 + (h)) * HTB)
#define PG8_STAGE(bufoff, gbase, voff) do { _Pragma("unroll") for (int _i = 0; _i < 2; ++_i) \
        __builtin_amdgcn_global_load_lds((const unsigned*)((const char*)(gbase) + (voff)[_i]), (LAS unsigned*)(lds + (bufoff) + ldsw + _i * 8192), 16, 0, 0); } while (0)
#define PG8_LDA(dst, b, h) do { _Pragma("unroll") for (int m = 0; m < 4; ++m) _Pragma("unroll") for (int k = 0; k < 2; ++k) dst[m][k] = *(const LAS bf16x8*)(lds + PG8_SA(b, h) + aoff + m * 2048 + k * 1024); } while (0)
#define PG8_LDB(dst, b, h) do { _Pragma("unroll") for (int n = 0; n < 2; ++n) _Pragma("unroll") for (int k = 0; k < 2; ++k) dst[n][k] = *(const LAS bf16x8*)(lds + PG8_SB(b, h) + boff + n * 2048 + k * 1024); } while (0)
#define PG8_MMA(ai, bj, At, Bt) do { __builtin_amdgcn_s_setprio(1); _Pragma("unroll") for (int m = 0; m < 4; ++m) _Pragma("unroll") for (int n = 0; n < 2; ++n) _Pragma("unroll") for (int k = 0; k < 2; ++k) \
        acc[ai][bj][m][n] = __builtin_amdgcn_mfma_f32_16x16x32_bf16(Bt[n][k], At[m][k], acc[ai][bj][m][n], 0, 0, 0); __builtin_amdgcn_s_setprio(0); } while (0)
#define PG8_WAIT_V(n) asm volatile("s_waitcnt vmcnt(" #n ")" ::: "memory")
#define PG8_WAIT_L(n) asm volatile("s_waitcnt lgkmcnt(" #n ")" ::: "memory")
#define PG8_BAR __builtin_amdgcn_s_barrier()
#define PG8_SCHED __builtin_amdgcn_sched_barrier(0)
    f32x4 acc[2][2][4][2];
#pragma unroll
    for (int a = 0; a < 2; ++a)
#pragma unroll
        for (int b = 0; b < 2; ++b)
#pragma unroll
            for (int m = 0; m < 4; ++m)
#pragma unroll
                for (int n = 0; n < 2; ++n) acc[a][b][m][n] = (f32x4){0.f, 0.f, 0.f, 0.f};
    bf16x8 At[4][2], B0[2][2], B1[2][2];
    const char* cA = cur.A; const char* cB = cur.B;
    PG8_STAGE(PG8_SB(0, 0), cB, voffB); PG8_STAGE(PG8_SA(0, 0), cA, offA[0]); PG8_STAGE(PG8_SB(0, 1), cB + hstep, voffB); PG8_STAGE(PG8_SA(0, 1), cA, offA[1]);
    if (wr == 1) PG8_BAR;
    PG8_WAIT_V(4); PG8_BAR;
    PG8_STAGE(PG8_SB(1, 0), cB + kstep, voffB); PG8_STAGE(PG8_SA(1, 0), cA + kstep, offA[0]); PG8_STAGE(PG8_SB(1, 1), cB + hstep + kstep, voffB);
    PG8_WAIT_V(6); PG8_BAR;
    for (;;) {
        const bool has_next = S.next(ui + 1, nxt);
        const char* nA = has_next ? nxt.A : cA; const char* nB = has_next ? nxt.B : cB;
        if (GATHER && has_next && wid < 4)
            __builtin_amdgcn_global_load_lds((const unsigned*)(nxt.rows + wid * 64 + lane), (LAS unsigned*)(lds + LDS_RIDX + ((ui + 1) & 1) * 1024 + wid * 256), 4, 0, 0);
        for (int t = 0; t < nt; t += 2) {
            const bool last = (t == nt - 2);
            const char* a1 = cA + (size_t)(t + 1) * kstep;
            const char* a2 = last ? nA : cA + (size_t)(t + 2) * kstep; const char* b2 = last ? nB : cB + (size_t)(t + 2) * kstep;
            const char* a3 = a2 + kstep; const char* b3 = b2 + kstep;
            PG8_LDB(B0, 0, 0); PG8_SCHED; PG8_LDA(At, 0, 0); PG8_STAGE(PG8_SA(1, 1), a1, offA[1]);
            PG8_WAIT_L(8); PG8_BAR; PG8_WAIT_L(0); PG8_MMA(0, 0, At, B0); PG8_BAR; PG8_SCHED;
            if (GATHER && last && has_next) {
                LAS int* rn = ridx + ((ui + 1) & 1) * 256;
#pragma unroll
                for (int h = 0; h < 2; ++h)
#pragma unroll
                    for (int i = 0; i < 2; ++i) { int R, C; stage_rc(tid * 16 + i * 8192, R, C); const int rr = h * HALF + R; const int tok = (rr < nxt.nvalid) ? rn[rr] : 0; offA[h][i] = (unsigned)tok * (unsigned)(K * 2) + (unsigned)C * 2u; }
            }
            PG8_LDB(B1, 0, 1); PG8_STAGE(PG8_SB(0, 0), b2, voffB);
            PG8_BAR; PG8_WAIT_L(0); PG8_MMA(0, 1, At, B1); PG8_BAR;
            PG8_LDA(At, 0, 1); PG8_STAGE(PG8_SA(0, 0), a2, offA[0]);
            PG8_BAR; PG8_WAIT_L(0); PG8_MMA(1, 0, At, B0); PG8_BAR; PG8_SCHED;
            PG8_STAGE(PG8_SB(0, 1), b2 + hstep, voffB);
            PG8_WAIT_V(6); PG8_BAR; PG8_MMA(1, 1, At, B1); PG8_BAR;
            PG8_LDB(B0, 1, 0); PG8_SCHED; PG8_LDA(At, 1, 0); PG8_STAGE(PG8_SA(0, 1), a2, offA[1]);
            PG8_WAIT_L(8); PG8_BAR; PG8_WAIT_L(0); PG8_MMA(0, 0, At, B0); PG8_BAR; PG8_SCHED;
            PG8_LDB(B1, 1, 1); PG8_STAGE(PG8_SB(1, 0), b3, voffB);
            PG8_BAR; PG8_WAIT_L(0); PG8_MMA(0, 1, At, B1); PG8_BAR;
            PG8_LDA(At, 1, 1); PG8_STAGE(PG8_SA(1, 0), a3, offA[0]);
            PG8_BAR; PG8_WAIT_L(0); PG8_MMA(1, 0, At, B0); PG8_BAR; PG8_SCHED;
            PG8_STAGE(PG8_SB(1, 1), b3 + hstep, voffB);
            PG8_WAIT_V(6); PG8_BAR; PG8_MMA(1, 1, At, B1); PG8_BAR;
        }
        { Unit eu; S.next(ui, eu); E(acc, eu); }
        if (!has_next) break;
#pragma unroll
        for (int a = 0; a < 2; ++a)
#pragma unroll
            for (int b = 0; b < 2; ++b)
#pragma unroll
                for (int m = 0; m < 4; ++m)
#pragma unroll
                    for (int n = 0; n < 2; ++n) acc[a][b][m][n] = (f32x4){0.f, 0.f, 0.f, 0.f};
        cur = nxt; cA = nA; cB = nB; ++ui;
    }
    PG8_WAIT_V(0);
    if (wr == 0) PG8_BAR;
    PG8_BAR;
#undef PG8_SA
#undef PG8_SB
#undef PG8_STAGE
#undef PG8_LDA
#undef PG8_LDB
#undef PG8_MMA
#undef PG8_WAIT_V
#undef PG8_WAIT_L
#undef PG8_BAR
#undef PG8_SCHED
}
}

namespace att {
constexpr int D = 128, NW = 8, QBLK = 32, KVBLK = 64;
constexpr float SCALE = ATT_SCALE;
constexpr float THR = 8.f;
constexpr float NEGM = -30000.f;
constexpr size_t SHM_V = KVBLK * D * 2, SHM_K = KVBLK * D * 2, SHM_ATTN = 2 * SHM_V + 2 * SHM_K + NW * 64 * 4;
constexpr int LDS_BIAS = 69632;
#define KSWZ(row, colB) ((row) * 256 + ((colB) ^ (((row) & 7) << 4)))
#define SBAR() __builtin_amdgcn_sched_barrier(0)
__device__ __forceinline__ int crow(int r, int hi) { return (r & 3) + 8 * (r >> 2) + 4 * hi; }

__device__ __forceinline__ void partialSM(f32x16& p0, f32x16& p1, float& m_reg, float& mn, float& alpha) {
  constexpr float C = SCALE * 1.4426950408889634f;
  float pmax = p0[0];
#pragma unroll
  for (int r = 1; r < 16; ++r) pmax = fmaxf(pmax, p0[r]);
#pragma unroll
  for (int r = 0; r < 16; ++r) pmax = fmaxf(pmax, p1[r]);
  { auto rr = __builtin_amdgcn_permlane32_swap(__float_as_uint(pmax), __float_as_uint(pmax), false, false);
    pmax = fmaxf(__uint_as_float(rr[0]), __uint_as_float(rr[1])); }
  if (__builtin_expect(__all(pmax - m_reg <= THR / SCALE), 1)) { mn = m_reg; alpha = 1.f; }
  else { mn = fmaxf(m_reg, pmax); alpha = __builtin_amdgcn_exp2f((m_reg - mn) * C); m_reg = mn; }
  float mnC = -mn * C;
#pragma unroll
  for (int r = 0; r < 16; ++r) p0[r] = fmaf(p0[r], C, mnC);
#pragma unroll
  for (int r = 0; r < 16; ++r) p1[r] = fmaf(p1[r], C, mnC);
#pragma unroll
  for (int r = 0; r < 16; ++r) p0[r] = __builtin_amdgcn_exp2f(p0[r]);
}
__device__ __forceinline__ void finishSM(f32x16& p0, f32x16& p1, float alpha, float& l_reg, bf16x8& pa0, bf16x8& pa1, bf16x8& pa2, bf16x8& pa3) {
#pragma unroll
  for (int r = 0; r < 16; ++r) p1[r] = __builtin_amdgcn_exp2f(p1[r]);
  float ps = 0;
#pragma unroll
  for (int r = 0; r < 16; ++r) ps += p0[r];
#pragma unroll
  for (int r = 0; r < 16; ++r) ps += p1[r];
  { auto rr = __builtin_amdgcn_permlane32_swap(__float_as_uint(ps), __float_as_uint(ps), false, false);
    ps = __uint_as_float(rr[0]) + __uint_as_float(rr[1]); }
  l_reg = l_reg * alpha + ps;
#define PK4(P, BASE, OUT) do { unsigned a0 = cvt_pk_bf16(P[BASE + 0], P[BASE + 1]), a1 = cvt_pk_bf16(P[BASE + 2], P[BASE + 3]);   \
    unsigned b0 = cvt_pk_bf16(P[BASE + 4], P[BASE + 5]), b1 = cvt_pk_bf16(P[BASE + 6], P[BASE + 7]);                              \
    auto r0 = __builtin_amdgcn_permlane32_swap(a0, b0, false, false); auto r1 = __builtin_amdgcn_permlane32_swap(a1, b1, false, false); \
    u32x4 w = {r0[0], r1[0], r0[1], r1[1]}; OUT = *reinterpret_cast<bf16x8*>(&w); } while (0)
  PK4(p0, 0, pa0); PK4(p0, 8, pa1); PK4(p1, 0, pa2); PK4(p1, 8, pa3);
#undef PK4
}
__device__ __forceinline__ void qkt(f32x16& p0, f32x16& p1, const char* Ks, const bf16x8* qr, int r32, int hi) {
  p0 = f32x16{}; p1 = f32x16{};
#pragma unroll
  for (int d0 = 0; d0 < 8; ++d0) { int cb = (d0 * 16 + hi * 8) * 2;
    bf16x8 b0 = *reinterpret_cast<const bf16x8*>(Ks + KSWZ(r32, cb));
    bf16x8 b1 = *reinterpret_cast<const bf16x8*>(Ks + KSWZ(32 + r32, cb));
    p0 = __builtin_amdgcn_mfma_f32_32x32x16_bf16(b0, qr[d0], p0, 0, 0, 0);
    p1 = __builtin_amdgcn_mfma_f32_32x32x16_bf16(b1, qr[d0], p1, 0, 0, 0); }
}
__device__ __forceinline__ int v_st(int k, int c) { const int kk = (k & ~0xC) | ((k & 4) << 1) | ((k & 8) >> 1); return ((kk >> 3) * 4 + (c >> 5)) * 512 + ((kk & 7) * 32 + (c & 31)) * 2; }
__device__ __forceinline__ int v_rd_base(int lane) { return ((lane & 3) << 3) | (((lane >> 2) & 3) << 6) | (((lane >> 4) & 1) << 5) | (((lane >> 5) & 1) << 8); }
constexpr int v_rd_off(int d0, int ks, int half) { return d0 * 512 + ks * 4096 + half * 2048; }
template <int OFF> __device__ __forceinline__ s16x4 tr_read(int vb) {
  s16x4 r; asm volatile("ds_read_b64_tr_b16 %0, %1 offset:%2" : "=&v"(r) : "v"(vb), "i"(OFF) : "memory"); return r;
}
template <int D0> __device__ __forceinline__ void pv_one(f32x16& od, int vb, bf16x8 pa0, bf16x8 pa1, bf16x8 pa2, bf16x8 pa3) {
  const s16x4 l0 = tr_read<v_rd_off(D0, 0, 0)>(vb), h0 = tr_read<v_rd_off(D0, 0, 1)>(vb), l1 = tr_read<v_rd_off(D0, 1, 0)>(vb), h1 = tr_read<v_rd_off(D0, 1, 1)>(vb);
  const s16x4 l2 = tr_read<v_rd_off(D0, 2, 0)>(vb), h2 = tr_read<v_rd_off(D0, 2, 1)>(vb), l3 = tr_read<v_rd_off(D0, 3, 0)>(vb), h3 = tr_read<v_rd_off(D0, 3, 1)>(vb);
  asm volatile("s_waitcnt lgkmcnt(0)" ::: "memory"); SBAR();
#define PK(L, H) (bf16x8){L[0], L[1], L[2], L[3], H[0], H[1], H[2], H[3]}
  od = __builtin_amdgcn_mfma_f32_32x32x16_bf16(pa0, PK(l0, h0), od, 0, 0, 0);
  od = __builtin_amdgcn_mfma_f32_32x32x16_bf16(pa1, PK(l1, h1), od, 0, 0, 0);
  od = __builtin_amdgcn_mfma_f32_32x32x16_bf16(pa2, PK(l2, h2), od, 0, 0, 0);
  od = __builtin_amdgcn_mfma_f32_32x32x16_bf16(pa3, PK(l3, h3), od, 0, 0, 0);
#undef PK
}
__device__ __forceinline__ void pv_d0(f32x16* o, int vb, bf16x8 pa0, bf16x8 pa1, bf16x8 pa2, bf16x8 pa3) {
  pv_one<0>(o[0], vb, pa0, pa1, pa2, pa3); pv_one<1>(o[1], vb, pa0, pa1, pa2, pa3); pv_one<2>(o[2], vb, pa0, pa1, pa2, pa3); pv_one<3>(o[3], vb, pa0, pa1, pa2, pa3);
}

template <bool NA, int ldq, int ldk, int ldo>
__device__ __forceinline__ void attn_body(const bf16_t* __restrict__ Qb, const bf16_t* __restrict__ Kh, const bf16_t* __restrict__ Vh,
                                          bf16_t* __restrict__ Ob, const int NT, const int nloc, const int bs, const int q0r, char* lds) {
  const int tid = opaque_tid(), wid = tid >> 6, lane = tid & 63, r32 = lane & 31, hi = lane >> 5;
  char* V_lds = lds; char* K_lds = lds + 2 * SHM_V;
  float* ws = (float*)(lds + 2 * SHM_V + 2 * SHM_K) + wid * 64; float* li_l = ws; float* al_l = ws + 32;
  float m_reg = -1e30f, l_reg = 0; f32x16 o[4] = {}; bf16x8 qr[8];
  const bf16_t* Qw = Qb + (wid * QBLK + r32) * ldq + hi * 8;
#pragma unroll
  for (int d0 = 0; d0 < 8; ++d0) qr[d0] = *reinterpret_cast<const bf16x8*>(Qw + d0 * 16);
  const int sr = tid >> 4, sc = (tid & 15) * 8, vst0 = v_st(sr, sc), vst1 = v_st(32 + sr, sc);
  const int vb0 = (int)(uintptr_t)V_lds + v_rd_base(lane);
  const unsigned kvo = (unsigned)(sr * ldk + sc) * 2u;
  const float* btab = (const float*)(lds + LDS_BIAS) + 64;
  struct { bf16x8 vs0, vs1, ks0, ks1; } sr_[2];
#define KOFF(j) (NA ? ((j) < nloc ? (bs + (j)) * 64 : LSEQ + ((j) - nloc) * 64) : (j) * 64)
#define SLOAD(i, k0) do { const unsigned _ko = (unsigned)((k0) * ldk * 2) + kvo; sr_[i].vs0 = *reinterpret_cast<const bf16x8*>((const char*)Vh + _ko); sr_[i].vs1 = *reinterpret_cast<const bf16x8*>((const char*)Vh + (_ko + 64u * ldk)); \
    sr_[i].ks0 = *reinterpret_cast<const bf16x8*>((const char*)Kh + _ko); sr_[i].ks1 = *reinterpret_cast<const bf16x8*>((const char*)Kh + (_ko + 64u * ldk)); } while (0)
#define SWRITE(b, i) do { int sr_w = sr, sc_w = sc, v0_w = vst0, v1_w = vst1; \
    if (NA) { const int t_ = opaque_tid(); sr_w = t_ >> 4; sc_w = (t_ & 15) * 8; v0_w = v_st(sr_w, sc_w); v1_w = v_st(32 + sr_w, sc_w); }     \
    *(bf16x8*)(V_lds + (b) * SHM_V + v0_w) = sr_[i].vs0;          \
    *(bf16x8*)(V_lds + (b) * SHM_V + v1_w) = sr_[i].vs1; int kc = sc_w * 2;               \
    *(bf16x8*)(K_lds + (b) * SHM_K + KSWZ(sr_w, kc)) = sr_[i].ks0;                       \
    *(bf16x8*)(K_lds + (b) * SHM_K + KSWZ(32 + sr_w, kc)) = sr_[i].ks1; } while (0)
#define SWAIT() asm volatile("s_waitcnt vmcnt(4)" ::: "memory")
#define RESC(a) do { if (__any((a) < 1.f)) { if (hi == 0) al_l[r32] = (a); asm volatile("s_waitcnt lgkmcnt(0)" ::: "memory"); \
    _Pragma("unroll") for (int d = 0; d < 4; ++d) _Pragma("unroll") for (int r = 0; r < 16; ++r) o[d][r] *= al_l[crow(r, hi)]; } } while (0)
#define NAMASK(P0, P1, j) do { if (NA && (j) < nloc) { const int kr = bs + (j); const int t_ = opaque_tid(); \
    const int qrow = q0r + __builtin_amdgcn_readfirstlane(t_ >> 7), qcol = ((t_ >> 6) & 1) * 32 + (t_ & 31), hi_ = (t_ >> 5) & 1; \
    const int rstart = min(max(qrow - 4, 0), 56), cstart = min(max(qcol - 8, 0), 48); \
    if (kr >= rstart && kr < rstart + 8) { const float* bp = btab + (kr - qrow + 7) * 31 + (4 * hi_ - qcol + 15); const int cs = cstart - 4 * hi_; \
      _Pragma("unroll") for (int r = 0; r < 16; ++r) { const int kc = (r & 3) + 8 * (r >> 2); \
        P0[r] = ((unsigned)(kc - cs) < 16u) ? P0[r] + bp[kc] : NEGM; P1[r] = ((unsigned)(kc + 32 - cs) < 16u) ? P1[r] + bp[kc + 32] : NEGM; } } \
    else { _Pragma("unroll") for (int r = 0; r < 16; ++r) { P0[r] = NEGM; P1[r] = NEGM; } } } } while (0)
  f32x16 pA0, pA1, pB0, pB1; float mnA, mnB, alA, alB; bf16x8 pa0, pa1, pa2, pa3;
  constexpr int SE = 0, SO = 1;
  SLOAD(SE, KOFF(0)); asm volatile("s_waitcnt vmcnt(0)" ::: "memory"); SWRITE(0, SE); __syncthreads();
  qkt(pA0, pA1, K_lds, qr, r32, hi); NAMASK(pA0, pA1, 0); partialSM(pA0, pA1, m_reg, mnA, alA);
  SLOAD(SO, KOFF(1)); if (2 < NT) SLOAD(SE, KOFF(2));
  SWAIT(); SWRITE(1, SO); __syncthreads();
  for (int j = 1; j + 1 < NT; j += 2) {
    SBAR(); qkt(pB0, pB1, K_lds + SHM_K, qr, r32, hi); NAMASK(pB0, pB1, j);
    finishSM(pA0, pA1, alA, l_reg, pa0, pa1, pa2, pa3); SBAR();
    SLOAD(SO, KOFF(j + 2)); SBAR();
    pv_d0(o, vb0, pa0, pa1, pa2, pa3); partialSM(pB0, pB1, m_reg, mnB, alB);
    __syncthreads(); SWAIT(); SWRITE(0, SE);
    RESC(alB); __syncthreads();
    SBAR(); qkt(pA0, pA1, K_lds, qr, r32, hi); NAMASK(pA0, pA1, j + 1);
    finishSM(pB0, pB1, alB, l_reg, pa0, pa1, pa2, pa3); SBAR();
    if (j + 3 < NT) SLOAD(SE, KOFF(j + 3)); SBAR();
    pv_d0(o, vb0 + (int)SHM_V, pa0, pa1, pa2, pa3); partialSM(pA0, pA1, m_reg, mnA, alA);
    __syncthreads(); SWAIT(); SWRITE(1, SO);
    RESC(alA); __syncthreads();
  }
  SBAR(); qkt(pB0, pB1, K_lds + SHM_K, qr, r32, hi); NAMASK(pB0, pB1, NT - 1);
  finishSM(pA0, pA1, alA, l_reg, pa0, pa1, pa2, pa3); SBAR();
  pv_d0(o, vb0, pa0, pa1, pa2, pa3); partialSM(pB0, pB1, m_reg, mnB, alB);
  __syncthreads(); RESC(alB);
  finishSM(pB0, pB1, alB, l_reg, pa0, pa1, pa2, pa3); SBAR();
  pv_d0(o, vb0 + (int)SHM_V, pa0, pa1, pa2, pa3);
  if (hi == 0) li_l[r32] = l_reg; asm volatile("s_waitcnt lgkmcnt(0)" ::: "memory");
  float rli[16];
#pragma unroll
  for (int r = 0; r < 16; ++r) rli[r] = __builtin_amdgcn_rcpf(li_l[crow(r, hi)]);
  bf16_t* Ow = Ob + (wid * QBLK) * ldo + r32;
#pragma unroll
  for (int r = 0; r < 16; ++r) { const int orow = crow(r, hi);
#pragma unroll
    for (int d0 = 0; d0 < 4; ++d0) { const unsigned pk = cvt_pk_bf16(o[d0][r] * rli[r], 0.f); Ow[orow * ldo + d0 * 32] = (bf16_t)(pk & 0xffffu); } }
  __syncthreads();
#undef KOFF
#undef SLOAD
#undef SWRITE
#undef SWAIT
#undef RESC
#undef NAMASK
}
#undef KSWZ
#undef SBAR
}

#define XB_TMO      128
#define XB_XCNT(j)  (256  + 64 * (j))
#define XB_XSUB(j)  (1280 + 64 * (j))
#define XB_XGEN(j)  (2304 + 64 * (j))
#define XB_TOP      3328
#define XB_TOPGEN   3392
#define XCD_BAR_WORDS 3456
#define XB_SPIN_CAP (1u << 22)
__device__ __forceinline__ unsigned xb_ld(unsigned* p)              { return __hip_atomic_load(p, __ATOMIC_RELAXED, __HIP_MEMORY_SCOPE_AGENT); }
__device__ __forceinline__ unsigned xb_add(unsigned* p, unsigned v) { return __hip_atomic_fetch_add(p, v, __ATOMIC_RELAXED, __HIP_MEMORY_SCOPE_AGENT); }
__device__ __forceinline__ unsigned xb_xcc_id() { return (unsigned)__builtin_amdgcn_s_getreg((3 << 11) | 20) & 0xFu; }
#define XB_SPIN(cond, bar) do { unsigned _sp = 0; while (cond) { __builtin_amdgcn_s_sleep(1); \
    if ((++_sp & 255u) == 0u) { if (xb_ld(&(bar)[XB_TMO])) break; if (_sp > XB_SPIN_CAP) { atomicAdd(&(bar)[XB_TMO], 1u); break; } } } } while (0)
struct XcdBarrier { unsigned* bar; unsigned x; volatile LAS unsigned* st; };
__device__ __forceinline__ XcdBarrier xcd_barrier_post(unsigned* bar, volatile LAS unsigned* st) {
    XcdBarrier b; b.bar = bar; b.x = xb_xcc_id(); b.st = st;
    if (threadIdx.x == 0) (void)xb_add(&bar[XB_XCNT(b.x)], 1u);
    return b;
}
__device__ __forceinline__ void xcd_barrier_complete(unsigned* bar, unsigned x, unsigned& nloc, unsigned& nx) {
    const unsigned G = gridDim.x * gridDim.y * gridDim.z;
    unsigned sum, cnt, mine, sp = 0u;
    for (;;) {
        sum = 0u; cnt = 0u; mine = 0u;
#pragma unroll
        for (unsigned j = 0; j < 16; ++j) { const unsigned c = xb_ld(&bar[XB_XCNT(j)]); sum += c; cnt += (c > 0u) ? 1u : 0u; mine = (j == x) ? c : mine; }
        if (sum == G) break;
        __builtin_amdgcn_s_sleep(1);
        if ((++sp & 255u) == 0u) { if (xb_ld(&bar[XB_TMO])) break; if (sp > XB_SPIN_CAP) { atomicAdd(&bar[XB_TMO], 1u); break; } }
    }
    nloc = mine > 0u ? mine : 1u; nx = cnt > 0u ? cnt : 1u;
}
__device__ __forceinline__ void xcd_barrier(const XcdBarrier& b) {
    asm volatile("s_waitcnt vmcnt(0)" ::: "memory");
    __syncthreads();
    if (threadIdx.x == 0) {
        unsigned* bar = b.bar;
        __builtin_amdgcn_s_waitcnt(0);
        unsigned nloc = b.st[0], nx = b.st[1];
        if (nloc == 0u) { xcd_barrier_complete(bar, b.x, nloc, nx); b.st[0] = nloc; b.st[1] = nx; }
        const unsigned old = xb_add(&bar[XB_XSUB(b.x)], 1u);
        const unsigned gen = old / nloc;
        if (old + 1u == (gen + 1u) * nloc) {
            __builtin_amdgcn_fence(__ATOMIC_RELEASE, "agent");
            asm volatile("s_waitcnt vmcnt(0)" ::: "memory");
            const unsigned og = xb_add(&bar[XB_TOP], 1u);
            const unsigned tg = og / nx;
            if (og + 1u == (tg + 1u) * nx) xb_add(&bar[XB_TOPGEN], 1u);
            else XB_SPIN(xb_ld(&bar[XB_TOPGEN]) == tg, bar);
            __builtin_amdgcn_fence(__ATOMIC_ACQUIRE, "agent");
            xb_add(&bar[XB_XGEN(b.x)], 1u);
            asm volatile("s_waitcnt vmcnt(0)" ::: "memory");
        } else {
            XB_SPIN(xb_ld(&bar[XB_XGEN(b.x)]) == gen, bar);
            __builtin_amdgcn_fence(__ATOMIC_ACQUIRE, "agent");
            asm volatile("s_waitcnt vmcnt(0)" ::: "memory");
        }
    }
    __syncthreads();
}

enum { I_X = 0, I_C, I_CTX, I_CCTX, I_WMOD, I_BMOD, I_LN1G, I_LN1B, I_LN2G, I_LN2B, I_ABWIN, I_ABWF, I_ABQN, I_ABKN, I_ABWOUT, I_NAWIN, I_NARPB, I_NAWOUT,
       I_WR, I_EBIAS, I_WG, I_WU, I_WDN, I_SG, I_SU, I_SD, N_IN };
struct Args { const float* in[N_IN]; float* out; unsigned char* ws; int ph_lo, ph_hi; };
struct KA {
    __device__ __forceinline__ const __attribute__((address_space(4))) char* base() const { const __attribute__((address_space(4))) char* p = (const __attribute__((address_space(4))) char*)__builtin_amdgcn_kernarg_segment_ptr(); asm volatile("" : "+s"(p)); return p; }
    __device__ __forceinline__ const float* in(int i) const { return *(const float* const __attribute__((address_space(4)))*)(base() + 8 * i); }
    __device__ __forceinline__ float* out() const { return *(float* const __attribute__((address_space(4)))*)(base() + 8 * N_IN); }
    __device__ __forceinline__ int ph_lo() const { return *(const int __attribute__((address_space(4)))*)(base() + 8 * N_IN + 16); }
    __device__ __forceinline__ int ph_hi() const { return *(const int __attribute__((address_space(4)))*)(base() + 8 * N_IN + 20); }
    __device__ __forceinline__ unsigned char* ws() const { return *(unsigned char* const __attribute__((address_space(4)))*)(base() + 8 * N_IN + 8); }
};

__device__ __forceinline__ int tok_batchrow(int m) { return m < TLAT ? (m >> 12) : 4; }

__host__ __device__ __forceinline__ int rope_phys(int d) { const int hf = d >> 6, dd = d & 63, i = dd & 31, second = dd >> 5; return hf * 64 + (i >> 2) * 8 + second * 4 + (i & 3); }

constexpr int CV_GU = 65 * 2 * 128, CV_DN = 65 * 128, CV_OUT = 512;
__host__ __device__ constexpr int cv_in(int l) { return (l & 1) ? 1536 : 640; }
__host__ __device__ constexpr int cv_items(int l) { return CV_GU + CV_DN + cv_in(l) + CV_OUT; }
struct CvItem { const float* src; bf16_t* dst; int ldw, K, k0, n0, kind, which; };
__device__ __forceinline__ int cv_row(const CvItem& d, int n) {
    if (d.kind == 1) return (n >> 7) * 256 + d.which * 128 + (n & 127);
    if (d.kind == 2) { const int c = n - 256; return c < 1024 ? (c & ~127) + rope_phys(c & 127) : c; }
    return n;
}
__device__ __forceinline__ CvItem cv_decode(const KA& a, int l, int it) {
    CvItem d; unsigned char* ws = a.ws(); const int j = l >> 1; int r = it; d.which = 0;
    if (r < CV_GU) { const int mat = r >> 7, item = r & 127, which = mat & 1, e = mat >> 1;
        d.src = (e < 64) ? a.in(which ? I_WU : I_WG) + ((size_t)(l * 64 + e) * DM * EDIM) : a.in(which ? I_SU : I_SG) + (size_t)l * DM * EDIM;
        d.dst = (bf16_t*)(ws + WS_WGU) + (size_t)(l * 65 + e) * 512 * DM; d.ldw = EDIM; d.K = DM; d.k0 = 64 * (item >> 3); d.n0 = 32 * (item & 7); d.kind = 1; d.which = which; return d; }
    r -= CV_GU;
    if (r < CV_DN) { const int e = r >> 7, item = r & 127;
        d.src = (e < 64) ? a.in(I_WDN) + ((size_t)(l * 64 + e) * EDIM * DM) : a.in(I_SD) + (size_t)l * EDIM * DM;
        d.dst = (bf16_t*)(ws + WS_WD) + (size_t)(l * 65 + e) * DM * EDIM; d.ldw = DM; d.K = EDIM; d.k0 = 64 * (item >> 5); d.n0 = 32 * (item & 31); d.kind = 0; return d; }
    r -= CV_DN;
    if (r < cv_in(l)) {
        if ((l & 1) == 0) { d.src = a.in(I_ABWIN) + (size_t)j * DM * 1536; d.dst = (bf16_t*)(ws + WS_WINE) + (size_t)j * 1280 * DM; d.ldw = 1536; d.K = DM; d.k0 = 64 * (r / 40); d.n0 = 256 + 32 * (r % 40); d.kind = 2; }
        else { d.src = a.in(I_NAWIN) + (size_t)j * DM * 3072; d.dst = (bf16_t*)(ws + WS_WINO) + (size_t)j * 3072 * DM; d.ldw = 3072; d.K = DM; d.k0 = 64 * (r / 96); d.n0 = 32 * (r % 96); d.kind = 0; }
        return d; }
    r -= cv_in(l);
    d.src = ((l & 1) ? a.in(I_NAWOUT) : a.in(I_ABWOUT)) + (size_t)j * DM * DM; d.dst = (bf16_t*)(ws + WS_WOUT) + (size_t)l * DM * DM; d.ldw = DM; d.K = DM; d.k0 = 64 * (r >> 5); d.n0 = 32 * (r & 31); d.kind = 0;
    return d;
}
__device__ __forceinline__ void cv_load(const CvItem& d, f32x4 (&v)[8], int lane) {
    const float* p = d.src + (size_t)(d.k0 + (lane >> 3)) * d.ldw + d.n0 + (lane & 7) * 4;
#pragma unroll
    for (int i = 0; i < 8; ++i) v[i] = *(const f32x4*)(p + (size_t)(8 * i) * d.ldw);
}
__device__ __forceinline__ void cv_store(const CvItem& d, const f32x4 (&v)[8], LAS float* scr, int lane) {
    { LAS float* w = scr + (lane >> 3) * 33 + (lane & 7) * 4;
#pragma unroll
      for (int i = 0; i < 8; ++i) { w[i * 8 * 33 + 0] = v[i][0]; w[i * 8 * 33 + 1] = v[i][1]; w[i * 8 * 33 + 2] = v[i][2]; w[i * 8 * 33 + 3] = v[i][3]; } }
    LDS_WAIT(); asm volatile("" ::: "memory");
    const int c = lane & 7;
#pragma unroll
    for (int j = 0; j < 4; ++j) { const int n = (lane >> 3) + 8 * j; const LAS float* s = scr + (8 * c) * 33 + n;
        u32x4 o; o.x = cvt_pk_bf16(s[0 * 33], s[1 * 33]); o.y = cvt_pk_bf16(s[2 * 33], s[3 * 33]); o.z = cvt_pk_bf16(s[4 * 33], s[5 * 33]); o.w = cvt_pk_bf16(s[6 * 33], s[7 * 33]);
        *(u32x4*)(d.dst + (size_t)cv_row(d, d.n0 + n) * d.K + d.k0 + 8 * c) = o; }
    LDS_WAIT(); asm volatile("" ::: "memory");
}
__device__ __forceinline__ void convert_items(LAS unsigned char* lds, int l, int lo, int hi, int worker, int nworkers) {
    const KA a;
    const int t_ = opaque_tid(), wave = __builtin_amdgcn_readfirstlane(t_ >> 6), lane = t_ & 63;
    LAS float* scr = (LAS float*)(lds + wave * 8704);
    int it = lo + worker;
    if (it >= hi) return;
    CvItem d0 = cv_decode(a, l, it); f32x4 v0[8]; cv_load(d0, v0, lane);
    for (;;) {
        const int itn = it + nworkers; const bool more = itn < hi;
        CvItem d1 = d0; f32x4 v1[8];
        if (more) { d1 = cv_decode(a, l, itn); cv_load(d1, v1, lane); }
        cv_store(d0, v0, scr, lane);
        if (!more) break;
        d0 = d1; it = itn;
#pragma unroll
        for (int i = 0; i < 8; ++i) v0[i] = v1[i];
    }
}
struct CvSlice { int l, i0, i1; };
#ifndef CV_MODE
#define CV_MODE 1
#endif
__device__ __forceinline__ CvSlice cv_slice(int l, int phase  ) {
    if (CV_MODE == 0) return {0, 0, 0};
    constexpr int n2 = cv_items(2);
    if (l == 0) { if (phase == 1) return {1, 0, cv_items(1)}; if (phase == 2) return {2, 0, 7000}; if (phase == 4) return {2, 7000, 14000}; if (phase == 5) return {2, 14000, 16500}; }
    if (l == 1) { if (phase == 2) return {2, 16500, 20500}; if (phase == 4) return {2, 20500, 24500}; if (phase == 5) return {2, 24500, n2}; }
    if (l == 2) { if (phase == 1) return {3, 0, cv_items(3)}; }
    return {0, 0, 0};
}
__device__ __forceinline__ void cv_tail(LAS unsigned char* lds, int l, int phase, int n_units, int bid, int G) {
    const CvSlice c = cv_slice(l, phase);
    if (c.i1 <= c.i0) return;
    const int rem = n_units % G, nw = (rem == 0) ? G : G - rem, w = (rem == 0) ? bid : bid - rem;
    if (w < 0) return;
    __syncthreads();
    convert_items(lds, c.l, c.i0, c.i1, w * 8 + __builtin_amdgcn_readfirstlane(opaque_tid() >> 6), nw * 8);
}

__device__ __forceinline__ void p0_mod(const KA& a, LAS unsigned char* lds, int bid, int G, int tid, int wave, int lane) {
    LAS float* sl = (LAS float*)(lds + 69632);
    LAS float* part = (LAS float*)(lds + 69632 + 20480);
    for (int i = tid; i < 5 * DM; i += 512) { const int r = i >> 10, k = i & 1023; const float v = (r < 4) ? a.in(I_C)[r * DM + k] : a.in(I_CCTX)[k]; sl[i] = v / (1.0f + __expf(-v)); }
    __syncthreads();
    float* mod = (float*)(a.ws() + WS_MOD);
    for (int task = bid; task < DEPTH * 96; task += G) {
        const int l = task / 96, c0 = (task % 96) * 64;
        const float* w = a.in(I_WMOD) + (size_t)l * DM * 6144 + c0 + lane;
        float acc[5] = {0.f, 0.f, 0.f, 0.f, 0.f};
#pragma unroll 8
        for (int k = wave * 128; k < wave * 128 + 128; ++k) { const float wv = w[(size_t)k * 6144];
#pragma unroll
            for (int r = 0; r < 5; ++r) acc[r] += sl[r * DM + k] * wv; }
#pragma unroll
        for (int r = 0; r < 5; ++r) part[(wave * 5 + r) * 64 + lane] = acc[r];
        __syncthreads();
        if (tid < 320) { const int r = tid >> 6, c = tid & 63; float s = a.in(I_BMOD)[l * 6144 + c0 + c];
#pragma unroll
            for (int w8 = 0; w8 < 8; ++w8) s += part[(w8 * 5 + r) * 64 + c];
            mod[((size_t)l * 5 + r) * 6144 + c0 + c] = s; }
        __syncthreads();
    }
}

__device__ __forceinline__ void p0_fourier_fold(const KA& a, LAS unsigned char* lds, int task, int tid, int wave, int lane) {
    const int j = task >> 3, q = (task >> 2) & 1, g = task & 3;
    LAS float* M = (LAS float*)(lds + 100352);
    const float* Wf = a.in(I_ABWF) + (size_t)(j * 4 + g) * 64 * 64;
    __syncthreads();
    for (int i = tid; i < 4096; i += 512) { const int c = i >> 6, d = i & 63; float s = 0.f;
        for (int m = 0; m < 64; ++m) { const float ang = (float)((m * c) & 63) * (1.0f / 32.0f); s += (q ? sinpif(ang) : cospif(ang)) * Wf[m * 64 + d]; }
        M[i] = s; }
    __syncthreads();
    float mcol[64];
#pragma unroll
    for (int c = 0; c < 64; ++c) mcol[c] = M[c * 64 + lane];
    bf16_t* dst = (bf16_t*)(a.ws() + WS_WF) + ((size_t)j * 512 + q * 256 + g * 64 + lane) * DM;
    const float* win = a.in(I_ABWIN) + (size_t)j * DM * 1536 + g * 64 + lane;
    for (int k = wave * 128; k < wave * 128 + 128; ++k) {
        const float wv = win[(size_t)k * 1536]; float s = 0.f;
#pragma unroll
        for (int c = 0; c < 64; ++c) s += __int_as_float(__builtin_amdgcn_readlane(__float_as_int(wv), c)) * mcol[c];
        dst[k] = (bf16_t)(cvt_pk_bf16(s, 0.f) & 0xffffu);
    }
}

__device__ __forceinline__ void p0_tables(const KA& a, LAS unsigned char* lds, int gtid, int NGT, int tid) {
    LAS float* ctab = (LAS float*)(lds + 116736);
    for (int i = tid; i < 4096; i += 512) ctab[i] = cospif((float)i * (1.0f / 2048.0f));
    __syncthreads();
    bf16_t* TW = (bf16_t*)(a.ws() + WS_TW);
    for (int it = gtid; it < 4096 * 1024; it += NGT) {
        const int k = it >> 10, c8 = (it & 1023) * 8, n0 = c8 & 4095, sh = (c8 >> 12) ? 1024 : 0; const float sg = (c8 >> 12) ? (-1.0f / 512.0f) : (1.0f / 512.0f);
        float v[8];
#pragma unroll
        for (int j = 0; j < 8; ++j) v[j] = ctab[(k * (n0 + j) - sh) & 4095] * sg;
        u32x4 o; o.x = cvt_pk_bf16(v[0], v[1]); o.y = cvt_pk_bf16(v[2], v[3]); o.z = cvt_pk_bf16(v[4], v[5]); o.w = cvt_pk_bf16(v[6], v[7]);
        *(u32x4*)(TW + (size_t)k * 8192 + c8) = o;
    }
    bf16_t* TWC = (bf16_t*)(a.ws() + WS_TWC);
    for (int it = gtid; it < 256 * 64; it += NGT) {
        const int k = it >> 6, c8 = (it & 63) * 8, n0 = c8 & 255, sh = (c8 >> 8) ? 1024 : 0; const float sg = (c8 >> 8) ? (-1.0f / 128.0f) : (1.0f / 128.0f);
        float v[8];
#pragma unroll
        for (int j = 0; j < 8; ++j) v[j] = ctab[(((k * (n0 + j)) & 255) * 16 - sh) & 4095] * sg;
        u32x4 o; o.x = cvt_pk_bf16(v[0], v[1]); o.y = cvt_pk_bf16(v[2], v[3]); o.z = cvt_pk_bf16(v[4], v[5]); o.w = cvt_pk_bf16(v[6], v[7]);
        *(u32x4*)(TWC + (size_t)k * 512 + c8) = o;
    }
    bf16_t* WH = (bf16_t*)(a.ws() + WS_WRHI); bf16_t* WL = (bf16_t*)(a.ws() + WS_WRLO);
    for (int it = gtid; it < DEPTH * 64 * DM; it += NGT) {
        const int l = it >> 16, e = (it >> 10) & 63, k = it & 1023; const float w = a.in(I_WR)[((size_t)l * DM + k) * 64 + e];
        const unsigned h = cvt_pk_bf16(w, 0.f) & 0xffffu; const float r = w - __uint_as_float(h << 16);
        WH[it] = (bf16_t)h; WL[it] = (bf16_t)(cvt_pk_bf16(r, 0.f) & 0xffffu);
    }
    float* gp = (float*)(a.ws() + WS_GAINP);
    for (int it = gtid; it < 2 * 2 * 128; it += NGT) { const int j = it >> 8, qk = (it >> 7) & 1, d = it & 127; gp[(j * 2 + qk) * 128 + rope_phys(d)] = a.in(qk ? I_ABKN : I_ABQN)[j * 128 + d]; }
    f32x2* rp = (f32x2*)(a.ws() + WS_ROPE);
    for (int it = gtid; it < 64 * 32; it += NGT) { const int pos = it >> 5, i = it & 31; const float inv = exp2f(-(float)i * (13.287712379549449f / 32.0f));
        const float ang = (float)pos * inv; rp[it] = (f32x2){cosf(ang), sinf(ang)}; }
}

__device__ __forceinline__ const float* xrow_in(const KA& a, int l, int m) {
    if (l == 0) return m < TLAT ? a.in(I_X) + (size_t)m * DM : a.in(I_CTX) + (size_t)(m - TLAT) * DM;
    return (const float*)(a.ws() + WS_XS) + (size_t)m * DM;
}
__device__ __forceinline__ void p0b_modulate(const KA& a, int gw, int NGW, int lane) {
    const float* mod = (const float*)(a.ws() + WS_MOD);
    bf16_t* H = (bf16_t*)(a.ws() + WS_H);
    for (int m = gw; m < TT; m += NGW) {
        const f32x4* xr = (const f32x4*)xrow_in(a, 0, m) + lane; const float* md = mod + (size_t)tok_batchrow(m) * 6144;
        u32x2* o = (u32x2*)(H + (size_t)m * DM) + lane;
#pragma unroll
        for (int j = 0; j < 4; ++j) { const f32x4 x = xr[64 * j], sh = *((const f32x4*)md + lane + 64 * j), sc = *((const f32x4*)(md + DM) + lane + 64 * j);
            const f32x4 h = x * (sc + 1.0f) + sh; o[64 * j] = (u32x2){cvt_pk_bf16(h[0], h[1]), cvt_pk_bf16(h[2], h[3])}; }
    }
}

__device__ __forceinline__ void phase_ln1_router(const KA& a, LAS unsigned char* lds, int l, int bid, int tid, int wave, int lane, const bool dry) {
    LAS float* lg = (LAS float*)lds;
    LAS int* hist = (LAS int*)(lds + 80 * 64 * 4);
    LAS int* pend = hist + 128;
    const float* mod = (const float*)(a.ws() + WS_MOD) + (size_t)l * 5 * 6144;
    const bf16_t* Y = (const bf16_t*)(a.ws() + WS_Y);
    float* XS = (float*)(a.ws() + (dry ? WS_ACT : WS_XS)); bf16_t* H = (bf16_t*)(a.ws() + (dry ? WS_YB + ((size_t)200 << 20) : WS_H)); bf16_t* HL = (bf16_t*)(a.ws() + (dry ? WS_YB + ((size_t)240 << 20) : WS_HL));
    if (tid < 64) hist[tid] = 0;
    const int NTOK = (l == DEPTH - 1) ? 64 : 68;
    const int tok0 = bid * NTOK;
    {
        f32x4 lng[4], lnb[4], g1[4], sc2[4], sh2[4];
        { const f32x4* pg = (const f32x4*)(a.in(I_LN1G) + l * DM) + lane; const f32x4* pb = (const f32x4*)(a.in(I_LN1B) + l * DM) + lane;
#pragma unroll
          for (int j = 0; j < 4; ++j) { lng[j] = pg[64 * j]; lnb[j] = pb[64 * j]; } }
        int cur_br = -1;
        f32x4 xn[4]; u32x2 yn[4];
        { const int m = tok0 + wave; const f32x4* xr = (const f32x4*)xrow_in(a, l, m) + lane; const u32x2* yr = (const u32x2*)(Y + (size_t)m * DM) + lane;
#pragma unroll
          for (int j = 0; j < 4; ++j) { xn[j] = xr[64 * j]; yn[j] = yr[64 * j]; } }
        for (int r = wave; r < NTOK; r += 8) {
            const int m = tok0 + r, br = tok_batchrow(m);
            if (br != cur_br) { cur_br = br; const float* md = mod + (size_t)br * 6144;
#pragma unroll
                for (int j = 0; j < 4; ++j) { g1[j] = *((const f32x4*)(md + 2 * DM) + lane + 64 * j); sh2[j] = *((const f32x4*)(md + 3 * DM) + lane + 64 * j); sc2[j] = *((const f32x4*)(md + 4 * DM) + lane + 64 * j) + 1.0f; } }
            f32x4 v[4]; float s = 0.f;
#pragma unroll
            for (int j = 0; j < 4; ++j) { const f32x4 y = {bf_lo(yn[j].x), bf_hi(yn[j].x), bf_lo(yn[j].y), bf_hi(yn[j].y)}; v[j] = xn[j] * DN_ALPHA + g1[j] * y; s += (v[j][0] + v[j][1]) + (v[j][2] + v[j][3]); }
            if (r + 8 < NTOK) { const int mn = m + 8; const f32x4* xr = (const f32x4*)xrow_in(a, l, mn) + lane; const u32x2* yr = (const u32x2*)(Y + (size_t)mn * DM) + lane;
#pragma unroll
                for (int j = 0; j < 4; ++j) { xn[j] = xr[64 * j]; yn[j] = yr[64 * j]; } }
            const float mean = wave_sum(s) * (1.0f / DM); float s2 = 0.f;
#pragma unroll
            for (int j = 0; j < 4; ++j) { v[j] = v[j] - mean; s2 += (v[j][0] * v[j][0] + v[j][1] * v[j][1]) + (v[j][2] * v[j][2] + v[j][3] * v[j][3]); }
            const float rstd = __builtin_amdgcn_rsqf(wave_sum(s2) * (1.0f / DM) + LN_EPS);
            f32x4* xo = (f32x4*)(XS + (size_t)m * DM) + lane; u32x2* ho = (u32x2*)(H + (size_t)m * DM) + lane; u32x2* hl = (u32x2*)(HL + (size_t)m * DM) + lane;
#pragma unroll
            for (int j = 0; j < 4; ++j) { const f32x4 x1 = v[j] * rstd * lng[j] + lnb[j]; xo[64 * j] = x1;
                const f32x4 h = x1 * sc2[j] + sh2[j];
                const unsigned h01 = cvt_pk_bf16(h[0], h[1]), h23 = cvt_pk_bf16(h[2], h[3]);
                ho[64 * j] = (u32x2){h01, h23};
                hl[64 * j] = (u32x2){cvt_pk_bf16(h[0] - bf_lo(h01), h[1] - bf_hi(h01)), cvt_pk_bf16(h[2] - bf_lo(h23), h[3] - bf_hi(h23))}; }
        }
    }
    VM_WAIT(); __syncthreads();
    __builtin_amdgcn_fence(__ATOMIC_ACQUIRE, "agent"); VM_WAIT();
    {
        const bf16_t* WH = (const bf16_t*)(a.ws() + WS_WRHI) + (size_t)l * 64 * DM; const bf16_t* WL = (const bf16_t*)(a.ws() + WS_WRLO) + (size_t)l * 64 * DM;
        const int ntile = wave & 3, mt0 = wave >> 2, fr = lane & 15, fq = lane >> 4;
        const bf16_t* pbh = WH + (size_t)(ntile * 16 + fr) * DM + fq * 8; const bf16_t* pbl = WL + (size_t)(ntile * 16 + fr) * DM + fq * 8;
        size_t ro[3];
#pragma unroll
        for (int i = 0; i < 3; ++i) ro[i] = (size_t)(tok0 + min((mt0 + 2 * i) * 16 + fr, NTOK - 1)) * DM + fq * 8;
        f32x4 acc[3];
#pragma unroll
        for (int i = 0; i < 3; ++i) acc[i] = (f32x4){0.f, 0.f, 0.f, 0.f};
#pragma unroll 4
        for (int ks = 0; ks < 32; ++ks) {
            const bf16x8 bhv = *(const bf16x8*)(pbh + ks * 32), blv = *(const bf16x8*)(pbl + ks * 32);
#pragma unroll
            for (int i = 0; i < 3; ++i) if (i < 2 || mt0 == 0) {
                const bf16x8 ahv = *(const bf16x8*)(H + ro[i] + ks * 32), alv = *(const bf16x8*)(HL + ro[i] + ks * 32);
                acc[i] = __builtin_amdgcn_mfma_f32_16x16x32_bf16(ahv, bhv, acc[i], 0, 0, 0);
                acc[i] = __builtin_amdgcn_mfma_f32_16x16x32_bf16(ahv, blv, acc[i], 0, 0, 0);
                acc[i] = __builtin_amdgcn_mfma_f32_16x16x32_bf16(alv, bhv, acc[i], 0, 0, 0); }
        }
#pragma unroll
        for (int i = 0; i < 3; ++i) if (i < 2 || mt0 == 0)
#pragma unroll
            for (int q = 0; q < 4; ++q) lg[((mt0 + 2 * i) * 16 + fq * 4 + q) * 64 + ntile * 16 + fr] = acc[i][q];
    }
    __syncthreads();
    {
        int* tke = (int*)(a.ws() + WS_TKE); float* tkw = (float*)(a.ws() + WS_TKW);
        const float ebias = a.in(I_EBIAS)[l * 64 + lane];
        for (int r = wave; r < NTOK; r += 8) {
            const int m = tok0 + r;
            const float score = 1.0f / (1.0f + __expf(-lg[r * 64 + lane]));
            const float sel = score + ebias; int rank = 0;
#pragma unroll
            for (int c = 0; c < 64; ++c) { const float o = __int_as_float(__builtin_amdgcn_readlane(__float_as_int(sel), c)); rank += (o > sel || (o == sel && c < lane)) ? 1 : 0; }
            const bool mine = rank < TOPK;
            const unsigned long long taken = __ballot(mine);
            const float wsum = wave_sum(mine ? score : 0.f);
            if (mine) { const int k = __popcll(taken & ((1ull << lane) - 1ull)); const int lr = __hip_atomic_fetch_add(&hist[lane], 1, __ATOMIC_RELAXED, __HIP_MEMORY_SCOPE_WORKGROUP);
                if (!dry) { tke[m * 8 + k] = lane; tkw[m * 8 + k] = score / wsum * ROUTE_SCALE; } pend[r * 8 + k] = (lane << 16) | lr; }
        }
    }
    __syncthreads();
    if (dry) return;
    { unsigned* cnt = (unsigned*)(a.ws() + WS_CTL) + CW_CNT + l * 64;
      if (tid < 64) hist[64 + tid] = (int)atomicAdd(&cnt[tid], (unsigned)hist[tid]); }
    __syncthreads();
    { int* tkp = (int*)(a.ws() + WS_TKP); int* list = (int*)(a.ws() + WS_LIST);
      for (int i = tid; i < NTOK * 8; i += 512) { const int pe = pend[i], e = pe >> 16, p = hist[64 + e] + (pe & 0xffff); const int m = tok0 + (i >> 3);
        tkp[m * 8 + (i & 7)] = p; list[(size_t)e * TT + p] = m; } }
    __syncthreads();
}

constexpr float YB_SCALE_G = 32.0f;
__device__ __forceinline__ void phase_combine_ln2(const KA& a, LAS unsigned char* lds, int l, int gw, int NGW, int tid, int lane, const bool dry) {
    LAS int* rst = (LAS int*)(lds + LDS_TAB) + 66;
    const float* mod = (const float*)(a.ws() + WS_MOD) + (size_t)l * 5 * 6144;
    const unsigned char* YB = (const unsigned char*)(a.ws() + WS_YB);
    const float* XSi = (const float*)(a.ws() + WS_XS); float* XS = (float*)(a.ws() + (dry ? WS_ACT : WS_XS)); bf16_t* H = (bf16_t*)(a.ws() + (dry ? WS_HL : WS_H));
    const int* tke = (const int*)(a.ws() + WS_TKE); const float* tkw = (const float*)(a.ws() + WS_TKW); const int* tkp = (const int*)(a.ws() + WS_TKP);
    const int mend = (l == DEPTH - 1) ? TLAT : TT;
    const int e0 = 16 * lane;
    f32x4 lng[4], lnb[4];
    { const f32x4* pg = (const f32x4*)(a.in(I_LN2G) + l * DM + e0); const f32x4* pb = (const f32x4*)(a.in(I_LN2B) + l * DM + e0);
#pragma unroll
      for (int j = 0; j < 4; ++j) { lng[j] = pg[j]; lnb[j] = pb[j]; } }
    float* outp = dry ? (float*)(a.ws() + WS_ACT) : a.out();
    for (int m0 = gw; m0 < mend; m0 += 2 * NGW) {
        int mm[2]; mm[0] = m0; mm[1] = (m0 + NGW < mend) ? m0 + NGW : m0;
        const bool two = (m0 + NGW < mend);
        int slot[2]; float w[2];
#pragma unroll
        for (int q = 0; q < 2; ++q) { slot[q] = 0; w[q] = 1.0f / YB_SCALE_G;
            if (lane < 8) { slot[q] = rst[tke[mm[q] * 8 + lane]] + tkp[mm[q] * 8 + lane]; w[q] = tkw[mm[q] * 8 + lane] * (1.0f / YB_SCALE_G); }
            if (lane == 8) slot[q] = rst[64] + mm[q]; }
        f32x4 ff[2][4]; f32x4 xv[2][4];
#pragma unroll
        for (int q = 0; q < 2; ++q) { const f32x4* xi = (const f32x4*)(XSi + (size_t)mm[q] * DM + e0);
#pragma unroll
            for (int j = 0; j < 4; ++j) { ff[q][j] = (f32x4){0.f, 0.f, 0.f, 0.f}; xv[q][j] = xi[j]; } }
        u32x4 yy[2][9];
#pragma unroll
        for (int k = 0; k < 9; ++k)
#pragma unroll
            for (int q = 0; q < 2; ++q) { const int sk = __builtin_amdgcn_readlane(slot[q], k); yy[q][k] = *(const u32x4*)(YB + (size_t)sk * DM + e0); }
#pragma unroll
        for (int k = 0; k < 9; ++k)
#pragma unroll
            for (int q = 0; q < 2; ++q) { const float wk = __int_as_float(__builtin_amdgcn_readlane(__float_as_int(w[q]), k));
#pragma unroll
                for (int j = 0; j < 4; ++j) { const f32x2 lo2 = __builtin_amdgcn_cvt_pk_f32_fp8((int)yy[q][k][j], false), hi2 = __builtin_amdgcn_cvt_pk_f32_fp8((int)yy[q][k][j], true);
                    ff[q][j] += (f32x4){lo2.x, lo2.y, hi2.x, hi2.y} * wk; } }
#pragma unroll
        for (int q = 0; q < 2; ++q) {
            if (q == 1 && !two) break;
            const int m = mm[q]; const float* md = mod + (size_t)tok_batchrow(m) * 6144;
            f32x4 v[4]; float s = 0.f;
#pragma unroll
            for (int j = 0; j < 4; ++j) { const f32x4 g2 = *((const f32x4*)(md + 5 * DM + e0) + j);
                v[j] = xv[q][j] * DN_ALPHA + g2 * ff[q][j]; s += (v[j][0] + v[j][1]) + (v[j][2] + v[j][3]); }
            const float mean = wave_sum(s) * (1.0f / DM); float s2 = 0.f;
#pragma unroll
            for (int j = 0; j < 4; ++j) { v[j] = v[j] - mean; s2 += (v[j][0] * v[j][0] + v[j][1] * v[j][1]) + (v[j][2] * v[j][2] + v[j][3] * v[j][3]); }
            const float rstd = __builtin_amdgcn_rsqf(wave_sum(s2) * (1.0f / DM) + LN_EPS);
            if (l == DEPTH - 1) {
                f32x4* oo = (f32x4*)(outp + (size_t)m * DM + e0);
#pragma unroll
                for (int j = 0; j < 4; ++j) oo[j] = v[j] * rstd * lng[j] + lnb[j];
            } else {
                const float* mdn = md + 5 * 6144;
                f32x4* xio = (f32x4*)(XS + (size_t)m * DM + e0); u32x4* ho = (u32x4*)(H + (size_t)m * DM + e0);
                unsigned hp[8];
#pragma unroll
                for (int j = 0; j < 4; ++j) { const f32x4 x2 = v[j] * rstd * lng[j] + lnb[j]; xio[j] = x2;
                    const f32x4 sh = *((const f32x4*)(mdn + e0) + j), sc = *((const f32x4*)(mdn + DM + e0) + j);
                    const f32x4 h = x2 * (sc + 1.0f) + sh; hp[2 * j] = cvt_pk_bf16(h[0], h[1]); hp[2 * j + 1] = cvt_pk_bf16(h[2], h[3]); }
                ho[0] = (u32x4){hp[0], hp[1], hp[2], hp[3]}; ho[1] = (u32x4){hp[4], hp[5], hp[6], hp[7]};
            }
        }
    }
}

__device__ __forceinline__ void build_expert_tables(const KA& a, LAS unsigned char* lds, int l, int tid) {
    LAS int* tst = (LAS int*)(lds + LDS_TAB); LAS int* rst = tst + 66; LAS int* cn = rst + 66;
    __syncthreads();
    if (tid < 64) {
        const unsigned* cnt = (const unsigned*)(a.ws() + WS_CTL) + CW_CNT + l * 64;
        const int c = (int)__hip_atomic_load(cnt + tid, __ATOMIC_RELAXED, __HIP_MEMORY_SCOPE_AGENT);
        int t = (c + 255) >> 8, r = c;
#pragma unroll
        for (int o = 1; o < 64; o <<= 1) { const int t2 = __shfl_up(t, o), r2 = __shfl_up(r, o); if (tid >= o) { t += t2; r += r2; } }
        tst[tid] = t - ((c + 255) >> 8); rst[tid] = r - c; cn[tid] = c;
        const int nsh = (l == DEPTH - 1) ? TLAT : TT;
        if (tid == 63) { tst[64] = t; rst[64] = r; cn[64] = nsh; tst[65] = t + (nsh >> 8); rst[65] = r + nsh; }
    }
    __syncthreads();
}

struct Seg {
    int i0, c, G, first, n;
    __device__ __forceinline__ void init(int first_, int n_, int c_, int G_) { first = first_; n = n_; c = c_; G = G_; i0 = (first_ <= c_) ? 0 : (first_ - c_ + G_ - 1) / G_; }
    __device__ __forceinline__ int idx(int i) const { const int L = (i0 + i) * G + c - first; return L < n ? L : -1; }
};
__device__ __forceinline__ int kv_row0(int pm) { return pm < 64 ? (pm >> 4) * KVR + (pm & 15) * 256 : (pm - 64) * KVR + LSEQ; }

struct SchedQKVE { Seg s; unsigned char* ws; int j;
    __device__ __forceinline__ bool next(int i, pg8::Unit& u) { const int L = s.idx(i); if (L < 0) return false; const int pm = L % 68, pn = L / 68;
        u.A = (const char*)(ws + WS_H) + (size_t)pm * 256 * 2048; u.B = (const char*)(ws + WS_WINE) + ((size_t)j * 1280 + pn * 256) * 2048; u.rows = nullptr; u.nvalid = 256;
        u.x1 = pm < 64 ? (pm & 15) * 256 : -1;
        if (pn < 3) { u.C = (char*)(ws + WS_QB) + ((size_t)pm * 256 * 768 + pn * 256) * 2; u.ldc = 768; u.x0 = 0; }
        else { u.C = (char*)(ws + (pn == 3 ? WS_KB : WS_VB)) + (size_t)kv_row0(pm) * 256 * 2; u.ldc = 256; u.x0 = pn - 2; }
        return true; } };
struct SchedFP { Seg s; unsigned char* ws; int j;
    __device__ __forceinline__ bool next(int i, pg8::Unit& u) { const int L = s.idx(i); if (L < 0) return false; u.rows = nullptr; u.nvalid = 256; u.x0 = 0; u.x1 = 0;
        if (L < 128) { const int q = L >> 6, mt = L & 63, b = mt >> 4;
            u.A = (const char*)(ws + WS_WF) + ((size_t)j * 512 + q * 256) * 2048; u.B = (const char*)(ws + WS_H) + (size_t)mt * 256 * 2048;
            u.C = (char*)(ws + WS_ZT) + ((size_t)b * 256 * 8192 + q * 4096 + (mt & 15) * 256) * 2; u.ldc = 8192; }
        else { const int q = (L - 128) >> 2, b = (L - 128) & 3;
            u.A = (const char*)(ws + WS_WF) + ((size_t)j * 512 + q * 256) * 2048; u.B = (const char*)(ws + WS_H) + (size_t)(TLAT + b * 256) * 2048;
            u.C = (char*)(ws + WS_ZCT) + ((size_t)b * 256 * 512 + q * 256) * 2; u.ldc = 512; }
        return true; } };
struct SchedQKVO { Seg s; unsigned char* ws; int j;
    __device__ __forceinline__ bool next(int i, pg8::Unit& u) { const int L = s.idx(i); if (L < 0) return false; const int pm = L % 68, pn = L / 68;
        u.A = (const char*)(ws + WS_H) + (size_t)pm * 256 * 2048; u.B = (const char*)(ws + WS_WINO) + ((size_t)j * 3072 + pn * 256) * 2048; u.rows = nullptr; u.nvalid = 256; u.x0 = 0; u.x1 = 0; u.ldc = 1024;
        if (pn < 4) u.C = (char*)(ws + WS_QB) + ((size_t)pm * 256 * 1024 + pn * 256) * 2;
        else u.C = (char*)(ws + (pn < 8 ? WS_KB : WS_VB)) + ((size_t)kv_row0(pm) * 1024 + (pn & 3) * 256) * 2;
        return true; } };
struct SchedDFT { Seg s; unsigned char* ws;
    __device__ __forceinline__ bool next(int i, pg8::Unit& u) { const int L = s.idx(i); if (L < 0) return false; const int pm = L & 15, b = L >> 4;
        u.A = (const char*)(ws + WS_TW) + (size_t)pm * 256 * 16384; u.B = (const char*)(ws + WS_ZT) + (size_t)b * 256 * 16384;
        u.C = (char*)(ws + WS_O) + (size_t)(b * LSEQ + pm * 256) * 1024 * 2; u.ldc = 1024; u.rows = nullptr; u.nvalid = 256; u.x0 = 0; u.x1 = 0; return true; } };
struct SchedDFTC { Seg s; unsigned char* ws;
    __device__ __forceinline__ bool next(int i, pg8::Unit& u) { const int b = s.idx(i); if (b < 0) return false;
        u.A = (const char*)(ws + WS_TWC); u.B = (const char*)(ws + WS_ZCT) + (size_t)b * 256 * 1024;
        u.C = (char*)(ws + WS_O) + (size_t)(TLAT + b * 256) * 1024 * 2; u.ldc = 1024; u.rows = nullptr; u.nvalid = 256; u.x0 = 0; u.x1 = 0; return true; } };
struct SchedOUT { Seg s; unsigned char* ws; int l, nm;
    __device__ __forceinline__ bool next(int i, pg8::Unit& u) { const int L = s.idx(i); if (L < 0) return false; const int pm = L % nm, pn = L / nm;
        u.A = (const char*)(ws + WS_O) + (size_t)pm * 256 * 2048; u.B = (const char*)(ws + WS_WOUT) + ((size_t)l * 1024 + pn * 256) * 2048;
        u.C = (char*)(ws + WS_Y) + ((size_t)pm * 256 * 1024 + pn * 256) * 2; u.ldc = 1024; u.rows = nullptr; u.nvalid = 256; u.x0 = 0; u.x1 = 0; return true; } };
struct SchedGU { Seg s; unsigned char* ws; int l; const LAS int* tab; int e;
    __device__ __forceinline__ bool next(int i, pg8::Unit& u) { const int L = s.idx(i); if (L < 0) return false; const int mtg = L >> 1, nt = L & 1;
        while (tab[e + 1] <= mtg) ++e;
        while (tab[e] > mtg) --e;
        const int mt = mtg - tab[e], r0 = tab[66 + e] + mt * 256;
        u.A = (const char*)(ws + WS_H); u.rows = (const int*)(ws + WS_LIST) + (size_t)e * TT + mt * 256; u.nvalid = min(256, tab[132 + e] - mt * 256);
        u.B = (const char*)(ws + WS_WGU) + ((size_t)(l * 65 + e) * 512 + nt * 256) * 2048;
        u.C = (char*)(ws + WS_ACT) + ((size_t)r0 * 256 + nt * 128) * 2; u.ldc = 256; u.x0 = 0; u.x1 = 0; return true; } };
struct SchedDN { Seg s; unsigned char* ws; int l; const LAS int* tab; int e; int probe;
    __device__ __forceinline__ bool next(int i, pg8::Unit& u) { const int L = s.idx(i); if (L < 0) return false; const int mtg = L >> 2, nt = L & 3;
        while (tab[e + 1] <= mtg) ++e;
        while (tab[e] > mtg) --e;
        const int mt = mtg - tab[e], r0 = tab[66 + e] + mt * 256;
        u.A = (const char*)(ws + WS_ACT) + (size_t)r0 * 512; u.rows = nullptr; u.nvalid = min(256, tab[132 + e] - mt * 256);
        u.B = (const char*)(ws + WS_WD) + ((size_t)(l * 65 + e) * 1024 + nt * 256) * 512;
        u.C = (char*)(ws + WS_YB) + ((size_t)r0 * 1024 + nt * 256); u.ldc = 1024; u.x0 = 0; u.x1 = 0;
        if (probe & 1) u.nvalid = 0;
        if (probe & 2) { u.A = (const char*)(ws + WS_ACT); u.B = (const char*)(ws + WS_WD) + (size_t)(l * 65) * 1024 * 512; }
        return true; } };

constexpr int NPHASE = 2 + 7 * DEPTH;
#ifndef PHMASK
#define PHMASK 0xFFFFF
#endif
#define SITE(b) if constexpr ((PHMASK >> (b)) & 1)
#ifndef REP_A
#define REP_A 1
#endif
#ifndef REP_B
#define REP_B 1
#endif
#ifndef REP_BO
#define REP_BO 1
#endif
#ifndef REP_C
#define REP_C 1
#endif
#ifndef REP_E
#define REP_E 1
#endif
#ifndef REP_F
#define REP_F 1
#endif
#ifndef REP_D
#define REP_D 1
#endif
#ifndef REP_G
#define REP_G 1
#endif
#ifndef REP_BAR
#define REP_BAR 1
#endif
#ifndef PROBE_F
#define PROBE_F 0
#endif
#ifndef REP_P0
#define REP_P0 1
#endif
__global__ void __launch_bounds__(512, 2) fwd(Args args_) {
    extern __shared__ __attribute__((aligned(16))) unsigned char lds_raw[];
    LAS unsigned char* lds = (LAS unsigned char*)lds_raw;
    const int G = gridDim.x, bid = ((G & 7) == 0) ? (int)(blockIdx.x & 7) * (G >> 3) + (int)(blockIdx.x >> 3) : (int)blockIdx.x;
#define tid (opaque_tid())
#define lane (opaque_tid() & 63)
#define wave (__builtin_amdgcn_readfirstlane(opaque_tid() >> 6))
    const KA a;
#define WSP (a.ws())
#define args a
    volatile LAS unsigned* MISC = (volatile LAS unsigned*)(lds + LDS_MISC);
    { const int t0 = threadIdx.x; if (t0 < 64) MISC[t0] = 0u; }
    __syncthreads();
#define lo (a.ph_lo())
#define hi (a.ph_hi())
    XcdBarrier bar; bar.bar = (unsigned*)(WSP + WS_CTL) + CW_BAR; bar.x = 0; bar.st = MISC + 8;
    if (hi - lo > 1) bar = xcd_barrier_post((unsigned*)(WSP + WS_CTL) + CW_BAR, MISC + 8);
#define IN(k) (lo <= (k) && (k) < hi)
#define SEAM(k) do { if (IN(k) && IN((k) + 1)) for (int rb = 0; rb < REP_BAR; ++rb) xcd_barrier(bar); } while (0)
    const int NGW = G * 8;
#define gw (bid * 8 + wave)

    if (IN(0)) SITE(0) for (int rep = 0; rep < REP_P0; ++rep) {
        __syncthreads();
        p0_mod(args, lds, bid, G, tid, wave, lane);
        for (int task = bid; task < 16; task += G) p0_fourier_fold(args, lds, task, tid, wave, lane);
        p0_tables(args, lds, bid * 512 + tid, G * 512, tid);
        { int* ident = (int*)(WSP + WS_LIST) + (size_t)NEXP * TT; for (int i = bid * 512 + tid; i < TT; i += G * 512) ident[i] = i; }
        convert_items(lds, 0, 0, cv_items(0), gw, NGW);
        if (CV_MODE == 0) for (int lq = 1; lq < DEPTH; ++lq) convert_items(lds, lq, 0, cv_items(lq), gw, NGW);
    }
    SEAM(0);
    if (IN(1)) SITE(0) p0b_modulate(args, gw, NGW, lane);
    SEAM(1);

    for (int l = 0; l < DEPTH; ++l) {
        const int pb = 2 + 7 * l, j = l >> 1;
        if (IN(pb + 0)) for (int rep = 0; rep < REP_A; ++rep) {
            if ((l & 1) == 0) {
                SITE(1) { SchedQKVE S; S.s.init(0, 340, bid, G); S.ws = WSP; S.j = j;
                  pg8::EpiQKVE E; E.P = (LAS float*)(lds + LDS_EPI); E.gainp = (const float*)(WSP + WS_GAINP) + j * 256; E.rope = (const f32x2*)(WSP + WS_ROPE);
                  pg8::gemm_phase<pg8::EpiQKVE, SchedQKVE, false>(lds, 1024, S, E); }
                SITE(2) { SchedFP S; S.s.init(340, 136, bid, G); S.ws = WSP; S.j = j; pg8::EpiStore E;
                  pg8::gemm_phase<pg8::EpiStore, SchedFP, false>(lds, 1024, S, E); }
            } else SITE(3) {
                SchedQKVO S; S.s.init(0, 816, bid, G); S.ws = WSP; S.j = j; pg8::EpiStore E;
                pg8::gemm_phase<pg8::EpiStore, SchedQKVO, false>(lds, 1024, S, E);
            }
        }
        SEAM(pb + 0);
        if (IN(pb + 1)) for (int rep = 0; rep < ((l & 1) ? REP_BO : REP_B); ++rep) {
            __syncthreads();
            const bf16_t* QB = (const bf16_t*)(WSP + WS_QB); const bf16_t* KB = (const bf16_t*)(WSP + WS_KB); const bf16_t* VB = (const bf16_t*)(WSP + WS_VB); bf16_t* O = (bf16_t*)(WSP + WS_O);
            if ((l & 1) == 0) {
                SITE(4) { SchedDFT S; S.s.init(0, 64, bid, G); S.ws = WSP; pg8::EpiStore E; pg8::gemm_phase<pg8::EpiStore, SchedDFT, false>(lds, 8192, S, E); }
                SITE(5) { SchedDFTC S; S.s.init(28, 4, bid, G); S.ws = WSP; pg8::EpiStore E; pg8::gemm_phase<pg8::EpiStore, SchedDFTC, false>(lds, 512, S, E); }
                __syncthreads();
                if (bid < 64 && rep == 0) { const CvSlice c = cv_slice(l, 1); if (c.i1 > c.i0) { __syncthreads(); convert_items(lds, c.l, c.i0, c.i1, bid * 8 + wave, 64 * 8); __syncthreads(); } }
                SITE(6) {
                    int u = (bid < 24) ? bid : (bid >= 64 ? bid - 40 : 408);
                    while (u < 408) {
                        const bf16_t *q, *k, *v; bf16_t* o; int ntile;
                        if (u < 24) { const int b = u / 6, h = u % 6; q = QB + (TLAT + b * 256) * 768 + h * 128; k = KB + (b * KVR + LSEQ) * 256 + (h / 3) * 128; v = VB + (b * KVR + LSEQ) * 256 + (h / 3) * 128;
                            o = O + (TLAT + b * 256) * 1024 + 256 + h * 128; ntile = 4; u = 408; }
                        else { const int uu = u - 24, bk = uu / 48, x = uu % 48, b = bk >> 1, kvh = bk & 1, h = kvh * 3 + x / 16, qb = x & 15;
                            q = QB + (b * LSEQ + qb * 256) * 768 + h * 128; k = KB + b * KVR * 256 + kvh * 128; v = VB + b * KVR * 256 + kvh * 128;
                            o = O + (b * LSEQ + qb * 256) * 1024 + 256 + h * 128; ntile = 68; u += 192; }
                        att::attn_body<false, 768, 256, 1024>(q, k, v, o, ntile, 0, 0, 0, (char*)lds_raw);
                    }
                }
            } else {
                const float* rpb = a.in(I_NARPB) + (size_t)j * 8 * 465;
                LAS float* bt = (LAS float*)(lds + att::LDS_BIAS);
                SITE(7) for (int u = bid; u < ((l == DEPTH - 1) ? 512 : 544); u += G) {
                    const bf16_t *q, *k, *v; bf16_t* o; int ntile, nloc, bs, q0r, h;
                    if (u < 512) { const int bh = u >> 4, blk = u & 15, b = bh >> 3; h = bh & 7; bs = min(max(4 * blk - 4, 0), 52); q0r = 4 * blk; ntile = 16; nloc = 12;
                        q = QB + (b * LSEQ + blk * 256) * 1024 + h * 128; k = KB + b * KVR * 1024 + h * 128; v = VB + b * KVR * 1024 + h * 128; o = O + (b * LSEQ + blk * 256) * 1024 + h * 128; }
                    else { const int b = (u - 512) >> 3; h = u & 7; bs = 0; q0r = 0; ntile = 4; nloc = 0;
                        q = QB + (TLAT + b * 256) * 1024 + h * 128; k = KB + b * KVR * 1024 + h * 128; v = VB + b * KVR * 1024 + h * 128; o = O + (TLAT + b * 256) * 1024 + h * 128; }
                    for (int i = tid; i < 465; i += 512) bt[64 + i] = rpb[h * 465 + i] * (1.0f / ATT_SCALE);
                    att::attn_body<true, 1024, 1024, 1024>(q, k, v, o, ntile, nloc, bs, q0r, (char*)lds_raw);
                }
            }
        }
        SEAM(pb + 1);
        if (IN(pb + 2)) SITE(9) for (int rep = 0; rep < REP_C; ++rep) { const int nm = (l == DEPTH - 1) ? 64 : 68;
            SchedOUT S; S.s.init(0, nm * 4, bid, G); S.ws = WSP; S.l = l; S.nm = nm; pg8::EpiStore E; pg8::gemm_phase<pg8::EpiStore, SchedOUT, false>(lds, 1024, S, E);
            if (rep == 0) cv_tail(lds, l, 2, nm * 4, bid, G); }
        SEAM(pb + 2);
        if (IN(pb + 3)) SITE(10) for (int rep = 0; rep < REP_D; ++rep) { __syncthreads(); phase_ln1_router(args, lds, l, bid, tid, wave, lane, rep + 1 < REP_D); }
        SEAM(pb + 3);
        if (IN(pb + 4)) SITE(11) for (int rep = 0; rep < REP_E; ++rep) { build_expert_tables(args, lds, l, tid);
            const LAS int* tab = (const LAS int*)(lds + LDS_TAB);
            SchedGU S; S.s.init(0, tab[65] * 2, bid, G); S.ws = WSP; S.l = l; S.tab = tab; S.e = 0; pg8::EpiSwiGLU E;
            pg8::gemm_phase<pg8::EpiSwiGLU, SchedGU, true>(lds, 1024, S, E);
            if (rep == 0) cv_tail(lds, l, 4, tab[65] * 2, bid, G); }
        SEAM(pb + 4);
        if (IN(pb + 5)) SITE(12) for (int rep = 0; rep < REP_F; ++rep) { build_expert_tables(args, lds, l, tid);
            const LAS int* tab = (const LAS int*)(lds + LDS_TAB);
            SchedDN S; S.s.init(0, tab[65] * 4, bid, G); S.ws = WSP; S.l = l; S.tab = tab; S.e = 0; S.probe = (rep + 1 < REP_F) ? PROBE_F : 0; pg8::EpiStoreF8 E;
            int k256 = 256; asm volatile("" : "+s"(k256));
            pg8::gemm_phase<pg8::EpiStoreF8, SchedDN, false>(lds, k256, S, E);
            if (rep == 0) cv_tail(lds, l, 5, tab[65] * 4, bid, G); }
        SEAM(pb + 5);
        if (IN(pb + 6)) SITE(13) for (int rep = 0; rep < REP_G; ++rep) { build_expert_tables(args, lds, l, tid); phase_combine_ln2(args, lds, l, gw, NGW, tid, lane, rep + 1 < REP_G); }
        SEAM(pb + 6);
    }
#undef IN
#undef SEAM
#undef lo
#undef hi
#undef lane
#undef wave
#undef gw
#undef tid
#undef WSP
#undef args
}

extern "C" void kernel_launch(void* const* d_in, const int* in_sizes, int n_in, void* d_out, int out_size, void* d_ws, size_t ws_size, hipStream_t stream) {
    static int ok = 0;
    if (ok == 0) {
        if (n_in != N_IN || ws_size < WS_END) { fprintf(stderr, "kernel_launch: n_in %d (want %d), ws %zu (want >= %zu)\n", n_in, (int)N_IN, ws_size, (size_t)WS_END); return; }
        if (hipFuncSetAttribute((const void*)fwd, hipFuncAttributeMaxDynamicSharedMemorySize, LDS_BYTES) != hipSuccess) { fprintf(stderr, "kernel_launch: hipFuncSetAttribute failed\n"); return; }
        int per_cu = 0;
        if (hipOccupancyMaxActiveBlocksPerMultiprocessor(&per_cu, (const void*)fwd, 512, LDS_BYTES) != hipSuccess || per_cu < 1) fprintf(stderr, "kernel_launch: occupancy query reports %d\n", per_cu);
        ok = 1;
    }
    Args a;
    memset(&a, 0, sizeof(a));
    for (int i = 0; i < N_IN; ++i) a.in[i] = (const float*)d_in[i];
    a.out = (float*)d_out; a.ws = (unsigned char*)d_ws;
    hipMemsetAsync((char*)d_ws + WS_CTL, 0, CTL_BYTES, stream);
#if MK_ONE_LAUNCH
    a.ph_lo = 0; a.ph_hi = NPHASE;
    hipLaunchKernelGGL(fwd, dim3(256), dim3(512), LDS_BYTES, stream, a);
#else
    for (int p = 0; p < NPHASE; ++p) { a.ph_lo = p; a.ph_hi = p + 1; hipLaunchKernelGGL(fwd, dim3(256), dim3(512), LDS_BYTES, stream, a); }
#endif
    const hipError_t le = hipPeekAtLastError();
    if (le != hipSuccess) fprintf(stderr, "kernel_launch: launch failed: %s\n", hipGetErrorName(le));
}
```

```cpp
#include <hip/hip_runtime.h>
#include <cstdio>
#include <cstdint>
#include <cstring>

#define LAS __attribute__((address_space(3)))
#define GAS __attribute__((address_space(1)))
typedef unsigned short bf16_t;
typedef short bf16x8 __attribute__((ext_vector_type(8)));
typedef short s16x4 __attribute__((ext_vector_type(4)));
typedef float f32x2 __attribute__((ext_vector_type(2)));
typedef float f32x4 __attribute__((ext_vector_type(4)));
typedef float f32x16 __attribute__((ext_vector_type(16)));
typedef unsigned u32x2 __attribute__((ext_vector_type(2)));
typedef unsigned u32x4 __attribute__((ext_vector_type(4)));

#ifndef MK_ONE_LAUNCH
#define MK_ONE_LAUNCH 1
#endif

constexpr int NB = 4, LSEQ = 4096, DM = 1024, NCTX = 256, DEPTH = 4;
constexpr int TLAT = NB * LSEQ, TCTX = NB * NCTX, TT = TLAT + TCTX;
constexpr int KVR = LSEQ + NCTX;
constexpr int NEXP = 64, TOPK = 8, EDIM = 256;
constexpr int NPAIR = TT * TOPK, NSLOT = NPAIR + TT;
constexpr float DN_ALPHA = 1.681792830507429f;
constexpr float LN_EPS = 1e-6f, RMS_EPS = 1e-6f, ROUTE_SCALE = 2.5f;
constexpr float ATT_SCALE = 0.088388347648318440f;

constexpr size_t al256(size_t x) { return (x + 255) / 256 * 256; }
constexpr size_t WS_CTL = 0, CTL_BYTES = 65536;
constexpr size_t WS_MOD = WS_CTL + CTL_BYTES;
constexpr size_t WS_GAINP = WS_MOD + al256((size_t)DEPTH * 5 * 6 * DM * 4);
constexpr size_t WS_ROPE = WS_GAINP + 2048;
constexpr size_t WS_WRHI = WS_ROPE + 16384;
constexpr size_t WS_WRLO = WS_WRHI + (size_t)DEPTH * 64 * DM * 2;
constexpr size_t WS_WF = WS_WRLO + (size_t)DEPTH * 64 * DM * 2;
constexpr size_t WS_WINE = WS_WF + (size_t)2 * 512 * DM * 2;
constexpr size_t WS_WINO = WS_WINE + (size_t)2 * 1280 * DM * 2;
constexpr size_t WS_WOUT = WS_WINO + (size_t)2 * 3072 * DM * 2;
constexpr size_t WS_WGU = WS_WOUT + (size_t)DEPTH * DM * DM * 2;
constexpr size_t WS_WD = WS_WGU + (size_t)DEPTH * 65 * 512 * DM * 2;
constexpr size_t WS_TW = WS_WD + (size_t)DEPTH * 65 * DM * 256 * 2;
constexpr size_t WS_TWC = WS_TW + (size_t)4096 * 8192 * 2;
constexpr size_t WS_XS = WS_TWC + (size_t)256 * 512 * 2;
constexpr size_t WS_H = WS_XS + (size_t)TT * DM * 4;
constexpr size_t WS_TKE = WS_H + (size_t)TT * DM * 2;
constexpr size_t WS_TKW = WS_TKE + (size_t)NPAIR * 4;
constexpr size_t WS_TKP = WS_TKW + (size_t)NPAIR * 4;
constexpr size_t WS_LIST = WS_TKP + (size_t)NPAIR * 4;
constexpr size_t WS_ACT = WS_LIST + (size_t)(NEXP + 1) * TT * 4;
constexpr size_t WS_YB = WS_ACT + (size_t)(NSLOT + 256) * EDIM * 2;
constexpr size_t WS_QB = WS_YB;
constexpr size_t WS_KB = WS_QB + (size_t)TT * DM * 2;
constexpr size_t WS_VB = WS_KB + (size_t)NB * KVR * DM * 2;
constexpr size_t WS_O = WS_VB + (size_t)NB * KVR * DM * 2;
constexpr size_t WS_Y = WS_O + (size_t)TT * DM * 2;
constexpr size_t WS_ZT = WS_Y + (size_t)TT * DM * 2;
constexpr size_t WS_ZCT = WS_ZT + (size_t)1024 * 8192 * 2;
constexpr size_t WS_OVL_END = WS_ZCT + (size_t)1024 * 512 * 2;
constexpr size_t WS_HL = WS_YB + (size_t)NSLOT * DM * 2;
constexpr size_t WS_TRASH = WS_HL + (size_t)TT * DM * 2;
constexpr size_t WS_END = WS_TRASH + (size_t)256 * 16384;
static_assert(WS_OVL_END <= WS_HL, "overlay fits in YB");
static_assert(WS_END <= (size_t)1 << 30, "workspace must fit 1 GiB");
constexpr int CW_TMO = 0, CW_CNT = 64  , CW_BAR = 1024;

constexpr int LDS_BYTES = 147456;
constexpr int LDS_STAGE = 0;
constexpr int LDS_EPI = 131072;
constexpr int LDS_RIDX = 139264;
constexpr int LDS_TAB = 141312;
constexpr int LDS_MISC = 147456 - 256;

__device__ __forceinline__ unsigned cvt_pk_bf16(float lo, float hi) { unsigned r; asm volatile("v_cvt_pk_bf16_f32 %0, %1, %2" : "=v"(r) : "v"(lo), "v"(hi)); return r; }
__device__ __forceinline__ float bf_lo(unsigned u) { return __uint_as_float(u << 16); }
__device__ __forceinline__ float bf_hi(unsigned u) { return __uint_as_float(u & 0xffff0000u); }
__device__ __forceinline__ float wave_sum(float v) {
#pragma unroll
    for (int o = 1; o < 64; o <<= 1) v += __shfl_xor(v, o);
    return v;
}
__device__ __forceinline__ float wave_max(float v) {
#pragma unroll
    for (int o = 1; o < 64; o <<= 1) v = fmaxf(v, __shfl_xor(v, o));
    return v;
}
#define LDS_WAIT() asm volatile("s_waitcnt lgkmcnt(0)" ::: "memory")
#define VM_WAIT() asm volatile("s_waitcnt vmcnt(0)" ::: "memory")

#ifndef PROBE_TS
#define PROBE_TS 0
#endif
#define TS(k) do { if (PROBE_TS && blockIdx.x == 0 && threadIdx.x == 0) { const unsigned long long now_ = __builtin_amdgcn_s_memrealtime(); volatile LAS float* ta_ = (volatile LAS float*)(lds + LDS_MISC + 64); \
    ta_[k] = ta_[k] + (float)(now_ - *(volatile LAS unsigned long long*)(lds + LDS_MISC + 192)); *(volatile LAS unsigned long long*)(lds + LDS_MISC + 192) = now_; } } while (0)

__device__ __forceinline__ int opaque_tid() { int t = threadIdx.x; asm volatile("" : "+v"(t)); return t; }
namespace pg8 {
constexpr int BM = 256, BK = 64, HALF = 128, HTB = HALF * BK * 2  , STAGE_BYTES = 8 * HTB;

__host__ __device__ __forceinline__ int lds_byte(int r, int c) { const int st = (r >> 4) * 2 + (c >> 5), rr = r & 15, cc = c & 31, ob = rr * 64 + cc * 2; return st * 1024 + (ob ^ (((ob >> 9) & 1) << 5)); }
__host__ __device__ __forceinline__ void stage_rc(int b, int& R, int& C) { const int st = b / 1024, sb = b % 1024, swz = sb ^ (((sb >> 9) & 1) << 5); R = (st >> 1) * 16 + swz / 64; C = (st & 1) * 32 + (swz % 64) / 2; }
__host__ __device__ __forceinline__ int perm32(int rho) { const int n = rho >> 4, i = rho & 15; return 8 * (i >> 2) + 4 * n + (i & 3); }

struct Unit { const char* A; const char* B; char* C; const int* rows; int ldc, nvalid, x0, x1; };

struct EpiStore {
    __device__ __forceinline__ void operator()(const f32x4 (&acc)[2][2][4][2], const Unit& u) const {
        const int tid = opaque_tid(), wid = tid >> 6, lane = tid & 63, wr = wid >> 2, wc = wid & 3, fr = lane & 15, fq = lane >> 4;
        const int row0 = wr * 64 + fr, col0 = wc * 32 + 8 * fq;
#pragma unroll
        for (int ai = 0; ai < 2; ++ai)
#pragma unroll
            for (int m = 0; m < 4; ++m) {
                const int r = row0 + ai * HALF + m * 16;
                if (r < u.nvalid) {
                    bf16_t* rowp = (bf16_t*)u.C + (size_t)r * u.ldc + col0;
#pragma unroll
                    for (int bj = 0; bj < 2; ++bj) { const f32x4 v0 = acc[ai][bj][m][0], v1 = acc[ai][bj][m][1];
                        u32x4 w; w.x = cvt_pk_bf16(v0[0], v0[1]); w.y = cvt_pk_bf16(v0[2], v0[3]); w.z = cvt_pk_bf16(v1[0], v1[1]); w.w = cvt_pk_bf16(v1[2], v1[3]);
                        *(u32x4*)(rowp + bj * HALF) = w; }
                }
            }
    }
};
constexpr float YB_SCALE = 32.0f;
struct EpiStoreF8 {
    __device__ __forceinline__ void operator()(const f32x4 (&acc)[2][2][4][2], const Unit& u) const {
        const int tid = opaque_tid(), wid = tid >> 6, lane = tid & 63, wr = wid >> 2, wc = wid & 3, fr = lane & 15, fq = lane >> 4;
        const int row0 = wr * 64 + fr, col0 = wc * 32 + 8 * fq;
#pragma unroll
        for (int ai = 0; ai < 2; ++ai)
#pragma unroll
            for (int m = 0; m < 4; ++m) {
                const int r = row0 + ai * HALF + m * 16;
                if (r < u.nvalid) {
                    unsigned char* rowp = (unsigned char*)u.C + (size_t)r * u.ldc + col0;
#pragma unroll
                    for (int bj = 0; bj < 2; ++bj) { f32x4 v0 = acc[ai][bj][m][0] * YB_SCALE, v1 = acc[ai][bj][m][1] * YB_SCALE;
#pragma unroll
                        for (int t = 0; t < 4; ++t) { v0[t] = __builtin_amdgcn_fmed3f(v0[t], -448.0f, 448.0f); v1[t] = __builtin_amdgcn_fmed3f(v1[t], -448.0f, 448.0f); }
                        int w0 = 0, w1 = 0;
                        w0 = __builtin_amdgcn_cvt_pk_fp8_f32(v0[0], v0[1], w0, false); w0 = __builtin_amdgcn_cvt_pk_fp8_f32(v0[2], v0[3], w0, true);
                        w1 = __builtin_amdgcn_cvt_pk_fp8_f32(v1[0], v1[1], w1, false); w1 = __builtin_amdgcn_cvt_pk_fp8_f32(v1[2], v1[3], w1, true);
                        *(u32x2*)(rowp + bj * HALF) = (u32x2){(unsigned)w0, (unsigned)w1}; }
                }
            }
    }
};
struct EpiSwiGLU {
    __device__ __forceinline__ void operator()(const f32x4 (&acc)[2][2][4][2], const Unit& u) const {
        const int tid = opaque_tid(), wid = tid >> 6, lane = tid & 63, wr = wid >> 2, wc = wid & 3, fr = lane & 15, fq = lane >> 4;
        const int row0 = wr * 64 + fr, col0 = wc * 32 + 8 * fq;
#pragma unroll
        for (int ai = 0; ai < 2; ++ai)
#pragma unroll
            for (int m = 0; m < 4; ++m) {
                const int r = row0 + ai * HALF + m * 16;
                if (r < u.nvalid) {
                    float o[8];
#pragma unroll
                    for (int n = 0; n < 2; ++n)
#pragma unroll
                        for (int j = 0; j < 4; ++j) { const float g = acc[ai][0][m][n][j], up = acc[ai][1][m][n][j];
                            o[n * 4 + j] = g * __builtin_amdgcn_rcpf(1.0f + __builtin_amdgcn_exp2f(-1.4426950408889634f * g)) * up; }
                    u32x4 w; w.x = cvt_pk_bf16(o[0], o[1]); w.y = cvt_pk_bf16(o[2], o[3]); w.z = cvt_pk_bf16(o[4], o[5]); w.w = cvt_pk_bf16(o[6], o[7]);
                    *(u32x4*)((bf16_t*)u.C + (size_t)r * u.ldc + col0) = w;
                }
            }
    }
};
struct EpiQKVE {
    LAS float* P;
    const float* gainp;
    const f32x2* rope;
    __device__ __forceinline__ void operator()(const f32x4 (&acc)[2][2][4][2], const Unit& u) const {
        const int tid = opaque_tid(), wid = tid >> 6, lane = tid & 63, wr = wid >> 2, wc = wid & 3, fr = lane & 15, fq = lane >> 4;
        const int row0 = wr * 64 + fr, col0 = wc * 32 + 8 * fq;
        if (u.x0 >= 2) {
            const size_t bjs = (u.x0 == 2) ? (size_t)NB * KVR * 128 : (size_t)HALF;
#pragma unroll
            for (int ai = 0; ai < 2; ++ai)
#pragma unroll
                for (int m = 0; m < 4; ++m) { bf16_t* rowp = (bf16_t*)u.C + (size_t)(row0 + ai * HALF + m * 16) * u.ldc + col0;
#pragma unroll
                    for (int bj = 0; bj < 2; ++bj) { const f32x4 v0 = acc[ai][bj][m][0], v1 = acc[ai][bj][m][1];
                        u32x4 w; w.x = cvt_pk_bf16(v0[0], v0[1]); w.y = cvt_pk_bf16(v0[2], v0[3]); w.z = cvt_pk_bf16(v1[0], v1[1]); w.w = cvt_pk_bf16(v1[2], v1[3]);
                        *(u32x4*)(rowp + bj * bjs) = w; } }
            asm volatile("" ::: "memory"); __builtin_amdgcn_s_barrier(); asm volatile("" ::: "memory");
            return;
        }
#pragma unroll
        for (int ai = 0; ai < 2; ++ai)
#pragma unroll
            for (int m = 0; m < 4; ++m)
#pragma unroll
                for (int bj = 0; bj < 2; ++bj) { const f32x4 a = acc[ai][bj][m][0], b = acc[ai][bj][m][1];
                    float s = (a[0] * a[0] + a[1] * a[1]) + (a[2] * a[2] + a[3] * a[3]) + (b[0] * b[0] + b[1] * b[1]) + (b[2] * b[2] + b[3] * b[3]);
                    s += __shfl_xor(s, 16); s += __shfl_xor(s, 32);
                    if (fq == 0) P[(bj * 256 + row0 + ai * HALF + m * 16) * 4 + wc] = s; }
        asm volatile("s_waitcnt lgkmcnt(0)" ::: "memory"); __builtin_amdgcn_s_barrier(); asm volatile("" ::: "memory");
        const f32x4 g0 = *(const f32x4*)(gainp + u.x0 * 128 + col0), g1 = *(const f32x4*)(gainp + u.x0 * 128 + col0 + 4);
        const int half = wc >> 1, fi = ((wc & 1) * 4 + fq) * 4;
#pragma unroll
        for (int ai = 0; ai < 2; ++ai)
#pragma unroll
            for (int m = 0; m < 4; ++m) {
                const int r = row0 + ai * HALF + m * 16;
                int pos = 0;
                if (u.x1 >= 0) { const int t = u.x1 + r; pos = half ? (t & 63) : (t >> 6); }
                const f32x4 cs0 = *(const f32x4*)(rope + pos * 32 + fi), cs1 = *(const f32x4*)(rope + pos * 32 + fi + 2);
                const float cc[4] = {cs0[0], cs0[2], cs1[0], cs1[2]}, ss[4] = {cs0[1], cs0[3], cs1[1], cs1[3]};
                bf16_t* rowp = (bf16_t*)u.C + (size_t)r * u.ldc + col0;
#pragma unroll
                for (int bj = 0; bj < 2; ++bj) {
                    const f32x4 pp = *(const LAS f32x4*)(P + (bj * 256 + r) * 4);
                    const float rs = __builtin_amdgcn_rsqf(((pp[0] + pp[1]) + (pp[2] + pp[3])) * (1.0f / 128.0f) + RMS_EPS);
                    float o1[4], o2[4];
#pragma unroll
                    for (int j = 0; j < 4; ++j) { const float v1 = acc[ai][bj][m][0][j] * rs * g0[j], v2 = acc[ai][bj][m][1][j] * rs * g1[j];
                        o1[j] = v1 * cc[j] - v2 * ss[j]; o2[j] = v1 * ss[j] + v2 * cc[j]; }
                    u32x4 w; w.x = cvt_pk_bf16(o1[0], o1[1]); w.y = cvt_pk_bf16(o1[2], o1[3]); w.z = cvt_pk_bf16(o2[0], o2[1]); w.w = cvt_pk_bf16(o2[2], o2[3]);
                    *(u32x4*)(rowp + bj * ((u.x0 == 0) ? (size_t)HALF : (size_t)NB * KVR * 128)) = w;
                }
            }
    }
};

template <class Epi, class Sched, bool GATHER>
__device__ __forceinline__ void gemm_phase(LAS unsigned char* lds, const int K_, Sched& S, const Epi& E) {
    const int K = K_;
    const int tid = opaque_tid(), wid = __builtin_amdgcn_readfirstlane(tid >> 6), lane = tid & 63, wr = wid >> 2, wc = wid & 3, fr = lane & 15, fq = lane >> 4;
    const int nt = K / BK;
    Unit cur, nxt; int ui = 0;
    if (!S.next(0, cur)) return;
    unsigned voffB[2], offA[2][2];
#pragma unroll
    for (int i = 0; i < 2; ++i) { int R, C; stage_rc(tid * 16 + i * 8192, R, C); const int Rb = (R & ~31) + perm32(R & 31);
        voffB[i] = (unsigned)(Rb * K + C) * 2u; }
    LAS int* ridx = (LAS int*)(lds + LDS_RIDX);
    if (GATHER) {
        if (tid < 256) ridx[tid] = (tid < cur.nvalid) ? cur.rows[tid] : 0;
        __syncthreads();
#pragma unroll
        for (int h = 0; h < 2; ++h)
#pragma unroll
            for (int i = 0; i < 2; ++i) { int R, C; stage_rc(tid * 16 + i * 8192, R, C); offA[h][i] = (unsigned)ridx[h * HALF + R] * (unsigned)(K * 2) + (unsigned)C * 2u; }
    } else {
#pragma unroll
        for (int h = 0; h < 2; ++h)
#pragma unroll
            for (int i = 0; i < 2; ++i) { int R, C; stage_rc(tid * 16 + i * 8192, R, C); offA[h][i] = (unsigned)((h * HALF + R) * K + C) * 2u; }
    }
    const size_t kstep = (size_t)(BK * 2);
    const size_t hstep = (size_t)HALF * K * 2;
    const unsigned ldsw = (unsigned)wid * 1024u;
    const int aoff = lds_byte(wr * 64 + fr, fq * 8), boff = lds_byte(wc * 32 + fr, fq * 8);
#define PG8_SA(b, h) (((b) * 2 + (h)) * HTB)
#define PG8_SB(b, h) ((4 + (b) * 2 + (h)) * HTB)
#define PG8_STAGE(bufoff, gbase, voff) do { _Pragma("unroll") for (int _i = 0; _i < 2; ++_i) \
        __builtin_amdgcn_global_load_lds((const unsigned*)((const char*)(gbase) + (voff)[_i]), (LAS unsigned*)(lds + (bufoff) + ldsw + _i * 8192), 16, 0, 0); } while (0)
#define PG8_LDA(dst, b, h) do { _Pragma("unroll") for (int m = 0; m < 4; ++m) _Pragma("unroll") for (int k = 0; k < 2; ++k) dst[m][k] = *(const LAS bf16x8*)(lds + PG8_SA(b, h) + aoff + m * 2048 + k * 1024); } while (0)
#define PG8_LDB(dst, b, h) do { _Pragma("unroll") for (int n = 0; n < 2; ++n) _Pragma("unroll") for (int k = 0; k < 2; ++k) dst[n][k] = *(const LAS bf16x8*)(lds + PG8_SB(b, h) + boff + n * 2048 + k * 1024); } while (0)
#define PG8_MMA(ai, bj, At, Bt) do { __builtin_amdgcn_s_setprio(1); _Pragma("unroll") for (int m = 0; m < 4; ++m) _Pragma("unroll") for (int n = 0; n < 2; ++n) _Pragma("unroll") for (int k = 0; k < 2; ++k) \
        acc[ai][bj][m][n] = __builtin_amdgcn_mfma_f32_16x16x32_bf16(Bt[n][k], At[m][k], acc[ai][bj][m][n], 0, 0, 0); __builtin_amdgcn_s_setprio(0); } while (0)
#define PG8_WAIT_V(n) asm volatile("s_waitcnt vmcnt(" #n ")" ::: "memory")
#define PG8_WAIT_L(n) asm volatile("s_waitcnt lgkmcnt(" #n ")" ::: "memory")
#define PG8_BAR __builtin_amdgcn_s_barrier()
#define PG8_SCHED __builtin_amdgcn_sched_barrier(0)
    f32x4 acc[2][2][4][2];
#pragma unroll
    for (int a = 0; a < 2; ++a)
#pragma unroll
        for (int b = 0; b < 2; ++b)
#pragma unroll
            for (int m = 0; m < 4; ++m)
#pragma unroll
                for (int n = 0; n < 2; ++n) acc[a][b][m][n] = (f32x4){0.f, 0.f, 0.f, 0.f};
    bf16x8 At[4][2], B0[2][2], B1[2][2];
    const char* cA = cur.A; const char* cB = cur.B;
    PG8_STAGE(PG8_SB(0, 0), cB, voffB); PG8_STAGE(PG8_SA(0, 0), cA, offA[0]); PG8_STAGE(PG8_SB(0, 1), cB + hstep, voffB); PG8_STAGE(PG8_SA(0, 1), cA, offA[1]);
    if (wr == 1) PG8_BAR;
    PG8_WAIT_V(4); PG8_BAR;
    PG8_STAGE(PG8_SB(1, 0), cB + kstep, voffB); PG8_STAGE(PG8_SA(1, 0), cA + kstep, offA[0]); PG8_STAGE(PG8_SB(1, 1), cB + hstep + kstep, voffB);
    PG8_WAIT_V(6); PG8_BAR;
    for (;;) {
        const bool has_next = S.next(ui + 1, nxt);
        const char* nA = has_next ? nxt.A : cA; const char* nB = has_next ? nxt.B : cB;
        if (GATHER && has_next && wid < 4)
            __builtin_amdgcn_global_load_lds((const unsigned*)(nxt.rows + wid * 64 + lane), (LAS unsigned*)(lds + LDS_RIDX + ((ui + 1) & 1) * 1024 + wid * 256), 4, 0, 0);
        for (int t = 0; t < nt; t += 2) {
            const bool last = (t == nt - 2);
            const char* a1 = cA + (size_t)(t + 1) * kstep;
            const char* a2 = last ? nA : cA + (size_t)(t + 2) * kstep; const char* b2 = last ? nB : cB + (size_t)(t + 2) * kstep;
            const char* a3 = a2 + kstep; const char* b3 = b2 + kstep;
            PG8_LDB(B0, 0, 0); PG8_SCHED; PG8_LDA(At, 0, 0); PG8_STAGE(PG8_SA(1, 1), a1, offA[1]);
            PG8_WAIT_L(8); PG8_BAR; PG8_WAIT_L(0); PG8_MMA(0, 0, At, B0); PG8_BAR; PG8_SCHED;
            if (GATHER && last && has_next) {
                LAS int* rn = ridx + ((ui + 1) & 1) * 256;
#pragma unroll
                for (int h = 0; h < 2; ++h)
#pragma unroll
                    for (int i = 0; i < 2; ++i) { int R, C; stage_rc(tid * 16 + i * 8192, R, C); const int rr = h * HALF + R; const int tok = (rr < nxt.nvalid) ? rn[rr] : 0; offA[h][i] = (unsigned)tok * (unsigned)(K * 2) + (unsigned)C * 2u; }
            }
            PG8_LDB(B1, 0, 1); PG8_STAGE(PG8_SB(0, 0), b2, voffB);
            PG8_BAR; PG8_WAIT_L(0); PG8_MMA(0, 1, At, B1); PG8_BAR;
            PG8_LDA(At, 0, 1); PG8_STAGE(PG8_SA(0, 0), a2, offA[0]);
            PG8_BAR; PG8_WAIT_L(0); PG8_MMA(1, 0, At, B0); PG8_BAR; PG8_SCHED;
            PG8_STAGE(PG8_SB(0, 1), b2 + hstep, voffB);
            PG8_WAIT_V(6); PG8_BAR; PG8_MMA(1, 1, At, B1); PG8_BAR;
            PG8_LDB(B0, 1, 0); PG8_SCHED; PG8_LDA(At, 1, 0); PG8_STAGE(PG8_SA(0, 1), a2, offA[1]);
            PG8_WAIT_L(8); PG8_BAR; PG8_WAIT_L(0); PG8_MMA(0, 0, At, B0); PG8_BAR; PG8_SCHED;
            PG8_LDB(B1, 1, 1); PG8_STAGE(PG8_SB(1, 0), b3, voffB);
            PG8_BAR; PG8_WAIT_L(0); PG8_MMA(0, 1, At, B1); PG8_BAR;
            PG8_LDA(At, 1, 1); PG8_STAGE(PG8_SA(1, 0), a3, offA[0]);
            PG8_BAR; PG8_WAIT_L(0); PG8_MMA(1, 0, At, B0); PG8_BAR; PG8_SCHED;
            PG8_STAGE(PG8_SB(1, 1), b3 + hstep, voffB);
            PG8_WAIT_V(6); PG8_BAR; PG8_MMA(1, 1, At, B1); PG8_BAR;
        }
        { Unit eu; S.next(ui, eu); E(acc, eu); }
        if (!has_next) break;
#pragma unroll
        for (int a = 0; a < 2; ++a)
#pragma unroll
            for (int b = 0; b < 2; ++b)
#pragma unroll
                for (int m = 0; m < 4; ++m)
#pragma unroll
                    for (int n = 0; n < 2; ++n) acc[a][b][m][n] = (f32x4){0.f, 0.f, 0.f, 0.f};
        cur = nxt; cA = nA; cB = nB; ++ui;
    }
    PG8_WAIT_V(0);
    if (wr == 0) PG8_BAR;
    PG8_BAR;
#undef PG8_SA
#undef PG8_SB
#undef PG8_STAGE
#undef PG8_LDA
#undef PG8_LDB
#undef PG8_MMA
#undef PG8_WAIT_V
#undef PG8_WAIT_L
#undef PG8_BAR
#undef PG8_SCHED
}
}

namespace att {
constexpr int D = 128, NW = 8, QBLK = 32, KVBLK = 64;
constexpr float SCALE = ATT_SCALE;
constexpr float THR = 8.f;
constexpr float NEGM = -30000.f;
constexpr size_t SHM_V = KVBLK * D * 2, SHM_K = KVBLK * D * 2, SHM_ATTN = 2 * SHM_V + 2 * SHM_K + NW * 64 * 4;
constexpr int LDS_BIAS = 69632;
#define KSWZ(row, colB) ((row) * 256 + ((colB) ^ (((row) & 7) << 4)))
#define SBAR() __builtin_amdgcn_sched_barrier(0)
__device__ __forceinline__ int crow(int r, int hi) { return (r & 3) + 8 * (r >> 2) + 4 * hi; }

__device__ __forceinline__ void partialSM(f32x16& p0, f32x16& p1, float& m_reg, float& mn, float& alpha) {
  constexpr float C = SCALE * 1.4426950408889634f;
  float pmax = p0[0];
#pragma unroll
  for (int r = 1; r < 16; ++r) pmax = fmaxf(pmax, p0[r]);
#pragma unroll
  for (int r = 0; r < 16; ++r) pmax = fmaxf(pmax, p1[r]);
  { auto rr = __builtin_amdgcn_permlane32_swap(__float_as_uint(pmax), __float_as_uint(pmax), false, false);
    pmax = fmaxf(__uint_as_float(rr[0]), __uint_as_float(rr[1])); }
  if (__builtin_expect(__all(pmax - m_reg <= THR / SCALE), 1)) { mn = m_reg; alpha = 1.f; }
  else { mn = fmaxf(m_reg, pmax); alpha = __builtin_amdgcn_exp2f((m_reg - mn) * C); m_reg = mn; }
  float mnC = -mn * C;
#pragma unroll
  for (int r = 0; r < 16; ++r) p0[r] = fmaf(p0[r], C, mnC);
#pragma unroll
  for (int r = 0; r < 16; ++r) p1[r] = fmaf(p1[r], C, mnC);
#pragma unroll
  for (int r = 0; r < 16; ++r) p0[r] = __builtin_amdgcn_exp2f(p0[r]);
}
__device__ __forceinline__ void finishSM(f32x16& p0, f32x16& p1, float alpha, float& l_reg, bf16x8& pa0, bf16x8& pa1, bf16x8& pa2, bf16x8& pa3) {
#pragma unroll
  for (int r = 0; r < 16; ++r) p1[r] = __builtin_amdgcn_exp2f(p1[r]);
  float ps = 0;
#pragma unroll
  for (int r = 0; r < 16; ++r) ps += p0[r];
#pragma unroll
  for (int r = 0; r < 16; ++r) ps += p1[r];
  { auto rr = __builtin_amdgcn_permlane32_swap(__float_as_uint(ps), __float_as_uint(ps), false, false);
    ps = __uint_as_float(rr[0]) + __uint_as_float(rr[1]); }
  l_reg = l_reg * alpha + ps;
#define PK4(P, BASE, OUT) do { unsigned a0 = cvt_pk_bf16(P[BASE + 0], P[BASE + 1]), a1 = cvt_pk_bf16(P[BASE + 2], P[BASE + 3]);   \
    unsigned b0 = cvt_pk_bf16(P[BASE + 4], P[BASE + 5]), b1 = cvt_pk_bf16(P[BASE + 6], P[BASE + 7]);                              \
    auto r0 = __builtin_amdgcn_permlane32_swap(a0, b0, false, false); auto r1 = __builtin_amdgcn_permlane32_swap(a1, b1, false, false); \
    u32x4 w = {r0[0], r1[0], r0[1], r1[1]}; OUT = *reinterpret_cast<bf16x8*>(&w); } while (0)
  PK4(p0, 0, pa0); PK4(p0, 8, pa1); PK4(p1, 0, pa2); PK4(p1, 8, pa3);
#undef PK4
}
__device__ __forceinline__ void qkt(f32x16& p0, f32x16& p1, const char* Ks, const bf16x8* qr, int r32, int hi) {
  p0 = f32x16{}; p1 = f32x16{};
#pragma unroll
  for (int d0 = 0; d0 < 8; ++d0) { int cb = (d0 * 16 + hi * 8) * 2;
    bf16x8 b0 = *reinterpret_cast<const bf16x8*>(Ks + KSWZ(r32, cb));
    bf16x8 b1 = *reinterpret_cast<const bf16x8*>(Ks + KSWZ(32 + r32, cb));
    p0 = __builtin_amdgcn_mfma_f32_32x32x16_bf16(b0, qr[d0], p0, 0, 0, 0);
    p1 = __builtin_amdgcn_mfma_f32_32x32x16_bf16(b1, qr[d0], p1, 0, 0, 0); }
}
__device__ __forceinline__ int v_st(int k, int c) { const int kk = (k & ~0xC) | ((k & 4) << 1) | ((k & 8) >> 1); return ((kk >> 3) * 4 + (c >> 5)) * 512 + ((kk & 7) * 32 + (c & 31)) * 2; }
__device__ __forceinline__ int v_rd_base(int lane) { return ((lane & 3) << 3) | (((lane >> 2) & 3) << 6) | (((lane >> 4) & 1) << 5) | (((lane >> 5) & 1) << 8); }
constexpr int v_rd_off(int d0, int ks, int half) { return d0 * 512 + ks * 4096 + half * 2048; }
template <int OFF> __device__ __forceinline__ s16x4 tr_read(int vb) {
  s16x4 r; asm volatile("ds_read_b64_tr_b16 %0, %1 offset:%2" : "=&v"(r) : "v"(vb), "i"(OFF) : "memory"); return r;
}
template <int D0> __device__ __forceinline__ void pv_one(f32x16& od, int vb, bf16x8 pa0, bf16x8 pa1, bf16x8 pa2, bf16x8 pa3) {
  const s16x4 l0 = tr_read<v_rd_off(D0, 0, 0)>(vb), h0 = tr_read<v_rd_off(D0, 0, 1)>(vb), l1 = tr_read<v_rd_off(D0, 1, 0)>(vb), h1 = tr_read<v_rd_off(D0, 1, 1)>(vb);
  const s16x4 l2 = tr_read<v_rd_off(D0, 2, 0)>(vb), h2 = tr_read<v_rd_off(D0, 2, 1)>(vb), l3 = tr_read<v_rd_off(D0, 3, 0)>(vb), h3 = tr_read<v_rd_off(D0, 3, 1)>(vb);
  asm volatile("s_waitcnt lgkmcnt(0)" ::: "memory"); SBAR();
#define PK(L, H) (bf16x8){L[0], L[1], L[2], L[3], H[0], H[1], H[2], H[3]}
  od = __builtin_amdgcn_mfma_f32_32x32x16_bf16(pa0, PK(l0, h0), od, 0, 0, 0);
  od = __builtin_amdgcn_mfma_f32_32x32x16_bf16(pa1, PK(l1, h1), od, 0, 0, 0);
  od = __builtin_amdgcn_mfma_f32_32x32x16_bf16(pa2, PK(l2, h2), od, 0, 0, 0);
  od = __builtin_amdgcn_mfma_f32_32x32x16_bf16(pa3, PK(l3, h3), od, 0, 0, 0);
#undef PK
}
__device__ __forceinline__ void pv_d0(f32x16* o, int vb, bf16x8 pa0, bf16x8 pa1, bf16x8 pa2, bf16x8 pa3) {
  pv_one<0>(o[0], vb, pa0, pa1, pa2, pa3); pv_one<1>(o[1], vb, pa0, pa1, pa2, pa3); pv_one<2>(o[2], vb, pa0, pa1, pa2, pa3); pv_one<3>(o[3], vb, pa0, pa1, pa2, pa3);
}

template <bool NA, int ldq, int ldk, int ldo>
__device__ __forceinline__ void attn_body(const bf16_t* __restrict__ Qb, const bf16_t* __restrict__ Kh, const bf16_t* __restrict__ Vh,
                                          bf16_t* __restrict__ Ob, const int NT, const int nloc, const int bs, const int q0r, char* lds) {
  const int tid = opaque_tid(), wid = tid >> 6, lane = tid & 63, r32 = lane & 31, hi = lane >> 5;
  char* V_lds = lds; char* K_lds = lds + 2 * SHM_V;
  float* ws = (float*)(lds + 2 * SHM_V + 2 * SHM_K) + wid * 64; float* li_l = ws; float* al_l = ws + 32;
  float m_reg = -1e30f, l_reg = 0; f32x16 o[4] = {}; bf16x8 qr[8];
  const bf16_t* Qw = Qb + (wid * QBLK + r32) * ldq + hi * 8;
#pragma unroll
  for (int d0 = 0; d0 < 8; ++d0) qr[d0] = *reinterpret_cast<const bf16x8*>(Qw + d0 * 16);
  const int sr = tid >> 4, sc = (tid & 15) * 8, vst0 = v_st(sr, sc), vst1 = v_st(32 + sr, sc);
  const int vb0 = (int)(uintptr_t)V_lds + v_rd_base(lane);
  const unsigned kvo = (unsigned)(sr * ldk + sc) * 2u;
  const float* btab = (const float*)(lds + LDS_BIAS) + 64;
  constexpr int SD = NA ? 1 : 2;
  struct { bf16x8 vs0, vs1, ks0, ks1; } sr_[SD];
#define KOFF(j) (NA ? ((j) < nloc ? (bs + (j)) * 64 : LSEQ + ((j) - nloc) * 64) : (j) * 64)
#define SLOAD(i, k0) do { const unsigned _ko = (unsigned)((k0) * ldk * 2) + kvo; sr_[i].vs0 = *reinterpret_cast<const bf16x8*>((const char*)Vh + _ko); sr_[i].vs1 = *reinterpret_cast<const bf16x8*>((const char*)Vh + (_ko + 64u * ldk)); \
    sr_[i].ks0 = *reinterpret_cast<const bf16x8*>((const char*)Kh + _ko); sr_[i].ks1 = *reinterpret_cast<const bf16x8*>((const char*)Kh + (_ko + 64u * ldk)); } while (0)
#define SWRITE(b, i) do { int sr_w = sr, sc_w = sc, v0_w = vst0, v1_w = vst1; \
    if (NA) { const int t_ = opaque_tid(); sr_w = t_ >> 4; sc_w = (t_ & 15) * 8; v0_w = v_st(sr_w, sc_w); v1_w = v_st(32 + sr_w, sc_w); }     \
    *(bf16x8*)(V_lds + (b) * SHM_V + v0_w) = sr_[i].vs0;          \
    *(bf16x8*)(V_lds + (b) * SHM_V + v1_w) = sr_[i].vs1; int kc = sc_w * 2;               \
    *(bf16x8*)(K_lds + (b) * SHM_K + KSWZ(sr_w, kc)) = sr_[i].ks0;                       \
    *(bf16x8*)(K_lds + (b) * SHM_K + KSWZ(32 + sr_w, kc)) = sr_[i].ks1; } while (0)
#define SWAIT() do { if (SD == 2) asm volatile("s_waitcnt vmcnt(4)" ::: "memory"); else asm volatile("s_waitcnt vmcnt(0)" ::: "memory"); } while (0)
#define RESC(a) do { if (__any((a) < 1.f)) { if (hi == 0) al_l[r32] = (a); asm volatile("s_waitcnt lgkmcnt(0)" ::: "memory"); \
    _Pragma("unroll") for (int d = 0; d < 4; ++d) _Pragma("unroll") for (int r = 0; r < 16; ++r) o[d][r] *= al_l[crow(r, hi)]; } } while (0)
#define ACT(j) (!NA || (j) >= nloc || ((bs + (j)) >= min(max(q0r + __builtin_amdgcn_readfirstlane(opaque_tid() >> 7) - 4, 0), 56) && (bs + (j)) < min(max(q0r + __builtin_amdgcn_readfirstlane(opaque_tid() >> 7) - 4, 0), 56) + 8))
#define NAMASK(P0, P1, j) do { if (NA && (j) < nloc) { const int kr = bs + (j); const int t_ = opaque_tid(); \
    const int qrow = q0r + __builtin_amdgcn_readfirstlane(t_ >> 7), qcol = ((t_ >> 6) & 1) * 32 + (t_ & 31), hi_ = (t_ >> 5) & 1; \
    const int cstart = min(max(qcol - 8, 0), 48); \
    const float* bp = btab + (kr - qrow + 7) * 31 + (4 * hi_ - qcol + 15); const int cs = cstart - 4 * hi_; \
    _Pragma("unroll") for (int r = 0; r < 16; ++r) { const int kc = (r & 3) + 8 * (r >> 2); \
        P0[r] = ((unsigned)(kc - cs) < 16u) ? P0[r] + bp[kc] : NEGM; P1[r] = ((unsigned)(kc + 32 - cs) < 16u) ? P1[r] + bp[kc + 32] : NEGM; } } } while (0)
  f32x16 pA0, pA1, pB0, pB1; float mnA, mnB, alA = 1.f, alB = 1.f; bf16x8 pa0, pa1, pa2, pa3;
  bool actA, actB;
  constexpr int SE = 0, SO = SD - 1;
  SLOAD(SE, KOFF(0)); asm volatile("s_waitcnt vmcnt(0)" ::: "memory"); SWRITE(0, SE); __syncthreads();
  actA = ACT(0);
  if (actA) { qkt(pA0, pA1, K_lds, qr, r32, hi); NAMASK(pA0, pA1, 0); partialSM(pA0, pA1, m_reg, mnA, alA); } else alA = 1.f;
  SLOAD(SO, KOFF(1)); if (SD == 2 && 2 < NT) SLOAD(SE, KOFF(2));
  SWAIT(); SWRITE(1, SO); __syncthreads();
  for (int j = 1; j + 1 < NT; j += 2) {
    SBAR(); actB = ACT(j); if (actB) { qkt(pB0, pB1, K_lds + SHM_K, qr, r32, hi); NAMASK(pB0, pB1, j); }
    if (actA) finishSM(pA0, pA1, alA, l_reg, pa0, pa1, pa2, pa3); SBAR();
    SLOAD(SO, KOFF(j + SD)); SBAR();
    if (actA) pv_d0(o, vb0, pa0, pa1, pa2, pa3); if (actB) partialSM(pB0, pB1, m_reg, mnB, alB); else alB = 1.f;
    __syncthreads(); SWAIT(); SWRITE(0, SE);
    RESC(alB); __syncthreads();
    SBAR(); actA = ACT(j + 1); if (actA) { qkt(pA0, pA1, K_lds, qr, r32, hi); NAMASK(pA0, pA1, j + 1); }
    if (actB) finishSM(pB0, pB1, alB, l_reg, pa0, pa1, pa2, pa3); SBAR();
    if (SD == 1 || j + 3 < NT) SLOAD(SE, KOFF(j + 1 + SD)); SBAR();
    if (actB) pv_d0(o, vb0 + (int)SHM_V, pa0, pa1, pa2, pa3); if (actA) partialSM(pA0, pA1, m_reg, mnA, alA); else alA = 1.f;
    __syncthreads(); SWAIT(); SWRITE(1, SO);
    RESC(alA); __syncthreads();
  }
  SBAR(); actB = ACT(NT - 1); if (actB) { qkt(pB0, pB1, K_lds + SHM_K, qr, r32, hi); NAMASK(pB0, pB1, NT - 1); }
  if (actA) finishSM(pA0, pA1, alA, l_reg, pa0, pa1, pa2, pa3); SBAR();
  if (actA) pv_d0(o, vb0, pa0, pa1, pa2, pa3); if (actB) partialSM(pB0, pB1, m_reg, mnB, alB); else alB = 1.f;
  __syncthreads(); RESC(alB);
  if (actB) { finishSM(pB0, pB1, alB, l_reg, pa0, pa1, pa2, pa3); SBAR();
    pv_d0(o, vb0 + (int)SHM_V, pa0, pa1, pa2, pa3); }
  if (hi == 0) li_l[r32] = l_reg; asm volatile("s_waitcnt lgkmcnt(0)" ::: "memory");
  float rli[16];
#pragma unroll
  for (int r = 0; r < 16; ++r) rli[r] = __builtin_amdgcn_rcpf(li_l[crow(r, hi)]);
  bf16_t* Ow = Ob + (wid * QBLK) * ldo + r32;
#pragma unroll
  for (int r = 0; r < 16; ++r) { const int orow = crow(r, hi);
#pragma unroll
    for (int d0 = 0; d0 < 4; ++d0) { const unsigned pk = cvt_pk_bf16(o[d0][r] * rli[r], 0.f); Ow[orow * ldo + d0 * 32] = (bf16_t)(pk & 0xffffu); } }
  __syncthreads();
#undef ACT
#undef KOFF
#undef SLOAD
#undef SWRITE
#undef SWAIT
#undef RESC
#undef NAMASK
}
#undef KSWZ
#undef SBAR
}

#define XB_TMO      128
#define XB_XCNT(j)  (256  + 64 * (j))
#define XB_XSUB(j)  (1280 + 64 * (j))
#define XB_XGEN(j)  (2304 + 64 * (j))
#define XB_TOP      3328
#define XB_TOPGEN   3392
#define XCD_BAR_WORDS 3456
#define XB_SPIN_CAP (1u << 22)
__device__ __forceinline__ unsigned xb_ld(unsigned* p)              { return __hip_atomic_load(p, __ATOMIC_RELAXED, __HIP_MEMORY_SCOPE_AGENT); }
__device__ __forceinline__ unsigned xb_add(unsigned* p, unsigned v) { return __hip_atomic_fetch_add(p, v, __ATOMIC_RELAXED, __HIP_MEMORY_SCOPE_AGENT); }
__device__ __forceinline__ unsigned xb_xcc_id() { return (unsigned)__builtin_amdgcn_s_getreg((3 << 11) | 20) & 0xFu; }
#define XB_SPIN(cond, bar) do { unsigned _sp = 0; while (cond) { __builtin_amdgcn_s_sleep(1); \
    if ((++_sp & 255u) == 0u) { if (xb_ld(&(bar)[XB_TMO])) break; if (_sp > XB_SPIN_CAP) { atomicAdd(&(bar)[XB_TMO], 1u); break; } } } } while (0)
struct XcdBarrier { unsigned* bar; unsigned x; volatile LAS unsigned* st; };
__device__ __forceinline__ XcdBarrier xcd_barrier_post(unsigned* bar, volatile LAS unsigned* st) {
    XcdBarrier b; b.bar = bar; b.x = xb_xcc_id(); b.st = st;
    if (threadIdx.x == 0) (void)xb_add(&bar[XB_XCNT(b.x)], 1u);
    return b;
}
__device__ __forceinline__ void xcd_barrier_complete(unsigned* bar, unsigned x, unsigned& nloc, unsigned& nx) {
    const unsigned G = gridDim.x * gridDim.y * gridDim.z;
    unsigned sum, cnt, mine, sp = 0u;
    for (;;) {
        sum = 0u; cnt = 0u; mine = 0u;
#pragma unroll
        for (unsigned j = 0; j < 16; ++j) { const unsigned c = xb_ld(&bar[XB_XCNT(j)]); sum += c; cnt += (c > 0u) ? 1u : 0u; mine = (j == x) ? c : mine; }
        if (sum == G) break;
        __builtin_amdgcn_s_sleep(1);
        if ((++sp & 255u) == 0u) { if (xb_ld(&bar[XB_TMO])) break; if (sp > XB_SPIN_CAP) { atomicAdd(&bar[XB_TMO], 1u); break; } }
    }
    nloc = mine > 0u ? mine : 1u; nx = cnt > 0u ? cnt : 1u;
}
__device__ __forceinline__ void xcd_barrier(const XcdBarrier& b) {
    asm volatile("s_waitcnt vmcnt(0)" ::: "memory");
    __syncthreads();
    if (threadIdx.x == 0) {
        unsigned* bar = b.bar;
        __builtin_amdgcn_s_waitcnt(0);
        unsigned nloc = b.st[0], nx = b.st[1];
        if (nloc == 0u) { xcd_barrier_complete(bar, b.x, nloc, nx); b.st[0] = nloc; b.st[1] = nx; }
        const unsigned old = xb_add(&bar[XB_XSUB(b.x)], 1u);
        const unsigned gen = old / nloc;
        if (old + 1u == (gen + 1u) * nloc) {
            __builtin_amdgcn_fence(__ATOMIC_RELEASE, "agent");
            asm volatile("s_waitcnt vmcnt(0)" ::: "memory");
            const unsigned og = xb_add(&bar[XB_TOP], 1u);
            const unsigned tg = og / nx;
            if (og + 1u == (tg + 1u) * nx) xb_add(&bar[XB_TOPGEN], 1u);
            else XB_SPIN(xb_ld(&bar[XB_TOPGEN]) == tg, bar);
            __builtin_amdgcn_fence(__ATOMIC_ACQUIRE, "agent");
            xb_add(&bar[XB_XGEN(b.x)], 1u);
            asm volatile("s_waitcnt vmcnt(0)" ::: "memory");
        } else {
            XB_SPIN(xb_ld(&bar[XB_XGEN(b.x)]) == gen, bar);
            __builtin_amdgcn_fence(__ATOMIC_ACQUIRE, "agent");
            asm volatile("s_waitcnt vmcnt(0)" ::: "memory");
        }
    }
    __syncthreads();
}

enum { I_X = 0, I_C, I_CTX, I_CCTX, I_WMOD, I_BMOD, I_LN1G, I_LN1B, I_LN2G, I_LN2B, I_ABWIN, I_ABWF, I_ABQN, I_ABKN, I_ABWOUT, I_NAWIN, I_NARPB, I_NAWOUT,
       I_WR, I_EBIAS, I_WG, I_WU, I_WDN, I_SG, I_SU, I_SD, N_IN };
struct Args { const float* in[N_IN]; float* out; unsigned char* ws; int ph_lo, ph_hi; };
struct KA {
    __device__ __forceinline__ const __attribute__((address_space(4))) char* base() const { const __attribute__((address_space(4))) char* p = (const __attribute__((address_space(4))) char*)__builtin_amdgcn_kernarg_segment_ptr(); asm volatile("" : "+s"(p)); return p; }
    __device__ __forceinline__ const float* in(int i) const { return *(const float* const __attribute__((address_space(4)))*)(base() + 8 * i); }
    __device__ __forceinline__ float* out() const { return *(float* const __attribute__((address_space(4)))*)(base() + 8 * N_IN); }
    __device__ __forceinline__ int ph_lo() const { return *(const int __attribute__((address_space(4)))*)(base() + 8 * N_IN + 16); }
    __device__ __forceinline__ int ph_hi() const { return *(const int __attribute__((address_space(4)))*)(base() + 8 * N_IN + 20); }
    __device__ __forceinline__ unsigned char* ws() const { return *(unsigned char* const __attribute__((address_space(4)))*)(base() + 8 * N_IN + 8); }
};

__device__ __forceinline__ int tok_batchrow(int m) { return m < TLAT ? (m >> 12) : 4; }

__host__ __device__ __forceinline__ int rope_phys(int d) { const int hf = d >> 6, dd = d & 63, i = dd & 31, second = dd >> 5; return hf * 64 + (i >> 2) * 8 + second * 4 + (i & 3); }

constexpr int CV_GU = 65 * 2 * 16, CV_DN = 65 * 16, CV_OUT = 64;
__host__ __device__ constexpr int cv_in(int l) { return (l & 1) ? 192 : 80; }
__host__ __device__ constexpr int cv_items(int l) { return CV_GU + CV_DN + cv_in(l) + CV_OUT; }
struct CvItem { const float* src; bf16_t* dst; int ldw, K, k0, n0, kind, which; };
__device__ __forceinline__ int cv_row(const CvItem& d, int n) {
    if (d.kind == 1) return (n >> 7) * 256 + d.which * 128 + (n & 127);
    if (d.kind == 2) { const int c = n - 256; return c < 1024 ? (c & ~127) + rope_phys(c & 127) : c; }
    return n;
}
__device__ __forceinline__ CvItem cv_decode(const KA& a, int l, int it) {
    CvItem d; unsigned char* ws = a.ws(); const int j = l >> 1; int r = it; d.which = 0;
    if (r < CV_GU) { const int mat = r >> 4, kb = r & 15, which = mat & 1, e = mat >> 1;
        d.src = (e < 64) ? a.in(which ? I_WU : I_WG) + ((size_t)(l * 64 + e) * DM * EDIM) : a.in(which ? I_SU : I_SG) + (size_t)l * DM * EDIM;
        d.dst = (bf16_t*)(ws + WS_WGU) + (size_t)(l * 65 + e) * 512 * DM; d.ldw = EDIM; d.K = DM; d.k0 = 64 * kb; d.n0 = 0; d.kind = 1; d.which = which; return d; }
    r -= CV_GU;
    if (r < CV_DN) { const int e = r >> 4, item = r & 15;
        d.src = (e < 64) ? a.in(I_WDN) + ((size_t)(l * 64 + e) * EDIM * DM) : a.in(I_SD) + (size_t)l * EDIM * DM;
        d.dst = (bf16_t*)(ws + WS_WD) + (size_t)(l * 65 + e) * DM * EDIM; d.ldw = DM; d.K = EDIM; d.k0 = 64 * (item >> 2); d.n0 = 256 * (item & 3); d.kind = 0; return d; }
    r -= CV_DN;
    if (r < cv_in(l)) {
        if ((l & 1) == 0) { d.src = a.in(I_ABWIN) + (size_t)j * DM * 1536; d.dst = (bf16_t*)(ws + WS_WINE) + (size_t)j * 1280 * DM; d.ldw = 1536; d.K = DM; d.k0 = 64 * (r / 5); d.n0 = 256 + 256 * (r % 5); d.kind = 2; }
        else { d.src = a.in(I_NAWIN) + (size_t)j * DM * 3072; d.dst = (bf16_t*)(ws + WS_WINO) + (size_t)j * 3072 * DM; d.ldw = 3072; d.K = DM; d.k0 = 64 * (r / 12); d.n0 = 256 * (r % 12); d.kind = 0; }
        return d; }
    r -= cv_in(l);
    d.src = ((l & 1) ? a.in(I_NAWOUT) : a.in(I_ABWOUT)) + (size_t)j * DM * DM; d.dst = (bf16_t*)(ws + WS_WOUT) + (size_t)l * DM * DM; d.ldw = DM; d.K = DM; d.k0 = 64 * (r >> 2); d.n0 = 256 * (r & 3); d.kind = 0;
    return d;
}
constexpr int CV_LS = 260;
__device__ __forceinline__ void cv_load(const CvItem& d, f32x4 (&v)[8], int t) {
    const float* p = d.src + (size_t)(d.k0 + (t >> 6)) * d.ldw + d.n0 + (t & 63) * 4;
#pragma unroll
    for (int i = 0; i < 8; ++i) v[i] = *(const f32x4*)(p + (size_t)(8 * i) * d.ldw);
}
__device__ __forceinline__ void convert_items(LAS unsigned char* lds, int l, int lo, int hi, int worker, int nworkers) {
    const KA a;
    const int t = opaque_tid();
    LAS float* img = (LAS float*)lds;
    int it = lo + worker;
    if (it >= hi) return;
    CvItem d0 = cv_decode(a, l, it); f32x4 v[8]; cv_load(d0, v, t);
    for (;;) {
        { LAS float* w = img + (t >> 6) * CV_LS + (t & 63) * 4;
#pragma unroll
          for (int i = 0; i < 8; ++i) *(LAS f32x4*)(w + i * 8 * CV_LS) = v[i]; }
        __syncthreads();
        const int itn = it + nworkers; const bool more = itn < hi;
        CvItem d1 = d0;
        if (more) { d1 = cv_decode(a, l, itn); cv_load(d1, v, t); }
        { const int n = (t >> 6) * 32 + (t & 31), qh = (t >> 5) & 1; bf16_t* orow = d0.dst + (size_t)cv_row(d0, d0.n0 + n) * d0.K + d0.k0;
#pragma unroll
          for (int p = 0; p < 4; ++p) { const int q = 2 * p + qh; const LAS float* s = img + (8 * q) * CV_LS + n;
              u32x4 o; o.x = cvt_pk_bf16(s[0 * CV_LS], s[1 * CV_LS]); o.y = cvt_pk_bf16(s[2 * CV_LS], s[3 * CV_LS]); o.z = cvt_pk_bf16(s[4 * CV_LS], s[5 * CV_LS]); o.w = cvt_pk_bf16(s[6 * CV_LS], s[7 * CV_LS]);
              *(u32x4*)(orow + 8 * q) = o; } }
        __syncthreads();
        if (!more) break;
        d0 = d1; it = itn;
    }
}
struct CvSlice { int l, i0, i1, l2, j0, j1; };
constexpr int CV_EX = CV_GU + CV_DN;
#ifndef CV_MODE
#define CV_MODE 1
#endif
__device__ __forceinline__ CvSlice cv_slice(int l, int phase  ) {
    const CvSlice none = {0, 0, 0, 0, 0, 0};
    if (CV_MODE == 0) return none;
    if (l == 0) { if (phase == 1) return {0, 0, 2000, 0, 0, 0}; if (phase == 2) return {0, 2000, 3000, 0, 0, 0};
                  if (phase == 4) return {1, CV_EX, cv_items(1), 1, 0, 744}; if (phase == 5) return {1, 744, 1144, 0, 0, 0}; }
    if (l == 1) { if (phase == 0) return {1, 1144, 2120, 0, 0, 0}; if (phase == 2) return {1, 2120, CV_EX, 0, 0, 0};
                  if (phase == 4) return {2, CV_EX, cv_items(2), 2, 0, 856}; if (phase == 5) return {2, 856, 1256, 0, 0, 0}; }
    if (l == 2) { if (phase == 1) return {2, 1256, CV_EX, 0, 0, 0}; if (phase == 2) return {3, CV_EX, cv_items(3), 3, 0, 744};
                  if (phase == 4) return {3, 744, 1744, 0, 0, 0}; if (phase == 5) return {3, 1744, 2144, 0, 0, 0}; }
    if (l == 3) { if (phase == 0) return {3, 2144, 3044, 0, 0, 0}; if (phase == 2) return {3, 3044, CV_EX, 0, 0, 0}; }
    return none;
}
__device__ __forceinline__ void cv_tail(LAS unsigned char* lds, int l, int phase, int n_units, int bid, int G) {
    const CvSlice c = cv_slice(l, phase);
    if (c.i1 <= c.i0 && c.j1 <= c.j0) return;
    const int rem = n_units % G, nw = (rem == 0) ? G : G - rem, w = (rem == 0) ? bid : bid - rem;
    if (w < 0) return;
    __syncthreads();
    if (c.i1 > c.i0) convert_items(lds, c.l, c.i0, c.i1, w, nw);
    if (c.j1 > c.j0) convert_items(lds, c.l2, c.j0, c.j1, w, nw);
}

__device__ __forceinline__ void p0_mod(const KA& a, LAS unsigned char* lds, int bid, int G, int tid, int wave, int lane) {
    LAS float* sl = (LAS float*)(lds + 69632);
    LAS float* part = (LAS float*)(lds + 69632 + 20480);
    for (int i = tid; i < 5 * DM; i += 512) { const int r = i >> 10, k = i & 1023; const float v = (r < 4) ? a.in(I_C)[r * DM + k] : a.in(I_CCTX)[k]; sl[i] = v / (1.0f + __expf(-v)); }
    __syncthreads();
    float* mod = (float*)(a.ws() + WS_MOD);
    for (int task = bid; task < DEPTH * 96; task += G) {
        const int l = task / 96, c0 = (task % 96) * 64;
        const float* w = a.in(I_WMOD) + (size_t)l * DM * 6144 + c0 + lane;
        float acc[5] = {0.f, 0.f, 0.f, 0.f, 0.f};
#pragma unroll 32
        for (int k = wave * 128; k < wave * 128 + 128; ++k) { const float wv = w[(size_t)k * 6144];
#pragma unroll
            for (int r = 0; r < 5; ++r) acc[r] += sl[r * DM + k] * wv; }
#pragma unroll
        for (int r = 0; r < 5; ++r) part[(wave * 5 + r) * 64 + lane] = acc[r];
        __syncthreads();
        if (tid < 320) { const int r = tid >> 6, c = tid & 63; float s = a.in(I_BMOD)[l * 6144 + c0 + c];
#pragma unroll
            for (int w8 = 0; w8 < 8; ++w8) s += part[(w8 * 5 + r) * 64 + c];
            mod[((size_t)l * 5 + r) * 6144 + c0 + c] = s; }
        __syncthreads();
    }
}

__device__ __forceinline__ void p0_fourier_fold(const KA& a, LAS unsigned char* lds, int task, int tid, int wave, int lane) {
    const int kq = task & 3, g = (task >> 2) & 3, q = (task >> 4) & 1, j = task >> 5;
    LAS float* M = (LAS float*)(lds + 100352);
    LAS float* trg = M + 4096;
    const float* Wf = a.in(I_ABWF) + (size_t)(j * 4 + g) * 64 * 64;
    __syncthreads();
    if (tid < 64) { const float ang = (float)tid * (1.0f / 32.0f); trg[tid] = q ? sinpif(ang) : cospif(ang); }
    __syncthreads();
    for (int i = tid; i < 4096; i += 512) { const int c = i >> 6, d = i & 63; float s = 0.f;
#pragma unroll 8
        for (int m = 0; m < 64; ++m) s += trg[(m * c) & 63] * Wf[m * 64 + d];
        M[i] = s; }
    __syncthreads();
    float mcol[64];
#pragma unroll
    for (int c = 0; c < 64; ++c) mcol[c] = M[c * 64 + lane];
    bf16_t* dst = (bf16_t*)(a.ws() + WS_WF) + ((size_t)j * 512 + q * 256 + g * 64 + lane) * DM;
    const float* win = a.in(I_ABWIN) + (size_t)j * DM * 1536 + g * 64 + lane;
    const int kbeg = kq * 256 + wave * 32;
    float wv = win[(size_t)kbeg * 1536];
    for (int k = kbeg; k < kbeg + 32; ++k) {
        const float wn = (k + 1 < kbeg + 32) ? win[(size_t)(k + 1) * 1536] : 0.f; float s = 0.f;
#pragma unroll
        for (int c = 0; c < 64; ++c) s += __int_as_float(__builtin_amdgcn_readlane(__float_as_int(wv), c)) * mcol[c];
        dst[k] = (bf16_t)(cvt_pk_bf16(s, 0.f) & 0xffffu);
        wv = wn;
    }
}

__device__ __forceinline__ void p0_tables(const KA& a, LAS unsigned char* lds, int gtid, int NGT, int tid) {
    LAS float* ctab = (LAS float*)(lds + 116736);
    for (int i = tid; i < 4096; i += 512) ctab[i] = cospif((float)i * (1.0f / 2048.0f));
    __syncthreads();
    bf16_t* TW = (bf16_t*)(a.ws() + WS_TW);
    for (int it = gtid; it < 4096 * 1024; it += NGT) {
        const int k = it >> 10, c8 = (it & 1023) * 8, n0 = c8 & 4095, sh = (c8 >> 12) ? 1024 : 0; const float sg = (c8 >> 12) ? (-1.0f / 512.0f) : (1.0f / 512.0f);
        float v[8];
#pragma unroll
        for (int j = 0; j < 8; ++j) v[j] = ctab[(k * (n0 + j) - sh) & 4095] * sg;
        u32x4 o; o.x = cvt_pk_bf16(v[0], v[1]); o.y = cvt_pk_bf16(v[2], v[3]); o.z = cvt_pk_bf16(v[4], v[5]); o.w = cvt_pk_bf16(v[6], v[7]);
        *(u32x4*)(TW + (size_t)k * 8192 + c8) = o;
    }
    bf16_t* TWC = (bf16_t*)(a.ws() + WS_TWC);
    for (int it = gtid; it < 256 * 64; it += NGT) {
        const int k = it >> 6, c8 = (it & 63) * 8, n0 = c8 & 255, sh = (c8 >> 8) ? 1024 : 0; const float sg = (c8 >> 8) ? (-1.0f / 128.0f) : (1.0f / 128.0f);
        float v[8];
#pragma unroll
        for (int j = 0; j < 8; ++j) v[j] = ctab[(((k * (n0 + j)) & 255) * 16 - sh) & 4095] * sg;
        u32x4 o; o.x = cvt_pk_bf16(v[0], v[1]); o.y = cvt_pk_bf16(v[2], v[3]); o.z = cvt_pk_bf16(v[4], v[5]); o.w = cvt_pk_bf16(v[6], v[7]);
        *(u32x4*)(TWC + (size_t)k * 512 + c8) = o;
    }
    bf16_t* WH = (bf16_t*)(a.ws() + WS_WRHI); bf16_t* WL = (bf16_t*)(a.ws() + WS_WRLO);
    for (int it = gtid; it < DEPTH * 64 * DM; it += NGT) {
        const int l = it >> 16, e = (it >> 10) & 63, k = it & 1023; const float w = a.in(I_WR)[((size_t)l * DM + k) * 64 + e];
        const unsigned h = cvt_pk_bf16(w, 0.f) & 0xffffu; const float r = w - __uint_as_float(h << 16);
        WH[it] = (bf16_t)h; WL[it] = (bf16_t)(cvt_pk_bf16(r, 0.f) & 0xffffu);
    }
    float* gp = (float*)(a.ws() + WS_GAINP);
    for (int it = gtid; it < 2 * 2 * 128; it += NGT) { const int j = it >> 8, qk = (it >> 7) & 1, d = it & 127; gp[(j * 2 + qk) * 128 + rope_phys(d)] = a.in(qk ? I_ABKN : I_ABQN)[j * 128 + d]; }
    f32x2* rp = (f32x2*)(a.ws() + WS_ROPE);
    for (int it = gtid; it < 64 * 32; it += NGT) { const int pos = it >> 5, i = it & 31; const float inv = exp2f(-(float)i * (13.287712379549449f / 32.0f));
        const float ang = (float)pos * inv; rp[it] = (f32x2){cosf(ang), sinf(ang)}; }
}

__device__ __forceinline__ const float* xrow_in(const KA& a, int l, int m) {
    if (l == 0) return m < TLAT ? a.in(I_X) + (size_t)m * DM : a.in(I_CTX) + (size_t)(m - TLAT) * DM;
    return (const float*)(a.ws() + WS_XS) + (size_t)m * DM;
}
__device__ __forceinline__ void p0b_modulate(const KA& a, int gw, int NGW, int lane) {
    const float* mod = (const float*)(a.ws() + WS_MOD);
    bf16_t* H = (bf16_t*)(a.ws() + WS_H);
    for (int m = gw; m < TT; m += NGW) {
        const f32x4* xr = (const f32x4*)xrow_in(a, 0, m) + lane; const float* md = mod + (size_t)tok_batchrow(m) * 6144;
        u32x2* o = (u32x2*)(H + (size_t)m * DM) + lane;
#pragma unroll
        for (int j = 0; j < 4; ++j) { const f32x4 x = xr[64 * j], sh = *((const f32x4*)md + lane + 64 * j), sc = *((const f32x4*)(md + DM) + lane + 64 * j);
            const f32x4 h = x * (sc + 1.0f) + sh; o[64 * j] = (u32x2){cvt_pk_bf16(h[0], h[1]), cvt_pk_bf16(h[2], h[3])}; }
    }
}

#ifndef PROBE_D
#define PROBE_D 7
#endif
__device__ __forceinline__ void phase_ln1_router(const KA& a, LAS unsigned char* lds, int l, int bid, int tid, int wave, int lane, const bool dry) {
    LAS float* lg = (LAS float*)lds;
    LAS int* hist = (LAS int*)(lds + 96 * 64 * 4);
    LAS int* pend = hist + 128;
    const float* mod = (const float*)(a.ws() + WS_MOD) + (size_t)l * 5 * 6144;
    const bf16_t* Y = (const bf16_t*)(a.ws() + WS_Y);
    float* XS = (float*)(a.ws() + (dry ? WS_ACT : WS_XS)); bf16_t* H = (bf16_t*)(a.ws() + (dry ? WS_YB + ((size_t)200 << 20) : WS_H)); bf16_t* HL = (bf16_t*)(a.ws() + (dry ? WS_YB + ((size_t)240 << 20) : WS_HL));
    if (tid < 64) hist[tid] = 0;
    const int NTOK = (l == DEPTH - 1) ? 64 : 68;
    const int tok0 = bid * NTOK;
    if (!dry || (PROBE_D & 1)) {
        f32x4 lng[4], lnb[4], g1[4], sc2[4], sh2[4];
        { const f32x4* pg = (const f32x4*)(a.in(I_LN1G) + l * DM) + lane; const f32x4* pb = (const f32x4*)(a.in(I_LN1B) + l * DM) + lane;
#pragma unroll
          for (int j = 0; j < 4; ++j) { lng[j] = pg[64 * j]; lnb[j] = pb[64 * j]; } }
        int cur_br = -1;
        f32x4 xn[4]; u32x2 yn[4];
        { const int m = tok0 + wave; const f32x4* xr = (const f32x4*)xrow_in(a, l, m) + lane; const u32x2* yr = (const u32x2*)(Y + (size_t)m * DM) + lane;
#pragma unroll
          for (int j = 0; j < 4; ++j) { xn[j] = xr[64 * j]; yn[j] = yr[64 * j]; } }
        for (int r = wave; r < NTOK; r += 8) {
            const int m = tok0 + r, br = tok_batchrow(m);
            if (br != cur_br) { cur_br = br; const float* md = mod + (size_t)br * 6144;
#pragma unroll
                for (int j = 0; j < 4; ++j) { g1[j] = *((const f32x4*)(md + 2 * DM) + lane + 64 * j); sh2[j] = *((const f32x4*)(md + 3 * DM) + lane + 64 * j); sc2[j] = *((const f32x4*)(md + 4 * DM) + lane + 64 * j) + 1.0f; } }
            f32x4 v[4]; float s = 0.f;
#pragma unroll
            for (int j = 0; j < 4; ++j) { const f32x4 y = {bf_lo(yn[j].x), bf_hi(yn[j].x), bf_lo(yn[j].y), bf_hi(yn[j].y)}; v[j] = xn[j] * DN_ALPHA + g1[j] * y; s += (v[j][0] + v[j][1]) + (v[j][2] + v[j][3]); }
            if (r + 8 < NTOK) { const int mn = m + 8; const f32x4* xr = (const f32x4*)xrow_in(a, l, mn) + lane; const u32x2* yr = (const u32x2*)(Y + (size_t)mn * DM) + lane;
#pragma unroll
                for (int j = 0; j < 4; ++j) { xn[j] = xr[64 * j]; yn[j] = yr[64 * j]; } }
            const float mean = wave_sum(s) * (1.0f / DM); float s2 = 0.f;
#pragma unroll
            for (int j = 0; j < 4; ++j) { v[j] = v[j] - mean; s2 += (v[j][0] * v[j][0] + v[j][1] * v[j][1]) + (v[j][2] * v[j][2] + v[j][3] * v[j][3]); }
            const float rstd = __builtin_amdgcn_rsqf(wave_sum(s2) * (1.0f / DM) + LN_EPS);
            f32x4* xo = (f32x4*)(XS + (size_t)m * DM) + lane; u32x2* ho = (u32x2*)(H + (size_t)m * DM) + lane; u32x2* hl = (u32x2*)(HL + (size_t)m * DM) + lane;
#pragma unroll
            for (int j = 0; j < 4; ++j) { const f32x4 x1 = v[j] * rstd * lng[j] + lnb[j]; xo[64 * j] = x1;
                const f32x4 h = x1 * sc2[j] + sh2[j];
                const unsigned h01 = cvt_pk_bf16(h[0], h[1]), h23 = cvt_pk_bf16(h[2], h[3]);
                ho[64 * j] = (u32x2){h01, h23};
                hl[64 * j] = (u32x2){cvt_pk_bf16(h[0] - bf_lo(h01), h[1] - bf_hi(h01)), cvt_pk_bf16(h[2] - bf_lo(h23), h[3] - bf_hi(h23))}; }
        }
    }
    VM_WAIT(); __syncthreads(); TS(4);
    __builtin_amdgcn_fence(__ATOMIC_ACQUIRE, "agent"); VM_WAIT();
    if (!dry || (PROBE_D & 2)) {
        const bf16_t* WH = (const bf16_t*)(a.ws() + WS_WRHI) + (size_t)l * 64 * DM; const bf16_t* WL = (const bf16_t*)(a.ws() + WS_WRLO) + (size_t)l * 64 * DM;
        const int ntile = wave & 3, mt0 = wave >> 2, fr = lane & 15, fq = lane >> 4;
        const bf16_t* pbh = WH + (size_t)(ntile * 16 + fr) * DM + fq * 8; const bf16_t* pbl = WL + (size_t)(ntile * 16 + fr) * DM + fq * 8;
        size_t ro[3];
#pragma unroll
        for (int i = 0; i < 3; ++i) ro[i] = (size_t)(tok0 + min((mt0 + 2 * i) * 16 + fr, NTOK - 1)) * DM + fq * 8;
        f32x4 acc[3];
#pragma unroll
        for (int i = 0; i < 3; ++i) acc[i] = (f32x4){0.f, 0.f, 0.f, 0.f};
#pragma unroll 1
        for (int kb = 0; kb < 32; kb += 4) {
            bf16x8 bh[4], bl[4], ah[4][3], al[4][3];
#pragma unroll
            for (int q = 0; q < 4; ++q) { bh[q] = *(const bf16x8*)(pbh + (kb + q) * 32); bl[q] = *(const bf16x8*)(pbl + (kb + q) * 32);
#pragma unroll
                for (int i = 0; i < 3; ++i) { ah[q][i] = *(const bf16x8*)(H + ro[i] + (kb + q) * 32); al[q][i] = *(const bf16x8*)(HL + ro[i] + (kb + q) * 32); } }
            __builtin_amdgcn_sched_barrier(0);
#pragma unroll
            for (int q = 0; q < 4; ++q)
#pragma unroll
                for (int i = 0; i < 3; ++i) {
                    acc[i] = __builtin_amdgcn_mfma_f32_16x16x32_bf16(ah[q][i], bh[q], acc[i], 0, 0, 0);
                    acc[i] = __builtin_amdgcn_mfma_f32_16x16x32_bf16(ah[q][i], bl[q], acc[i], 0, 0, 0);
                    acc[i] = __builtin_amdgcn_mfma_f32_16x16x32_bf16(al[q][i], bh[q], acc[i], 0, 0, 0); }
            __builtin_amdgcn_sched_barrier(0);
        }
#pragma unroll
        for (int i = 0; i < 3; ++i)
#pragma unroll
            for (int q = 0; q < 4; ++q) lg[((mt0 + 2 * i) * 16 + fq * 4 + q) * 64 + ntile * 16 + fr] = acc[i][q];
    }
    __syncthreads(); TS(5);
    if (!dry || (PROBE_D & 4)) {
        int* tke = (int*)(a.ws() + WS_TKE); float* tkw = (float*)(a.ws() + WS_TKW);
        const float ebias = a.in(I_EBIAS)[l * 64 + lane];
        for (int r = wave; r < NTOK; r += 8) {
            const int m = tok0 + r;
            const float score = 1.0f / (1.0f + __expf(-lg[r * 64 + lane]));
            const float sel = score + ebias; int rank = 0;
#pragma unroll
            for (int c = 0; c < 64; ++c) { const float o = __int_as_float(__builtin_amdgcn_readlane(__float_as_int(sel), c)); rank += (o > sel || (o == sel && c < lane)) ? 1 : 0; }
            const bool mine = rank < TOPK;
            const unsigned long long taken = __ballot(mine);
            const float wsum = wave_sum(mine ? score : 0.f);
            if (mine) { const int k = __popcll(taken & ((1ull << lane) - 1ull)); const int lr = __hip_atomic_fetch_add(&hist[lane], 1, __ATOMIC_RELAXED, __HIP_MEMORY_SCOPE_WORKGROUP);
                if (!dry) { tke[m * 8 + k] = lane; tkw[m * 8 + k] = score / wsum * ROUTE_SCALE; } pend[r * 8 + k] = (lane << 16) | lr; }
        }
    }
    __syncthreads();
    if (dry) return;
    { unsigned* cnt = (unsigned*)(a.ws() + WS_CTL) + CW_CNT + l * 64;
      if (tid < 64) hist[64 + tid] = (int)atomicAdd(&cnt[tid], (unsigned)hist[tid]); }
    __syncthreads();
    { int* tkp = (int*)(a.ws() + WS_TKP); int* list = (int*)(a.ws() + WS_LIST);
      for (int i = tid; i < NTOK * 8; i += 512) { const int pe = pend[i], e = pe >> 16, p = hist[64 + e] + (pe & 0xffff); const int m = tok0 + (i >> 3);
        tkp[m * 8 + (i & 7)] = p; list[(size_t)e * TT + p] = m; } }
    __syncthreads();
}

constexpr float YB_SCALE_G = 32.0f;
__device__ __forceinline__ void phase_combine_ln2(const KA& a, LAS unsigned char* lds, int l, int gw, int NGW, int tid, int lane, const bool dry) {
    LAS int* rst = (LAS int*)(lds + LDS_TAB) + 66;
    const float* mod = (const float*)(a.ws() + WS_MOD) + (size_t)l * 5 * 6144;
    const unsigned char* YB = (const unsigned char*)(a.ws() + WS_YB);
    const float* XSi = (const float*)(a.ws() + WS_XS); float* XS = (float*)(a.ws() + (dry ? WS_ACT : WS_XS)); bf16_t* H = (bf16_t*)(a.ws() + (dry ? WS_HL : WS_H));
    const int* tke = (const int*)(a.ws() + WS_TKE); const float* tkw = (const float*)(a.ws() + WS_TKW); const int* tkp = (const int*)(a.ws() + WS_TKP);
    const int mend = (l == DEPTH - 1) ? TLAT : TT;
    const int e0 = 16 * lane;
    f32x4 lng[4], lnb[4];
    { const f32x4* pg = (const f32x4*)(a.in(I_LN2G) + l * DM + e0); const f32x4* pb = (const f32x4*)(a.in(I_LN2B) + l * DM + e0);
#pragma unroll
      for (int j = 0; j < 4; ++j) { lng[j] = pg[j]; lnb[j] = pb[j]; } }
    float* outp = dry ? (float*)(a.ws() + WS_ACT) : a.out();
#define G_SLOTS(M0, SLOT, W) do { _Pragma("unroll") for (int q = 0; q < 2; ++q) { const int mq = (q == 0 || (M0) + NGW < mend) ? (M0) + q * NGW : (M0); SLOT[q] = 0; W[q] = 1.0f / YB_SCALE_G; \
        if ((M0) < mend) { if (lane < 8) { SLOT[q] = rst[tke[mq * 8 + lane]] + tkp[mq * 8 + lane]; W[q] = tkw[mq * 8 + lane] * (1.0f / YB_SCALE_G); } if (lane == 8) SLOT[q] = rst[64] + mq; } } } while (0)
    int slotn[2]; float wn[2];
    G_SLOTS(gw, slotn, wn);
    for (int m0 = gw; m0 < mend; m0 += 2 * NGW) {
        int mm[2]; mm[0] = m0; mm[1] = (m0 + NGW < mend) ? m0 + NGW : m0;
        const bool two = (m0 + NGW < mend);
        int slot[2]; float w[2];
        slot[0] = slotn[0]; slot[1] = slotn[1]; w[0] = wn[0]; w[1] = wn[1];
        G_SLOTS(m0 + 2 * NGW, slotn, wn);
        f32x4 ff[2][4]; f32x4 xv[2][4];
#pragma unroll
        for (int q = 0; q < 2; ++q) { const f32x4* xi = (const f32x4*)(XSi + (size_t)mm[q] * DM + e0);
#pragma unroll
            for (int j = 0; j < 4; ++j) { ff[q][j] = (f32x4){0.f, 0.f, 0.f, 0.f}; xv[q][j] = xi[j]; } }
        u32x4 yy[2][9];
#pragma unroll
        for (int k = 0; k < 9; ++k)
#pragma unroll
            for (int q = 0; q < 2; ++q) { const int sk = __builtin_amdgcn_readlane(slot[q], k); yy[q][k] = *(const u32x4*)(YB + (size_t)sk * DM + e0); }
#pragma unroll
        for (int k = 0; k < 9; ++k)
#pragma unroll
            for (int q = 0; q < 2; ++q) { const float wk = __int_as_float(__builtin_amdgcn_readlane(__float_as_int(w[q]), k));
#pragma unroll
                for (int j = 0; j < 4; ++j) { const f32x2 lo2 = __builtin_amdgcn_cvt_pk_f32_fp8((int)yy[q][k][j], false), hi2 = __builtin_amdgcn_cvt_pk_f32_fp8((int)yy[q][k][j], true);
                    ff[q][j] += (f32x4){lo2.x, lo2.y, hi2.x, hi2.y} * wk; } }
#pragma unroll
        for (int q = 0; q < 2; ++q) {
            if (q == 1 && !two) break;
            const int m = mm[q]; const float* md = mod + (size_t)tok_batchrow(m) * 6144;
            f32x4 v[4]; float s = 0.f;
#pragma unroll
            for (int j = 0; j < 4; ++j) { const f32x4 g2 = *((const f32x4*)(md + 5 * DM + e0) + j);
                v[j] = xv[q][j] * DN_ALPHA + g2 * ff[q][j]; s += (v[j][0] + v[j][1]) + (v[j][2] + v[j][3]); }
            const float mean = wave_sum(s) * (1.0f / DM); float s2 = 0.f;
#pragma unroll
            for (int j = 0; j < 4; ++j) { v[j] = v[j] - mean; s2 += (v[j][0] * v[j][0] + v[j][1] * v[j][1]) + (v[j][2] * v[j][2] + v[j][3] * v[j][3]); }
            const float rstd = __builtin_amdgcn_rsqf(wave_sum(s2) * (1.0f / DM) + LN_EPS);
            if (l == DEPTH - 1) {
                f32x4* oo = (f32x4*)(outp + (size_t)m * DM + e0);
#pragma unroll
                for (int j = 0; j < 4; ++j) oo[j] = v[j] * rstd * lng[j] + lnb[j];
            } else {
                const float* mdn = md + 5 * 6144;
                f32x4* xio = (f32x4*)(XS + (size_t)m * DM + e0); u32x4* ho = (u32x4*)(H + (size_t)m * DM + e0);
                unsigned hp[8];
#pragma unroll
                for (int j = 0; j < 4; ++j) { const f32x4 x2 = v[j] * rstd * lng[j] + lnb[j]; xio[j] = x2;
                    const f32x4 sh = *((const f32x4*)(mdn + e0) + j), sc = *((const f32x4*)(mdn + DM + e0) + j);
                    const f32x4 h = x2 * (sc + 1.0f) + sh; hp[2 * j] = cvt_pk_bf16(h[0], h[1]); hp[2 * j + 1] = cvt_pk_bf16(h[2], h[3]); }
                ho[0] = (u32x4){hp[0], hp[1], hp[2], hp[3]}; ho[1] = (u32x4){hp[4], hp[5], hp[6], hp[7]};
            }
        }
    }
#undef G_SLOTS
}

__device__ __forceinline__ void build_expert_tables(const KA& a, LAS unsigned char* lds, int l, int tid) {
    LAS int* tst = (LAS int*)(lds + LDS_TAB); LAS int* rst = tst + 66; LAS int* cn = rst + 66;
    __syncthreads();
    if (tid < 64) {
        const unsigned* cnt = (const unsigned*)(a.ws() + WS_CTL) + CW_CNT + l * 64;
        const int c = (int)__hip_atomic_load(cnt + tid, __ATOMIC_RELAXED, __HIP_MEMORY_SCOPE_AGENT);
        int t = (c + 255) >> 8, r = c;
#pragma unroll
        for (int o = 1; o < 64; o <<= 1) { const int t2 = __shfl_up(t, o), r2 = __shfl_up(r, o); if (tid >= o) { t += t2; r += r2; } }
        tst[tid] = t - ((c + 255) >> 8); rst[tid] = r - c; cn[tid] = c;
        const int nsh = (l == DEPTH - 1) ? TLAT : TT;
        if (tid == 63) { tst[64] = t; rst[64] = r; cn[64] = nsh; tst[65] = t + (nsh >> 8); rst[65] = r + nsh; }
    }
    __syncthreads();
}

struct Seg {
    int i0, c, G, first, n;
    __device__ __forceinline__ void init(int first_, int n_, int c_, int G_) { first = first_; n = n_; c = c_; G = G_; i0 = (first_ <= c_) ? 0 : (first_ - c_ + G_ - 1) / G_; }
    __device__ __forceinline__ int idx(int i) const { const int L = (i0 + i) * G + c - first; return L < n ? L : -1; }
};
__device__ __forceinline__ int kv_row0(int pm) { return pm < 64 ? (pm >> 4) * KVR + (pm & 15) * 256 : (pm - 64) * KVR + LSEQ; }

struct SchedQKVE { Seg s; unsigned char* ws; int j;
    __device__ __forceinline__ bool next(int i, pg8::Unit& u) { const int L0 = s.idx(i); if (L0 < 0) return false;
        size_t offA, offB, offC; int ldc, x0, x1 = 0;
        if (L0 >= 340) { const int L = L0 - 340; x0 = 3;
            if (L < 128) { const int q = L >> 6, mt = L & 63, b = mt >> 4;
                offA = WS_WF + ((size_t)j * 512 + q * 256) * 2048; offB = WS_H + (size_t)mt * 256 * 2048; offC = WS_ZT + ((size_t)b * 256 * 8192 + q * 4096 + (mt & 15) * 256) * 2; ldc = 8192; }
            else { const int q = (L - 128) >> 2, b = (L - 128) & 3;
                offA = WS_WF + ((size_t)j * 512 + q * 256) * 2048; offB = WS_H + (size_t)(TLAT + b * 256) * 2048; offC = WS_ZCT + ((size_t)b * 256 * 512 + q * 256) * 2; ldc = 512; }
        } else { const int pm = L0 % 68, pn = L0 / 68;
            offA = WS_H + (size_t)pm * 256 * 2048; offB = WS_WINE + ((size_t)j * 1280 + pn * 256) * 2048; x1 = pm < 64 ? (pm & 15) * 256 : -1;
            if (pn < 3) { offC = WS_QB + ((size_t)pm * 256 * 768 + pn * 256) * 2; ldc = 768; x0 = 0; }
            else { offC = (pn == 3 ? WS_KB : WS_VB) + (size_t)kv_row0(pm) * 128 * 2; ldc = 128; x0 = pn - 2; } }
        u.A = (const char*)(ws + offA); u.B = (const char*)(ws + offB); u.C = (char*)(ws + offC); u.ldc = ldc; u.x0 = x0; u.x1 = x1; u.rows = nullptr; u.nvalid = 256;
        return true; } };
struct SchedQKVO { Seg s; unsigned char* ws; int j;
    __device__ __forceinline__ bool next(int i, pg8::Unit& u) { const int L = s.idx(i); if (L < 0) return false; const int pm = L % 68, pn = L / 68;
        u.A = (const char*)(ws + WS_H) + (size_t)pm * 256 * 2048; u.B = (const char*)(ws + WS_WINO) + ((size_t)j * 3072 + pn * 256) * 2048; u.rows = nullptr; u.nvalid = 256; u.x0 = 0; u.x1 = 0; u.ldc = 1024;
        if (pn < 4) u.C = (char*)(ws + WS_QB) + ((size_t)pm * 256 * 1024 + pn * 256) * 2;
        else u.C = (char*)(ws + (pn < 8 ? WS_KB : WS_VB)) + ((size_t)kv_row0(pm) * 1024 + (pn & 3) * 256) * 2;
        return true; } };
struct SchedDFT { Seg s; unsigned char* ws;
    __device__ __forceinline__ bool next(int i, pg8::Unit& u) { const int L = s.idx(i); if (L < 0) return false; const int pm = L & 15, b = L >> 4;
        u.A = (const char*)(ws + WS_TW) + (size_t)pm * 256 * 16384; u.B = (const char*)(ws + WS_ZT) + (size_t)b * 256 * 16384;
        u.C = (char*)(ws + WS_O) + (size_t)(b * LSEQ + pm * 256) * 1024 * 2; u.ldc = 1024; u.rows = nullptr; u.nvalid = 256; u.x0 = 0; u.x1 = 0; return true; } };
struct SchedDFTC { Seg s; unsigned char* ws;
    __device__ __forceinline__ bool next(int i, pg8::Unit& u) { const int b = s.idx(i); if (b < 0) return false;
        u.A = (const char*)(ws + WS_TWC); u.B = (const char*)(ws + WS_ZCT) + (size_t)b * 256 * 1024;
        u.C = (char*)(ws + WS_O) + (size_t)(TLAT + b * 256) * 1024 * 2; u.ldc = 1024; u.rows = nullptr; u.nvalid = 256; u.x0 = 0; u.x1 = 0; return true; } };
struct SchedOUT { Seg s; unsigned char* ws; int l, nm;
    __device__ __forceinline__ bool next(int i, pg8::Unit& u) { const int L = s.idx(i); if (L < 0) return false; const int pm = L % nm, pn = L / nm;
        u.A = (const char*)(ws + WS_O) + (size_t)pm * 256 * 2048; u.B = (const char*)(ws + WS_WOUT) + ((size_t)l * 1024 + pn * 256) * 2048;
        u.C = (char*)(ws + WS_Y) + ((size_t)pm * 256 * 1024 + pn * 256) * 2; u.ldc = 1024; u.rows = nullptr; u.nvalid = 256; u.x0 = 0; u.x1 = 0; return true; } };
struct SchedGU { Seg s; unsigned char* ws; int l; const LAS int* tab; int e; int L0, cnt; int probe;
    __device__ __forceinline__ bool next(int i, pg8::Unit& u) { const int L = cnt > 0 ? (i < cnt ? L0 + i : -1) : s.idx(i); if (L < 0) return false; const int mtg = L >> 1, nt = L & 1;
        while (tab[e + 1] <= mtg) ++e;
        while (tab[e] > mtg) --e;
        const int mt = mtg - tab[e], r0 = tab[66 + e] + mt * 256;
        u.A = (const char*)(ws + WS_H); u.rows = (const int*)(ws + WS_LIST) + (size_t)e * TT + mt * 256; u.nvalid = min(256, tab[132 + e] - mt * 256);
        u.B = (const char*)(ws + WS_WGU) + ((size_t)(l * 65 + e) * 512 + nt * 256) * 2048;
        u.C = (char*)(ws + WS_ACT) + ((size_t)r0 * 256 + nt * 128) * 2; u.ldc = 256; u.x0 = 0; u.x1 = 0;
        if (probe & 1) u.rows = (const int*)(ws + WS_LIST) + (size_t)64 * TT + (mtg & 63) * 256;
        if (probe & 2) u.nvalid = 0;
        return true; } };
struct SchedDN { Seg s; unsigned char* ws; int l; const LAS int* tab; int e; int probe; int L0, cnt;
    __device__ __forceinline__ bool next(int i, pg8::Unit& u) { const int L = cnt > 0 ? (i < cnt ? L0 + i : -1) : s.idx(i); if (L < 0) return false; const int mtg = L >> 2, nt = L & 3;
        while (tab[e + 1] <= mtg) ++e;
        while (tab[e] > mtg) --e;
        const int mt = mtg - tab[e], r0 = tab[66 + e] + mt * 256;
        u.A = (const char*)(ws + WS_ACT) + (size_t)r0 * 512; u.rows = nullptr; u.nvalid = min(256, tab[132 + e] - mt * 256);
        u.B = (const char*)(ws + WS_WD) + ((size_t)(l * 65 + e) * 1024 + nt * 256) * 512;
        u.C = (char*)(ws + WS_YB) + ((size_t)r0 * 1024 + nt * 256); u.ldc = 1024; u.x0 = 0; u.x1 = 0;
        if (probe & 1) u.nvalid = 0;
        if (probe & 2) { u.A = (const char*)(ws + WS_ACT); u.B = (const char*)(ws + WS_WD) + (size_t)(l * 65) * 1024 * 512; }
        return true; } };

constexpr int NPHASE = 2 + 7 * DEPTH;
#ifndef PHMASK
#define PHMASK 0xFFFFF
#endif
#define SITE(b) if constexpr ((PHMASK >> (b)) & 1)
#ifndef REP_A
#define REP_A 1
#endif
#ifndef REP_B
#define REP_B 1
#endif
#ifndef REP_BO
#define REP_BO 1
#endif
#ifndef REP_C
#define REP_C 1
#endif
#ifndef REP_E
#define REP_E 1
#endif
#ifndef REP_F
#define REP_F 1
#endif
#ifndef REP_D
#define REP_D 1
#endif
#ifndef REP_G
#define REP_G 1
#endif
#ifndef REP_BAR
#define REP_BAR 1
#endif
#ifndef PROBE_TS_A
#define PROBE_TS_A 0
#endif
#ifndef PROBE_TS_B
#define PROBE_TS_B 1
#endif
#ifndef EF_FUSED
#define EF_FUSED 0
#endif
#ifndef E_STAGGER
#define E_STAGGER 0
#endif
#ifndef PROBE_E
#define PROBE_E 0
#endif
#ifndef PROBE_F
#define PROBE_F 0
#endif
#ifndef REP_P0
#define REP_P0 2
#endif
__global__ void __launch_bounds__(512, 2) fwd(Args args_) {
    extern __shared__ __attribute__((aligned(16))) unsigned char lds_raw[];
    LAS unsigned char* lds = (LAS unsigned char*)lds_raw;
    const int G = gridDim.x, bid = ((G & 7) == 0) ? (int)(blockIdx.x & 7) * (G >> 3) + (int)(blockIdx.x >> 3) : (int)blockIdx.x;
#define tid (opaque_tid())
#define lane (opaque_tid() & 63)
#define wave (__builtin_amdgcn_readfirstlane(opaque_tid() >> 6))
    const KA a;
#define WSP (a.ws())
#define args a
    volatile LAS unsigned* MISC = (volatile LAS unsigned*)(lds + LDS_MISC);
    { const int t0 = threadIdx.x; if (t0 < 64) MISC[t0] = 0u; }
    __syncthreads();
    if (PROBE_TS && threadIdx.x == 0) *(volatile LAS unsigned long long*)(lds + LDS_MISC + 192) = __builtin_amdgcn_s_memrealtime();
#define lo (a.ph_lo())
#define hi (a.ph_hi())
    XcdBarrier bar; bar.bar = (unsigned*)(WSP + WS_CTL) + CW_BAR; bar.x = 0; bar.st = MISC + 8;
    if (hi - lo > 1) bar = xcd_barrier_post((unsigned*)(WSP + WS_CTL) + CW_BAR, MISC + 8);
#define IN(k) (lo <= (k) && (k) < hi)
#define SEAM(k) do { if (IN(k) && IN((k) + 1)) for (int rb = 0; rb < REP_BAR; ++rb) xcd_barrier(bar); TS(10); } while (0)
    const int NGW = G * 8;
#define gw (bid * 8 + wave)

    if (IN(0)) SITE(0) for (int rep = 0; rep < REP_P0; ++rep) {
        __syncthreads();
        p0_mod(args, lds, bid, G, tid, wave, lane);
        if (bid >= G - 64) p0_fourier_fold(args, lds, G - 1 - bid, tid, wave, lane);
        p0_tables(args, lds, bid * 512 + tid, G * 512, tid);
        { int* ident = (int*)(WSP + WS_LIST) + (size_t)NEXP * TT; for (int i = bid * 512 + tid; i < TT; i += G * 512) ident[i] = i; }
        __syncthreads();
        if (CV_MODE == 0) convert_items(lds, 0, 0, cv_items(0), bid, G);
        else { convert_items(lds, 0, CV_EX, cv_items(0), bid, G); convert_items(lds, 0, 3000, CV_EX, bid, G); }
        if (CV_MODE == 0) { for (int lq = 1; lq < DEPTH; ++lq) convert_items(lds, lq, 0, cv_items(lq), bid, G); }
    }
    TS(0); SEAM(0);
    if (IN(1)) SITE(0) p0b_modulate(args, gw, NGW, lane);
    TS(0); SEAM(1);

    for (int l = 0; l < DEPTH; ++l) {
        const int pb = 2 + 7 * l, j = l >> 1;
        if (IN(pb + 0)) for (int rep = 0; rep < REP_A; ++rep) {
            if ((l & 1) == 0) {
                SITE(1) { SchedQKVE S; S.s.init(0, 476, bid, G); S.ws = WSP; S.j = j;
                  pg8::EpiQKVE E; E.P = (LAS float*)(lds + LDS_EPI); E.gainp = (const float*)(WSP + WS_GAINP) + j * 256; E.rope = (const f32x2*)(WSP + WS_ROPE);
                  pg8::gemm_phase<pg8::EpiQKVE, SchedQKVE, false>(lds, 1024, S, E); }
            } else SITE(3) {
                SchedQKVO S; S.s.init(0, 816, bid, G); S.ws = WSP; S.j = j; pg8::EpiStore E;
                pg8::gemm_phase<pg8::EpiStore, SchedQKVO, false>(lds, 1024, S, E);
                if (rep == 0) cv_tail(lds, l, 0, 816, bid, G);
            }
        }
        TS(1); SEAM(pb + 0);
        if (IN(pb + 1)) for (int rep = 0; rep < ((l & 1) ? REP_BO : REP_B); ++rep) {
            __syncthreads();
            const bf16_t* QB = (const bf16_t*)(WSP + WS_QB); const bf16_t* KB = (const bf16_t*)(WSP + WS_KB); const bf16_t* VB = (const bf16_t*)(WSP + WS_VB); bf16_t* O = (bf16_t*)(WSP + WS_O);
            if ((l & 1) == 0) {
                SITE(4) { SchedDFT S; S.s.init(0, 64, bid, G); S.ws = WSP; pg8::EpiStore E; pg8::gemm_phase<pg8::EpiStore, SchedDFT, false>(lds, 8192, S, E); }
                SITE(5) { SchedDFTC S; S.s.init(28, 4, bid, G); S.ws = WSP; pg8::EpiStore E; pg8::gemm_phase<pg8::EpiStore, SchedDFTC, false>(lds, 512, S, E); }
                __syncthreads();
                if (bid < 64 && rep == 0) { const CvSlice c = cv_slice(l, 1); if (c.i1 > c.i0) { __syncthreads(); convert_items(lds, c.l, c.i0, c.i1, bid, 64); __syncthreads(); } }
                SITE(6) {
                    int u = (bid < 24) ? bid : (bid >= 64 ? bid - 40 : 408);
                    while (u < 408) {
                        const bf16_t *q, *k, *v; bf16_t* o; int ntile;
                        if (u < 24) { const int b = u / 6, h = u % 6; q = QB + (TLAT + b * 256) * 768 + h * 128; k = KB + ((h / 3) * NB * KVR + b * KVR + LSEQ) * 128; v = VB + ((h / 3) * NB * KVR + b * KVR + LSEQ) * 128;
                            o = O + (TLAT + b * 256) * 1024 + 256 + h * 128; ntile = 4; u = 408; }
                        else { const int uu = u - 24, bk = uu / 48, x = uu % 48, b = bk >> 1, kvh = bk & 1, h = kvh * 3 + x / 16, qb = x & 15;
                            q = QB + (b * LSEQ + qb * 256) * 768 + h * 128; k = KB + (kvh * NB * KVR + b * KVR) * 128; v = VB + (kvh * NB * KVR + b * KVR) * 128;
                            o = O + (b * LSEQ + qb * 256) * 1024 + 256 + h * 128; ntile = 68; u += 192; }
                        att::attn_body<false, 768, 128, 1024>(q, k, v, o, ntile, 0, 0, 0, (char*)lds_raw);
                    }
                }
            } else {
                const float* rpb = a.in(I_NARPB) + (size_t)j * 8 * 465;
                LAS float* bt = (LAS float*)(lds + att::LDS_BIAS);
                SITE(7) for (int u = bid; u < ((l == DEPTH - 1) ? 512 : 544); u += G) {
                    const bf16_t *q, *k, *v; bf16_t* o; int ntile, nloc, bs, q0r, h;
                    if (u < 512) { const int bh = u >> 4, blk = u & 15, b = bh >> 3; h = bh & 7; bs = min(max(4 * blk - 4, 0), 52); q0r = 4 * blk; ntile = 16; nloc = 12;
                        q = QB + (b * LSEQ + blk * 256) * 1024 + h * 128; k = KB + b * KVR * 1024 + h * 128; v = VB + b * KVR * 1024 + h * 128; o = O + (b * LSEQ + blk * 256) * 1024 + h * 128; }
                    else { const int b = (u - 512) >> 3; h = u & 7; bs = 0; q0r = 0; ntile = 4; nloc = 0;
                        q = QB + (TLAT + b * 256) * 1024 + h * 128; k = KB + b * KVR * 1024 + h * 128; v = VB + b * KVR * 1024 + h * 128; o = O + (TLAT + b * 256) * 1024 + h * 128; }
                    for (int i = tid; i < 465; i += 512) bt[64 + i] = rpb[h * 465 + i] * (1.0f / ATT_SCALE);
                    att::attn_body<true, 1024, 1024, 1024>(q, k, v, o, ntile, nloc, bs, q0r, (char*)lds_raw);
                }
            }
        }
        TS(2); SEAM(pb + 1);
        if (IN(pb + 2)) SITE(9) for (int rep = 0; rep < REP_C; ++rep) { const int nm = (l == DEPTH - 1) ? 64 : 68;
            SchedOUT S; S.s.init(0, nm * 4, bid, G); S.ws = WSP; S.l = l; S.nm = nm; pg8::EpiStore E; pg8::gemm_phase<pg8::EpiStore, SchedOUT, false>(lds, 1024, S, E);
            if (rep == 0) cv_tail(lds, l, 2, nm * 4, bid, G); }
        TS(3); SEAM(pb + 2);
        if (IN(pb + 3)) SITE(10) for (int rep = 0; rep < REP_D; ++rep) { __syncthreads(); phase_ln1_router(args, lds, l, bid, tid, wave, lane, rep + 1 < REP_D); }
        TS(6); SEAM(pb + 3);
#if EF_FUSED
        if (IN(pb + 4)) SITE(11) for (int rep = 0; rep < REP_E; ++rep) { build_expert_tables(args, lds, l, tid);
            const LAS int* tab = (const LAS int*)(lds + LDS_TAB);
            const int nsu = tab[65]; int ecur = 0;
            for (int su = bid; su < nsu; su += G) {
                { SchedGU S; S.s.init(0, 0, bid, G); S.ws = WSP; S.l = l; S.tab = tab; S.e = ecur; S.L0 = su * 2; S.cnt = 2; S.probe = 0; pg8::EpiSwiGLU E;
                  pg8::gemm_phase<pg8::EpiSwiGLU, SchedGU, true>(lds, 1024, S, E); ecur = S.e; }
                VM_WAIT(); __syncthreads();
                __builtin_amdgcn_fence(__ATOMIC_ACQUIRE, "agent"); VM_WAIT();
                { SchedDN S; S.s.init(0, 0, bid, G); S.ws = WSP; S.l = l; S.tab = tab; S.e = ecur; S.probe = 0; S.L0 = su * 4; S.cnt = 4; pg8::EpiStoreF8 E;
                  int k256 = 256; asm volatile("" : "+s"(k256));
                  pg8::gemm_phase<pg8::EpiStoreF8, SchedDN, false>(lds, k256, S, E); }
            }
            if (rep == 0) { cv_tail(lds, l, 4, nsu, bid, G); cv_tail(lds, l, 5, nsu, bid, G); } }
        TS(7); SEAM(pb + 4);
        if (IN(pb + 5) && !IN(pb + 4)) {}
#else
        if (IN(pb + 4)) SITE(11) for (int rep = 0; rep < REP_E; ++rep) { build_expert_tables(args, lds, l, tid);
            const LAS int* tab = (const LAS int*)(lds + LDS_TAB);
            if (E_STAGGER && (bid & 1) && bid >= 8) { const unsigned long long t0s = __builtin_amdgcn_s_memrealtime(); while (__builtin_amdgcn_s_memrealtime() - t0s < (unsigned long long)E_STAGGER) __builtin_amdgcn_s_sleep(16); }
            SchedGU S; S.s.init(0, tab[65] * 2, bid, G); S.ws = WSP; S.l = l; S.tab = tab; S.e = 0; S.L0 = 0; S.cnt = 0; S.probe = (rep + 1 < REP_E) ? PROBE_E : 0; pg8::EpiSwiGLU E;
            pg8::gemm_phase<pg8::EpiSwiGLU, SchedGU, true>(lds, 1024, S, E);
            if (rep == 0) cv_tail(lds, l, 4, tab[65] * 2, bid, G); }
        TS(7); SEAM(pb + 4);
        if (IN(pb + 5)) SITE(12) for (int rep = 0; rep < REP_F; ++rep) { build_expert_tables(args, lds, l, tid);
            const LAS int* tab = (const LAS int*)(lds + LDS_TAB);
            SchedDN S; S.s.init(0, tab[65] * 4, bid, G); S.ws = WSP; S.l = l; S.tab = tab; S.e = 0; S.probe = (rep + 1 < REP_F) ? PROBE_F : 0; S.L0 = 0; S.cnt = 0; pg8::EpiStoreF8 E;
            int k256 = 256; asm volatile("" : "+s"(k256));
            pg8::gemm_phase<pg8::EpiStoreF8, SchedDN, false>(lds, k256, S, E);
            if (rep == 0) cv_tail(lds, l, 5, tab[65] * 4, bid, G); }
        TS(8); SEAM(pb + 5);
#endif
        if (IN(pb + 6)) SITE(13) for (int rep = 0; rep < REP_G; ++rep) { build_expert_tables(args, lds, l, tid); phase_combine_ln2(args, lds, l, gw, NGW, tid, lane, rep + 1 < REP_G); }
        TS(9); SEAM(pb + 6);
    }
    if (PROBE_TS) { xcd_barrier(bar); volatile LAS float* ta_ = (volatile LAS float*)(lds + LDS_MISC + 64);
        if (blockIdx.x == 0) { float* o_ = a.out(); const float va = ta_[PROBE_TS_A] * 0.01f * 16.0f, vb = ta_[PROBE_TS_B] * 0.01f * 0.25f;
            for (int i = threadIdx.x; i < 65536; i += 512) o_[1 + i] += vb; __syncthreads(); if (threadIdx.x == 0) o_[0] = va; } }
#undef IN
#undef SEAM
#undef lo
#undef hi
#undef lane
#undef wave
#undef gw
#undef tid
#undef WSP
#undef args
}

extern "C" void kernel_launch(void* const* d_in, const int* in_sizes, int n_in, void* d_out, int out_size, void* d_ws, size_t ws_size, hipStream_t stream) {
    static int ok = 0;
    if (ok == 0) {
        if (n_in != N_IN || ws_size < WS_END) { fprintf(stderr, "kernel_launch: n_in %d (want %d), ws %zu (want >= %zu)\n", n_in, (int)N_IN, ws_size, (size_t)WS_END); return; }
        if (hipFuncSetAttribute((const void*)fwd, hipFuncAttributeMaxDynamicSharedMemorySize, LDS_BYTES) != hipSuccess) { fprintf(stderr, "kernel_launch: hipFuncSetAttribute failed\n"); return; }
        int per_cu = 0;
        if (hipOccupancyMaxActiveBlocksPerMultiprocessor(&per_cu, (const void*)fwd, 512, LDS_BYTES) != hipSuccess || per_cu < 1) fprintf(stderr, "kernel_launch: occupancy query reports %d\n", per_cu);
        ok = 1;
    }
    Args a;
    memset(&a, 0, sizeof(a));
    for (int i = 0; i < N_IN; ++i) a.in[i] = (const float*)d_in[i];
    a.out = (float*)d_out; a.ws = (unsigned char*)d_ws;
    hipMemsetAsync((char*)d_ws + WS_CTL, 0, CTL_BYTES, stream);
#if MK_ONE_LAUNCH
    a.ph_lo = 0; a.ph_hi = NPHASE;
    hipLaunchKernelGGL(fwd, dim3(256), dim3(512), LDS_BYTES, stream, a);
#else
    for (int p = 0; p < NPHASE; ++p) { a.ph_lo = p; a.ph_hi = p + 1; hipLaunchKernelGGL(fwd, dim3(256), dim3(512), LDS_BYTES, stream, a); }
#endif
    const hipError_t le = hipPeekAtLastError();
    if (le != hipSuccess) fprintf(stderr, "kernel_launch: launch failed: %s\n", hipGetErrorName(le));
}
```

```cpp
#include <hip/hip_runtime.h>
#include <cstdio>
#include <cstdint>
#include <cstring>

#define LAS __attribute__((address_space(3)))
#define GAS __attribute__((address_space(1)))
typedef unsigned short bf16_t;
typedef short bf16x8 __attribute__((ext_vector_type(8)));
typedef short s16x4 __attribute__((ext_vector_type(4)));
typedef float f32x2 __attribute__((ext_vector_type(2)));
typedef float f32x4 __attribute__((ext_vector_type(4)));
typedef float f32x16 __attribute__((ext_vector_type(16)));
typedef unsigned u32x2 __attribute__((ext_vector_type(2)));
typedef unsigned u32x4 __attribute__((ext_vector_type(4)));

#ifndef MK_ONE_LAUNCH
#define MK_ONE_LAUNCH 1
#endif

constexpr int NB = 4, LSEQ = 4096, DM = 1024, NCTX = 256, DEPTH = 4;
constexpr int TLAT = NB * LSEQ, TCTX = NB * NCTX, TT = TLAT + TCTX;
constexpr int KVR = LSEQ + NCTX;
constexpr int NEXP = 64, TOPK = 8, EDIM = 256;
constexpr int NPAIR = TT * TOPK, NSLOT = NPAIR + TT;
constexpr float DN_ALPHA = 1.681792830507429f;
constexpr float LN_EPS = 1e-6f, RMS_EPS = 1e-6f, ROUTE_SCALE = 2.5f;
constexpr float ATT_SCALE = 0.088388347648318440f;

constexpr size_t al256(size_t x) { return (x + 255) / 256 * 256; }
constexpr size_t WS_CTL = 0, CTL_BYTES = 65536;
constexpr size_t WS_MOD = WS_CTL + CTL_BYTES;
constexpr size_t WS_GAINP = WS_MOD + al256((size_t)DEPTH * 5 * 6 * DM * 4);
constexpr size_t WS_ROPE = WS_GAINP + 2048;
constexpr size_t WS_WRHI = WS_ROPE + 16384;
constexpr size_t WS_WRLO = WS_WRHI + (size_t)DEPTH * 64 * DM * 2;
constexpr size_t WS_WF = WS_WRLO + (size_t)DEPTH * 64 * DM * 2;
constexpr size_t WS_WINE = WS_WF + (size_t)2 * 512 * DM * 2;
constexpr size_t WS_WINO = WS_WINE + (size_t)2 * 1280 * DM * 2;
constexpr size_t WS_WOUT = WS_WINO + (size_t)2 * 3072 * DM * 2;
constexpr size_t WS_WGU = WS_WOUT + (size_t)DEPTH * DM * DM * 2;
constexpr size_t WS_WD = WS_WGU + (size_t)DEPTH * 65 * 512 * DM * 2;
constexpr size_t WS_TW = WS_WD + (size_t)DEPTH * 65 * DM * 256 * 2;
constexpr size_t WS_TWC = WS_TW + (size_t)4096 * 8192 * 2;
constexpr size_t WS_XS = WS_TWC + (size_t)256 * 512 * 2;
constexpr size_t WS_H = WS_XS + (size_t)TT * DM * 4;
constexpr size_t WS_TKE = WS_H + (size_t)TT * DM * 2;
constexpr size_t WS_TKW = WS_TKE + (size_t)NPAIR * 4;
constexpr size_t WS_TKP = WS_TKW + (size_t)NPAIR * 4;
constexpr size_t WS_LIST = WS_TKP + (size_t)NPAIR * 4;
constexpr size_t WS_ACT = WS_LIST + (size_t)(NEXP + 1) * TT * 4;
constexpr size_t WS_YB = WS_ACT + (size_t)(NSLOT + 256) * EDIM * 2;
constexpr size_t WS_QB = WS_YB;
constexpr size_t WS_KB = WS_QB + (size_t)TT * DM * 2;
constexpr size_t WS_VB = WS_KB + (size_t)NB * KVR * DM * 2;
constexpr size_t WS_O = WS_VB + (size_t)NB * KVR * DM * 2;
constexpr size_t WS_Y = WS_O + (size_t)TT * DM * 2;
constexpr size_t WS_ZT = WS_Y + (size_t)TT * DM * 2;
constexpr size_t WS_ZCT = WS_ZT + (size_t)1024 * 8192 * 2;
constexpr size_t WS_OVL_END = WS_ZCT + (size_t)1024 * 512 * 2;
constexpr size_t WS_HL = WS_YB + (size_t)NSLOT * DM * 2;
constexpr size_t WS_TRASH = WS_HL + (size_t)TT * DM * 2;
constexpr size_t WS_END = WS_TRASH + (size_t)256 * 16384;
static_assert(WS_OVL_END <= WS_HL, "overlay fits in YB");
static_assert(WS_END <= (size_t)1 << 30, "workspace must fit 1 GiB");
constexpr int CW_TMO = 0, CW_CNT = 64  , CW_BAR = 1024;

constexpr int LDS_BYTES = 147456;
constexpr int LDS_STAGE = 0;
constexpr int LDS_EPI = 131072;
constexpr int LDS_RIDX = 139264;
constexpr int LDS_TAB = 141312;
constexpr int LDS_MISC = 147456 - 256;

__device__ __forceinline__ unsigned cvt_pk_bf16(float lo, float hi) { unsigned r; asm volatile("v_cvt_pk_bf16_f32 %0, %1, %2" : "=v"(r) : "v"(lo), "v"(hi)); return r; }
__device__ __forceinline__ float bf_lo(unsigned u) { return __uint_as_float(u << 16); }
__device__ __forceinline__ float bf_hi(unsigned u) { return __uint_as_float(u & 0xffff0000u); }
__device__ __forceinline__ float wave_sum(float v) {
#pragma unroll
    for (int o = 1; o < 64; o <<= 1) v += __shfl_xor(v, o);
    return v;
}
__device__ __forceinline__ float wave_max(float v) {
#pragma unroll
    for (int o = 1; o < 64; o <<= 1) v = fmaxf(v, __shfl_xor(v, o));
    return v;
}
#define LDS_WAIT() asm volatile("s_waitcnt lgkmcnt(0)" ::: "memory")
#define VM_WAIT() asm volatile("s_waitcnt vmcnt(0)" ::: "memory")

#ifndef PROBE_TS
#define PROBE_TS 0
#endif
#define TS(k) do { if (PROBE_TS && blockIdx.x == 0 && threadIdx.x == 0) { const unsigned long long now_ = __builtin_amdgcn_s_memrealtime(); volatile LAS float* ta_ = (volatile LAS float*)(lds + LDS_MISC + 64); \
    ta_[k] = ta_[k] + (float)(now_ - *(volatile LAS unsigned long long*)(lds + LDS_MISC + 192)); *(volatile LAS unsigned long long*)(lds + LDS_MISC + 192) = now_; } } while (0)

__device__ __forceinline__ int opaque_tid() { int t = threadIdx.x; asm volatile("" : "+v"(t)); return t; }
namespace pg8 {
constexpr int BM = 256, BK = 64, HALF = 128, HTB = HALF * BK * 2  , STAGE_BYTES = 8 * HTB;

__host__ __device__ __forceinline__ int lds_byte(int r, int c) { const int st = (r >> 4) * 2 + (c >> 5), rr = r & 15, cc = c & 31, ob = rr * 64 + cc * 2; return st * 1024 + (ob ^ (((ob >> 9) & 1) << 5)); }
__host__ __device__ __forceinline__ void stage_rc(int b, int& R, int& C) { const int st = b / 1024, sb = b % 1024, swz = sb ^ (((sb >> 9) & 1) << 5); R = (st >> 1) * 16 + swz / 64; C = (st & 1) * 32 + (swz % 64) / 2; }
__host__ __device__ __forceinline__ int perm32(int rho) { const int n = rho >> 4, i = rho & 15; return 8 * (i >> 2) + 4 * n + (i & 3); }

struct Unit { const char* A; const char* B; char* C; const int* rows; int ldc, nvalid, x0, x1; };

struct EpiStore {
    __device__ __forceinline__ void operator()(const f32x4 (&acc)[2][2][4][2], const Unit& u) const {
        const int tid = opaque_tid(), wid = tid >> 6, lane = tid & 63, wr = wid >> 2, wc = wid & 3, fr = lane & 15, fq = lane >> 4;
        const int row0 = wr * 64 + fr, col0 = wc * 32 + 8 * fq;
#pragma unroll
        for (int ai = 0; ai < 2; ++ai)
#pragma unroll
            for (int m = 0; m < 4; ++m) {
                const int r = row0 + ai * HALF + m * 16;
                if (r < u.nvalid) {
                    bf16_t* rowp = (bf16_t*)u.C + (size_t)r * u.ldc + col0;
#pragma unroll
                    for (int bj = 0; bj < 2; ++bj) { const f32x4 v0 = acc[ai][bj][m][0], v1 = acc[ai][bj][m][1];
                        u32x4 w; w.x = cvt_pk_bf16(v0[0], v0[1]); w.y = cvt_pk_bf16(v0[2], v0[3]); w.z = cvt_pk_bf16(v1[0], v1[1]); w.w = cvt_pk_bf16(v1[2], v1[3]);
                        *(u32x4*)(rowp + bj * HALF) = w; }
                }
            }
    }
};
constexpr float YB_SCALE = 32.0f;
struct EpiStoreF8 {
    __device__ __forceinline__ void operator()(const f32x4 (&acc)[2][2][4][2], const Unit& u) const {
        const int tid = opaque_tid(), wid = tid >> 6, lane = tid & 63, wr = wid >> 2, wc = wid & 3, fr = lane & 15, fq = lane >> 4;
        const int row0 = wr * 64 + fr, col0 = wc * 32 + 8 * fq;
#pragma unroll
        for (int ai = 0; ai < 2; ++ai)
#pragma unroll
            for (int m = 0; m < 4; ++m) {
                const int r = row0 + ai * HALF + m * 16;
                if (r < u.nvalid) {
                    unsigned char* rowp = (unsigned char*)u.C + (size_t)r * u.ldc + col0;
#pragma unroll
                    for (int bj = 0; bj < 2; ++bj) { f32x4 v0 = acc[ai][bj][m][0] * YB_SCALE, v1 = acc[ai][bj][m][1] * YB_SCALE;
#pragma unroll
                        for (int t = 0; t < 4; ++t) { v0[t] = __builtin_amdgcn_fmed3f(v0[t], -448.0f, 448.0f); v1[t] = __builtin_amdgcn_fmed3f(v1[t], -448.0f, 448.0f); }
                        int w0 = 0, w1 = 0;
                        w0 = __builtin_amdgcn_cvt_pk_fp8_f32(v0[0], v0[1], w0, false); w0 = __builtin_amdgcn_cvt_pk_fp8_f32(v0[2], v0[3], w0, true);
                        w1 = __builtin_amdgcn_cvt_pk_fp8_f32(v1[0], v1[1], w1, false); w1 = __builtin_amdgcn_cvt_pk_fp8_f32(v1[2], v1[3], w1, true);
                        *(u32x2*)(rowp + bj * HALF) = (u32x2){(unsigned)w0, (unsigned)w1}; }
                }
            }
    }
};
struct EpiSwiGLU {
    __device__ __forceinline__ void operator()(const f32x4 (&acc)[2][2][4][2], const Unit& u) const {
        const int tid = opaque_tid(), wid = tid >> 6, lane = tid & 63, wr = wid >> 2, wc = wid & 3, fr = lane & 15, fq = lane >> 4;
        const int row0 = wr * 64 + fr, col0 = wc * 32 + 8 * fq;
#pragma unroll
        for (int ai = 0; ai < 2; ++ai)
#pragma unroll
            for (int m = 0; m < 4; ++m) {
                const int r = row0 + ai * HALF + m * 16;
                if (r < u.nvalid) {
                    float o[8];
#pragma unroll
                    for (int n = 0; n < 2; ++n)
#pragma unroll
                        for (int j = 0; j < 4; ++j) { const float g = acc[ai][0][m][n][j], up = acc[ai][1][m][n][j];
                            o[n * 4 + j] = g * __builtin_amdgcn_rcpf(1.0f + __builtin_amdgcn_exp2f(-1.4426950408889634f * g)) * up; }
                    u32x4 w; w.x = cvt_pk_bf16(o[0], o[1]); w.y = cvt_pk_bf16(o[2], o[3]); w.z = cvt_pk_bf16(o[4], o[5]); w.w = cvt_pk_bf16(o[6], o[7]);
                    *(u32x4*)((bf16_t*)u.C + (size_t)r * u.ldc + col0) = w;
                }
            }
    }
};
struct EpiQKVE {
    LAS float* P;
    const float* gainp;
    const f32x2* rope;
    __device__ __forceinline__ void operator()(const f32x4 (&acc)[2][2][4][2], const Unit& u) const {
        const int tid = opaque_tid(), wid = tid >> 6, lane = tid & 63, wr = wid >> 2, wc = wid & 3, fr = lane & 15, fq = lane >> 4;
        const int row0 = wr * 64 + fr, col0 = wc * 32 + 8 * fq;
        if (u.x0 >= 2) {
            const size_t bjs = (u.x0 == 2) ? (size_t)NB * KVR * 128 : (size_t)HALF;
#pragma unroll
            for (int ai = 0; ai < 2; ++ai)
#pragma unroll
                for (int m = 0; m < 4; ++m) { bf16_t* rowp = (bf16_t*)u.C + (size_t)(row0 + ai * HALF + m * 16) * u.ldc + col0;
#pragma unroll
                    for (int bj = 0; bj < 2; ++bj) { const f32x4 v0 = acc[ai][bj][m][0], v1 = acc[ai][bj][m][1];
                        u32x4 w; w.x = cvt_pk_bf16(v0[0], v0[1]); w.y = cvt_pk_bf16(v0[2], v0[3]); w.z = cvt_pk_bf16(v1[0], v1[1]); w.w = cvt_pk_bf16(v1[2], v1[3]);
                        *(u32x4*)(rowp + bj * bjs) = w; } }
            asm volatile("" ::: "memory"); __builtin_amdgcn_s_barrier(); asm volatile("" ::: "memory");
            return;
        }
#pragma unroll
        for (int ai = 0; ai < 2; ++ai)
#pragma unroll
            for (int m = 0; m < 4; ++m)
#pragma unroll
                for (int bj = 0; bj < 2; ++bj) { const f32x4 a = acc[ai][bj][m][0], b = acc[ai][bj][m][1];
                    float s = (a[0] * a[0] + a[1] * a[1]) + (a[2] * a[2] + a[3] * a[3]) + (b[0] * b[0] + b[1] * b[1]) + (b[2] * b[2] + b[3] * b[3]);
                    s += __shfl_xor(s, 16); s += __shfl_xor(s, 32);
                    if (fq == 0) P[(bj * 256 + row0 + ai * HALF + m * 16) * 4 + wc] = s; }
        asm volatile("s_waitcnt lgkmcnt(0)" ::: "memory"); __builtin_amdgcn_s_barrier(); asm volatile("" ::: "memory");
        const f32x4 g0 = *(const f32x4*)(gainp + u.x0 * 128 + col0), g1 = *(const f32x4*)(gainp + u.x0 * 128 + col0 + 4);
        const int half = wc >> 1, fi = ((wc & 1) * 4 + fq) * 4;
#pragma unroll
        for (int ai = 0; ai < 2; ++ai)
#pragma unroll
            for (int m = 0; m < 4; ++m) {
                const int r = row0 + ai * HALF + m * 16;
                int pos = 0;
                if (u.x1 >= 0) { const int t = u.x1 + r; pos = half ? (t & 63) : (t >> 6); }
                const f32x4 cs0 = *(const f32x4*)(rope + pos * 32 + fi), cs1 = *(const f32x4*)(rope + pos * 32 + fi + 2);
                const float cc[4] = {cs0[0], cs0[2], cs1[0], cs1[2]}, ss[4] = {cs0[1], cs0[3], cs1[1], cs1[3]};
                bf16_t* rowp = (bf16_t*)u.C + (size_t)r * u.ldc + col0;
#pragma unroll
                for (int bj = 0; bj < 2; ++bj) {
                    const f32x4 pp = *(const LAS f32x4*)(P + (bj * 256 + r) * 4);
                    const float rs = __builtin_amdgcn_rsqf(((pp[0] + pp[1]) + (pp[2] + pp[3])) * (1.0f / 128.0f) + RMS_EPS);
                    float o1[4], o2[4];
#pragma unroll
                    for (int j = 0; j < 4; ++j) { const float v1 = acc[ai][bj][m][0][j] * rs * g0[j], v2 = acc[ai][bj][m][1][j] * rs * g1[j];
                        o1[j] = v1 * cc[j] - v2 * ss[j]; o2[j] = v1 * ss[j] + v2 * cc[j]; }
                    u32x4 w; w.x = cvt_pk_bf16(o1[0], o1[1]); w.y = cvt_pk_bf16(o1[2], o1[3]); w.z = cvt_pk_bf16(o2[0], o2[1]); w.w = cvt_pk_bf16(o2[2], o2[3]);
                    *(u32x4*)(rowp + bj * ((u.x0 == 0) ? (size_t)HALF : (size_t)NB * KVR * 128)) = w;
                }
            }
    }
};

template <class Epi, class Sched, bool GATHER>
__device__ __forceinline__ void gemm_phase(LAS unsigned char* lds, const int K_, Sched& S, const Epi& E) {
    const int K = K_;
    const int tid = opaque_tid(), wid = __builtin_amdgcn_readfirstlane(tid >> 6), lane = tid & 63, wr = wid >> 2, wc = wid & 3, fr = lane & 15, fq = lane >> 4;
    const int nt = K / BK;
    Unit cur, nxt; int ui = 0;
    if (!S.next(0, cur)) return;
    unsigned voffB[2], offA[2][2];
#pragma unroll
    for (int i = 0; i < 2; ++i) { int R, C; stage_rc(tid * 16 + i * 8192, R, C); const int Rb = (R & ~31) + perm32(R & 31);
        voffB[i] = (unsigned)(Rb * K + C) * 2u; }
    LAS int* ridx = (LAS int*)(lds + LDS_RIDX);
    if (GATHER) {
        if (tid < 256) ridx[tid] = (tid < cur.nvalid) ? cur.rows[tid] : 0;
        __syncthreads();
#pragma unroll
        for (int h = 0; h < 2; ++h)
#pragma unroll
            for (int i = 0; i < 2; ++i) { int R, C; stage_rc(tid * 16 + i * 8192, R, C); offA[h][i] = (unsigned)ridx[h * HALF + R] * (unsigned)(K * 2) + (unsigned)C * 2u; }
    } else {
#pragma unroll
        for (int h = 0; h < 2; ++h)
#pragma unroll
            for (int i = 0; i < 2; ++i) { int R, C; stage_rc(tid * 16 + i * 8192, R, C); offA[h][i] = (unsigned)((h * HALF + R) * K + C) * 2u; }
    }
    const size_t kstep = (size_t)(BK * 2);
    const size_t hstep = (size_t)HALF * K * 2;
    const unsigned ldsw = (unsigned)wid * 1024u;
    const int aoff = lds_byte(wr * 64 + fr, fq * 8), boff = lds_byte(wc * 32 + fr, fq * 8);
#define PG8_SA(b, h) (((b) * 2 + (h)) * HTB)
#define PG8_SB(b, h) ((4 + (b) * 2 + (h)) * HTB)
#define PG8_STAGE(bufoff, gbase, voff) do { _Pragma("unroll") for (int _i = 0; _i < 2; ++_i) \
        __builtin_amdgcn_global_load_lds((const unsigned*)((const char*)(gbase) + (voff)[_i]), (LAS unsigned*)(lds + (bufoff) + ldsw + _i * 8192), 16, 0, 0); } while (0)
#define PG8_LDA(dst, b, h) do { _Pragma("unroll") for (int m = 0; m < 4; ++m) _Pragma("unroll") for (int k = 0; k < 2; ++k) dst[m][k] = *(const LAS bf16x8*)(lds + PG8_SA(b, h) + aoff + m * 2048 + k * 1024); } while (0)
#define PG8_LDB(dst, b, h) do { _Pragma("unroll") for (int n = 0; n < 2; ++n) _Pragma("unroll") for (int k = 0; k < 2; ++k) dst[n][k] = *(const LAS bf16x8*)(lds + PG8_SB(b, h) + boff + n * 2048 + k * 1024); } while (0)
#define PG8_MMA(ai, bj, At, Bt) do { __builtin_amdgcn_s_setprio(1); _Pragma("unroll") for (int m = 0; m < 4; ++m) _Pragma("unroll") for (int n = 0; n < 2; ++n) _Pragma("unroll") for (int k = 0; k < 2; ++k) \
        acc[ai][bj][m][n] = __builtin_amdgcn_mfma_f32_16x16x32_bf16(Bt[n][k], At[m][k], acc[ai][bj][m][n], 0, 0, 0); __builtin_amdgcn_s_setprio(0); } while (0)
#define PG8_WAIT_V(n) asm volatile("s_waitcnt vmcnt(" #n ")" ::: "memory")
#define PG8_WAIT_L(n) asm volatile("s_waitcnt lgkmcnt(" #n ")" ::: "memory")
#define PG8_BAR __builtin_amdgcn_s_barrier()
#define PG8_SCHED __builtin_amdgcn_sched_barrier(0)
    f32x4 acc[2][2][4][2];
#pragma unroll
    for (int a = 0; a < 2; ++a)
#pragma unroll
        for (int b = 0; b < 2; ++b)
#pragma unroll
            for (int m = 0; m < 4; ++m)
#pragma unroll
                for (int n = 0; n < 2; ++n) acc[a][b][m][n] = (f32x4){0.f, 0.f, 0.f, 0.f};
    bf16x8 At[4][2], B0[2][2], B1[2][2];
    const char* cA = cur.A; const char* cB = cur.B;
    PG8_STAGE(PG8_SB(0, 0), cB, voffB); PG8_STAGE(PG8_SA(0, 0), cA, offA[0]); PG8_STAGE(PG8_SB(0, 1), cB + hstep, voffB); PG8_STAGE(PG8_SA(0, 1), cA, offA[1]);
    if (wr == 1) PG8_BAR;
    PG8_WAIT_V(4); PG8_BAR;
    PG8_STAGE(PG8_SB(1, 0), cB + kstep, voffB); PG8_STAGE(PG8_SA(1, 0), cA + kstep, offA[0]); PG8_STAGE(PG8_SB(1, 1), cB + hstep + kstep, voffB);
    PG8_WAIT_V(6); PG8_BAR;
    for (;;) {
        const bool has_next = S.next(ui + 1, nxt);
        const char* nA = has_next ? nxt.A : cA; const char* nB = has_next ? nxt.B : cB;
        if (GATHER && has_next && wid < 4)
            __builtin_amdgcn_global_load_lds((const unsigned*)(nxt.rows + wid * 64 + lane), (LAS unsigned*)(lds + LDS_RIDX + ((ui + 1) & 1) * 1024 + wid * 256), 4, 0, 0);
        for (int t = 0; t < nt; t += 2) {
            const bool last = (t == nt - 2);
            const char* a1 = cA + (size_t)(t + 1) * kstep;
            const char* a2 = last ? nA : cA + (size_t)(t + 2) * kstep; const char* b2 = last ? nB : cB + (size_t)(t + 2) * kstep;
            const char* a3 = a2 + kstep; const char* b3 = b2 + kstep;
            PG8_LDB(B0, 0, 0); PG8_SCHED; PG8_LDA(At, 0, 0); PG8_STAGE(PG8_SA(1, 1), a1, offA[1]);
            PG8_WAIT_L(8); PG8_BAR; PG8_WAIT_L(0); PG8_MMA(0, 0, At, B0); PG8_BAR; PG8_SCHED;
            if (GATHER && last && has_next) {
                LAS int* rn = ridx + ((ui + 1) & 1) * 256;
#pragma unroll
                for (int h = 0; h < 2; ++h)
#pragma unroll
                    for (int i = 0; i < 2; ++i) { int R, C; stage_rc(tid * 16 + i * 8192, R, C); const int rr = h * HALF + R; const int tok = (rr < nxt.nvalid) ? rn[rr] : 0; offA[h][i] = (unsigned)tok * (unsigned)(K * 2) + (unsigned)C * 2u; }
            }
            PG8_LDB(B1, 0, 1); PG8_STAGE(PG8_SB(0, 0), b2, voffB);
            PG8_BAR; PG8_WAIT_L(0); PG8_MMA(0, 1, At, B1); PG8_BAR;
            PG8_LDA(At, 0, 1); PG8_STAGE(PG8_SA(0, 0), a2, offA[0]);
            PG8_BAR; PG8_WAIT_L(0); PG8_MMA(1, 0, At, B0); PG8_BAR; PG8_SCHED;
            PG8_STAGE(PG8_SB(0, 1), b2 + hstep, voffB);
            PG8_WAIT_V(6); PG8_BAR; PG8_MMA(1, 1, At, B1); PG8_BAR;
            PG8_LDB(B0, 1, 0); PG8_SCHED; PG8_LDA(At, 1, 0); PG8_STAGE(PG8_SA(0, 1), a2, offA[1]);
            PG8_WAIT_L(8); PG8_BAR; PG8_WAIT_L(0); PG8_MMA(0, 0, At, B0); PG8_BAR; PG8_SCHED;
            PG8_LDB(B1, 1, 1); PG8_STAGE(PG8_SB(1, 0), b3, voffB);
            PG8_BAR; PG8_WAIT_L(0); PG8_MMA(0, 1, At, B1); PG8_BAR;
            PG8_LDA(At, 1, 1); PG8_STAGE(PG8_SA(1, 0), a3, offA[0]);
            PG8_BAR; PG8_WAIT_L(0); PG8_MMA(1, 0, At, B0); PG8_BAR; PG8_SCHED;
            PG8_STAGE(PG8_SB(1, 1), b3 + hstep, voffB);
            PG8_WAIT_V(6); PG8_BAR; PG8_MMA(1, 1, At, B1); PG8_BAR;
        }
        { Unit eu; S.next(ui, eu); E(acc, eu); }
        if (!has_next) break;
#pragma unroll
        for (int a = 0; a < 2; ++a)
#pragma unroll
            for (int b = 0; b < 2; ++b)
#pragma unroll
                for (int m = 0; m < 4; ++m)
#pragma unroll
                    for (int n = 0; n < 2; ++n) acc[a][b][m][n] = (f32x4){0.f, 0.f, 0.f, 0.f};
        cur = nxt; cA = nA; cB = nB; ++ui;
    }
    PG8_WAIT_V(0);
    if (wr == 0) PG8_BAR;
    PG8_BAR;
#undef PG8_SA
#undef PG8_SB
#undef PG8_STAGE
#undef PG8_LDA
#undef PG8_LDB
#undef PG8_MMA
#undef PG8_WAIT_V
#undef PG8_WAIT_L
#undef PG8_BAR
#undef PG8_SCHED
}
}

namespace att {
constexpr int D = 128, NW = 8, QBLK = 32, KVBLK = 64;
constexpr float SCALE = ATT_SCALE;
constexpr float THR = 8.f;
constexpr float NEGM = -30000.f;
constexpr size_t SHM_V = KVBLK * D * 2, SHM_K = KVBLK * D * 2, SHM_ATTN = 2 * SHM_V + 2 * SHM_K + NW * 64 * 4;
constexpr int LDS_BIAS = 69632;
#define KSWZ(row, colB) ((row) * 256 + ((colB) ^ (((row) & 7) << 4)))
#define SBAR() __builtin_amdgcn_sched_barrier(0)
__device__ __forceinline__ int crow(int r, int hi) { return (r & 3) + 8 * (r >> 2) + 4 * hi; }

__device__ __forceinline__ void partialSM(f32x16& p0, f32x16& p1, float& m_reg, float& mn, float& alpha) {
  constexpr float C = SCALE * 1.4426950408889634f;
  float pmax = p0[0];
#pragma unroll
  for (int r = 1; r < 16; ++r) pmax = fmaxf(pmax, p0[r]);
#pragma unroll
  for (int r = 0; r < 16; ++r) pmax = fmaxf(pmax, p1[r]);
  { auto rr = __builtin_amdgcn_permlane32_swap(__float_as_uint(pmax), __float_as_uint(pmax), false, false);
    pmax = fmaxf(__uint_as_float(rr[0]), __uint_as_float(rr[1])); }
  if (__builtin_expect(__all(pmax - m_reg <= THR / SCALE), 1)) { mn = m_reg; alpha = 1.f; }
  else { mn = fmaxf(m_reg, pmax); alpha = __builtin_amdgcn_exp2f((m_reg - mn) * C); m_reg = mn; }
  float mnC = -mn * C;
#pragma unroll
  for (int r = 0; r < 16; ++r) p0[r] = fmaf(p0[r], C, mnC);
#pragma unroll
  for (int r = 0; r < 16; ++r) p1[r] = fmaf(p1[r], C, mnC);
#pragma unroll
  for (int r = 0; r < 16; ++r) p0[r] = __builtin_amdgcn_exp2f(p0[r]);
}
__device__ __forceinline__ void finishSM(f32x16& p0, f32x16& p1, float alpha, float& l_reg, bf16x8& pa0, bf16x8& pa1, bf16x8& pa2, bf16x8& pa3) {
#pragma unroll
  for (int r = 0; r < 16; ++r) p1[r] = __builtin_amdgcn_exp2f(p1[r]);
  float ps = 0;
#pragma unroll
  for (int r = 0; r < 16; ++r) ps += p0[r];
#pragma unroll
  for (int r = 0; r < 16; ++r) ps += p1[r];
  { auto rr = __builtin_amdgcn_permlane32_swap(__float_as_uint(ps), __float_as_uint(ps), false, false);
    ps = __uint_as_float(rr[0]) + __uint_as_float(rr[1]); }
  l_reg = l_reg * alpha + ps;
#define PK4(P, BASE, OUT) do { unsigned a0 = cvt_pk_bf16(P[BASE + 0], P[BASE + 1]), a1 = cvt_pk_bf16(P[BASE + 2], P[BASE + 3]);   \
    unsigned b0 = cvt_pk_bf16(P[BASE + 4], P[BASE + 5]), b1 = cvt_pk_bf16(P[BASE + 6], P[BASE + 7]);                              \
    auto r0 = __builtin_amdgcn_permlane32_swap(a0, b0, false, false); auto r1 = __builtin_amdgcn_permlane32_swap(a1, b1, false, false); \
    u32x4 w = {r0[0], r1[0], r0[1], r1[1]}; OUT = *reinterpret_cast<bf16x8*>(&w); } while (0)
  PK4(p0, 0, pa0); PK4(p0, 8, pa1); PK4(p1, 0, pa2); PK4(p1, 8, pa3);
#undef PK4
}
__device__ __forceinline__ void qkt(f32x16& p0, f32x16& p1, const char* Ks, const bf16x8* qr, int r32, int hi) {
  p0 = f32x16{}; p1 = f32x16{};
#pragma unroll
  for (int d0 = 0; d0 < 8; ++d0) { int cb = (d0 * 16 + hi * 8) * 2;
    bf16x8 b0 = *reinterpret_cast<const bf16x8*>(Ks + KSWZ(r32, cb));
    bf16x8 b1 = *reinterpret_cast<const bf16x8*>(Ks + KSWZ(32 + r32, cb));
    p0 = __builtin_amdgcn_mfma_f32_32x32x16_bf16(b0, qr[d0], p0, 0, 0, 0);
    p1 = __builtin_amdgcn_mfma_f32_32x32x16_bf16(b1, qr[d0], p1, 0, 0, 0); }
}
__device__ __forceinline__ int v_st(int k, int c) { const int kk = (k & ~0xC) | ((k & 4) << 1) | ((k & 8) >> 1); return ((kk >> 3) * 4 + (c >> 5)) * 512 + ((kk & 7) * 32 + (c & 31)) * 2; }
__device__ __forceinline__ int v_rd_base(int lane) { return ((lane & 3) << 3) | (((lane >> 2) & 3) << 6) | (((lane >> 4) & 1) << 5) | (((lane >> 5) & 1) << 8); }
constexpr int v_rd_off(int d0, int ks, int half) { return d0 * 512 + ks * 4096 + half * 2048; }
template <int OFF> __device__ __forceinline__ s16x4 tr_read(int vb) {
  s16x4 r; asm volatile("ds_read_b64_tr_b16 %0, %1 offset:%2" : "=&v"(r) : "v"(vb), "i"(OFF) : "memory"); return r;
}
template <int D0> __device__ __forceinline__ void pv_one(f32x16& od, int vb, bf16x8 pa0, bf16x8 pa1, bf16x8 pa2, bf16x8 pa3) {
  const s16x4 l0 = tr_read<v_rd_off(D0, 0, 0)>(vb), h0 = tr_read<v_rd_off(D0, 0, 1)>(vb), l1 = tr_read<v_rd_off(D0, 1, 0)>(vb), h1 = tr_read<v_rd_off(D0, 1, 1)>(vb);
  const s16x4 l2 = tr_read<v_rd_off(D0, 2, 0)>(vb), h2 = tr_read<v_rd_off(D0, 2, 1)>(vb), l3 = tr_read<v_rd_off(D0, 3, 0)>(vb), h3 = tr_read<v_rd_off(D0, 3, 1)>(vb);
  asm volatile("s_waitcnt lgkmcnt(0)" ::: "memory"); SBAR();
#define PK(L, H) (bf16x8){L[0], L[1], L[2], L[3], H[0], H[1], H[2], H[3]}
  od = __builtin_amdgcn_mfma_f32_32x32x16_bf16(pa0, PK(l0, h0), od, 0, 0, 0);
  od = __builtin_amdgcn_mfma_f32_32x32x16_bf16(pa1, PK(l1, h1), od, 0, 0, 0);
  od = __builtin_amdgcn_mfma_f32_32x32x16_bf16(pa2, PK(l2, h2), od, 0, 0, 0);
  od = __builtin_amdgcn_mfma_f32_32x32x16_bf16(pa3, PK(l3, h3), od, 0, 0, 0);
#undef PK
}
__device__ __forceinline__ void pv_d0(f32x16* o, int vb, bf16x8 pa0, bf16x8 pa1, bf16x8 pa2, bf16x8 pa3) {
  pv_one<0>(o[0], vb, pa0, pa1, pa2, pa3); pv_one<1>(o[1], vb, pa0, pa1, pa2, pa3); pv_one<2>(o[2], vb, pa0, pa1, pa2, pa3); pv_one<3>(o[3], vb, pa0, pa1, pa2, pa3);
}

template <bool NA, int ldq, int ldk, int ldo>
__device__ __forceinline__ void attn_body(const bf16_t* __restrict__ Qb, const bf16_t* __restrict__ Kh, const bf16_t* __restrict__ Vh,
                                          bf16_t* __restrict__ Ob, const int NT, const int nloc, const int bs, const int q0r, char* lds) {
  const int tid = opaque_tid(), wid = tid >> 6, lane = tid & 63, r32 = lane & 31, hi = lane >> 5;
  char* V_lds = lds; char* K_lds = lds + 2 * SHM_V;
  float* ws = (float*)(lds + 2 * SHM_V + 2 * SHM_K) + wid * 64; float* li_l = ws; float* al_l = ws + 32;
  float m_reg = -1e30f, l_reg = 0; f32x16 o[4] = {}; bf16x8 qr[8];
  const bf16_t* Qw = Qb + (wid * QBLK + r32) * ldq + hi * 8;
#pragma unroll
  for (int d0 = 0; d0 < 8; ++d0) qr[d0] = *reinterpret_cast<const bf16x8*>(Qw + d0 * 16);
  const int sr = tid >> 4, sc = (tid & 15) * 8, vst0 = v_st(sr, sc), vst1 = v_st(32 + sr, sc);
  const int vb0 = (int)(uintptr_t)V_lds + v_rd_base(lane);
  const unsigned kvo = (unsigned)(sr * ldk + sc) * 2u;
  const float* btab = (const float*)(lds + LDS_BIAS) + 64;
  constexpr int SD = NA ? 1 : 2;
  struct { bf16x8 vs0, vs1, ks0, ks1; } sr_[SD];
#define KOFF(j) (NA ? ((j) < nloc ? (bs + (j)) * 64 : LSEQ + ((j) - nloc) * 64) : (j) * 64)
#define SLOAD(i, k0) do { const unsigned _ko = (unsigned)((k0) * ldk * 2) + kvo; sr_[i].vs0 = *reinterpret_cast<const bf16x8*>((const char*)Vh + _ko); sr_[i].vs1 = *reinterpret_cast<const bf16x8*>((const char*)Vh + (_ko + 64u * ldk)); \
    sr_[i].ks0 = *reinterpret_cast<const bf16x8*>((const char*)Kh + _ko); sr_[i].ks1 = *reinterpret_cast<const bf16x8*>((const char*)Kh + (_ko + 64u * ldk)); } while (0)
#define SWRITE(b, i) do { int sr_w = sr, sc_w = sc, v0_w = vst0, v1_w = vst1; \
    if (NA) { const int t_ = opaque_tid(); sr_w = t_ >> 4; sc_w = (t_ & 15) * 8; v0_w = v_st(sr_w, sc_w); v1_w = v_st(32 + sr_w, sc_w); }     \
    *(bf16x8*)(V_lds + (b) * SHM_V + v0_w) = sr_[i].vs0;          \
    *(bf16x8*)(V_lds + (b) * SHM_V + v1_w) = sr_[i].vs1; int kc = sc_w * 2;               \
    *(bf16x8*)(K_lds + (b) * SHM_K + KSWZ(sr_w, kc)) = sr_[i].ks0;                       \
    *(bf16x8*)(K_lds + (b) * SHM_K + KSWZ(32 + sr_w, kc)) = sr_[i].ks1; } while (0)
#define SWAIT() do { if (SD == 2) asm volatile("s_waitcnt vmcnt(4)" ::: "memory"); else asm volatile("s_waitcnt vmcnt(0)" ::: "memory"); } while (0)
#define RESC(a) do { if (__any((a) < 1.f)) { if (hi == 0) al_l[r32] = (a); asm volatile("s_waitcnt lgkmcnt(0)" ::: "memory"); \
    _Pragma("unroll") for (int d = 0; d < 4; ++d) _Pragma("unroll") for (int r = 0; r < 16; ++r) o[d][r] *= al_l[crow(r, hi)]; } } while (0)
#define ACT(j) (!NA || (j) >= nloc || ((bs + (j)) >= min(max(q0r + __builtin_amdgcn_readfirstlane(opaque_tid() >> 7) - 4, 0), 56) && (bs + (j)) < min(max(q0r + __builtin_amdgcn_readfirstlane(opaque_tid() >> 7) - 4, 0), 56) + 8))
#define NAMASK(P0, P1, j) do { if (NA && (j) < nloc) { const int kr = bs + (j); const int t_ = opaque_tid(); \
    const int qrow = q0r + __builtin_amdgcn_readfirstlane(t_ >> 7), qcol = ((t_ >> 6) & 1) * 32 + (t_ & 31), hi_ = (t_ >> 5) & 1; \
    const int cstart = min(max(qcol - 8, 0), 48); \
    const float* bp = btab + (kr - qrow + 7) * 31 + (4 * hi_ - qcol + 15); const int cs = cstart - 4 * hi_; \
    _Pragma("unroll") for (int r = 0; r < 16; ++r) { const int kc = (r & 3) + 8 * (r >> 2); \
        P0[r] = ((unsigned)(kc - cs) < 16u) ? P0[r] + bp[kc] : NEGM; P1[r] = ((unsigned)(kc + 32 - cs) < 16u) ? P1[r] + bp[kc + 32] : NEGM; } } } while (0)
  f32x16 pA0, pA1, pB0, pB1; float mnA, mnB, alA = 1.f, alB = 1.f; bf16x8 pa0, pa1, pa2, pa3;
  bool actA, actB;
  constexpr int SE = 0, SO = SD - 1;
  SLOAD(SE, KOFF(0)); asm volatile("s_waitcnt vmcnt(0)" ::: "memory"); SWRITE(0, SE); __syncthreads();
  actA = ACT(0);
  if (actA) { qkt(pA0, pA1, K_lds, qr, r32, hi); NAMASK(pA0, pA1, 0); partialSM(pA0, pA1, m_reg, mnA, alA); } else alA = 1.f;
  SLOAD(SO, KOFF(1)); if (SD == 2 && 2 < NT) SLOAD(SE, KOFF(2));
  SWAIT(); SWRITE(1, SO); __syncthreads();
  for (int j = 1; j + 1 < NT; j += 2) {
    SBAR(); actB = ACT(j); if (actB) { qkt(pB0, pB1, K_lds + SHM_K, qr, r32, hi); NAMASK(pB0, pB1, j); }
    if (actA) finishSM(pA0, pA1, alA, l_reg, pa0, pa1, pa2, pa3); SBAR();
    SLOAD(SO, KOFF(j + SD)); SBAR();
    if (actA) pv_d0(o, vb0, pa0, pa1, pa2, pa3); if (actB) partialSM(pB0, pB1, m_reg, mnB, alB); else alB = 1.f;
    __syncthreads(); SWAIT(); SWRITE(0, SE);
    RESC(alB); __syncthreads();
    SBAR(); actA = ACT(j + 1); if (actA) { qkt(pA0, pA1, K_lds, qr, r32, hi); NAMASK(pA0, pA1, j + 1); }
    if (actB) finishSM(pB0, pB1, alB, l_reg, pa0, pa1, pa2, pa3); SBAR();
    if (SD == 1 || j + 3 < NT) SLOAD(SE, KOFF(j + 1 + SD)); SBAR();
    if (actB) pv_d0(o, vb0 + (int)SHM_V, pa0, pa1, pa2, pa3); if (actA) partialSM(pA0, pA1, m_reg, mnA, alA); else alA = 1.f;
    __syncthreads(); SWAIT(); SWRITE(1, SO);
    RESC(alA); __syncthreads();
  }
  SBAR(); actB = ACT(NT - 1); if (actB) { qkt(pB0, pB1, K_lds + SHM_K, qr, r32, hi); NAMASK(pB0, pB1, NT - 1); }
  if (actA) finishSM(pA0, pA1, alA, l_reg, pa0, pa1, pa2, pa3); SBAR();
  if (actA) pv_d0(o, vb0, pa0, pa1, pa2, pa3); if (actB) partialSM(pB0, pB1, m_reg, mnB, alB); else alB = 1.f;
  __syncthreads(); RESC(alB);
  if (actB) { finishSM(pB0, pB1, alB, l_reg, pa0, pa1, pa2, pa3); SBAR();
    pv_d0(o, vb0 + (int)SHM_V, pa0, pa1, pa2, pa3); }
  if (hi == 0) li_l[r32] = l_reg; asm volatile("s_waitcnt lgkmcnt(0)" ::: "memory");
  float rli[16];
#pragma unroll
  for (int r = 0; r < 16; ++r) rli[r] = __builtin_amdgcn_rcpf(li_l[crow(r, hi)]);
  bf16_t* Ow = Ob + (wid * QBLK) * ldo + r32;
#pragma unroll
  for (int r = 0; r < 16; ++r) { const int orow = crow(r, hi);
#pragma unroll
    for (int d0 = 0; d0 < 4; ++d0) { const unsigned pk = cvt_pk_bf16(o[d0][r] * rli[r], 0.f); Ow[orow * ldo + d0 * 32] = (bf16_t)(pk & 0xffffu); } }
  __syncthreads();
#undef ACT
#undef KOFF
#undef SLOAD
#undef SWRITE
#undef SWAIT
#undef RESC
#undef NAMASK
}
#undef KSWZ
#undef SBAR
}

#define XB_TMO      128
#define XB_XCNT(j)  (256  + 64 * (j))
#define XB_XSUB(j)  (1280 + 64 * (j))
#define XB_XGEN(j)  (2304 + 64 * (j))
#define XB_TOP      3328
#define XB_TOPGEN   3392
#define XCD_BAR_WORDS 3456
#define XB_SPIN_CAP (1u << 22)
__device__ __forceinline__ unsigned xb_ld(unsigned* p)              { return __hip_atomic_load(p, __ATOMIC_RELAXED, __HIP_MEMORY_SCOPE_AGENT); }
__device__ __forceinline__ unsigned xb_add(unsigned* p, unsigned v) { return __hip_atomic_fetch_add(p, v, __ATOMIC_RELAXED, __HIP_MEMORY_SCOPE_AGENT); }
__device__ __forceinline__ unsigned xb_xcc_id() { return (unsigned)__builtin_amdgcn_s_getreg((3 << 11) | 20) & 0xFu; }
#define XB_SPIN(cond, bar) do { unsigned _sp = 0; while (cond) { __builtin_amdgcn_s_sleep(1); \
    if ((++_sp & 255u) == 0u) { if (xb_ld(&(bar)[XB_TMO])) break; if (_sp > XB_SPIN_CAP) { atomicAdd(&(bar)[XB_TMO], 1u); break; } } } } while (0)
struct XcdBarrier { unsigned* bar; unsigned x; volatile LAS unsigned* st; };
__device__ __forceinline__ XcdBarrier xcd_barrier_post(unsigned* bar, volatile LAS unsigned* st) {
    XcdBarrier b; b.bar = bar; b.x = xb_xcc_id(); b.st = st;
    if (threadIdx.x == 0) (void)xb_add(&bar[XB_XCNT(b.x)], 1u);
    return b;
}
__device__ __forceinline__ void xcd_barrier_complete(unsigned* bar, unsigned x, unsigned& nloc, unsigned& nx) {
    const unsigned G = gridDim.x * gridDim.y * gridDim.z;
    unsigned sum, cnt, mine, sp = 0u;
    for (;;) {
        sum = 0u; cnt = 0u; mine = 0u;
#pragma unroll
        for (unsigned j = 0; j < 16; ++j) { const unsigned c = xb_ld(&bar[XB_XCNT(j)]); sum += c; cnt += (c > 0u) ? 1u : 0u; mine = (j == x) ? c : mine; }
        if (sum == G) break;
        __builtin_amdgcn_s_sleep(1);
        if ((++sp & 255u) == 0u) { if (xb_ld(&bar[XB_TMO])) break; if (sp > XB_SPIN_CAP) { atomicAdd(&bar[XB_TMO], 1u); break; } }
    }
    nloc = mine > 0u ? mine : 1u; nx = cnt > 0u ? cnt : 1u;
}
__device__ __forceinline__ void xcd_barrier(const XcdBarrier& b) {
    asm volatile("s_waitcnt vmcnt(0)" ::: "memory");
    __syncthreads();
    if (threadIdx.x == 0) {
        unsigned* bar = b.bar;
        __builtin_amdgcn_s_waitcnt(0);
        unsigned nloc = b.st[0], nx = b.st[1];
        if (nloc == 0u) { xcd_barrier_complete(bar, b.x, nloc, nx); b.st[0] = nloc; b.st[1] = nx; }
        const unsigned old = xb_add(&bar[XB_XSUB(b.x)], 1u);
        const unsigned gen = old / nloc;
        if (old + 1u == (gen + 1u) * nloc) {
            __builtin_amdgcn_fence(__ATOMIC_RELEASE, "agent");
            asm volatile("s_waitcnt vmcnt(0)" ::: "memory");
            const unsigned og = xb_add(&bar[XB_TOP], 1u);
            const unsigned tg = og / nx;
            if (og + 1u == (tg + 1u) * nx) xb_add(&bar[XB_TOPGEN], 1u);
            else XB_SPIN(xb_ld(&bar[XB_TOPGEN]) == tg, bar);
            __builtin_amdgcn_fence(__ATOMIC_ACQUIRE, "agent");
            xb_add(&bar[XB_XGEN(b.x)], 1u);
            asm volatile("s_waitcnt vmcnt(0)" ::: "memory");
        } else {
            XB_SPIN(xb_ld(&bar[XB_XGEN(b.x)]) == gen, bar);
            __builtin_amdgcn_fence(__ATOMIC_ACQUIRE, "agent");
            asm volatile("s_waitcnt vmcnt(0)" ::: "memory");
        }
    }
    __syncthreads();
}

enum { I_X = 0, I_C, I_CTX, I_CCTX, I_WMOD, I_BMOD, I_LN1G, I_LN1B, I_LN2G, I_LN2B, I_ABWIN, I_ABWF, I_ABQN, I_ABKN, I_ABWOUT, I_NAWIN, I_NARPB, I_NAWOUT,
       I_WR, I_EBIAS, I_WG, I_WU, I_WDN, I_SG, I_SU, I_SD, N_IN };
struct Args { const float* in[N_IN]; float* out; unsigned char* ws; int ph_lo, ph_hi; };
struct KA {
    __device__ __forceinline__ const __attribute__((address_space(4))) char* base() const { const __attribute__((address_space(4))) char* p = (const __attribute__((address_space(4))) char*)__builtin_amdgcn_kernarg_segment_ptr(); asm volatile("" : "+s"(p)); return p; }
    __device__ __forceinline__ const float* in(int i) const { return *(const float* const __attribute__((address_space(4)))*)(base() + 8 * i); }
    __device__ __forceinline__ float* out() const { return *(float* const __attribute__((address_space(4)))*)(base() + 8 * N_IN); }
    __device__ __forceinline__ int ph_lo() const { return *(const int __attribute__((address_space(4)))*)(base() + 8 * N_IN + 16); }
    __device__ __forceinline__ int ph_hi() const { return *(const int __attribute__((address_space(4)))*)(base() + 8 * N_IN + 20); }
    __device__ __forceinline__ unsigned char* ws() const { return *(unsigned char* const __attribute__((address_space(4)))*)(base() + 8 * N_IN + 8); }
};

__device__ __forceinline__ int tok_batchrow(int m) { return m < TLAT ? (m >> 12) : 4; }

__host__ __device__ __forceinline__ int rope_phys(int d) { const int hf = d >> 6, dd = d & 63, i = dd & 31, second = dd >> 5; return hf * 64 + (i >> 2) * 8 + second * 4 + (i & 3); }

constexpr int CV_GU = 65 * 2 * 16, CV_DN = 65 * 16, CV_OUT = 64;
__host__ __device__ constexpr int cv_in(int l) { return (l & 1) ? 192 : 80; }
__host__ __device__ constexpr int cv_items(int l) { return CV_GU + CV_DN + cv_in(l) + CV_OUT; }
struct CvItem { const float* src; bf16_t* dst; int ldw, K, k0, n0, kind, which; };
__device__ __forceinline__ int cv_row(const CvItem& d, int n) {
    if (d.kind == 1) return (n >> 7) * 256 + d.which * 128 + (n & 127);
    if (d.kind == 2) { const int c = n - 256; return c < 1024 ? (c & ~127) + rope_phys(c & 127) : c; }
    return n;
}
__device__ __forceinline__ CvItem cv_decode(const KA& a, int l, int it) {
    CvItem d; unsigned char* ws = a.ws(); const int j = l >> 1; int r = it; d.which = 0;
    if (r < CV_GU) { const int mat = r >> 4, kb = r & 15, which = mat & 1, e = mat >> 1;
        d.src = (e < 64) ? a.in(which ? I_WU : I_WG) + ((size_t)(l * 64 + e) * DM * EDIM) : a.in(which ? I_SU : I_SG) + (size_t)l * DM * EDIM;
        d.dst = (bf16_t*)(ws + WS_WGU) + (size_t)(l * 65 + e) * 512 * DM; d.ldw = EDIM; d.K = DM; d.k0 = 64 * kb; d.n0 = 0; d.kind = 1; d.which = which; return d; }
    r -= CV_GU;
    if (r < CV_DN) { const int e = r >> 4, item = r & 15;
        d.src = (e < 64) ? a.in(I_WDN) + ((size_t)(l * 64 + e) * EDIM * DM) : a.in(I_SD) + (size_t)l * EDIM * DM;
        d.dst = (bf16_t*)(ws + WS_WD) + (size_t)(l * 65 + e) * DM * EDIM; d.ldw = DM; d.K = EDIM; d.k0 = 64 * (item >> 2); d.n0 = 256 * (item & 3); d.kind = 0; return d; }
    r -= CV_DN;
    if (r < cv_in(l)) {
        if ((l & 1) == 0) { d.src = a.in(I_ABWIN) + (size_t)j * DM * 1536; d.dst = (bf16_t*)(ws + WS_WINE) + (size_t)j * 1280 * DM; d.ldw = 1536; d.K = DM; d.k0 = 64 * (r / 5); d.n0 = 256 + 256 * (r % 5); d.kind = 2; }
        else { d.src = a.in(I_NAWIN) + (size_t)j * DM * 3072; d.dst = (bf16_t*)(ws + WS_WINO) + (size_t)j * 3072 * DM; d.ldw = 3072; d.K = DM; d.k0 = 64 * (r / 12); d.n0 = 256 * (r % 12); d.kind = 0; }
        return d; }
    r -= cv_in(l);
    d.src = ((l & 1) ? a.in(I_NAWOUT) : a.in(I_ABWOUT)) + (size_t)j * DM * DM; d.dst = (bf16_t*)(ws + WS_WOUT) + (size_t)l * DM * DM; d.ldw = DM; d.K = DM; d.k0 = 64 * (r >> 2); d.n0 = 256 * (r & 3); d.kind = 0;
    return d;
}
constexpr int CV_LS = 260;
__device__ __forceinline__ void cv_load(const CvItem& d, f32x4 (&v)[8], int t) {
    const float* p = d.src + (size_t)(d.k0 + (t >> 6)) * d.ldw + d.n0 + (t & 63) * 4;
#pragma unroll
    for (int i = 0; i < 8; ++i) v[i] = *(const f32x4*)(p + (size_t)(8 * i) * d.ldw);
}
__device__ __forceinline__ void convert_items(LAS unsigned char* lds, int l, int lo, int hi, int worker, int nworkers) {
    const KA a;
    const int t = opaque_tid();
    LAS float* img = (LAS float*)lds;
    int it = lo + worker;
    if (it >= hi) return;
    CvItem d0 = cv_decode(a, l, it); f32x4 v[8]; cv_load(d0, v, t);
    for (;;) {
        { LAS float* w = img + (t >> 6) * CV_LS + (t & 63) * 4;
#pragma unroll
          for (int i = 0; i < 8; ++i) *(LAS f32x4*)(w + i * 8 * CV_LS) = v[i]; }
        __syncthreads();
        const int itn = it + nworkers; const bool more = itn < hi;
        CvItem d1 = d0;
        if (more) { d1 = cv_decode(a, l, itn); cv_load(d1, v, t); }
        { const int n = (t >> 6) * 32 + (t & 31), qh = (t >> 5) & 1; bf16_t* orow = d0.dst + (size_t)cv_row(d0, d0.n0 + n) * d0.K + d0.k0;
#pragma unroll
          for (int p = 0; p < 4; ++p) { const int q = 2 * p + qh; const LAS float* s = img + (8 * q) * CV_LS + n;
              u32x4 o; o.x = cvt_pk_bf16(s[0 * CV_LS], s[1 * CV_LS]); o.y = cvt_pk_bf16(s[2 * CV_LS], s[3 * CV_LS]); o.z = cvt_pk_bf16(s[4 * CV_LS], s[5 * CV_LS]); o.w = cvt_pk_bf16(s[6 * CV_LS], s[7 * CV_LS]);
              *(u32x4*)(orow + 8 * q) = o; } }
        __syncthreads();
        if (!more) break;
        d0 = d1; it = itn;
    }
}
struct CvSlice { int l, i0, i1, l2, j0, j1; };
constexpr int CV_EX = CV_GU + CV_DN;
#ifndef CV_MODE
#define CV_MODE 1
#endif
__device__ __forceinline__ CvSlice cv_slice(int l, int phase  ) {
    const CvSlice none = {0, 0, 0, 0, 0, 0};
    if (CV_MODE == 0) return none;
    if (l == 0) { if (phase == 1) return {0, 0, 2000, 0, 0, 0}; if (phase == 2) return {0, 2000, 3000, 0, 0, 0};
                  if (phase == 4) return {1, CV_EX, cv_items(1), 1, 0, 744}; if (phase == 5) return {1, 744, 1144, 0, 0, 0}; }
    if (l == 1) { if (phase == 0) return {1, 1144, 2120, 0, 0, 0}; if (phase == 2) return {1, 2120, CV_EX, 0, 0, 0};
                  if (phase == 4) return {2, CV_EX, cv_items(2), 2, 0, 856}; if (phase == 5) return {2, 856, 1256, 0, 0, 0}; }
    if (l == 2) { if (phase == 1) return {2, 1256, CV_EX, 0, 0, 0}; if (phase == 2) return {3, CV_EX, cv_items(3), 3, 0, 744};
                  if (phase == 4) return {3, 744, 1744, 0, 0, 0}; if (phase == 5) return {3, 1744, 2144, 0, 0, 0}; }
    if (l == 3) { if (phase == 0) return {3, 2144, 3044, 0, 0, 0}; if (phase == 2) return {3, 3044, CV_EX, 0, 0, 0}; }
    return none;
}
__device__ __forceinline__ void cv_tail(LAS unsigned char* lds, int l, int phase, int n_units, int bid, int G) {
    const CvSlice c = cv_slice(l, phase);
    if (c.i1 <= c.i0 && c.j1 <= c.j0) return;
    const int rem = n_units % G, nw = (rem == 0) ? G : G - rem, w = (rem == 0) ? bid : bid - rem;
    if (w < 0) return;
    __syncthreads();
    if (c.i1 > c.i0) convert_items(lds, c.l, c.i0, c.i1, w, nw);
    if (c.j1 > c.j0) convert_items(lds, c.l2, c.j0, c.j1, w, nw);
}

__device__ __forceinline__ void p0_mod(const KA& a, LAS unsigned char* lds, int bid, int G, int tid, int wave, int lane) {
    LAS float* sl = (LAS float*)(lds + 69632);
    LAS float* part = (LAS float*)(lds + 69632 + 20480);
    for (int i = tid; i < 5 * DM; i += 512) { const int r = i >> 10, k = i & 1023; const float v = (r < 4) ? a.in(I_C)[r * DM + k] : a.in(I_CCTX)[k]; sl[i] = v / (1.0f + __expf(-v)); }
    __syncthreads();
    float* mod = (float*)(a.ws() + WS_MOD);
    for (int task = bid; task < DEPTH * 48; task += G) {
        const int l = task / 48, c0 = (task % 48) * 128;
        const float* w = a.in(I_WMOD) + (size_t)l * DM * 6144 + c0 + 2 * lane;
        f32x2 acc[5];
#pragma unroll
        for (int r = 0; r < 5; ++r) acc[r] = (f32x2){0.f, 0.f};
#pragma unroll 16
        for (int k = wave * 128; k < wave * 128 + 128; ++k) { const f32x2 wv = *(const f32x2*)(w + (size_t)k * 6144);
#pragma unroll
            for (int r = 0; r < 5; ++r) acc[r] += wv * sl[r * DM + k]; }
#pragma unroll
        for (int r = 0; r < 5; ++r) *(LAS f32x2*)(part + (wave * 5 + r) * 128 + 2 * lane) = acc[r];
        __syncthreads();
        for (int i = tid; i < 640; i += 512) { const int r = i >> 7, c = i & 127; float s = a.in(I_BMOD)[l * 6144 + c0 + c];
#pragma unroll
            for (int w8 = 0; w8 < 8; ++w8) s += part[(w8 * 5 + r) * 128 + c];
            mod[((size_t)l * 5 + r) * 6144 + c0 + c] = s; }
        __syncthreads();
    }
}

__device__ __forceinline__ void p0_fourier_fold(const KA& a, LAS unsigned char* lds, int task, int tid, int wave, int lane) {
    const int kq = task & 3, g = (task >> 2) & 3, q = (task >> 4) & 1, j = task >> 5;
    LAS float* M = (LAS float*)(lds + 100352);
    LAS float* trg = M + 4096;
    const float* Wf = a.in(I_ABWF) + (size_t)(j * 4 + g) * 64 * 64;
    LAS float* Wl = trg + 64;
    __syncthreads();
    if (tid < 64) { const float ang = (float)tid * (1.0f / 32.0f); trg[tid] = q ? sinpif(ang) : cospif(ang); }
    for (int i = tid; i < 1024; i += 512) *(LAS f32x4*)(Wl + 4 * i) = *(const f32x4*)(Wf + 4 * i);
    __syncthreads();
    for (int i = tid; i < 4096; i += 512) { const int c = i >> 6, d = i & 63; float s = 0.f;
#pragma unroll 8
        for (int m = 0; m < 64; ++m) s += trg[(m * c) & 63] * Wl[m * 64 + d];
        M[i] = s; }
    __syncthreads();
    float mcol[64];
#pragma unroll
    for (int c = 0; c < 64; ++c) mcol[c] = M[c * 64 + lane];
    bf16_t* dst = (bf16_t*)(a.ws() + WS_WF) + ((size_t)j * 512 + q * 256 + g * 64 + lane) * DM;
    const float* win = a.in(I_ABWIN) + (size_t)j * DM * 1536 + g * 64 + lane;
    const int kbeg = kq * 256 + wave * 32;
    float wv[32];
#pragma unroll
    for (int i = 0; i < 32; ++i) wv[i] = win[(size_t)(kbeg + i) * 1536];
#pragma unroll
    for (int i = 0; i < 32; ++i) { float s = 0.f;
#pragma unroll
        for (int c = 0; c < 64; ++c) s += __int_as_float(__builtin_amdgcn_readlane(__float_as_int(wv[i]), c)) * mcol[c];
        dst[kbeg + i] = (bf16_t)(cvt_pk_bf16(s, 0.f) & 0xffffu); }
}


__device__ __forceinline__ void p0_tables(const KA& a, LAS unsigned char* lds, int gtid, int NGT, int tid) {
    LAS float* ctab = (LAS float*)(lds + 116736);
    for (int i = tid; i < 4096; i += 512) ctab[i] = cospif((float)i * (1.0f / 2048.0f));
    __syncthreads();
    bf16_t* TW = (bf16_t*)(a.ws() + WS_TW);
    for (int it = gtid; it < 4096 * 1024; it += NGT) {
        const int k = it >> 10, c8 = (it & 1023) * 8, n0 = c8 & 4095, sh = (c8 >> 12) ? 1024 : 0; const float sg = (c8 >> 12) ? (-1.0f / 512.0f) : (1.0f / 512.0f);
        float v[8];
#pragma unroll
        for (int j = 0; j < 8; ++j) v[j] = ctab[(k * (n0 + j) - sh) & 4095] * sg;
        u32x4 o; o.x = cvt_pk_bf16(v[0], v[1]); o.y = cvt_pk_bf16(v[2], v[3]); o.z = cvt_pk_bf16(v[4], v[5]); o.w = cvt_pk_bf16(v[6], v[7]);
        *(u32x4*)(TW + (size_t)k * 8192 + c8) = o;
    }
    bf16_t* TWC = (bf16_t*)(a.ws() + WS_TWC);
    for (int it = gtid; it < 256 * 64; it += NGT) {
        const int k = it >> 6, c8 = (it & 63) * 8, n0 = c8 & 255, sh = (c8 >> 8) ? 1024 : 0; const float sg = (c8 >> 8) ? (-1.0f / 128.0f) : (1.0f / 128.0f);
        float v[8];
#pragma unroll
        for (int j = 0; j < 8; ++j) v[j] = ctab[(((k * (n0 + j)) & 255) * 16 - sh) & 4095] * sg;
        u32x4 o; o.x = cvt_pk_bf16(v[0], v[1]); o.y = cvt_pk_bf16(v[2], v[3]); o.z = cvt_pk_bf16(v[4], v[5]); o.w = cvt_pk_bf16(v[6], v[7]);
        *(u32x4*)(TWC + (size_t)k * 512 + c8) = o;
    }
    bf16_t* WH = (bf16_t*)(a.ws() + WS_WRHI); bf16_t* WL = (bf16_t*)(a.ws() + WS_WRLO);
    for (int it = gtid; it < DEPTH * 64 * DM; it += NGT) {
        const int l = it >> 16, e = (it >> 10) & 63, k = it & 1023; const float w = a.in(I_WR)[((size_t)l * DM + k) * 64 + e];
        const unsigned h = cvt_pk_bf16(w, 0.f) & 0xffffu; const float r = w - __uint_as_float(h << 16);
        WH[it] = (bf16_t)h; WL[it] = (bf16_t)(cvt_pk_bf16(r, 0.f) & 0xffffu);
    }
    float* gp = (float*)(a.ws() + WS_GAINP);
    for (int it = gtid; it < 2 * 2 * 128; it += NGT) { const int j = it >> 8, qk = (it >> 7) & 1, d = it & 127; gp[(j * 2 + qk) * 128 + rope_phys(d)] = a.in(qk ? I_ABKN : I_ABQN)[j * 128 + d]; }
    f32x2* rp = (f32x2*)(a.ws() + WS_ROPE);
    for (int it = gtid; it < 64 * 32; it += NGT) { const int pos = it >> 5, i = it & 31; const float inv = exp2f(-(float)i * (13.287712379549449f / 32.0f));
        const float ang = (float)pos * inv; rp[it] = (f32x2){cosf(ang), sinf(ang)}; }
}

__device__ __forceinline__ const float* xrow_in(const KA& a, int l, int m) {
    if (l == 0) return m < TLAT ? a.in(I_X) + (size_t)m * DM : a.in(I_CTX) + (size_t)(m - TLAT) * DM;
    return (const float*)(a.ws() + WS_XS) + (size_t)m * DM;
}
__device__ __forceinline__ void p0b_modulate(const KA& a, int gw, int NGW, int lane) {
    const float* mod = (const float*)(a.ws() + WS_MOD);
    bf16_t* H = (bf16_t*)(a.ws() + WS_H);
    for (int m = gw; m < TT; m += NGW) {
        const f32x4* xr = (const f32x4*)xrow_in(a, 0, m) + lane; const float* md = mod + (size_t)tok_batchrow(m) * 6144;
        u32x2* o = (u32x2*)(H + (size_t)m * DM) + lane;
#pragma unroll
        for (int j = 0; j < 4; ++j) { const f32x4 x = xr[64 * j], sh = *((const f32x4*)md + lane + 64 * j), sc = *((const f32x4*)(md + DM) + lane + 64 * j);
            const f32x4 h = x * (sc + 1.0f) + sh; o[64 * j] = (u32x2){cvt_pk_bf16(h[0], h[1]), cvt_pk_bf16(h[2], h[3])}; }
    }
}

#ifndef PROBE_D
#define PROBE_D 7
#endif
__device__ __forceinline__ void phase_ln1_router(const KA& a, LAS unsigned char* lds, int l, int bid, int tid, int wave, int lane, const bool dry) {
    LAS float* lg = (LAS float*)lds;
    LAS int* hist = (LAS int*)(lds + 96 * 64 * 4);
    LAS int* pend = hist + 128;
    const float* mod = (const float*)(a.ws() + WS_MOD) + (size_t)l * 5 * 6144;
    const bf16_t* Y = (const bf16_t*)(a.ws() + WS_Y);
    float* XS = (float*)(a.ws() + (dry ? WS_ACT : WS_XS)); bf16_t* H = (bf16_t*)(a.ws() + (dry ? WS_YB + ((size_t)200 << 20) : WS_H)); bf16_t* HL = (bf16_t*)(a.ws() + (dry ? WS_YB + ((size_t)240 << 20) : WS_HL));
    if (tid < 64) hist[tid] = 0;
    const int NTOK = (l == DEPTH - 1) ? 64 : 68;
    const int tok0 = bid * NTOK;
    if (!dry || (PROBE_D & 1)) {
        f32x4 lng[4], lnb[4], g1[4], sc2[4], sh2[4];
        { const f32x4* pg = (const f32x4*)(a.in(I_LN1G) + l * DM) + lane; const f32x4* pb = (const f32x4*)(a.in(I_LN1B) + l * DM) + lane;
#pragma unroll
          for (int j = 0; j < 4; ++j) { lng[j] = pg[64 * j]; lnb[j] = pb[64 * j]; } }
        int cur_br = -1;
        f32x4 xn[4]; u32x2 yn[4];
        { const int m = tok0 + wave; const f32x4* xr = (const f32x4*)xrow_in(a, l, m) + lane; const u32x2* yr = (const u32x2*)(Y + (size_t)m * DM) + lane;
#pragma unroll
          for (int j = 0; j < 4; ++j) { xn[j] = xr[64 * j]; yn[j] = yr[64 * j]; } }
        for (int r = wave; r < NTOK; r += 8) {
            const int m = tok0 + r, br = tok_batchrow(m);
            if (br != cur_br) { cur_br = br; const float* md = mod + (size_t)br * 6144;
#pragma unroll
                for (int j = 0; j < 4; ++j) { g1[j] = *((const f32x4*)(md + 2 * DM) + lane + 64 * j); sh2[j] = *((const f32x4*)(md + 3 * DM) + lane + 64 * j); sc2[j] = *((const f32x4*)(md + 4 * DM) + lane + 64 * j) + 1.0f; } }
            f32x4 v[4]; float s = 0.f;
#pragma unroll
            for (int j = 0; j < 4; ++j) { const f32x4 y = {bf_lo(yn[j].x), bf_hi(yn[j].x), bf_lo(yn[j].y), bf_hi(yn[j].y)}; v[j] = xn[j] * DN_ALPHA + g1[j] * y; s += (v[j][0] + v[j][1]) + (v[j][2] + v[j][3]); }
            if (r + 8 < NTOK) { const int mn = m + 8; const f32x4* xr = (const f32x4*)xrow_in(a, l, mn) + lane; const u32x2* yr = (const u32x2*)(Y + (size_t)mn * DM) + lane;
#pragma unroll
                for (int j = 0; j < 4; ++j) { xn[j] = xr[64 * j]; yn[j] = yr[64 * j]; } }
            const float mean = wave_sum(s) * (1.0f / DM); float s2 = 0.f;
#pragma unroll
            for (int j = 0; j < 4; ++j) { v[j] = v[j] - mean; s2 += (v[j][0] * v[j][0] + v[j][1] * v[j][1]) + (v[j][2] * v[j][2] + v[j][3] * v[j][3]); }
            const float rstd = __builtin_amdgcn_rsqf(wave_sum(s2) * (1.0f / DM) + LN_EPS);
            f32x4* xo = (f32x4*)(XS + (size_t)m * DM) + lane; u32x2* ho = (u32x2*)(H + (size_t)m * DM) + lane; u32x2* hl = (u32x2*)(HL + (size_t)m * DM) + lane;
#pragma unroll
            for (int j = 0; j < 4; ++j) { const f32x4 x1 = v[j] * rstd * lng[j] + lnb[j]; xo[64 * j] = x1;
                const f32x4 h = x1 * sc2[j] + sh2[j];
                const unsigned h01 = cvt_pk_bf16(h[0], h[1]), h23 = cvt_pk_bf16(h[2], h[3]);
                ho[64 * j] = (u32x2){h01, h23};
                hl[64 * j] = (u32x2){cvt_pk_bf16(h[0] - bf_lo(h01), h[1] - bf_hi(h01)), cvt_pk_bf16(h[2] - bf_lo(h23), h[3] - bf_hi(h23))}; }
        }
    }
    VM_WAIT(); __syncthreads(); TS(4);
    __builtin_amdgcn_fence(__ATOMIC_ACQUIRE, "agent"); VM_WAIT();
    if (!dry || (PROBE_D & 2)) {
        const bf16_t* WH = (const bf16_t*)(a.ws() + WS_WRHI) + (size_t)l * 64 * DM; const bf16_t* WL = (const bf16_t*)(a.ws() + WS_WRLO) + (size_t)l * 64 * DM;
        const int ntile = wave & 3, mt0 = wave >> 2, fr = lane & 15, fq = lane >> 4;
        const bf16_t* pbh = WH + (size_t)(ntile * 16 + fr) * DM + fq * 8; const bf16_t* pbl = WL + (size_t)(ntile * 16 + fr) * DM + fq * 8;
        size_t ro[3];
#pragma unroll
        for (int i = 0; i < 3; ++i) ro[i] = (size_t)(tok0 + min((mt0 + 2 * i) * 16 + fr, NTOK - 1)) * DM + fq * 8;
        f32x4 acc[3];
#pragma unroll
        for (int i = 0; i < 3; ++i) acc[i] = (f32x4){0.f, 0.f, 0.f, 0.f};
#pragma unroll 1
        for (int kb = 0; kb < 32; kb += 4) {
            bf16x8 bh[4], bl[4], ah[4][3], al[4][3];
#pragma unroll
            for (int q = 0; q < 4; ++q) { bh[q] = *(const bf16x8*)(pbh + (kb + q) * 32); bl[q] = *(const bf16x8*)(pbl + (kb + q) * 32);
#pragma unroll
                for (int i = 0; i < 3; ++i) { ah[q][i] = *(const bf16x8*)(H + ro[i] + (kb + q) * 32); al[q][i] = *(const bf16x8*)(HL + ro[i] + (kb + q) * 32); } }
            __builtin_amdgcn_sched_barrier(0);
#pragma unroll
            for (int q = 0; q < 4; ++q)
#pragma unroll
                for (int i = 0; i < 3; ++i) {
                    acc[i] = __builtin_amdgcn_mfma_f32_16x16x32_bf16(ah[q][i], bh[q], acc[i], 0, 0, 0);
                    acc[i] = __builtin_amdgcn_mfma_f32_16x16x32_bf16(ah[q][i], bl[q], acc[i], 0, 0, 0);
                    acc[i] = __builtin_amdgcn_mfma_f32_16x16x32_bf16(al[q][i], bh[q], acc[i], 0, 0, 0); }
            __builtin_amdgcn_sched_barrier(0);
        }
#pragma unroll
        for (int i = 0; i < 3; ++i)
#pragma unroll
            for (int q = 0; q < 4; ++q) lg[((mt0 + 2 * i) * 16 + fq * 4 + q) * 64 + ntile * 16 + fr] = acc[i][q];
    }
    __syncthreads(); TS(5);
    if (!dry || (PROBE_D & 4)) {
        int* tke = (int*)(a.ws() + WS_TKE); float* tkw = (float*)(a.ws() + WS_TKW);
        const float ebias = a.in(I_EBIAS)[l * 64 + lane];
        for (int r = wave; r < NTOK; r += 8) {
            const int m = tok0 + r;
            const float score = 1.0f / (1.0f + __expf(-lg[r * 64 + lane]));
            const float sel = score + ebias; int rank = 0;
#pragma unroll
            for (int c = 0; c < 64; ++c) { const float o = __int_as_float(__builtin_amdgcn_readlane(__float_as_int(sel), c)); rank += (o > sel || (o == sel && c < lane)) ? 1 : 0; }
            const bool mine = rank < TOPK;
            const unsigned long long taken = __ballot(mine);
            const float wsum = wave_sum(mine ? score : 0.f);
            if (mine) { const int k = __popcll(taken & ((1ull << lane) - 1ull)); const int lr = __hip_atomic_fetch_add(&hist[lane], 1, __ATOMIC_RELAXED, __HIP_MEMORY_SCOPE_WORKGROUP);
                if (!dry) { tke[m * 8 + k] = lane; tkw[m * 8 + k] = score / wsum * ROUTE_SCALE; } pend[r * 8 + k] = (lane << 16) | lr; }
        }
    }
    __syncthreads();
    if (dry) return;
    { unsigned* cnt = (unsigned*)(a.ws() + WS_CTL) + CW_CNT + l * 64;
      if (tid < 64) hist[64 + tid] = (int)atomicAdd(&cnt[tid], (unsigned)hist[tid]); }
    __syncthreads();
    { int* tkp = (int*)(a.ws() + WS_TKP); int* list = (int*)(a.ws() + WS_LIST);
      for (int i = tid; i < NTOK * 8; i += 512) { const int pe = pend[i], e = pe >> 16, p = hist[64 + e] + (pe & 0xffff); const int m = tok0 + (i >> 3);
        tkp[m * 8 + (i & 7)] = p; list[(size_t)e * TT + p] = m; } }
    __syncthreads();
}

constexpr float YB_SCALE_G = 32.0f;
__device__ __forceinline__ void phase_combine_ln2(const KA& a, LAS unsigned char* lds, int l, int gw, int NGW, int tid, int lane, const bool dry) {
    LAS int* rst = (LAS int*)(lds + LDS_TAB) + 66;
    const float* mod = (const float*)(a.ws() + WS_MOD) + (size_t)l * 5 * 6144;
    const unsigned char* YB = (const unsigned char*)(a.ws() + WS_YB);
    const float* XSi = (const float*)(a.ws() + WS_XS); float* XS = (float*)(a.ws() + (dry ? WS_ACT : WS_XS)); bf16_t* H = (bf16_t*)(a.ws() + (dry ? WS_HL : WS_H));
    const int* tke = (const int*)(a.ws() + WS_TKE); const float* tkw = (const float*)(a.ws() + WS_TKW); const int* tkp = (const int*)(a.ws() + WS_TKP);
    const int mend = (l == DEPTH - 1) ? TLAT : TT;
    const int e0 = 16 * lane;
    f32x4 lng[4], lnb[4];
    { const f32x4* pg = (const f32x4*)(a.in(I_LN2G) + l * DM + e0); const f32x4* pb = (const f32x4*)(a.in(I_LN2B) + l * DM + e0);
#pragma unroll
      for (int j = 0; j < 4; ++j) { lng[j] = pg[j]; lnb[j] = pb[j]; } }
    float* outp = dry ? (float*)(a.ws() + WS_ACT) : a.out();
#define G_SLOTS(M0, SLOT, W) do { _Pragma("unroll") for (int q = 0; q < 2; ++q) { const int mq = (q == 0 || (M0) + NGW < mend) ? (M0) + q * NGW : (M0); SLOT[q] = 0; W[q] = 1.0f / YB_SCALE_G; \
        if ((M0) < mend) { if (lane < 8) { SLOT[q] = rst[tke[mq * 8 + lane]] + tkp[mq * 8 + lane]; W[q] = tkw[mq * 8 + lane] * (1.0f / YB_SCALE_G); } if (lane == 8) SLOT[q] = rst[64] + mq; } } } while (0)
    int slotn[2]; float wn[2];
    G_SLOTS(gw, slotn, wn);
    for (int m0 = gw; m0 < mend; m0 += 2 * NGW) {
        int mm[2]; mm[0] = m0; mm[1] = (m0 + NGW < mend) ? m0 + NGW : m0;
        const bool two = (m0 + NGW < mend);
        int slot[2]; float w[2];
        slot[0] = slotn[0]; slot[1] = slotn[1]; w[0] = wn[0]; w[1] = wn[1];
        G_SLOTS(m0 + 2 * NGW, slotn, wn);
        f32x4 ff[2][4]; f32x4 xv[2][4];
#pragma unroll
        for (int q = 0; q < 2; ++q) { const f32x4* xi = (const f32x4*)(XSi + (size_t)mm[q] * DM + e0);
#pragma unroll
            for (int j = 0; j < 4; ++j) { ff[q][j] = (f32x4){0.f, 0.f, 0.f, 0.f}; xv[q][j] = xi[j]; } }
        u32x4 yy[2][9];
#pragma unroll
        for (int k = 0; k < 9; ++k)
#pragma unroll
            for (int q = 0; q < 2; ++q) { const int sk = __builtin_amdgcn_readlane(slot[q], k); yy[q][k] = *(const u32x4*)(YB + (size_t)sk * DM + e0); }
#pragma unroll
        for (int k = 0; k < 9; ++k)
#pragma unroll
            for (int q = 0; q < 2; ++q) { const float wk = __int_as_float(__builtin_amdgcn_readlane(__float_as_int(w[q]), k));
#pragma unroll
                for (int j = 0; j < 4; ++j) { const f32x2 lo2 = __builtin_amdgcn_cvt_pk_f32_fp8((int)yy[q][k][j], false), hi2 = __builtin_amdgcn_cvt_pk_f32_fp8((int)yy[q][k][j], true);
                    ff[q][j] += (f32x4){lo2.x, lo2.y, hi2.x, hi2.y} * wk; } }
#pragma unroll
        for (int q = 0; q < 2; ++q) {
            if (q == 1 && !two) break;
            const int m = mm[q]; const float* md = mod + (size_t)tok_batchrow(m) * 6144;
            f32x4 v[4]; float s = 0.f;
#pragma unroll
            for (int j = 0; j < 4; ++j) { const f32x4 g2 = *((const f32x4*)(md + 5 * DM + e0) + j);
                v[j] = xv[q][j] * DN_ALPHA + g2 * ff[q][j]; s += (v[j][0] + v[j][1]) + (v[j][2] + v[j][3]); }
            const float mean = wave_sum(s) * (1.0f / DM); float s2 = 0.f;
#pragma unroll
            for (int j = 0; j < 4; ++j) { v[j] = v[j] - mean; s2 += (v[j][0] * v[j][0] + v[j][1] * v[j][1]) + (v[j][2] * v[j][2] + v[j][3] * v[j][3]); }
            const float rstd = __builtin_amdgcn_rsqf(wave_sum(s2) * (1.0f / DM) + LN_EPS);
            if (l == DEPTH - 1) {
                f32x4* oo = (f32x4*)(outp + (size_t)m * DM + e0);
#pragma unroll
                for (int j = 0; j < 4; ++j) oo[j] = v[j] * rstd * lng[j] + lnb[j];
            } else {
                const float* mdn = md + 5 * 6144;
                f32x4* xio = (f32x4*)(XS + (size_t)m * DM + e0); u32x4* ho = (u32x4*)(H + (size_t)m * DM + e0);
                unsigned hp[8];
#pragma unroll
                for (int j = 0; j < 4; ++j) { const f32x4 x2 = v[j] * rstd * lng[j] + lnb[j]; xio[j] = x2;
                    const f32x4 sh = *((const f32x4*)(mdn + e0) + j), sc = *((const f32x4*)(mdn + DM + e0) + j);
                    const f32x4 h = x2 * (sc + 1.0f) + sh; hp[2 * j] = cvt_pk_bf16(h[0], h[1]); hp[2 * j + 1] = cvt_pk_bf16(h[2], h[3]); }
                ho[0] = (u32x4){hp[0], hp[1], hp[2], hp[3]}; ho[1] = (u32x4){hp[4], hp[5], hp[6], hp[7]};
            }
        }
    }
#undef G_SLOTS
}

__device__ __forceinline__ void build_expert_tables(const KA& a, LAS unsigned char* lds, int l, int tid) {
    LAS int* tst = (LAS int*)(lds + LDS_TAB); LAS int* rst = tst + 66; LAS int* cn = rst + 66;
    __syncthreads();
    if (tid < 64) {
        const unsigned* cnt = (const unsigned*)(a.ws() + WS_CTL) + CW_CNT + l * 64;
        const int c = (int)__hip_atomic_load(cnt + tid, __ATOMIC_RELAXED, __HIP_MEMORY_SCOPE_AGENT);
        int t = (c + 255) >> 8, r = c;
#pragma unroll
        for (int o = 1; o < 64; o <<= 1) { const int t2 = __shfl_up(t, o), r2 = __shfl_up(r, o); if (tid >= o) { t += t2; r += r2; } }
        tst[tid] = t - ((c + 255) >> 8); rst[tid] = r - c; cn[tid] = c;
        const int nsh = (l == DEPTH - 1) ? TLAT : TT;
        if (tid == 63) { tst[64] = t; rst[64] = r; cn[64] = nsh; tst[65] = t + (nsh >> 8); rst[65] = r + nsh; }
    }
    __syncthreads();
}

struct Seg {
    int i0, c, G, first, n;
    __device__ __forceinline__ void init(int first_, int n_, int c_, int G_) { first = first_; n = n_; c = c_; G = G_; i0 = (first_ <= c_) ? 0 : (first_ - c_ + G_ - 1) / G_; }
    __device__ __forceinline__ int idx(int i) const { const int L = (i0 + i) * G + c - first; return L < n ? L : -1; }
};
__device__ __forceinline__ int kv_row0(int pm) { return pm < 64 ? (pm >> 4) * KVR + (pm & 15) * 256 : (pm - 64) * KVR + LSEQ; }

struct SchedQKVE { Seg s; unsigned char* ws; int j;
    __device__ __forceinline__ bool next(int i, pg8::Unit& u) { const int L0 = s.idx(i); if (L0 < 0) return false;
        size_t offA, offB, offC; int ldc, x0, x1 = 0;
        if (L0 >= 340) { const int L = L0 - 340; x0 = 3;
            if (L < 128) { const int q = L >> 6, mt = L & 63, b = mt >> 4;
                offA = WS_WF + ((size_t)j * 512 + q * 256) * 2048; offB = WS_H + (size_t)mt * 256 * 2048; offC = WS_ZT + ((size_t)b * 256 * 8192 + q * 4096 + (mt & 15) * 256) * 2; ldc = 8192; }
            else { const int q = (L - 128) >> 2, b = (L - 128) & 3;
                offA = WS_WF + ((size_t)j * 512 + q * 256) * 2048; offB = WS_H + (size_t)(TLAT + b * 256) * 2048; offC = WS_ZCT + ((size_t)b * 256 * 512 + q * 256) * 2; ldc = 512; }
        } else { const int pm = L0 % 68, pn = L0 / 68;
            offA = WS_H + (size_t)pm * 256 * 2048; offB = WS_WINE + ((size_t)j * 1280 + pn * 256) * 2048; x1 = pm < 64 ? (pm & 15) * 256 : -1;
            if (pn < 3) { offC = WS_QB + ((size_t)pm * 256 * 768 + pn * 256) * 2; ldc = 768; x0 = 0; }
            else { offC = (pn == 3 ? WS_KB : WS_VB) + (size_t)kv_row0(pm) * 128 * 2; ldc = 128; x0 = pn - 2; } }
        u.A = (const char*)(ws + offA); u.B = (const char*)(ws + offB); u.C = (char*)(ws + offC); u.ldc = ldc; u.x0 = x0; u.x1 = x1; u.rows = nullptr; u.nvalid = 256;
        return true; } };
struct SchedQKVO { Seg s; unsigned char* ws; int j;
    __device__ __forceinline__ bool next(int i, pg8::Unit& u) { const int L = s.idx(i); if (L < 0) return false; const int pm = L % 68, pn = L / 68;
        u.A = (const char*)(ws + WS_H) + (size_t)pm * 256 * 2048; u.B = (const char*)(ws + WS_WINO) + ((size_t)j * 3072 + pn * 256) * 2048; u.rows = nullptr; u.nvalid = 256; u.x0 = 0; u.x1 = 0; u.ldc = 1024;
        if (pn < 4) u.C = (char*)(ws + WS_QB) + ((size_t)pm * 256 * 1024 + pn * 256) * 2;
        else u.C = (char*)(ws + (pn < 8 ? WS_KB : WS_VB)) + ((size_t)kv_row0(pm) * 1024 + (pn & 3) * 256) * 2;
        return true; } };
struct SchedDFT { Seg s; unsigned char* ws;
    __device__ __forceinline__ bool next(int i, pg8::Unit& u) { const int L = s.idx(i); if (L < 0) return false; const int pm = L & 15, b = L >> 4;
        u.A = (const char*)(ws + WS_TW) + (size_t)pm * 256 * 16384; u.B = (const char*)(ws + WS_ZT) + (size_t)b * 256 * 16384;
        u.C = (char*)(ws + WS_O) + (size_t)(b * LSEQ + pm * 256) * 1024 * 2; u.ldc = 1024; u.rows = nullptr; u.nvalid = 256; u.x0 = 0; u.x1 = 0; return true; } };
struct SchedDFTC { Seg s; unsigned char* ws;
    __device__ __forceinline__ bool next(int i, pg8::Unit& u) { const int b = s.idx(i); if (b < 0) return false;
        u.A = (const char*)(ws + WS_TWC); u.B = (const char*)(ws + WS_ZCT) + (size_t)b * 256 * 1024;
        u.C = (char*)(ws + WS_O) + (size_t)(TLAT + b * 256) * 1024 * 2; u.ldc = 1024; u.rows = nullptr; u.nvalid = 256; u.x0 = 0; u.x1 = 0; return true; } };
struct SchedOUT { Seg s; unsigned char* ws; int l, nm;
    __device__ __forceinline__ bool next(int i, pg8::Unit& u) { const int L = s.idx(i); if (L < 0) return false; const int pm = L % nm, pn = L / nm;
        u.A = (const char*)(ws + WS_O) + (size_t)pm * 256 * 2048; u.B = (const char*)(ws + WS_WOUT) + ((size_t)l * 1024 + pn * 256) * 2048;
        u.C = (char*)(ws + WS_Y) + ((size_t)pm * 256 * 1024 + pn * 256) * 2; u.ldc = 1024; u.rows = nullptr; u.nvalid = 256; u.x0 = 0; u.x1 = 0; return true; } };
struct SchedGU { Seg s; unsigned char* ws; int l; const LAS int* tab; int e; int L0, cnt; int probe;
    __device__ __forceinline__ bool next(int i, pg8::Unit& u) { const int L = cnt > 0 ? (i < cnt ? L0 + i : -1) : s.idx(i); if (L < 0) return false; const int mtg = L >> 1, nt = L & 1;
        while (tab[e + 1] <= mtg) ++e;
        while (tab[e] > mtg) --e;
        const int mt = mtg - tab[e], r0 = tab[66 + e] + mt * 256;
        u.A = (const char*)(ws + WS_H); u.rows = (const int*)(ws + WS_LIST) + (size_t)e * TT + mt * 256; u.nvalid = min(256, tab[132 + e] - mt * 256);
        u.B = (const char*)(ws + WS_WGU) + ((size_t)(l * 65 + e) * 512 + nt * 256) * 2048;
        u.C = (char*)(ws + WS_ACT) + ((size_t)r0 * 256 + nt * 128) * 2; u.ldc = 256; u.x0 = 0; u.x1 = 0;
        if (probe & 1) u.rows = (const int*)(ws + WS_LIST) + (size_t)64 * TT + (mtg & 63) * 256;
        if (probe & 2) u.nvalid = 0;
        return true; } };
struct SchedDN { Seg s; unsigned char* ws; int l; const LAS int* tab; int e; int probe; int L0, cnt;
    __device__ __forceinline__ bool next(int i, pg8::Unit& u) { const int L = cnt > 0 ? (i < cnt ? L0 + i : -1) : s.idx(i); if (L < 0) return false; const int mtg = L >> 2, nt = L & 3;
        while (tab[e + 1] <= mtg) ++e;
        while (tab[e] > mtg) --e;
        const int mt = mtg - tab[e], r0 = tab[66 + e] + mt * 256;
        u.A = (const char*)(ws + WS_ACT) + (size_t)r0 * 512; u.rows = nullptr; u.nvalid = min(256, tab[132 + e] - mt * 256);
        u.B = (const char*)(ws + WS_WD) + ((size_t)(l * 65 + e) * 1024 + nt * 256) * 512;
        u.C = (char*)(ws + WS_YB) + ((size_t)r0 * 1024 + nt * 256); u.ldc = 1024; u.x0 = 0; u.x1 = 0;
        if (probe & 1) u.nvalid = 0;
        if (probe & 2) { u.A = (const char*)(ws + WS_ACT); u.B = (const char*)(ws + WS_WD) + (size_t)(l * 65) * 1024 * 512; }
        return true; } };

constexpr int NPHASE = 2 + 7 * DEPTH;
#ifndef PHMASK
#define PHMASK 0xFFFFF
#endif
#define SITE(b) if constexpr ((PHMASK >> (b)) & 1)
#ifndef REP_A
#define REP_A 1
#endif
#ifndef REP_B
#define REP_B 1
#endif
#ifndef REP_BO
#define REP_BO 1
#endif
#ifndef REP_C
#define REP_C 1
#endif
#ifndef REP_E
#define REP_E 1
#endif
#ifndef REP_F
#define REP_F 1
#endif
#ifndef REP_D
#define REP_D 1
#endif
#ifndef REP_G
#define REP_G 1
#endif
#ifndef REP_BAR
#define REP_BAR 1
#endif
#ifndef PROBE_TS_SCALE
#define PROBE_TS_SCALE 0.0002f
#endif
#ifndef PROBE_TS_A
#define PROBE_TS_A 0
#endif
#ifndef PROBE_TS_B
#define PROBE_TS_B 1
#endif
#ifndef EF_FUSED
#define EF_FUSED 0
#endif
#ifndef E_STAGGER
#define E_STAGGER 0
#endif
#ifndef PROBE_E
#define PROBE_E 0
#endif
#ifndef PROBE_F
#define PROBE_F 0
#endif
#ifndef REP_P0
#define REP_P0 1
#endif
__global__ void __launch_bounds__(512, 2) fwd(Args args_) {
    extern __shared__ __attribute__((aligned(16))) unsigned char lds_raw[];
    LAS unsigned char* lds = (LAS unsigned char*)lds_raw;
    const int G = gridDim.x, bid = ((G & 7) == 0) ? (int)(blockIdx.x & 7) * (G >> 3) + (int)(blockIdx.x >> 3) : (int)blockIdx.x;
#define tid (opaque_tid())
#define lane (opaque_tid() & 63)
#define wave (__builtin_amdgcn_readfirstlane(opaque_tid() >> 6))
    const KA a;
#define WSP (a.ws())
#define args a
    volatile LAS unsigned* MISC = (volatile LAS unsigned*)(lds + LDS_MISC);
    { const int t0 = threadIdx.x; if (t0 < 64) MISC[t0] = 0u; }
    __syncthreads();
    if (PROBE_TS && threadIdx.x == 0) *(volatile LAS unsigned long long*)(lds + LDS_MISC + 192) = __builtin_amdgcn_s_memrealtime();
#define lo (a.ph_lo())
#define hi (a.ph_hi())
    XcdBarrier bar; bar.bar = (unsigned*)(WSP + WS_CTL) + CW_BAR; bar.x = 0; bar.st = MISC + 8;
    if (hi - lo > 1) bar = xcd_barrier_post((unsigned*)(WSP + WS_CTL) + CW_BAR, MISC + 8);
#define IN(k) (lo <= (k) && (k) < hi)
#define SEAM(k) do { if (IN(k) && IN((k) + 1)) for (int rb = 0; rb < REP_BAR; ++rb) xcd_barrier(bar); TS(((k) < 2) ? 16 : 17 + ((k) - 2) % 7); } while (0)
    const int NGW = G * 8;
#define gw (bid * 8 + wave)

    if (IN(0)) SITE(0) for (int rep = 0; rep < REP_P0; ++rep) {
        __syncthreads();
        p0_mod(args, lds, bid, G, tid, wave, lane);
        if (bid >= G - 64) p0_fourier_fold(args, lds, G - 1 - bid, tid, wave, lane);
        p0_tables(args, lds, bid * 512 + tid, G * 512, tid);
        { int* ident = (int*)(WSP + WS_LIST) + (size_t)NEXP * TT; for (int i = bid * 512 + tid; i < TT; i += G * 512) ident[i] = i; }
        __syncthreads();
        if (CV_MODE == 0) convert_items(lds, 0, 0, cv_items(0), bid, G);
        else { convert_items(lds, 0, CV_EX, cv_items(0), bid, G); convert_items(lds, 0, 3000, CV_EX, bid, G); }
        if (CV_MODE == 0) { for (int lq = 1; lq < DEPTH; ++lq) convert_items(lds, lq, 0, cv_items(lq), bid, G); }
    }
    TS(0); SEAM(0);
    if (IN(1)) SITE(0) p0b_modulate(args, gw, NGW, lane);
    TS(0); SEAM(1);

    for (int l = 0; l < DEPTH; ++l) {
        const int pb = 2 + 7 * l, j = l >> 1;
        if (IN(pb + 0)) for (int rep = 0; rep < REP_A; ++rep) {
            if ((l & 1) == 0) {
                SITE(1) { SchedQKVE S; S.s.init(0, 476, bid, G); S.ws = WSP; S.j = j;
                  pg8::EpiQKVE E; E.P = (LAS float*)(lds + LDS_EPI); E.gainp = (const float*)(WSP + WS_GAINP) + j * 256; E.rope = (const f32x2*)(WSP + WS_ROPE);
                  pg8::gemm_phase<pg8::EpiQKVE, SchedQKVE, false>(lds, 1024, S, E); }
            } else SITE(3) {
                SchedQKVO S; S.s.init(0, 816, bid, G); S.ws = WSP; S.j = j; pg8::EpiStore E;
                pg8::gemm_phase<pg8::EpiStore, SchedQKVO, false>(lds, 1024, S, E);
                if (rep == 0) cv_tail(lds, l, 0, 816, bid, G);
            }
        }
        TS(1); SEAM(pb + 0);
        if (IN(pb + 1)) for (int rep = 0; rep < ((l & 1) ? REP_BO : REP_B); ++rep) {
            __syncthreads();
            const bf16_t* QB = (const bf16_t*)(WSP + WS_QB); const bf16_t* KB = (const bf16_t*)(WSP + WS_KB); const bf16_t* VB = (const bf16_t*)(WSP + WS_VB); bf16_t* O = (bf16_t*)(WSP + WS_O);
            if ((l & 1) == 0) {
                SITE(4) { SchedDFT S; S.s.init(0, 64, bid, G); S.ws = WSP; pg8::EpiStore E; pg8::gemm_phase<pg8::EpiStore, SchedDFT, false>(lds, 8192, S, E); }
                SITE(5) { SchedDFTC S; S.s.init(28, 4, bid, G); S.ws = WSP; pg8::EpiStore E; pg8::gemm_phase<pg8::EpiStore, SchedDFTC, false>(lds, 512, S, E); }
                __syncthreads();
                if (bid < 64 && rep == 0) { const CvSlice c = cv_slice(l, 1); if (c.i1 > c.i0) { __syncthreads(); convert_items(lds, c.l, c.i0, c.i1, bid, 64); __syncthreads(); } }
                SITE(6) {
                    int u = (bid < 24) ? bid : (bid >= 64 ? bid - 40 : 408);
                    while (u < 408) {
                        const bf16_t *q, *k, *v; bf16_t* o; int ntile;
                        if (u < 24) { const int b = u / 6, h = u % 6; q = QB + (TLAT + b * 256) * 768 + h * 128; k = KB + ((h / 3) * NB * KVR + b * KVR + LSEQ) * 128; v = VB + ((h / 3) * NB * KVR + b * KVR + LSEQ) * 128;
                            o = O + (TLAT + b * 256) * 1024 + 256 + h * 128; ntile = 4; u = 408; }
                        else { const int uu = u - 24, bk = uu / 48, x = uu % 48, b = bk >> 1, kvh = bk & 1, h = kvh * 3 + x / 16, qb = x & 15;
                            q = QB + (b * LSEQ + qb * 256) * 768 + h * 128; k = KB + (kvh * NB * KVR + b * KVR) * 128; v = VB + (kvh * NB * KVR + b * KVR) * 128;
                            o = O + (b * LSEQ + qb * 256) * 1024 + 256 + h * 128; ntile = 68; u += 192; }
                        att::attn_body<false, 768, 128, 1024>(q, k, v, o, ntile, 0, 0, 0, (char*)lds_raw);
                    }
                }
            } else {
                const float* rpb = a.in(I_NARPB) + (size_t)j * 8 * 465;
                LAS float* bt = (LAS float*)(lds + att::LDS_BIAS);
                SITE(7) for (int u = bid; u < ((l == DEPTH - 1) ? 512 : 544); u += G) {
                    const bf16_t *q, *k, *v; bf16_t* o; int ntile, nloc, bs, q0r, h;
                    if (u < 512) { const int bh = u >> 4, blk = u & 15, b = bh >> 3; h = bh & 7; bs = min(max(4 * blk - 4, 0), 52); q0r = 4 * blk; ntile = 16; nloc = 12;
                        q = QB + (b * LSEQ + blk * 256) * 1024 + h * 128; k = KB + b * KVR * 1024 + h * 128; v = VB + b * KVR * 1024 + h * 128; o = O + (b * LSEQ + blk * 256) * 1024 + h * 128; }
                    else { const int b = (u - 512) >> 3; h = u & 7; bs = 0; q0r = 0; ntile = 4; nloc = 0;
                        q = QB + (TLAT + b * 256) * 1024 + h * 128; k = KB + b * KVR * 1024 + h * 128; v = VB + b * KVR * 1024 + h * 128; o = O + (TLAT + b * 256) * 1024 + h * 128; }
                    for (int i = tid; i < 465; i += 512) bt[64 + i] = rpb[h * 465 + i] * (1.0f / ATT_SCALE);
                    att::attn_body<true, 1024, 1024, 1024>(q, k, v, o, ntile, nloc, bs, q0r, (char*)lds_raw);
                }
            }
        }
        TS(2); SEAM(pb + 1);
        if (IN(pb + 2)) SITE(9) for (int rep = 0; rep < REP_C; ++rep) { const int nm = (l == DEPTH - 1) ? 64 : 68;
            SchedOUT S; S.s.init(0, nm * 4, bid, G); S.ws = WSP; S.l = l; S.nm = nm; pg8::EpiStore E; pg8::gemm_phase<pg8::EpiStore, SchedOUT, false>(lds, 1024, S, E);
            if (rep == 0) cv_tail(lds, l, 2, nm * 4, bid, G); }
        TS(3); SEAM(pb + 2);
        if (IN(pb + 3)) SITE(10) for (int rep = 0; rep < REP_D; ++rep) { __syncthreads(); phase_ln1_router(args, lds, l, bid, tid, wave, lane, rep + 1 < REP_D); }
        TS(6); SEAM(pb + 3);
#if EF_FUSED
        if (IN(pb + 4)) SITE(11) for (int rep = 0; rep < REP_E; ++rep) { build_expert_tables(args, lds, l, tid);
            const LAS int* tab = (const LAS int*)(lds + LDS_TAB);
            const int nsu = tab[65]; int ecur = 0;
            for (int su = bid; su < nsu; su += G) {
                { SchedGU S; S.s.init(0, 0, bid, G); S.ws = WSP; S.l = l; S.tab = tab; S.e = ecur; S.L0 = su * 2; S.cnt = 2; S.probe = 0; pg8::EpiSwiGLU E;
                  pg8::gemm_phase<pg8::EpiSwiGLU, SchedGU, true>(lds, 1024, S, E); ecur = S.e; }
                VM_WAIT(); __syncthreads();
                __builtin_amdgcn_fence(__ATOMIC_ACQUIRE, "agent"); VM_WAIT();
                { SchedDN S; S.s.init(0, 0, bid, G); S.ws = WSP; S.l = l; S.tab = tab; S.e = ecur; S.probe = 0; S.L0 = su * 4; S.cnt = 4; pg8::EpiStoreF8 E;
                  int k256 = 256; asm volatile("" : "+s"(k256));
                  pg8::gemm_phase<pg8::EpiStoreF8, SchedDN, false>(lds, k256, S, E); }
            }
            if (rep == 0) { cv_tail(lds, l, 4, nsu, bid, G); cv_tail(lds, l, 5, nsu, bid, G); } }
        TS(7); SEAM(pb + 4);
        if (IN(pb + 5) && !IN(pb + 4)) {}
#else
        if (IN(pb + 4)) SITE(11) for (int rep = 0; rep < REP_E; ++rep) { build_expert_tables(args, lds, l, tid);
            const LAS int* tab = (const LAS int*)(lds + LDS_TAB);
            if (E_STAGGER && (bid & 1) && bid >= 8) { const unsigned long long t0s = __builtin_amdgcn_s_memrealtime(); while (__builtin_amdgcn_s_memrealtime() - t0s < (unsigned long long)E_STAGGER) __builtin_amdgcn_s_sleep(16); }
            SchedGU S; S.s.init(0, tab[65] * 2, bid, G); S.ws = WSP; S.l = l; S.tab = tab; S.e = 0; S.L0 = 0; S.cnt = 0; S.probe = (rep + 1 < REP_E) ? PROBE_E : 0; pg8::EpiSwiGLU E;
            pg8::gemm_phase<pg8::EpiSwiGLU, SchedGU, true>(lds, 1024, S, E);
            if (rep == 0) cv_tail(lds, l, 4, tab[65] * 2, bid, G); }
        TS(7); SEAM(pb + 4);
        if (IN(pb + 5)) SITE(12) for (int rep = 0; rep < REP_F; ++rep) { build_expert_tables(args, lds, l, tid);
            const LAS int* tab = (const LAS int*)(lds + LDS_TAB);
            SchedDN S; S.s.init(0, tab[65] * 4, bid, G); S.ws = WSP; S.l = l; S.tab = tab; S.e = 0; S.probe = (rep + 1 < REP_F) ? PROBE_F : 0; S.L0 = 0; S.cnt = 0; pg8::EpiStoreF8 E;
            int k256 = 256; asm volatile("" : "+s"(k256));
            pg8::gemm_phase<pg8::EpiStoreF8, SchedDN, false>(lds, k256, S, E);
            if (rep == 0) cv_tail(lds, l, 5, tab[65] * 4, bid, G); }
        TS(8); SEAM(pb + 5);
#endif
        if (IN(pb + 6)) SITE(13) for (int rep = 0; rep < REP_G; ++rep) { build_expert_tables(args, lds, l, tid); phase_combine_ln2(args, lds, l, gw, NGW, tid, lane, rep + 1 < REP_G); }
        TS(9); SEAM(pb + 6);
    }
    if (PROBE_TS) { volatile LAS float* ta_ = (volatile LAS float*)(lds + LDS_MISC + 64);
        float* tsw = (float*)(WSP + WS_CTL) + 32;
        if (blockIdx.x == 0 && threadIdx.x == 0) __hip_atomic_store(tsw, ta_[PROBE_TS_A] * 0.01f * PROBE_TS_SCALE, __ATOMIC_RELAXED, __HIP_MEMORY_SCOPE_AGENT);
        xcd_barrier(bar);
        const float va0_unused = 0.f; (void)va0_unused; const float va = __hip_atomic_load(tsw, __ATOMIC_RELAXED, __HIP_MEMORY_SCOPE_AGENT); float* o_ = a.out();
        for (int i = blockIdx.x * 512 + threadIdx.x; i < TLAT * DM; i += G * 512) o_[i] += va; }
#undef IN
#undef SEAM
#undef lo
#undef hi
#undef lane
#undef wave
#undef gw
#undef tid
#undef WSP
#undef args
}

extern "C" void kernel_launch(void* const* d_in, const int* in_sizes, int n_in, void* d_out, int out_size, void* d_ws, size_t ws_size, hipStream_t stream) {
    static int ok = 0;
    if (ok == 0) {
        if (n_in != N_IN || ws_size < WS_END) { fprintf(stderr, "kernel_launch: n_in %d (want %d), ws %zu (want >= %zu)\n", n_in, (int)N_IN, ws_size, (size_t)WS_END); return; }
        if (hipFuncSetAttribute((const void*)fwd, hipFuncAttributeMaxDynamicSharedMemorySize, LDS_BYTES) != hipSuccess) { fprintf(stderr, "kernel_launch: hipFuncSetAttribute failed\n"); return; }
        int per_cu = 0;
        if (hipOccupancyMaxActiveBlocksPerMultiprocessor(&per_cu, (const void*)fwd, 512, LDS_BYTES) != hipSuccess || per_cu < 1) fprintf(stderr, "kernel_launch: occupancy query reports %d\n", per_cu);
        ok = 1;
    }
    Args a;
    memset(&a, 0, sizeof(a));
    for (int i = 0; i < N_IN; ++i) a.in[i] = (const float*)d_in[i];
    a.out = (float*)d_out; a.ws = (unsigned char*)d_ws;
    hipMemsetAsync((char*)d_ws + WS_CTL, 0, CTL_BYTES, stream);
#if MK_ONE_LAUNCH
    a.ph_lo = 0; a.ph_hi = NPHASE;
    hipLaunchKernelGGL(fwd, dim3(256), dim3(512), LDS_BYTES, stream, a);
#else
    for (int p = 0; p < NPHASE; ++p) { a.ph_lo = p; a.ph_hi = p + 1; hipLaunchKernelGGL(fwd, dim3(256), dim3(512), LDS_BYTES, stream, a); }
#endif
    const hipError_t le = hipPeekAtLastError();
    if (le != hipSuccess) fprintf(stderr, "kernel_launch: launch failed: %s\n", hipGetErrorName(le));
}
```

```cpp
#include <hip/hip_runtime.h>
#include <cstdio>
#include <cstdint>
#include <cstring>

#define LAS __attribute__((address_space(3)))
#define GAS __attribute__((address_space(1)))
typedef unsigned short bf16_t;
typedef short bf16x8 __attribute__((ext_vector_type(8)));
typedef short s16x4 __attribute__((ext_vector_type(4)));
typedef float f32x2 __attribute__((ext_vector_type(2)));
typedef float f32x4 __attribute__((ext_vector_type(4)));
typedef float f32x16 __attribute__((ext_vector_type(16)));
typedef unsigned u32x2 __attribute__((ext_vector_type(2)));
typedef unsigned u32x4 __attribute__((ext_vector_type(4)));

#ifndef MK_ONE_LAUNCH
#define MK_ONE_LAUNCH 1
#endif

constexpr int NB = 4, LSEQ = 4096, DM = 1024, NCTX = 256, DEPTH = 4;
constexpr int TLAT = NB * LSEQ, TCTX = NB * NCTX, TT = TLAT + TCTX;
constexpr int KVR = LSEQ + NCTX;
constexpr int NEXP = 64, TOPK = 8, EDIM = 256;
constexpr int NPAIR = TT * TOPK, NSLOT = NPAIR + TT;
constexpr float DN_ALPHA = 1.681792830507429f;
constexpr float LN_EPS = 1e-6f, RMS_EPS = 1e-6f, ROUTE_SCALE = 2.5f;
constexpr float ATT_SCALE = 0.088388347648318440f;

constexpr size_t al256(size_t x) { return (x + 255) / 256 * 256; }
constexpr size_t WS_CTL = 0, CTL_BYTES = 65536;
constexpr size_t WS_MOD = WS_CTL + CTL_BYTES;
constexpr size_t WS_GAINP = WS_MOD + al256((size_t)DEPTH * 5 * 6 * DM * 4);
constexpr size_t WS_ROPE = WS_GAINP + 2048;
constexpr size_t WS_WRHI = WS_ROPE + 16384;
constexpr size_t WS_WRLO = WS_WRHI + (size_t)DEPTH * 64 * DM * 2;
constexpr size_t WS_WF = WS_WRLO + (size_t)DEPTH * 64 * DM * 2;
constexpr size_t WS_WINE = WS_WF + (size_t)2 * 512 * DM * 2;
constexpr size_t WS_WINO = WS_WINE + (size_t)2 * 1280 * DM * 2;
constexpr size_t WS_WOUT = WS_WINO + (size_t)2 * 3072 * DM * 2;
constexpr size_t WS_WGU = WS_WOUT + (size_t)DEPTH * DM * DM * 2;
constexpr size_t WS_WD = WS_WGU + (size_t)DEPTH * 65 * 512 * DM * 2;
constexpr size_t WS_TW = WS_WD + (size_t)DEPTH * 65 * DM * 256 * 2;
constexpr size_t WS_TWC = WS_TW + (size_t)4096 * 8192 * 2;
constexpr size_t WS_XS = WS_TWC + (size_t)256 * 512 * 2;
constexpr size_t WS_H = WS_XS + (size_t)TT * DM * 4;
constexpr size_t WS_TKE = WS_H + (size_t)TT * DM * 2;
constexpr size_t WS_TKW = WS_TKE + (size_t)NPAIR * 4;
constexpr size_t WS_TKP = WS_TKW + (size_t)NPAIR * 4;
constexpr size_t WS_LIST = WS_TKP + (size_t)NPAIR * 4;
constexpr size_t WS_ACT = WS_LIST + (size_t)(NEXP + 1) * TT * 4;
constexpr size_t WS_YB = WS_ACT + (size_t)(NSLOT + 256) * EDIM * 2;
constexpr size_t WS_QB = WS_YB;
constexpr size_t WS_KB = WS_QB + (size_t)TT * DM * 2;
constexpr size_t WS_VB = WS_KB + (size_t)NB * KVR * DM * 2;
constexpr size_t WS_O = WS_VB + (size_t)NB * KVR * DM * 2;
constexpr size_t WS_Y = WS_O + (size_t)TT * DM * 2;
constexpr size_t WS_ZT = WS_Y + (size_t)TT * DM * 2;
constexpr size_t WS_ZCT = WS_ZT + (size_t)1024 * 8192 * 2;
constexpr size_t WS_OVL_END = WS_ZCT + (size_t)1024 * 512 * 2;
constexpr size_t WS_HL = WS_YB + (size_t)NSLOT * DM * 2;
constexpr size_t WS_TRASH = WS_HL + (size_t)TT * DM * 2;
constexpr size_t WS_END = WS_TRASH + (size_t)256 * 16384;
static_assert(WS_OVL_END <= WS_HL, "overlay fits in YB");
static_assert(WS_END <= (size_t)1 << 30, "workspace must fit 1 GiB");
constexpr int CW_TMO = 0, CW_CNT = 64  , CW_BAR = 1024;

constexpr int LDS_BYTES = 147456;
constexpr int LDS_STAGE = 0;
constexpr int LDS_EPI = 131072;
constexpr int LDS_RIDX = 139264;
constexpr int LDS_TAB = 141312;
constexpr int LDS_MISC = 147456 - 256;

__device__ __forceinline__ unsigned cvt_pk_bf16(float lo, float hi) { unsigned r; asm volatile("v_cvt_pk_bf16_f32 %0, %1, %2" : "=v"(r) : "v"(lo), "v"(hi)); return r; }
__device__ __forceinline__ float bf_lo(unsigned u) { return __uint_as_float(u << 16); }
__device__ __forceinline__ float bf_hi(unsigned u) { return __uint_as_float(u & 0xffff0000u); }
__device__ __forceinline__ float wave_sum(float v) {
#pragma unroll
    for (int o = 1; o < 64; o <<= 1) v += __shfl_xor(v, o);
    return v;
}
__device__ __forceinline__ float wave_max(float v) {
#pragma unroll
    for (int o = 1; o < 64; o <<= 1) v = fmaxf(v, __shfl_xor(v, o));
    return v;
}
#define LDS_WAIT() asm volatile("s_waitcnt lgkmcnt(0)" ::: "memory")
#define VM_WAIT() asm volatile("s_waitcnt vmcnt(0)" ::: "memory")

#ifndef PROBE_TS
#define PROBE_TS 0
#endif
#define TS(k) do { if (PROBE_TS && blockIdx.x == 0 && threadIdx.x == 0) { const unsigned long long now_ = __builtin_amdgcn_s_memrealtime(); volatile LAS float* ta_ = (volatile LAS float*)(lds + LDS_MISC + 64); \
    ta_[k] = ta_[k] + (float)(now_ - *(volatile LAS unsigned long long*)(lds + LDS_MISC + 192)); *(volatile LAS unsigned long long*)(lds + LDS_MISC + 192) = now_; } } while (0)

__device__ __forceinline__ int opaque_tid() { int t = threadIdx.x; asm volatile("" : "+v"(t)); return t; }
namespace pg8 {
constexpr int BM = 256, BK = 64, HALF = 128, HTB = HALF * BK * 2  , STAGE_BYTES = 8 * HTB;

__host__ __device__ __forceinline__ int lds_byte(int r, int c) { const int st = (r >> 4) * 2 + (c >> 5), rr = r & 15, cc = c & 31, ob = rr * 64 + cc * 2; return st * 1024 + (ob ^ (((ob >> 9) & 1) << 5)); }
__host__ __device__ __forceinline__ void stage_rc(int b, int& R, int& C) { const int st = b / 1024, sb = b % 1024, swz = sb ^ (((sb >> 9) & 1) << 5); R = (st >> 1) * 16 + swz / 64; C = (st & 1) * 32 + (swz % 64) / 2; }
__host__ __device__ __forceinline__ int perm32(int rho) { const int n = rho >> 4, i = rho & 15; return 8 * (i >> 2) + 4 * n + (i & 3); }

struct Unit { const char* A; const char* B; char* C; const int* rows; int ldc, nvalid, x0, x1; };

struct EpiStore {
    __device__ __forceinline__ void operator()(const f32x4 (&acc)[2][2][4][2], const Unit& u) const {
        const int tid = opaque_tid(), wid = tid >> 6, lane = tid & 63, wr = wid >> 2, wc = wid & 3, fr = lane & 15, fq = lane >> 4;
        const int row0 = wr * 64 + fr, col0 = wc * 32 + 8 * fq;
#pragma unroll
        for (int ai = 0; ai < 2; ++ai)
#pragma unroll
            for (int m = 0; m < 4; ++m) {
                const int r = row0 + ai * HALF + m * 16;
                if (r < u.nvalid) {
                    bf16_t* rowp = (bf16_t*)u.C + (size_t)r * u.ldc + col0;
#pragma unroll
                    for (int bj = 0; bj < 2; ++bj) { const f32x4 v0 = acc[ai][bj][m][0], v1 = acc[ai][bj][m][1];
                        u32x4 w; w.x = cvt_pk_bf16(v0[0], v0[1]); w.y = cvt_pk_bf16(v0[2], v0[3]); w.z = cvt_pk_bf16(v1[0], v1[1]); w.w = cvt_pk_bf16(v1[2], v1[3]);
                        *(u32x4*)(rowp + bj * HALF) = w; }
                }
            }
    }
};
constexpr float YB_SCALE = 32.0f;
struct EpiStoreF8 {
    __device__ __forceinline__ void operator()(const f32x4 (&acc)[2][2][4][2], const Unit& u) const {
        const int tid = opaque_tid(), wid = tid >> 6, lane = tid & 63, wr = wid >> 2, wc = wid & 3, fr = lane & 15, fq = lane >> 4;
        const int row0 = wr * 64 + fr, col0 = wc * 32 + 8 * fq;
#pragma unroll
        for (int ai = 0; ai < 2; ++ai)
#pragma unroll
            for (int m = 0; m < 4; ++m) {
                const int r = row0 + ai * HALF + m * 16;
                if (r < u.nvalid) {
                    unsigned char* rowp = (unsigned char*)u.C + (size_t)r * u.ldc + col0;
#pragma unroll
                    for (int bj = 0; bj < 2; ++bj) { f32x4 v0 = acc[ai][bj][m][0] * YB_SCALE, v1 = acc[ai][bj][m][1] * YB_SCALE;
#pragma unroll
                        for (int t = 0; t < 4; ++t) { v0[t] = __builtin_amdgcn_fmed3f(v0[t], -448.0f, 448.0f); v1[t] = __builtin_amdgcn_fmed3f(v1[t], -448.0f, 448.0f); }
                        int w0 = 0, w1 = 0;
                        w0 = __builtin_amdgcn_cvt_pk_fp8_f32(v0[0], v0[1], w0, false); w0 = __builtin_amdgcn_cvt_pk_fp8_f32(v0[2], v0[3], w0, true);
                        w1 = __builtin_amdgcn_cvt_pk_fp8_f32(v1[0], v1[1], w1, false); w1 = __builtin_amdgcn_cvt_pk_fp8_f32(v1[2], v1[3], w1, true);
                        *(u32x2*)(rowp + bj * HALF) = (u32x2){(unsigned)w0, (unsigned)w1}; }
                }
            }
    }
};
struct EpiSwiGLU {
    __device__ __forceinline__ void operator()(const f32x4 (&acc)[2][2][4][2], const Unit& u) const {
        const int tid = opaque_tid(), wid = tid >> 6, lane = tid & 63, wr = wid >> 2, wc = wid & 3, fr = lane & 15, fq = lane >> 4;
        const int row0 = wr * 64 + fr, col0 = wc * 32 + 8 * fq;
#pragma unroll
        for (int ai = 0; ai < 2; ++ai)
#pragma unroll
            for (int m = 0; m < 4; ++m) {
                const int r = row0 + ai * HALF + m * 16;
                if (r < u.nvalid) {
                    float o[8];
#pragma unroll
                    for (int n = 0; n < 2; ++n)
#pragma unroll
                        for (int j = 0; j < 4; ++j) { const float g = acc[ai][0][m][n][j], up = acc[ai][1][m][n][j];
                            o[n * 4 + j] = g * __builtin_amdgcn_rcpf(1.0f + __builtin_amdgcn_exp2f(-1.4426950408889634f * g)) * up; }
                    u32x4 w; w.x = cvt_pk_bf16(o[0], o[1]); w.y = cvt_pk_bf16(o[2], o[3]); w.z = cvt_pk_bf16(o[4], o[5]); w.w = cvt_pk_bf16(o[6], o[7]);
                    *(u32x4*)((bf16_t*)u.C + (size_t)r * u.ldc + col0) = w;
                }
            }
    }
};
struct EpiQKVE {
    LAS float* P;
    const float* gainp;
    const f32x2* rope;
    __device__ __forceinline__ void operator()(const f32x4 (&acc)[2][2][4][2], const Unit& u) const {
        const int tid = opaque_tid(), wid = tid >> 6, lane = tid & 63, wr = wid >> 2, wc = wid & 3, fr = lane & 15, fq = lane >> 4;
        const int row0 = wr * 64 + fr, col0 = wc * 32 + 8 * fq;
        if (u.x0 >= 2) {
            const size_t bjs = (u.x0 == 2) ? (size_t)NB * KVR * 128 : (size_t)HALF;
#pragma unroll
            for (int ai = 0; ai < 2; ++ai)
#pragma unroll
                for (int m = 0; m < 4; ++m) { bf16_t* rowp = (bf16_t*)u.C + (size_t)(row0 + ai * HALF + m * 16) * u.ldc + col0;
#pragma unroll
                    for (int bj = 0; bj < 2; ++bj) { const f32x4 v0 = acc[ai][bj][m][0], v1 = acc[ai][bj][m][1];
                        u32x4 w; w.x = cvt_pk_bf16(v0[0], v0[1]); w.y = cvt_pk_bf16(v0[2], v0[3]); w.z = cvt_pk_bf16(v1[0], v1[1]); w.w = cvt_pk_bf16(v1[2], v1[3]);
                        *(u32x4*)(rowp + bj * bjs) = w; } }
            asm volatile("" ::: "memory"); __builtin_amdgcn_s_barrier(); asm volatile("" ::: "memory");
            return;
        }
#pragma unroll
        for (int ai = 0; ai < 2; ++ai)
#pragma unroll
            for (int m = 0; m < 4; ++m)
#pragma unroll
                for (int bj = 0; bj < 2; ++bj) { const f32x4 a = acc[ai][bj][m][0], b = acc[ai][bj][m][1];
                    float s = (a[0] * a[0] + a[1] * a[1]) + (a[2] * a[2] + a[3] * a[3]) + (b[0] * b[0] + b[1] * b[1]) + (b[2] * b[2] + b[3] * b[3]);
                    s += __shfl_xor(s, 16); s += __shfl_xor(s, 32);
                    if (fq == 0) P[(bj * 256 + row0 + ai * HALF + m * 16) * 4 + wc] = s; }
        asm volatile("s_waitcnt lgkmcnt(0)" ::: "memory"); __builtin_amdgcn_s_barrier(); asm volatile("" ::: "memory");
        const f32x4 g0 = *(const f32x4*)(gainp + u.x0 * 128 + col0), g1 = *(const f32x4*)(gainp + u.x0 * 128 + col0 + 4);
        const int half = wc >> 1, fi = ((wc & 1) * 4 + fq) * 4;
#pragma unroll
        for (int ai = 0; ai < 2; ++ai)
#pragma unroll
            for (int m = 0; m < 4; ++m) {
                const int r = row0 + ai * HALF + m * 16;
                int pos = 0;
                if (u.x1 >= 0) { const int t = u.x1 + r; pos = half ? (t & 63) : (t >> 6); }
                const f32x4 cs0 = *(const f32x4*)(rope + pos * 32 + fi), cs1 = *(const f32x4*)(rope + pos * 32 + fi + 2);
                const float cc[4] = {cs0[0], cs0[2], cs1[0], cs1[2]}, ss[4] = {cs0[1], cs0[3], cs1[1], cs1[3]};
                bf16_t* rowp = (bf16_t*)u.C + (size_t)r * u.ldc + col0;
#pragma unroll
                for (int bj = 0; bj < 2; ++bj) {
                    const f32x4 pp = *(const LAS f32x4*)(P + (bj * 256 + r) * 4);
                    const float rs = __builtin_amdgcn_rsqf(((pp[0] + pp[1]) + (pp[2] + pp[3])) * (1.0f / 128.0f) + RMS_EPS);
                    float o1[4], o2[4];
#pragma unroll
                    for (int j = 0; j < 4; ++j) { const float v1 = acc[ai][bj][m][0][j] * rs * g0[j], v2 = acc[ai][bj][m][1][j] * rs * g1[j];
                        o1[j] = v1 * cc[j] - v2 * ss[j]; o2[j] = v1 * ss[j] + v2 * cc[j]; }
                    u32x4 w; w.x = cvt_pk_bf16(o1[0], o1[1]); w.y = cvt_pk_bf16(o1[2], o1[3]); w.z = cvt_pk_bf16(o2[0], o2[1]); w.w = cvt_pk_bf16(o2[2], o2[3]);
                    *(u32x4*)(rowp + bj * ((u.x0 == 0) ? (size_t)HALF : (size_t)NB * KVR * 128)) = w;
                }
            }
    }
};

template <class Epi, class Sched, bool GATHER>
__device__ __forceinline__ void gemm_phase(LAS unsigned char* lds, const int K_, Sched& S, const Epi& E) {
    const int K = K_;
    const int tid = opaque_tid(), wid = __builtin_amdgcn_readfirstlane(tid >> 6), lane = tid & 63, wr = wid >> 2, wc = wid & 3, fr = lane & 15, fq = lane >> 4;
    const int nt = K / BK;
    Unit cur, nxt; int ui = 0;
    if (!S.next(0, cur)) return;
    unsigned voffB[2], offA[2][2];
#pragma unroll
    for (int i = 0; i < 2; ++i) { int R, C; stage_rc(tid * 16 + i * 8192, R, C); const int Rb = (R & ~31) + perm32(R & 31);
        voffB[i] = (unsigned)(Rb * K + C) * 2u; }
    LAS int* ridx = (LAS int*)(lds + LDS_RIDX);
    if (GATHER) {
        if (tid < 256) ridx[tid] = (tid < cur.nvalid) ? cur.rows[tid] : 0;
        __syncthreads();
#pragma unroll
        for (int h = 0; h < 2; ++h)
#pragma unroll
            for (int i = 0; i < 2; ++i) { int R, C; stage_rc(tid * 16 + i * 8192, R, C); offA[h][i] = (unsigned)ridx[h * HALF + R] * (unsigned)(K * 2) + (unsigned)C * 2u; }
    } else {
#pragma unroll
        for (int h = 0; h < 2; ++h)
#pragma unroll
            for (int i = 0; i < 2; ++i) { int R, C; stage_rc(tid * 16 + i * 8192, R, C); offA[h][i] = (unsigned)((h * HALF + R) * K + C) * 2u; }
    }
    const size_t kstep = (size_t)(BK * 2);
    const size_t hstep = (size_t)HALF * K * 2;
    const unsigned ldsw = (unsigned)wid * 1024u;
    const int aoff = lds_byte(wr * 64 + fr, fq * 8), boff = lds_byte(wc * 32 + fr, fq * 8);
#define PG8_SA(b, h) (((b) * 2 + (h)) * HTB)
#define PG8_SB(b, h) ((4 + (b) * 2 + (h)) * HTB)
#define PG8_STAGE(bufoff, gbase, voff) do { _Pragma("unroll") for (int _i = 0; _i < 2; ++_i) \
        __builtin_amdgcn_global_load_lds((const unsigned*)((const char*)(gbase) + (voff)[_i]), (LAS unsigned*)(lds + (bufoff) + ldsw + _i * 8192), 16, 0, 0); } while (0)
#define PG8_LDA(dst, b, h) do { _Pragma("unroll") for (int m = 0; m < 4; ++m) _Pragma("unroll") for (int k = 0; k < 2; ++k) dst[m][k] = *(const LAS bf16x8*)(lds + PG8_SA(b, h) + aoff + m * 2048 + k * 1024); } while (0)
#define PG8_LDB(dst, b, h) do { _Pragma("unroll") for (int n = 0; n < 2; ++n) _Pragma("unroll") for (int k = 0; k < 2; ++k) dst[n][k] = *(const LAS bf16x8*)(lds + PG8_SB(b, h) + boff + n * 2048 + k * 1024); } while (0)
#define PG8_MMA(ai, bj, At, Bt) do { __builtin_amdgcn_s_setprio(1); _Pragma("unroll") for (int m = 0; m < 4; ++m) _Pragma("unroll") for (int n = 0; n < 2; ++n) _Pragma("unroll") for (int k = 0; k < 2; ++k) \
        acc[ai][bj][m][n] = __builtin_amdgcn_mfma_f32_16x16x32_bf16(Bt[n][k], At[m][k], acc[ai][bj][m][n], 0, 0, 0); __builtin_amdgcn_s_setprio(0); } while (0)
#define PG8_WAIT_V(n) asm volatile("s_waitcnt vmcnt(" #n ")" ::: "memory")
#define PG8_WAIT_L(n) asm volatile("s_waitcnt lgkmcnt(" #n ")" ::: "memory")
#define PG8_BAR __builtin_amdgcn_s_barrier()
#define PG8_SCHED __builtin_amdgcn_sched_barrier(0)
    f32x4 acc[2][2][4][2];
#pragma unroll
    for (int a = 0; a < 2; ++a)
#pragma unroll
        for (int b = 0; b < 2; ++b)
#pragma unroll
            for (int m = 0; m < 4; ++m)
#pragma unroll
                for (int n = 0; n < 2; ++n) acc[a][b][m][n] = (f32x4){0.f, 0.f, 0.f, 0.f};
    bf16x8 At[4][2], B0[2][2], B1[2][2];
    const char* cA = cur.A; const char* cB = cur.B;
    PG8_STAGE(PG8_SB(0, 0), cB, voffB); PG8_STAGE(PG8_SA(0, 0), cA, offA[0]); PG8_STAGE(PG8_SB(0, 1), cB + hstep, voffB); PG8_STAGE(PG8_SA(0, 1), cA, offA[1]);
    if (wr == 1) PG8_BAR;
    PG8_WAIT_V(4); PG8_BAR;
    PG8_STAGE(PG8_SB(1, 0), cB + kstep, voffB); PG8_STAGE(PG8_SA(1, 0), cA + kstep, offA[0]); PG8_STAGE(PG8_SB(1, 1), cB + hstep + kstep, voffB);
    PG8_WAIT_V(6); PG8_BAR;
    for (;;) {
        const bool has_next = S.next(ui + 1, nxt);
        const char* nA = has_next ? nxt.A : cA; const char* nB = has_next ? nxt.B : cB;
        if (GATHER && has_next && wid < 4)
            __builtin_amdgcn_global_load_lds((const unsigned*)(nxt.rows + wid * 64 + lane), (LAS unsigned*)(lds + LDS_RIDX + ((ui + 1) & 1) * 1024 + wid * 256), 4, 0, 0);
        for (int t = 0; t < nt; t += 2) {
            const bool last = (t == nt - 2);
            const char* a1 = cA + (size_t)(t + 1) * kstep;
            const char* a2 = last ? nA : cA + (size_t)(t + 2) * kstep; const char* b2 = last ? nB : cB + (size_t)(t + 2) * kstep;
            const char* a3 = a2 + kstep; const char* b3 = b2 + kstep;
            PG8_LDB(B0, 0, 0); PG8_SCHED; PG8_LDA(At, 0, 0); PG8_STAGE(PG8_SA(1, 1), a1, offA[1]);
            PG8_WAIT_L(8); PG8_BAR; PG8_WAIT_L(0); PG8_MMA(0, 0, At, B0); PG8_BAR; PG8_SCHED;
            if (GATHER && last && has_next) {
                LAS int* rn = ridx + ((ui + 1) & 1) * 256;
#pragma unroll
                for (int h = 0; h < 2; ++h)
#pragma unroll
                    for (int i = 0; i < 2; ++i) { int R, C; stage_rc(tid * 16 + i * 8192, R, C); const int rr = h * HALF + R; const int tok = (rr < nxt.nvalid) ? rn[rr] : 0; offA[h][i] = (unsigned)tok * (unsigned)(K * 2) + (unsigned)C * 2u; }
            }
            PG8_LDB(B1, 0, 1); PG8_STAGE(PG8_SB(0, 0), b2, voffB);
            PG8_BAR; PG8_WAIT_L(0); PG8_MMA(0, 1, At, B1); PG8_BAR;
            PG8_LDA(At, 0, 1); PG8_STAGE(PG8_SA(0, 0), a2, offA[0]);
            PG8_BAR; PG8_WAIT_L(0); PG8_MMA(1, 0, At, B0); PG8_BAR; PG8_SCHED;
            PG8_STAGE(PG8_SB(0, 1), b2 + hstep, voffB);
            PG8_WAIT_V(6); PG8_BAR; PG8_MMA(1, 1, At, B1); PG8_BAR;
            PG8_LDB(B0, 1, 0); PG8_SCHED; PG8_LDA(At, 1, 0); PG8_STAGE(PG8_SA(0, 1), a2, offA[1]);
            PG8_WAIT_L(8); PG8_BAR; PG8_WAIT_L(0); PG8_MMA(0, 0, At, B0); PG8_BAR; PG8_SCHED;
            PG8_LDB(B1, 1, 1); PG8_STAGE(PG8_SB(1, 0), b3, voffB);
            PG8_BAR; PG8_WAIT_L(0); PG8_MMA(0, 1, At, B1); PG8_BAR;
            PG8_LDA(At, 1, 1); PG8_STAGE(PG8_SA(1, 0), a3, offA[0]);
            PG8_BAR; PG8_WAIT_L(0); PG8_MMA(1, 0, At, B0); PG8_BAR; PG8_SCHED;
            PG8_STAGE(PG8_SB(1, 1), b3 + hstep, voffB);
            PG8_WAIT_V(6); PG8_BAR; PG8_MMA(1, 1, At, B1); PG8_BAR;
        }
        { Unit eu; S.next(ui, eu); E(acc, eu); }
        if (!has_next) break;
#pragma unroll
        for (int a = 0; a < 2; ++a)
#pragma unroll
            for (int b = 0; b < 2; ++b)
#pragma unroll
                for (int m = 0; m < 4; ++m)
#pragma unroll
                    for (int n = 0; n < 2; ++n) acc[a][b][m][n] = (f32x4){0.f, 0.f, 0.f, 0.f};
        cur = nxt; cA = nA; cB = nB; ++ui;
    }
    PG8_WAIT_V(0);
    if (wr == 0) PG8_BAR;
    PG8_BAR;
#undef PG8_SA
#undef PG8_SB
#undef PG8_STAGE
#undef PG8_LDA
#undef PG8_LDB
#undef PG8_MMA
#undef PG8_WAIT_V
#undef PG8_WAIT_L
#undef PG8_BAR
#undef PG8_SCHED
}
}

namespace att {
constexpr int D = 128, NW = 8, QBLK = 32, KVBLK = 64;
constexpr float SCALE = ATT_SCALE;
constexpr float THR = 8.f;
constexpr float NEGM = -30000.f;
constexpr size_t SHM_V = KVBLK * D * 2, SHM_K = KVBLK * D * 2, SHM_ATTN = 2 * SHM_V + 2 * SHM_K + NW * 64 * 4;
constexpr int LDS_BIAS = 69632;
#define KSWZ(row, colB) ((row) * 256 + ((colB) ^ (((row) & 7) << 4)))
#define SBAR() __builtin_amdgcn_sched_barrier(0)
__device__ __forceinline__ int crow(int r, int hi) { return (r & 3) + 8 * (r >> 2) + 4 * hi; }

__device__ __forceinline__ void partialSM(f32x16& p0, f32x16& p1, float& m_reg, float& mn, float& alpha) {
  constexpr float C = SCALE * 1.4426950408889634f;
  float pmax = p0[0];
#pragma unroll
  for (int r = 1; r < 16; ++r) pmax = fmaxf(pmax, p0[r]);
#pragma unroll
  for (int r = 0; r < 16; ++r) pmax = fmaxf(pmax, p1[r]);
  { auto rr = __builtin_amdgcn_permlane32_swap(__float_as_uint(pmax), __float_as_uint(pmax), false, false);
    pmax = fmaxf(__uint_as_float(rr[0]), __uint_as_float(rr[1])); }
  if (__builtin_expect(__all(pmax - m_reg <= THR / SCALE), 1)) { mn = m_reg; alpha = 1.f; }
  else { mn = fmaxf(m_reg, pmax); alpha = __builtin_amdgcn_exp2f((m_reg - mn) * C); m_reg = mn; }
  float mnC = -mn * C;
#pragma unroll
  for (int r = 0; r < 16; ++r) p0[r] = fmaf(p0[r], C, mnC);
#pragma unroll
  for (int r = 0; r < 16; ++r) p1[r] = fmaf(p1[r], C, mnC);
#pragma unroll
  for (int r = 0; r < 16; ++r) p0[r] = __builtin_amdgcn_exp2f(p0[r]);
}
__device__ __forceinline__ void finishSM(f32x16& p0, f32x16& p1, float alpha, float& l_reg, bf16x8& pa0, bf16x8& pa1, bf16x8& pa2, bf16x8& pa3) {
#pragma unroll
  for (int r = 0; r < 16; ++r) p1[r] = __builtin_amdgcn_exp2f(p1[r]);
  float ps = 0;
#pragma unroll
  for (int r = 0; r < 16; ++r) ps += p0[r];
#pragma unroll
  for (int r = 0; r < 16; ++r) ps += p1[r];
  { auto rr = __builtin_amdgcn_permlane32_swap(__float_as_uint(ps), __float_as_uint(ps), false, false);
    ps = __uint_as_float(rr[0]) + __uint_as_float(rr[1]); }
  l_reg = l_reg * alpha + ps;
#define PK4(P, BASE, OUT) do { unsigned a0 = cvt_pk_bf16(P[BASE + 0], P[BASE + 1]), a1 = cvt_pk_bf16(P[BASE + 2], P[BASE + 3]);   \
    unsigned b0 = cvt_pk_bf16(P[BASE + 4], P[BASE + 5]), b1 = cvt_pk_bf16(P[BASE + 6], P[BASE + 7]);                              \
    auto r0 = __builtin_amdgcn_permlane32_swap(a0, b0, false, false); auto r1 = __builtin_amdgcn_permlane32_swap(a1, b1, false, false); \
    u32x4 w = {r0[0], r1[0], r0[1], r1[1]}; OUT = *reinterpret_cast<bf16x8*>(&w); } while (0)
  PK4(p0, 0, pa0); PK4(p0, 8, pa1); PK4(p1, 0, pa2); PK4(p1, 8, pa3);
#undef PK4
}
__device__ __forceinline__ void qkt(f32x16& p0, f32x16& p1, const char* Ks, const bf16x8* qr, int r32, int hi) {
  p0 = f32x16{}; p1 = f32x16{};
#pragma unroll
  for (int d0 = 0; d0 < 8; ++d0) { int cb = (d0 * 16 + hi * 8) * 2;
    bf16x8 b0 = *reinterpret_cast<const bf16x8*>(Ks + KSWZ(r32, cb));
    bf16x8 b1 = *reinterpret_cast<const bf16x8*>(Ks + KSWZ(32 + r32, cb));
    p0 = __builtin_amdgcn_mfma_f32_32x32x16_bf16(b0, qr[d0], p0, 0, 0, 0);
    p1 = __builtin_amdgcn_mfma_f32_32x32x16_bf16(b1, qr[d0], p1, 0, 0, 0); }
}
__device__ __forceinline__ int v_st(int k, int c) { const int kk = (k & ~0xC) | ((k & 4) << 1) | ((k & 8) >> 1); return ((kk >> 3) * 4 + (c >> 5)) * 512 + ((kk & 7) * 32 + (c & 31)) * 2; }
__device__ __forceinline__ int v_rd_base(int lane) { return ((lane & 3) << 3) | (((lane >> 2) & 3) << 6) | (((lane >> 4) & 1) << 5) | (((lane >> 5) & 1) << 8); }
constexpr int v_rd_off(int d0, int ks, int half) { return d0 * 512 + ks * 4096 + half * 2048; }
template <int OFF> __device__ __forceinline__ s16x4 tr_read(int vb) {
  s16x4 r; asm volatile("ds_read_b64_tr_b16 %0, %1 offset:%2" : "=&v"(r) : "v"(vb), "i"(OFF) : "memory"); return r;
}
template <int D0> __device__ __forceinline__ void pv_one(f32x16& od, int vb, bf16x8 pa0, bf16x8 pa1, bf16x8 pa2, bf16x8 pa3) {
  const s16x4 l0 = tr_read<v_rd_off(D0, 0, 0)>(vb), h0 = tr_read<v_rd_off(D0, 0, 1)>(vb), l1 = tr_read<v_rd_off(D0, 1, 0)>(vb), h1 = tr_read<v_rd_off(D0, 1, 1)>(vb);
  const s16x4 l2 = tr_read<v_rd_off(D0, 2, 0)>(vb), h2 = tr_read<v_rd_off(D0, 2, 1)>(vb), l3 = tr_read<v_rd_off(D0, 3, 0)>(vb), h3 = tr_read<v_rd_off(D0, 3, 1)>(vb);
  asm volatile("s_waitcnt lgkmcnt(0)" ::: "memory"); SBAR();
#define PK(L, H) (bf16x8){L[0], L[1], L[2], L[3], H[0], H[1], H[2], H[3]}
  od = __builtin_amdgcn_mfma_f32_32x32x16_bf16(pa0, PK(l0, h0), od, 0, 0, 0);
  od = __builtin_amdgcn_mfma_f32_32x32x16_bf16(pa1, PK(l1, h1), od, 0, 0, 0);
  od = __builtin_amdgcn_mfma_f32_32x32x16_bf16(pa2, PK(l2, h2), od, 0, 0, 0);
  od = __builtin_amdgcn_mfma_f32_32x32x16_bf16(pa3, PK(l3, h3), od, 0, 0, 0);
#undef PK
}
__device__ __forceinline__ void pv_d0(f32x16* o, int vb, bf16x8 pa0, bf16x8 pa1, bf16x8 pa2, bf16x8 pa3) {
  pv_one<0>(o[0], vb, pa0, pa1, pa2, pa3); pv_one<1>(o[1], vb, pa0, pa1, pa2, pa3); pv_one<2>(o[2], vb, pa0, pa1, pa2, pa3); pv_one<3>(o[3], vb, pa0, pa1, pa2, pa3);
}

template <bool NA, int ldq, int ldk, int ldo>
__device__ __forceinline__ void attn_body(const bf16_t* __restrict__ Qb, const bf16_t* __restrict__ Kh, const bf16_t* __restrict__ Vh,
                                          bf16_t* __restrict__ Ob, const int NT, const int nloc, const int bs, const int q0r, char* lds) {
  const int tid = opaque_tid(), wid = tid >> 6, lane = tid & 63, r32 = lane & 31, hi = lane >> 5;
  char* V_lds = lds; char* K_lds = lds + 2 * SHM_V;
  float* ws = (float*)(lds + 2 * SHM_V + 2 * SHM_K) + wid * 64; float* li_l = ws; float* al_l = ws + 32;
  float m_reg = -1e30f, l_reg = 0; f32x16 o[4] = {}; bf16x8 qr[8];
  const bf16_t* Qw = Qb + (wid * QBLK + r32) * ldq + hi * 8;
#pragma unroll
  for (int d0 = 0; d0 < 8; ++d0) qr[d0] = *reinterpret_cast<const bf16x8*>(Qw + d0 * 16);
  const int sr = tid >> 4, sc = (tid & 15) * 8, vst0 = v_st(sr, sc), vst1 = v_st(32 + sr, sc);
  const int vb0 = (int)(uintptr_t)V_lds + v_rd_base(lane);
  const unsigned kvo = (unsigned)(sr * ldk + sc) * 2u;
  const float* btab = (const float*)(lds + LDS_BIAS) + 64;
  constexpr int SD = NA ? 1 : 2;
  struct { bf16x8 vs0, vs1, ks0, ks1; } sr_[SD];
#define KOFF(j) (NA ? ((j) < nloc ? (bs + (j)) * 64 : LSEQ + ((j) - nloc) * 64) : (j) * 64)
#define SLOAD(i, k0) do { const unsigned _ko = (unsigned)((k0) * ldk * 2) + kvo; sr_[i].vs0 = *reinterpret_cast<const bf16x8*>((const char*)Vh + _ko); sr_[i].vs1 = *reinterpret_cast<const bf16x8*>((const char*)Vh + (_ko + 64u * ldk)); \
    sr_[i].ks0 = *reinterpret_cast<const bf16x8*>((const char*)Kh + _ko); sr_[i].ks1 = *reinterpret_cast<const bf16x8*>((const char*)Kh + (_ko + 64u * ldk)); } while (0)
#define SWRITE(b, i) do { int sr_w = sr, sc_w = sc, v0_w = vst0, v1_w = vst1; \
    if (NA) { const int t_ = opaque_tid(); sr_w = t_ >> 4; sc_w = (t_ & 15) * 8; v0_w = v_st(sr_w, sc_w); v1_w = v_st(32 + sr_w, sc_w); }     \
    *(bf16x8*)(V_lds + (b) * SHM_V + v0_w) = sr_[i].vs0;          \
    *(bf16x8*)(V_lds + (b) * SHM_V + v1_w) = sr_[i].vs1; int kc = sc_w * 2;               \
    *(bf16x8*)(K_lds + (b) * SHM_K + KSWZ(sr_w, kc)) = sr_[i].ks0;                       \
    *(bf16x8*)(K_lds + (b) * SHM_K + KSWZ(32 + sr_w, kc)) = sr_[i].ks1; } while (0)
#define SWAIT() do { if (SD == 2) asm volatile("s_waitcnt vmcnt(4)" ::: "memory"); else asm volatile("s_waitcnt vmcnt(0)" ::: "memory"); } while (0)
#define RESC(a) do { if (__any((a) < 1.f)) { if (hi == 0) al_l[r32] = (a); asm volatile("s_waitcnt lgkmcnt(0)" ::: "memory"); \
    _Pragma("unroll") for (int d = 0; d < 4; ++d) _Pragma("unroll") for (int r = 0; r < 16; ++r) o[d][r] *= al_l[crow(r, hi)]; } } while (0)
#define ACT(j) (!NA || (j) >= nloc || ((bs + (j)) >= min(max(q0r + __builtin_amdgcn_readfirstlane(opaque_tid() >> 7) - 4, 0), 56) && (bs + (j)) < min(max(q0r + __builtin_amdgcn_readfirstlane(opaque_tid() >> 7) - 4, 0), 56) + 8))
#define NAMASK(P0, P1, j) do { if (NA && (j) < nloc) { const int kr = bs + (j); const int t_ = opaque_tid(); \
    const int qrow = q0r + __builtin_amdgcn_readfirstlane(t_ >> 7), qcol = ((t_ >> 6) & 1) * 32 + (t_ & 31), hi_ = (t_ >> 5) & 1; \
    const int cstart = min(max(qcol - 8, 0), 48); \
    const float* bp = btab + (kr - qrow + 7) * 31 + (4 * hi_ - qcol + 15); const int cs = cstart - 4 * hi_; \
    _Pragma("unroll") for (int r = 0; r < 16; ++r) { const int kc = (r & 3) + 8 * (r >> 2); \
        P0[r] = ((unsigned)(kc - cs) < 16u) ? P0[r] + bp[kc] : NEGM; P1[r] = ((unsigned)(kc + 32 - cs) < 16u) ? P1[r] + bp[kc + 32] : NEGM; } } } while (0)
  f32x16 pA0, pA1, pB0, pB1; float mnA, mnB, alA = 1.f, alB = 1.f; bf16x8 pa0, pa1, pa2, pa3;
  bool actA, actB;
  constexpr int SE = 0, SO = SD - 1;
  SLOAD(SE, KOFF(0)); asm volatile("s_waitcnt vmcnt(0)" ::: "memory"); SWRITE(0, SE); __syncthreads();
  actA = ACT(0);
  if (actA) { qkt(pA0, pA1, K_lds, qr, r32, hi); NAMASK(pA0, pA1, 0); partialSM(pA0, pA1, m_reg, mnA, alA); } else alA = 1.f;
  SLOAD(SO, KOFF(1)); if (SD == 2 && 2 < NT) SLOAD(SE, KOFF(2));
  SWAIT(); SWRITE(1, SO); __syncthreads();
  for (int j = 1; j + 1 < NT; j += 2) {
    SBAR(); actB = ACT(j); if (actB) { qkt(pB0, pB1, K_lds + SHM_K, qr, r32, hi); NAMASK(pB0, pB1, j); }
    if (actA) finishSM(pA0, pA1, alA, l_reg, pa0, pa1, pa2, pa3); SBAR();
    SLOAD(SO, KOFF(j + SD)); SBAR();
    if (actA) pv_d0(o, vb0, pa0, pa1, pa2, pa3); if (actB) partialSM(pB0, pB1, m_reg, mnB, alB); else alB = 1.f;
    __syncthreads(); SWAIT(); SWRITE(0, SE);
    RESC(alB); __syncthreads();
    SBAR(); actA = ACT(j + 1); if (actA) { qkt(pA0, pA1, K_lds, qr, r32, hi); NAMASK(pA0, pA1, j + 1); }
    if (actB) finishSM(pB0, pB1, alB, l_reg, pa0, pa1, pa2, pa3); SBAR();
    if (SD == 1 || j + 3 < NT) SLOAD(SE, KOFF(j + 1 + SD)); SBAR();
    if (actB) pv_d0(o, vb0 + (int)SHM_V, pa0, pa1, pa2, pa3); if (actA) partialSM(pA0, pA1, m_reg, mnA, alA); else alA = 1.f;
    __syncthreads(); SWAIT(); SWRITE(1, SO);
    RESC(alA); __syncthreads();
  }
  SBAR(); actB = ACT(NT - 1); if (actB) { qkt(pB0, pB1, K_lds + SHM_K, qr, r32, hi); NAMASK(pB0, pB1, NT - 1); }
  if (actA) finishSM(pA0, pA1, alA, l_reg, pa0, pa1, pa2, pa3); SBAR();
  if (actA) pv_d0(o, vb0, pa0, pa1, pa2, pa3); if (actB) partialSM(pB0, pB1, m_reg, mnB, alB); else alB = 1.f;
  __syncthreads(); RESC(alB);
  if (actB) { finishSM(pB0, pB1, alB, l_reg, pa0, pa1, pa2, pa3); SBAR();
    pv_d0(o, vb0 + (int)SHM_V, pa0, pa1, pa2, pa3); }
  if (hi == 0) li_l[r32] = l_reg; asm volatile("s_waitcnt lgkmcnt(0)" ::: "memory");
  float rli[16];
#pragma unroll
  for (int r = 0; r < 16; ++r) rli[r] = __builtin_amdgcn_rcpf(li_l[crow(r, hi)]);
  bf16_t* Ow = Ob + (wid * QBLK) * ldo + r32;
#pragma unroll
  for (int r = 0; r < 16; ++r) { const int orow = crow(r, hi);
#pragma unroll
    for (int d0 = 0; d0 < 4; ++d0) { const unsigned pk = cvt_pk_bf16(o[d0][r] * rli[r], 0.f); Ow[orow * ldo + d0 * 32] = (bf16_t)(pk & 0xffffu); } }
  __syncthreads();
#undef ACT
#undef KOFF
#undef SLOAD
#undef SWRITE
#undef SWAIT
#undef RESC
#undef NAMASK
}
#undef KSWZ
#undef SBAR
}

#define XB_TMO      128
#define XB_XCNT(j)  (256  + 64 * (j))
#define XB_XSUB(j)  (1280 + 64 * (j))
#define XB_XGEN(j)  (2304 + 64 * (j))
#define XB_TOP      3328
#define XB_TOPGEN   3392
#define XCD_BAR_WORDS 3456
#define XB_SPIN_CAP (1u << 22)
__device__ __forceinline__ unsigned xb_ld(unsigned* p)              { return __hip_atomic_load(p, __ATOMIC_RELAXED, __HIP_MEMORY_SCOPE_AGENT); }
__device__ __forceinline__ unsigned xb_add(unsigned* p, unsigned v) { return __hip_atomic_fetch_add(p, v, __ATOMIC_RELAXED, __HIP_MEMORY_SCOPE_AGENT); }
__device__ __forceinline__ unsigned xb_xcc_id() { return (unsigned)__builtin_amdgcn_s_getreg((3 << 11) | 20) & 0xFu; }
#define XB_SPIN(cond, bar) do { unsigned _sp = 0; while (cond) { __builtin_amdgcn_s_sleep(1); \
    if ((++_sp & 255u) == 0u) { if (xb_ld(&(bar)[XB_TMO])) break; if (_sp > XB_SPIN_CAP) { atomicAdd(&(bar)[XB_TMO], 1u); break; } } } } while (0)
struct XcdBarrier { unsigned* bar; unsigned x; volatile LAS unsigned* st; };
__device__ __forceinline__ XcdBarrier xcd_barrier_post(unsigned* bar, volatile LAS unsigned* st) {
    XcdBarrier b; b.bar = bar; b.x = xb_xcc_id(); b.st = st;
    if (threadIdx.x == 0) (void)xb_add(&bar[XB_XCNT(b.x)], 1u);
    return b;
}
__device__ __forceinline__ void xcd_barrier_complete(unsigned* bar, unsigned x, unsigned& nloc, unsigned& nx) {
    const unsigned G = gridDim.x * gridDim.y * gridDim.z;
    unsigned sum, cnt, mine, sp = 0u;
    for (;;) {
        sum = 0u; cnt = 0u; mine = 0u;
#pragma unroll
        for (unsigned j = 0; j < 16; ++j) { const unsigned c = xb_ld(&bar[XB_XCNT(j)]); sum += c; cnt += (c > 0u) ? 1u : 0u; mine = (j == x) ? c : mine; }
        if (sum == G) break;
        __builtin_amdgcn_s_sleep(1);
        if ((++sp & 255u) == 0u) { if (xb_ld(&bar[XB_TMO])) break; if (sp > XB_SPIN_CAP) { atomicAdd(&bar[XB_TMO], 1u); break; } }
    }
    nloc = mine > 0u ? mine : 1u; nx = cnt > 0u ? cnt : 1u;
}
__device__ __forceinline__ void xcd_barrier(const XcdBarrier& b) {
    asm volatile("s_waitcnt vmcnt(0)" ::: "memory");
    __syncthreads();
    if (threadIdx.x == 0) {
        unsigned* bar = b.bar;
        __builtin_amdgcn_s_waitcnt(0);
        unsigned nloc = b.st[0], nx = b.st[1];
        if (nloc == 0u) { xcd_barrier_complete(bar, b.x, nloc, nx); b.st[0] = nloc; b.st[1] = nx; }
        const unsigned old = xb_add(&bar[XB_XSUB(b.x)], 1u);
        const unsigned gen = old / nloc;
        if (old + 1u == (gen + 1u) * nloc) {
            __builtin_amdgcn_fence(__ATOMIC_RELEASE, "agent");
            asm volatile("s_waitcnt vmcnt(0)" ::: "memory");
            const unsigned og = xb_add(&bar[XB_TOP], 1u);
            const unsigned tg = og / nx;
            if (og + 1u == (tg + 1u) * nx) xb_add(&bar[XB_TOPGEN], 1u);
            else XB_SPIN(xb_ld(&bar[XB_TOPGEN]) == tg, bar);
            __builtin_amdgcn_fence(__ATOMIC_ACQUIRE, "agent");
            xb_add(&bar[XB_XGEN(b.x)], 1u);
            asm volatile("s_waitcnt vmcnt(0)" ::: "memory");
        } else {
            XB_SPIN(xb_ld(&bar[XB_XGEN(b.x)]) == gen, bar);
            __builtin_amdgcn_fence(__ATOMIC_ACQUIRE, "agent");
            asm volatile("s_waitcnt vmcnt(0)" ::: "memory");
        }
    }
    __syncthreads();
}

enum { I_X = 0, I_C, I_CTX, I_CCTX, I_WMOD, I_BMOD, I_LN1G, I_LN1B, I_LN2G, I_LN2B, I_ABWIN, I_ABWF, I_ABQN, I_ABKN, I_ABWOUT, I_NAWIN, I_NARPB, I_NAWOUT,
       I_WR, I_EBIAS, I_WG, I_WU, I_WDN, I_SG, I_SU, I_SD, N_IN };
struct Args { const float* in[N_IN]; float* out; unsigned char* ws; int ph_lo, ph_hi; };
struct KA {
    __device__ __forceinline__ const __attribute__((address_space(4))) char* base() const { const __attribute__((address_space(4))) char* p = (const __attribute__((address_space(4))) char*)__builtin_amdgcn_kernarg_segment_ptr(); asm volatile("" : "+s"(p)); return p; }
    __device__ __forceinline__ const float* in(int i) const { return *(const float* const __attribute__((address_space(4)))*)(base() + 8 * i); }
    __device__ __forceinline__ float* out() const { return *(float* const __attribute__((address_space(4)))*)(base() + 8 * N_IN); }
    __device__ __forceinline__ int ph_lo() const { return *(const int __attribute__((address_space(4)))*)(base() + 8 * N_IN + 16); }
    __device__ __forceinline__ int ph_hi() const { return *(const int __attribute__((address_space(4)))*)(base() + 8 * N_IN + 20); }
    __device__ __forceinline__ unsigned char* ws() const { return *(unsigned char* const __attribute__((address_space(4)))*)(base() + 8 * N_IN + 8); }
};

__device__ __forceinline__ int tok_batchrow(int m) { return m < TLAT ? (m >> 12) : 4; }

__host__ __device__ __forceinline__ int rope_phys(int d) { const int hf = d >> 6, dd = d & 63, i = dd & 31, second = dd >> 5; return hf * 64 + (i >> 2) * 8 + second * 4 + (i & 3); }

constexpr int CV_GU = 65 * 2 * 16, CV_DN = 65 * 16, CV_OUT = 64;
__host__ __device__ constexpr int cv_in(int l) { return (l & 1) ? 192 : 80; }
__host__ __device__ constexpr int cv_items(int l) { return CV_GU + CV_DN + cv_in(l) + CV_OUT; }
struct CvItem { const float* src; bf16_t* dst; int ldw, K, k0, n0, kind, which; };
__device__ __forceinline__ int cv_row(const CvItem& d, int n) {
    if (d.kind == 1) return (n >> 7) * 256 + d.which * 128 + (n & 127);
    if (d.kind == 2) { const int c = n - 256; return c < 1024 ? (c & ~127) + rope_phys(c & 127) : c; }
    return n;
}
__device__ __forceinline__ CvItem cv_decode(const KA& a, int l, int it) {
    CvItem d; unsigned char* ws = a.ws(); const int j = l >> 1; int r = it; d.which = 0;
    if (r < CV_GU) { const int mat = r >> 4, kb = r & 15, which = mat & 1, e = mat >> 1;
        d.src = (e < 64) ? a.in(which ? I_WU : I_WG) + ((size_t)(l * 64 + e) * DM * EDIM) : a.in(which ? I_SU : I_SG) + (size_t)l * DM * EDIM;
        d.dst = (bf16_t*)(ws + WS_WGU) + (size_t)(l * 65 + e) * 512 * DM; d.ldw = EDIM; d.K = DM; d.k0 = 64 * kb; d.n0 = 0; d.kind = 1; d.which = which; return d; }
    r -= CV_GU;
    if (r < CV_DN) { const int e = r >> 4, item = r & 15;
        d.src = (e < 64) ? a.in(I_WDN) + ((size_t)(l * 64 + e) * EDIM * DM) : a.in(I_SD) + (size_t)l * EDIM * DM;
        d.dst = (bf16_t*)(ws + WS_WD) + (size_t)(l * 65 + e) * DM * EDIM; d.ldw = DM; d.K = EDIM; d.k0 = 64 * (item >> 2); d.n0 = 256 * (item & 3); d.kind = 0; return d; }
    r -= CV_DN;
    if (r < cv_in(l)) {
        if ((l & 1) == 0) { d.src = a.in(I_ABWIN) + (size_t)j * DM * 1536; d.dst = (bf16_t*)(ws + WS_WINE) + (size_t)j * 1280 * DM; d.ldw = 1536; d.K = DM; d.k0 = 64 * (r / 5); d.n0 = 256 + 256 * (r % 5); d.kind = 2; }
        else { d.src = a.in(I_NAWIN) + (size_t)j * DM * 3072; d.dst = (bf16_t*)(ws + WS_WINO) + (size_t)j * 3072 * DM; d.ldw = 3072; d.K = DM; d.k0 = 64 * (r / 12); d.n0 = 256 * (r % 12); d.kind = 0; }
        return d; }
    r -= cv_in(l);
    d.src = ((l & 1) ? a.in(I_NAWOUT) : a.in(I_ABWOUT)) + (size_t)j * DM * DM; d.dst = (bf16_t*)(ws + WS_WOUT) + (size_t)l * DM * DM; d.ldw = DM; d.K = DM; d.k0 = 64 * (r >> 2); d.n0 = 256 * (r & 3); d.kind = 0;
    return d;
}
constexpr int CV_LS = 260;
__device__ __forceinline__ void cv_load(const CvItem& d, f32x4 (&v)[8], int t) {
    const float* p = d.src + (size_t)(d.k0 + (t >> 6)) * d.ldw + d.n0 + (t & 63) * 4;
#pragma unroll
    for (int i = 0; i < 8; ++i) v[i] = *(const f32x4*)(p + (size_t)(8 * i) * d.ldw);
}
__device__ __forceinline__ void convert_items(LAS unsigned char* lds, int l, int lo, int hi, int worker, int nworkers) {
    const KA a;
    const int t = opaque_tid();
    LAS float* img = (LAS float*)lds;
    int it = lo + worker;
    if (it >= hi) return;
    CvItem d0 = cv_decode(a, l, it); f32x4 v[8]; cv_load(d0, v, t);
    for (;;) {
        { LAS float* w = img + (t >> 6) * CV_LS + (t & 63) * 4;
#pragma unroll
          for (int i = 0; i < 8; ++i) *(LAS f32x4*)(w + i * 8 * CV_LS) = v[i]; }
        __syncthreads();
        const int itn = it + nworkers; const bool more = itn < hi;
        CvItem d1 = d0;
        if (more) { d1 = cv_decode(a, l, itn); cv_load(d1, v, t); }
        { const int n = (t >> 6) * 32 + (t & 31), qh = (t >> 5) & 1; bf16_t* orow = d0.dst + (size_t)cv_row(d0, d0.n0 + n) * d0.K + d0.k0;
#pragma unroll
          for (int p = 0; p < 4; ++p) { const int q = 2 * p + qh; const LAS float* s = img + (8 * q) * CV_LS + n;
              u32x4 o; o.x = cvt_pk_bf16(s[0 * CV_LS], s[1 * CV_LS]); o.y = cvt_pk_bf16(s[2 * CV_LS], s[3 * CV_LS]); o.z = cvt_pk_bf16(s[4 * CV_LS], s[5 * CV_LS]); o.w = cvt_pk_bf16(s[6 * CV_LS], s[7 * CV_LS]);
              *(u32x4*)(orow + 8 * q) = o; } }
        __syncthreads();
        if (!more) break;
        d0 = d1; it = itn;
    }
}
struct CvSlice { int l, i0, i1, l2, j0, j1; };
constexpr int CV_EX = CV_GU + CV_DN;
#ifndef CV_MODE
#define CV_MODE 1
#endif
__device__ __forceinline__ CvSlice cv_slice(int l, int phase  ) {
    const CvSlice none = {0, 0, 0, 0, 0, 0};
    if (CV_MODE == 0) return none;
    if (l == 0) { if (phase == 1) return {0, 0, 2000, 0, 0, 0}; if (phase == 2) return {0, 2000, 3000, 0, 0, 0};
                  if (phase == 4) return {1, CV_EX, cv_items(1), 1, 0, 744}; if (phase == 5) return {1, 744, 1144, 0, 0, 0}; }
    if (l == 1) { if (phase == 0) return {1, 1144, 2120, 0, 0, 0}; if (phase == 2) return {1, 2120, CV_EX, 0, 0, 0};
                  if (phase == 4) return {2, CV_EX, cv_items(2), 2, 0, 856}; if (phase == 5) return {2, 856, 1256, 0, 0, 0}; }
    if (l == 2) { if (phase == 1) return {2, 1256, CV_EX, 0, 0, 0}; if (phase == 2) return {3, CV_EX, cv_items(3), 3, 0, 744};
                  if (phase == 4) return {3, 744, 1744, 0, 0, 0}; if (phase == 5) return {3, 1744, 2144, 0, 0, 0}; }
    if (l == 3) { if (phase == 0) return {3, 2144, 3044, 0, 0, 0}; if (phase == 2) return {3, 3044, CV_EX, 0, 0, 0}; }
    return none;
}
__device__ __forceinline__ void cv_tail(LAS unsigned char* lds, int l, int phase, int n_units, int bid, int G) {
    const CvSlice c = cv_slice(l, phase);
    if (c.i1 <= c.i0 && c.j1 <= c.j0) return;
    const int rem = n_units % G, nw = (rem == 0) ? G : G - rem, w = (rem == 0) ? bid : bid - rem;
    if (w < 0) return;
    __syncthreads();
    if (c.i1 > c.i0) convert_items(lds, c.l, c.i0, c.i1, w, nw);
    if (c.j1 > c.j0) convert_items(lds, c.l2, c.j0, c.j1, w, nw);
}

__device__ __forceinline__ void p0_mod(const KA& a, LAS unsigned char* lds, int bid, int G, int tid, int wave, int lane) {
    LAS float* sl = (LAS float*)(lds + 69632);
    LAS float* part = (LAS float*)(lds + 69632 + 20480);
    for (int i = tid; i < 5 * DM; i += 512) { const int r = i >> 10, k = i & 1023; const float v = (r < 4) ? a.in(I_C)[r * DM + k] : a.in(I_CCTX)[k]; sl[i] = v / (1.0f + __expf(-v)); }
    __syncthreads();
    float* mod = (float*)(a.ws() + WS_MOD);
    for (int task = bid; task < DEPTH * 48; task += G) {
        const int l = task / 48, c0 = (task % 48) * 128;
        const float* w = a.in(I_WMOD) + (size_t)l * DM * 6144 + c0 + 2 * lane;
        f32x2 acc[5];
#pragma unroll
        for (int r = 0; r < 5; ++r) acc[r] = (f32x2){0.f, 0.f};
#pragma unroll 16
        for (int k = wave * 128; k < wave * 128 + 128; ++k) { const f32x2 wv = *(const f32x2*)(w + (size_t)k * 6144);
#pragma unroll
            for (int r = 0; r < 5; ++r) acc[r] += wv * sl[r * DM + k]; }
#pragma unroll
        for (int r = 0; r < 5; ++r) *(LAS f32x2*)(part + (wave * 5 + r) * 128 + 2 * lane) = acc[r];
        __syncthreads();
        for (int i = tid; i < 640; i += 512) { const int r = i >> 7, c = i & 127; float s = a.in(I_BMOD)[l * 6144 + c0 + c];
#pragma unroll
            for (int w8 = 0; w8 < 8; ++w8) s += part[(w8 * 5 + r) * 128 + c];
            mod[((size_t)l * 5 + r) * 6144 + c0 + c] = s; }
        __syncthreads();
    }
}

__device__ __forceinline__ void p0_fourier_fold(const KA& a, LAS unsigned char* lds, int task, int tid, int wave, int lane) {
    const int kq = task & 3, g = (task >> 2) & 3, q = (task >> 4) & 1, j = task >> 5;
    LAS float* M = (LAS float*)(lds + 100352);
    LAS float* trg = M + 4096;
    const float* Wf = a.in(I_ABWF) + (size_t)(j * 4 + g) * 64 * 64;
    LAS float* Wl = trg + 64;
    __syncthreads();
    if (tid < 64) { const float ang = (float)tid * (1.0f / 32.0f); trg[tid] = q ? sinpif(ang) : cospif(ang); }
    for (int i = tid; i < 1024; i += 512) *(LAS f32x4*)(Wl + 4 * i) = *(const f32x4*)(Wf + 4 * i);
    __syncthreads();
    for (int i = tid; i < 4096; i += 512) { const int c = i >> 6, d = i & 63; float s = 0.f;
#pragma unroll 8
        for (int m = 0; m < 64; ++m) s += trg[(m * c) & 63] * Wl[m * 64 + d];
        M[i] = s; }
    __syncthreads();
    float mcol[64];
#pragma unroll
    for (int c = 0; c < 64; ++c) mcol[c] = M[c * 64 + lane];
    bf16_t* dst = (bf16_t*)(a.ws() + WS_WF) + ((size_t)j * 512 + q * 256 + g * 64 + lane) * DM;
    const float* win = a.in(I_ABWIN) + (size_t)j * DM * 1536 + g * 64 + lane;
    const int kbeg = kq * 256 + wave * 32;
    float wv[32];
#pragma unroll
    for (int i = 0; i < 32; ++i) wv[i] = win[(size_t)(kbeg + i) * 1536];
#pragma unroll
    for (int i = 0; i < 32; ++i) { float s = 0.f;
#pragma unroll
        for (int c = 0; c < 64; ++c) s += __int_as_float(__builtin_amdgcn_readlane(__float_as_int(wv[i]), c)) * mcol[c];
        dst[kbeg + i] = (bf16_t)(cvt_pk_bf16(s, 0.f) & 0xffffu); }
}


__device__ __forceinline__ void p0_tables(const KA& a, LAS unsigned char* lds, int gtid, int NGT, int tid) {
    LAS float* ctab = (LAS float*)(lds + 116736);
    for (int i = tid; i < 4096; i += 512) ctab[i] = cospif((float)i * (1.0f / 2048.0f));
    __syncthreads();
    bf16_t* TW = (bf16_t*)(a.ws() + WS_TW);
    for (int it = gtid; it < 4096 * 1024; it += NGT) {
        const int k = it >> 10, c8 = (it & 1023) * 8, n0 = c8 & 4095, sh = (c8 >> 12) ? 1024 : 0; const float sg = (c8 >> 12) ? (-1.0f / 512.0f) : (1.0f / 512.0f);
        float v[8];
#pragma unroll
        for (int j = 0; j < 8; ++j) v[j] = ctab[(k * (n0 + j) - sh) & 4095] * sg;
        u32x4 o; o.x = cvt_pk_bf16(v[0], v[1]); o.y = cvt_pk_bf16(v[2], v[3]); o.z = cvt_pk_bf16(v[4], v[5]); o.w = cvt_pk_bf16(v[6], v[7]);
        *(u32x4*)(TW + (size_t)k * 8192 + c8) = o;
    }
    bf16_t* TWC = (bf16_t*)(a.ws() + WS_TWC);
    for (int it = gtid; it < 256 * 64; it += NGT) {
        const int k = it >> 6, c8 = (it & 63) * 8, n0 = c8 & 255, sh = (c8 >> 8) ? 1024 : 0; const float sg = (c8 >> 8) ? (-1.0f / 128.0f) : (1.0f / 128.0f);
        float v[8];
#pragma unroll
        for (int j = 0; j < 8; ++j) v[j] = ctab[(((k * (n0 + j)) & 255) * 16 - sh) & 4095] * sg;
        u32x4 o; o.x = cvt_pk_bf16(v[0], v[1]); o.y = cvt_pk_bf16(v[2], v[3]); o.z = cvt_pk_bf16(v[4], v[5]); o.w = cvt_pk_bf16(v[6], v[7]);
        *(u32x4*)(TWC + (size_t)k * 512 + c8) = o;
    }
    bf16_t* WH = (bf16_t*)(a.ws() + WS_WRHI); bf16_t* WL = (bf16_t*)(a.ws() + WS_WRLO);
    for (int it = gtid; it < DEPTH * 64 * DM; it += NGT) {
        const int i = it & 7, ln = (it >> 3) & 63, ks = (it >> 9) & 31, nt4 = (it >> 14) & 3, l = it >> 16, e = nt4 * 16 + (ln & 15), k = ks * 32 + (ln >> 4) * 8 + i;
        const float w = a.in(I_WR)[((size_t)l * DM + k) * 64 + e];
        const unsigned h = cvt_pk_bf16(w, 0.f) & 0xffffu; const float r = w - __uint_as_float(h << 16);
        WH[it] = (bf16_t)h; WL[it] = (bf16_t)(cvt_pk_bf16(r, 0.f) & 0xffffu);
    }
    float* gp = (float*)(a.ws() + WS_GAINP);
    for (int it = gtid; it < 2 * 2 * 128; it += NGT) { const int j = it >> 8, qk = (it >> 7) & 1, d = it & 127; gp[(j * 2 + qk) * 128 + rope_phys(d)] = a.in(qk ? I_ABKN : I_ABQN)[j * 128 + d]; }
    f32x2* rp = (f32x2*)(a.ws() + WS_ROPE);
    for (int it = gtid; it < 64 * 32; it += NGT) { const int pos = it >> 5, i = it & 31; const float inv = exp2f(-(float)i * (13.287712379549449f / 32.0f));
        const float ang = (float)pos * inv; rp[it] = (f32x2){cosf(ang), sinf(ang)}; }
}

__device__ __forceinline__ const float* xrow_in(const KA& a, int l, int m) {
    if (l == 0) return m < TLAT ? a.in(I_X) + (size_t)m * DM : a.in(I_CTX) + (size_t)(m - TLAT) * DM;
    return (const float*)(a.ws() + WS_XS) + (size_t)m * DM;
}
__device__ __forceinline__ void p0b_modulate(const KA& a, int gw, int NGW, int lane) {
    const float* mod = (const float*)(a.ws() + WS_MOD);
    bf16_t* H = (bf16_t*)(a.ws() + WS_H);
    for (int m = gw; m < TT; m += NGW) {
        const f32x4* xr = (const f32x4*)xrow_in(a, 0, m) + lane; const float* md = mod + (size_t)tok_batchrow(m) * 6144;
        u32x2* o = (u32x2*)(H + (size_t)m * DM) + lane;
#pragma unroll
        for (int j = 0; j < 4; ++j) { const f32x4 x = xr[64 * j], sh = *((const f32x4*)md + lane + 64 * j), sc = *((const f32x4*)(md + DM) + lane + 64 * j);
            const f32x4 h = x * (sc + 1.0f) + sh; o[64 * j] = (u32x2){cvt_pk_bf16(h[0], h[1]), cvt_pk_bf16(h[2], h[3])}; }
    }
}

#ifndef D_DELAY
#define D_DELAY 0
#endif
#ifndef PROBE_D
#define PROBE_D 7
#endif
__device__ __forceinline__ void phase_ln1_router(const KA& a, LAS unsigned char* lds, int l, int bid, int tid, int wave, int lane, const bool dry) {
    LAS float* lg = (LAS float*)lds;
    LAS int* hist = (LAS int*)(lds + 96 * 64 * 4);
    LAS int* pend = hist + 128;
    const float* mod = (const float*)(a.ws() + WS_MOD) + (size_t)l * 5 * 6144;
    const bf16_t* Y = (const bf16_t*)(a.ws() + WS_Y);
    float* XS = (float*)(a.ws() + (dry ? WS_ACT : WS_XS)); bf16_t* H = (bf16_t*)(a.ws() + (dry ? WS_YB + ((size_t)200 << 20) : WS_H)); bf16_t* HL = (bf16_t*)(a.ws() + (dry ? WS_YB + ((size_t)240 << 20) : WS_HL));
    if (tid < 64) hist[tid] = 0;
    const int NTOK = (l == DEPTH - 1) ? 64 : 68;
    const int tok0 = bid * NTOK;
    if (!dry || (PROBE_D & 1)) {
        f32x4 lng[4], lnb[4], g1[4], sc2[4], sh2[4];
        { const f32x4* pg = (const f32x4*)(a.in(I_LN1G) + l * DM) + lane; const f32x4* pb = (const f32x4*)(a.in(I_LN1B) + l * DM) + lane;
#pragma unroll
          for (int j = 0; j < 4; ++j) { lng[j] = pg[64 * j]; lnb[j] = pb[64 * j]; } }
        int cur_br = -1;
        f32x4 xn[4]; u32x2 yn[4];
        { const int m = tok0 + wave; const f32x4* xr = (const f32x4*)xrow_in(a, l, m) + lane; const u32x2* yr = (const u32x2*)(Y + (size_t)m * DM) + lane;
#pragma unroll
          for (int j = 0; j < 4; ++j) { xn[j] = xr[64 * j]; yn[j] = yr[64 * j]; } }
        for (int r = wave; r < NTOK; r += 8) {
            const int m = tok0 + r, br = tok_batchrow(m);
            if (br != cur_br) { cur_br = br; const float* md = mod + (size_t)br * 6144;
#pragma unroll
                for (int j = 0; j < 4; ++j) { g1[j] = *((const f32x4*)(md + 2 * DM) + lane + 64 * j); sh2[j] = *((const f32x4*)(md + 3 * DM) + lane + 64 * j); sc2[j] = *((const f32x4*)(md + 4 * DM) + lane + 64 * j) + 1.0f; } }
            f32x4 v[4]; float s = 0.f;
#pragma unroll
            for (int j = 0; j < 4; ++j) { const f32x4 y = {bf_lo(yn[j].x), bf_hi(yn[j].x), bf_lo(yn[j].y), bf_hi(yn[j].y)}; v[j] = xn[j] * DN_ALPHA + g1[j] * y; s += (v[j][0] + v[j][1]) + (v[j][2] + v[j][3]); }
            if (r + 8 < NTOK) { const int mn = m + 8; const f32x4* xr = (const f32x4*)xrow_in(a, l, mn) + lane; const u32x2* yr = (const u32x2*)(Y + (size_t)mn * DM) + lane;
#pragma unroll
                for (int j = 0; j < 4; ++j) { xn[j] = xr[64 * j]; yn[j] = yr[64 * j]; } }
            const float mean = wave_sum(s) * (1.0f / DM); float s2 = 0.f;
#pragma unroll
            for (int j = 0; j < 4; ++j) { v[j] = v[j] - mean; s2 += (v[j][0] * v[j][0] + v[j][1] * v[j][1]) + (v[j][2] * v[j][2] + v[j][3] * v[j][3]); }
            const float rstd = __builtin_amdgcn_rsqf(wave_sum(s2) * (1.0f / DM) + LN_EPS);
            f32x4* xo = (f32x4*)(XS + (size_t)m * DM) + lane; u32x2* ho = (u32x2*)(H + (size_t)m * DM) + lane; u32x2* hl = (u32x2*)(HL + (size_t)m * DM) + lane;
#pragma unroll
            for (int j = 0; j < 4; ++j) { const f32x4 x1 = v[j] * rstd * lng[j] + lnb[j]; xo[64 * j] = x1;
                const f32x4 h = x1 * sc2[j] + sh2[j];
                const unsigned h01 = cvt_pk_bf16(h[0], h[1]), h23 = cvt_pk_bf16(h[2], h[3]);
                ho[64 * j] = (u32x2){h01, h23};
                hl[64 * j] = (u32x2){cvt_pk_bf16(h[0] - bf_lo(h01), h[1] - bf_hi(h01)), cvt_pk_bf16(h[2] - bf_lo(h23), h[3] - bf_hi(h23))}; }
        }
    }
    VM_WAIT(); __syncthreads();
    if (D_DELAY) { const unsigned long long t0d = __builtin_amdgcn_s_memrealtime(); while (__builtin_amdgcn_s_memrealtime() - t0d < (unsigned long long)D_DELAY) __builtin_amdgcn_s_sleep(16); }
    TS(4);
    __builtin_amdgcn_fence(__ATOMIC_ACQUIRE, "agent"); VM_WAIT();
    if (!dry || (PROBE_D & 2)) {
        const bf16_t* WH = (const bf16_t*)(a.ws() + WS_WRHI) + (size_t)l * 64 * DM; const bf16_t* WL = (const bf16_t*)(a.ws() + WS_WRLO) + (size_t)l * 64 * DM;
        const int ntile = wave & 3, mt0 = wave >> 2, fr = lane & 15, fq = lane >> 4;
        constexpr int AQ = 264;
        LAS bf16_t* Ahi = (LAS bf16_t*)(lds + 32768); LAS bf16_t* Alo = Ahi + 80 * AQ;
        f32x4 acc[3];
#pragma unroll
        for (int i = 0; i < 3; ++i) acc[i] = (f32x4){0.f, 0.f, 0.f, 0.f};
#pragma unroll 1
        for (int kq = 0; kq < 4; ++kq) {
            bf16x8 bh[8], bl[8];
#pragma unroll
            for (int q = 0; q < 8; ++q) { const size_t fo = (((size_t)ntile * 32 + kq * 8 + q) * 64 + lane) * 8; bh[q] = *(const bf16x8*)(WH + fo); bl[q] = *(const bf16x8*)(WL + fo); }
            __syncthreads();
            for (int p = tid; p < NTOK * 32; p += 512) { const int row = p >> 5, c = p & 31; const size_t g = (size_t)(tok0 + row) * DM + kq * 256 + c * 8;
                *(LAS bf16x8*)(Ahi + row * AQ + c * 8) = *(const bf16x8*)(H + g); *(LAS bf16x8*)(Alo + row * AQ + c * 8) = *(const bf16x8*)(HL + g); }
            __syncthreads();
#pragma unroll
            for (int q = 0; q < 8; ++q)
#pragma unroll
                for (int i = 0; i < 3; ++i) if (i < 2 || mt0 == 0) {
                    const bf16x8 ahv = *(const LAS bf16x8*)(Ahi + ((mt0 + 2 * i) * 16 + fr) * AQ + q * 32 + fq * 8), alv = *(const LAS bf16x8*)(Alo + ((mt0 + 2 * i) * 16 + fr) * AQ + q * 32 + fq * 8);
                    acc[i] = __builtin_amdgcn_mfma_f32_16x16x32_bf16(ahv, bh[q], acc[i], 0, 0, 0);
                    acc[i] = __builtin_amdgcn_mfma_f32_16x16x32_bf16(ahv, bl[q], acc[i], 0, 0, 0);
                    acc[i] = __builtin_amdgcn_mfma_f32_16x16x32_bf16(alv, bh[q], acc[i], 0, 0, 0); }
        }
#pragma unroll
        for (int i = 0; i < 3; ++i) if (i < 2 || mt0 == 0)
#pragma unroll
            for (int q = 0; q < 4; ++q) lg[((mt0 + 2 * i) * 16 + fq * 4 + q) * 64 + ntile * 16 + fr] = acc[i][q];
    }
    __syncthreads(); TS(5);
    if (!dry || (PROBE_D & 4)) {
        int* tke = (int*)(a.ws() + WS_TKE); float* tkw = (float*)(a.ws() + WS_TKW);
        const float ebias = a.in(I_EBIAS)[l * 64 + lane];
        for (int r = wave; r < NTOK; r += 8) {
            const int m = tok0 + r;
            const float score = 1.0f / (1.0f + __expf(-lg[r * 64 + lane]));
            const float sel = score + ebias; int rank = 0;
#pragma unroll
            for (int c = 0; c < 64; ++c) { const float o = __int_as_float(__builtin_amdgcn_readlane(__float_as_int(sel), c)); rank += (o > sel || (o == sel && c < lane)) ? 1 : 0; }
            const bool mine = rank < TOPK;
            const unsigned long long taken = __ballot(mine);
            const float wsum = wave_sum(mine ? score : 0.f);
            if (mine) { const int k = __popcll(taken & ((1ull << lane) - 1ull)); const int lr = __hip_atomic_fetch_add(&hist[lane], 1, __ATOMIC_RELAXED, __HIP_MEMORY_SCOPE_WORKGROUP);
                if (!dry) { tke[m * 8 + k] = lane; tkw[m * 8 + k] = score / wsum * ROUTE_SCALE; } pend[r * 8 + k] = (lane << 16) | lr; }
        }
    }
    __syncthreads();
    if (dry) return;
    { unsigned* cnt = (unsigned*)(a.ws() + WS_CTL) + CW_CNT + l * 64;
      if (tid < 64) hist[64 + tid] = (int)atomicAdd(&cnt[tid], (unsigned)hist[tid]); }
    __syncthreads();
    { int* tkp = (int*)(a.ws() + WS_TKP); int* list = (int*)(a.ws() + WS_LIST);
      for (int i = tid; i < NTOK * 8; i += 512) { const int pe = pend[i], e = pe >> 16, p = hist[64 + e] + (pe & 0xffff); const int m = tok0 + (i >> 3);
        tkp[m * 8 + (i & 7)] = p; list[(size_t)e * TT + p] = m; } }
    __syncthreads();
}

constexpr float YB_SCALE_G = 32.0f;
__device__ __forceinline__ void phase_combine_ln2(const KA& a, LAS unsigned char* lds, int l, int gw, int NGW, int tid, int lane, const bool dry) {
    LAS int* rst = (LAS int*)(lds + LDS_TAB) + 66;
    const float* mod = (const float*)(a.ws() + WS_MOD) + (size_t)l * 5 * 6144;
    const unsigned char* YB = (const unsigned char*)(a.ws() + WS_YB);
    const float* XSi = (const float*)(a.ws() + WS_XS); float* XS = (float*)(a.ws() + (dry ? WS_ACT : WS_XS)); bf16_t* H = (bf16_t*)(a.ws() + (dry ? WS_HL : WS_H));
    const int* tke = (const int*)(a.ws() + WS_TKE); const float* tkw = (const float*)(a.ws() + WS_TKW); const int* tkp = (const int*)(a.ws() + WS_TKP);
    const int mend = (l == DEPTH - 1) ? TLAT : TT;
    const int e0 = 16 * lane;
    f32x4 lng[4], lnb[4];
    { const f32x4* pg = (const f32x4*)(a.in(I_LN2G) + l * DM + e0); const f32x4* pb = (const f32x4*)(a.in(I_LN2B) + l * DM + e0);
#pragma unroll
      for (int j = 0; j < 4; ++j) { lng[j] = pg[j]; lnb[j] = pb[j]; } }
    float* outp = dry ? (float*)(a.ws() + WS_ACT) : a.out();
#define G_SLOTS(M0, SLOT, W) do { _Pragma("unroll") for (int q = 0; q < 2; ++q) { const int mq = (q == 0 || (M0) + NGW < mend) ? (M0) + q * NGW : (M0); SLOT[q] = 0; W[q] = 1.0f / YB_SCALE_G; \
        if ((M0) < mend) { if (lane < 8) { SLOT[q] = rst[tke[mq * 8 + lane]] + tkp[mq * 8 + lane]; W[q] = tkw[mq * 8 + lane] * (1.0f / YB_SCALE_G); } if (lane == 8) SLOT[q] = rst[64] + mq; } } } while (0)
    int slotn[2]; float wn[2];
    G_SLOTS(gw, slotn, wn);
    for (int m0 = gw; m0 < mend; m0 += 2 * NGW) {
        int mm[2]; mm[0] = m0; mm[1] = (m0 + NGW < mend) ? m0 + NGW : m0;
        const bool two = (m0 + NGW < mend);
        int slot[2]; float w[2];
        slot[0] = slotn[0]; slot[1] = slotn[1]; w[0] = wn[0]; w[1] = wn[1];
        G_SLOTS(m0 + 2 * NGW, slotn, wn);
        f32x4 ff[2][4]; f32x4 xv[2][4];
#pragma unroll
        for (int q = 0; q < 2; ++q) { const f32x4* xi = (const f32x4*)(XSi + (size_t)mm[q] * DM + e0);
#pragma unroll
            for (int j = 0; j < 4; ++j) { ff[q][j] = (f32x4){0.f, 0.f, 0.f, 0.f}; xv[q][j] = xi[j]; } }
        u32x4 yy[2][9];
#pragma unroll
        for (int k = 0; k < 9; ++k)
#pragma unroll
            for (int q = 0; q < 2; ++q) { const int sk = __builtin_amdgcn_readlane(slot[q], k); yy[q][k] = *(const u32x4*)(YB + (size_t)sk * DM + e0); }
#pragma unroll
        for (int k = 0; k < 9; ++k)
#pragma unroll
            for (int q = 0; q < 2; ++q) { const float wk = __int_as_float(__builtin_amdgcn_readlane(__float_as_int(w[q]), k));
#pragma unroll
                for (int j = 0; j < 4; ++j) { const f32x2 lo2 = __builtin_amdgcn_cvt_pk_f32_fp8((int)yy[q][k][j], false), hi2 = __builtin_amdgcn_cvt_pk_f32_fp8((int)yy[q][k][j], true);
                    ff[q][j] += (f32x4){lo2.x, lo2.y, hi2.x, hi2.y} * wk; } }
#pragma unroll
        for (int q = 0; q < 2; ++q) {
            if (q == 1 && !two) break;
            const int m = mm[q]; const float* md = mod + (size_t)tok_batchrow(m) * 6144;
            f32x4 v[4]; float s = 0.f;
#pragma unroll
            for (int j = 0; j < 4; ++j) { const f32x4 g2 = *((const f32x4*)(md + 5 * DM + e0) + j);
                v[j] = xv[q][j] * DN_ALPHA + g2 * ff[q][j]; s += (v[j][0] + v[j][1]) + (v[j][2] + v[j][3]); }
            const float mean = wave_sum(s) * (1.0f / DM); float s2 = 0.f;
#pragma unroll
            for (int j = 0; j < 4; ++j) { v[j] = v[j] - mean; s2 += (v[j][0] * v[j][0] + v[j][1] * v[j][1]) + (v[j][2] * v[j][2] + v[j][3] * v[j][3]); }
            const float rstd = __builtin_amdgcn_rsqf(wave_sum(s2) * (1.0f / DM) + LN_EPS);
            if (l == DEPTH - 1) {
                f32x4* oo = (f32x4*)(outp + (size_t)m * DM + e0);
#pragma unroll
                for (int j = 0; j < 4; ++j) oo[j] = v[j] * rstd * lng[j] + lnb[j];
            } else {
                const float* mdn = md + 5 * 6144;
                f32x4* xio = (f32x4*)(XS + (size_t)m * DM + e0); u32x4* ho = (u32x4*)(H + (size_t)m * DM + e0);
                unsigned hp[8];
#pragma unroll
                for (int j = 0; j < 4; ++j) { const f32x4 x2 = v[j] * rstd * lng[j] + lnb[j]; xio[j] = x2;
                    const f32x4 sh = *((const f32x4*)(mdn + e0) + j), sc = *((const f32x4*)(mdn + DM + e0) + j);
                    const f32x4 h = x2 * (sc + 1.0f) + sh; hp[2 * j] = cvt_pk_bf16(h[0], h[1]); hp[2 * j + 1] = cvt_pk_bf16(h[2], h[3]); }
                ho[0] = (u32x4){hp[0], hp[1], hp[2], hp[3]}; ho[1] = (u32x4){hp[4], hp[5], hp[6], hp[7]};
            }
        }
    }
#undef G_SLOTS
}

__device__ __forceinline__ void build_expert_tables(const KA& a, LAS unsigned char* lds, int l, int tid) {
    LAS int* tst = (LAS int*)(lds + LDS_TAB); LAS int* rst = tst + 66; LAS int* cn = rst + 66;
    __syncthreads();
    if (tid < 64) {
        const unsigned* cnt = (const unsigned*)(a.ws() + WS_CTL) + CW_CNT + l * 64;
        const int c = (int)__hip_atomic_load(cnt + tid, __ATOMIC_RELAXED, __HIP_MEMORY_SCOPE_AGENT);
        int t = (c + 255) >> 8, r = c;
#pragma unroll
        for (int o = 1; o < 64; o <<= 1) { const int t2 = __shfl_up(t, o), r2 = __shfl_up(r, o); if (tid >= o) { t += t2; r += r2; } }
        tst[tid] = t - ((c + 255) >> 8); rst[tid] = r - c; cn[tid] = c;
        const int nsh = (l == DEPTH - 1) ? TLAT : TT;
        if (tid == 63) { tst[64] = t; rst[64] = r; cn[64] = nsh; tst[65] = t + (nsh >> 8); rst[65] = r + nsh; }
    }
    __syncthreads();
}

struct Seg {
    int i0, c, G, first, n;
    __device__ __forceinline__ void init(int first_, int n_, int c_, int G_) { first = first_; n = n_; c = c_; G = G_; i0 = (first_ <= c_) ? 0 : (first_ - c_ + G_ - 1) / G_; }
    __device__ __forceinline__ int idx(int i) const { const int L = (i0 + i) * G + c - first; return L < n ? L : -1; }
};
__device__ __forceinline__ int kv_row0(int pm) { return pm < 64 ? (pm >> 4) * KVR + (pm & 15) * 256 : (pm - 64) * KVR + LSEQ; }

struct SchedQKVE { Seg s; unsigned char* ws; int j;
    __device__ __forceinline__ bool next(int i, pg8::Unit& u) { const int L0 = s.idx(i); if (L0 < 0) return false;
        size_t offA, offB, offC; int ldc, x0, x1 = 0;
        if (L0 >= 340) { const int L = L0 - 340; x0 = 3;
            if (L < 128) { const int q = L >> 6, mt = L & 63, b = mt >> 4;
                offA = WS_WF + ((size_t)j * 512 + q * 256) * 2048; offB = WS_H + (size_t)mt * 256 * 2048; offC = WS_ZT + ((size_t)b * 256 * 8192 + q * 4096 + (mt & 15) * 256) * 2; ldc = 8192; }
            else { const int q = (L - 128) >> 2, b = (L - 128) & 3;
                offA = WS_WF + ((size_t)j * 512 + q * 256) * 2048; offB = WS_H + (size_t)(TLAT + b * 256) * 2048; offC = WS_ZCT + ((size_t)b * 256 * 512 + q * 256) * 2; ldc = 512; }
        } else { const int pm = L0 % 68, pn = L0 / 68;
            offA = WS_H + (size_t)pm * 256 * 2048; offB = WS_WINE + ((size_t)j * 1280 + pn * 256) * 2048; x1 = pm < 64 ? (pm & 15) * 256 : -1;
            if (pn < 3) { offC = WS_QB + ((size_t)pm * 256 * 768 + pn * 256) * 2; ldc = 768; x0 = 0; }
            else { offC = (pn == 3 ? WS_KB : WS_VB) + (size_t)kv_row0(pm) * 128 * 2; ldc = 128; x0 = pn - 2; } }
        u.A = (const char*)(ws + offA); u.B = (const char*)(ws + offB); u.C = (char*)(ws + offC); u.ldc = ldc; u.x0 = x0; u.x1 = x1; u.rows = nullptr; u.nvalid = 256;
        return true; } };
struct SchedQKVO { Seg s; unsigned char* ws; int j;
    __device__ __forceinline__ bool next(int i, pg8::Unit& u) { const int L = s.idx(i); if (L < 0) return false; const int pm = L % 68, pn = L / 68;
        u.A = (const char*)(ws + WS_H) + (size_t)pm * 256 * 2048; u.B = (const char*)(ws + WS_WINO) + ((size_t)j * 3072 + pn * 256) * 2048; u.rows = nullptr; u.nvalid = 256; u.x0 = 0; u.x1 = 0; u.ldc = 1024;
        if (pn < 4) u.C = (char*)(ws + WS_QB) + ((size_t)pm * 256 * 1024 + pn * 256) * 2;
        else u.C = (char*)(ws + (pn < 8 ? WS_KB : WS_VB)) + ((size_t)kv_row0(pm) * 1024 + (pn & 3) * 256) * 2;
        return true; } };
struct SchedDFT { Seg s; unsigned char* ws;
    __device__ __forceinline__ bool next(int i, pg8::Unit& u) { const int L = s.idx(i); if (L < 0) return false; const int pm = L & 15, b = L >> 4;
        u.A = (const char*)(ws + WS_TW) + (size_t)pm * 256 * 16384; u.B = (const char*)(ws + WS_ZT) + (size_t)b * 256 * 16384;
        u.C = (char*)(ws + WS_O) + (size_t)(b * LSEQ + pm * 256) * 1024 * 2; u.ldc = 1024; u.rows = nullptr; u.nvalid = 256; u.x0 = 0; u.x1 = 0; return true; } };
struct SchedDFTC { Seg s; unsigned char* ws;
    __device__ __forceinline__ bool next(int i, pg8::Unit& u) { const int b = s.idx(i); if (b < 0) return false;
        u.A = (const char*)(ws + WS_TWC); u.B = (const char*)(ws + WS_ZCT) + (size_t)b * 256 * 1024;
        u.C = (char*)(ws + WS_O) + (size_t)(TLAT + b * 256) * 1024 * 2; u.ldc = 1024; u.rows = nullptr; u.nvalid = 256; u.x0 = 0; u.x1 = 0; return true; } };
struct SchedOUT { Seg s; unsigned char* ws; int l, nm;
    __device__ __forceinline__ bool next(int i, pg8::Unit& u) { const int L = s.idx(i); if (L < 0) return false; const int pm = L % nm, pn = L / nm;
        u.A = (const char*)(ws + WS_O) + (size_t)pm * 256 * 2048; u.B = (const char*)(ws + WS_WOUT) + ((size_t)l * 1024 + pn * 256) * 2048;
        u.C = (char*)(ws + WS_Y) + ((size_t)pm * 256 * 1024 + pn * 256) * 2; u.ldc = 1024; u.rows = nullptr; u.nvalid = 256; u.x0 = 0; u.x1 = 0; return true; } };
struct SchedGU { Seg s; unsigned char* ws; int l; const LAS int* tab; int e; int L0, cnt; int probe;
    __device__ __forceinline__ bool next(int i, pg8::Unit& u) { const int L = cnt > 0 ? (i < cnt ? L0 + i : -1) : s.idx(i); if (L < 0) return false; const int mtg = L >> 1, nt = L & 1;
        while (tab[e + 1] <= mtg) ++e;
        while (tab[e] > mtg) --e;
        const int mt = mtg - tab[e], r0 = tab[66 + e] + mt * 256;
        u.A = (const char*)(ws + WS_H); u.rows = (const int*)(ws + WS_LIST) + (size_t)e * TT + mt * 256; u.nvalid = min(256, tab[132 + e] - mt * 256);
        u.B = (const char*)(ws + WS_WGU) + ((size_t)(l * 65 + e) * 512 + nt * 256) * 2048;
        u.C = (char*)(ws + WS_ACT) + ((size_t)r0 * 256 + nt * 128) * 2; u.ldc = 256; u.x0 = 0; u.x1 = 0;
        if (probe & 1) u.rows = (const int*)(ws + WS_LIST) + (size_t)64 * TT + (mtg & 63) * 256;
        if (probe & 2) u.nvalid = 0;
        return true; } };
struct SchedDN { Seg s; unsigned char* ws; int l; const LAS int* tab; int e; int probe; int L0, cnt;
    __device__ __forceinline__ bool next(int i, pg8::Unit& u) { const int L = cnt > 0 ? (i < cnt ? L0 + i : -1) : s.idx(i); if (L < 0) return false; const int mtg = L >> 2, nt = L & 3;
        while (tab[e + 1] <= mtg) ++e;
        while (tab[e] > mtg) --e;
        const int mt = mtg - tab[e], r0 = tab[66 + e] + mt * 256;
        u.A = (const char*)(ws + WS_ACT) + (size_t)r0 * 512; u.rows = nullptr; u.nvalid = min(256, tab[132 + e] - mt * 256);
        u.B = (const char*)(ws + WS_WD) + ((size_t)(l * 65 + e) * 1024 + nt * 256) * 512;
        u.C = (char*)(ws + WS_YB) + ((size_t)r0 * 1024 + nt * 256); u.ldc = 1024; u.x0 = 0; u.x1 = 0;
        if (probe & 1) u.nvalid = 0;
        if (probe & 2) { u.A = (const char*)(ws + WS_ACT); u.B = (const char*)(ws + WS_WD) + (size_t)(l * 65) * 1024 * 512; }
        return true; } };

constexpr int NPHASE = 2 + 7 * DEPTH;
#ifndef PHMASK
#define PHMASK 0xFFFFF
#endif
#define SITE(b) if constexpr ((PHMASK >> (b)) & 1)
#ifndef REP_A
#define REP_A 1
#endif
#ifndef REP_B
#define REP_B 1
#endif
#ifndef REP_BO
#define REP_BO 1
#endif
#ifndef REP_C
#define REP_C 1
#endif
#ifndef REP_E
#define REP_E 1
#endif
#ifndef REP_F
#define REP_F 1
#endif
#ifndef REP_D
#define REP_D 1
#endif
#ifndef REP_G
#define REP_G 1
#endif
#ifndef REP_BAR
#define REP_BAR 1
#endif
#ifndef PROBE_TS_SCALE
#define PROBE_TS_SCALE 0.0002f
#endif
#ifndef PROBE_TS_A
#define PROBE_TS_A 0
#endif
#ifndef PROBE_TS_B
#define PROBE_TS_B 1
#endif
#ifndef EF_FUSED
#define EF_FUSED 0
#endif
#ifndef E_STAGGER
#define E_STAGGER 0
#endif
#ifndef PROBE_E
#define PROBE_E 0
#endif
#ifndef PROBE_F
#define PROBE_F 0
#endif
#ifndef REP_P0
#define REP_P0 1
#endif
__global__ void __launch_bounds__(512, 2) fwd(Args args_) {
    extern __shared__ __attribute__((aligned(16))) unsigned char lds_raw[];
    LAS unsigned char* lds = (LAS unsigned char*)lds_raw;
    const int G = gridDim.x, bid = ((G & 7) == 0) ? (int)(blockIdx.x & 7) * (G >> 3) + (int)(blockIdx.x >> 3) : (int)blockIdx.x;
#define tid (opaque_tid())
#define lane (opaque_tid() & 63)
#define wave (__builtin_amdgcn_readfirstlane(opaque_tid() >> 6))
    const KA a;
#define WSP (a.ws())
#define args a
    volatile LAS unsigned* MISC = (volatile LAS unsigned*)(lds + LDS_MISC);
    { const int t0 = threadIdx.x; if (t0 < 64) MISC[t0] = 0u; }
    __syncthreads();
    if (PROBE_TS && threadIdx.x == 0) *(volatile LAS unsigned long long*)(lds + LDS_MISC + 192) = __builtin_amdgcn_s_memrealtime();
#define lo (a.ph_lo())
#define hi (a.ph_hi())
    XcdBarrier bar; bar.bar = (unsigned*)(WSP + WS_CTL) + CW_BAR; bar.x = 0; bar.st = MISC + 8;
    if (hi - lo > 1) bar = xcd_barrier_post((unsigned*)(WSP + WS_CTL) + CW_BAR, MISC + 8);
#define IN(k) (lo <= (k) && (k) < hi)
#define SEAM(k) do { if (IN(k) && IN((k) + 1)) for (int rb = 0; rb < REP_BAR; ++rb) xcd_barrier(bar); TS(((k) < 2) ? 16 : 17 + ((k) - 2) % 7); } while (0)
    const int NGW = G * 8;
#define gw (bid * 8 + wave)

    if (IN(0)) SITE(0) for (int rep = 0; rep < REP_P0; ++rep) {
        __syncthreads();
        p0_mod(args, lds, bid, G, tid, wave, lane);
        if (bid >= G - 64) p0_fourier_fold(args, lds, G - 1 - bid, tid, wave, lane);
        p0_tables(args, lds, bid * 512 + tid, G * 512, tid);
        { int* ident = (int*)(WSP + WS_LIST) + (size_t)NEXP * TT; for (int i = bid * 512 + tid; i < TT; i += G * 512) ident[i] = i; }
        __syncthreads();
        if (CV_MODE == 0) convert_items(lds, 0, 0, cv_items(0), bid, G);
        else { convert_items(lds, 0, CV_EX, cv_items(0), bid, G); convert_items(lds, 0, 3000, CV_EX, bid, G); }
        if (CV_MODE == 0) { for (int lq = 1; lq < DEPTH; ++lq) convert_items(lds, lq, 0, cv_items(lq), bid, G); }
    }
    TS(0); SEAM(0);
    if (IN(1)) SITE(0) p0b_modulate(args, gw, NGW, lane);
    TS(0); SEAM(1);

    for (int l = 0; l < DEPTH; ++l) {
        const int pb = 2 + 7 * l, j = l >> 1;
        if (IN(pb + 0)) for (int rep = 0; rep < REP_A; ++rep) {
            if ((l & 1) == 0) {
                SITE(1) { SchedQKVE S; S.s.init(0, 476, bid, G); S.ws = WSP; S.j = j;
                  pg8::EpiQKVE E; E.P = (LAS float*)(lds + LDS_EPI); E.gainp = (const float*)(WSP + WS_GAINP) + j * 256; E.rope = (const f32x2*)(WSP + WS_ROPE);
                  pg8::gemm_phase<pg8::EpiQKVE, SchedQKVE, false>(lds, 1024, S, E); }
            } else SITE(3) {
                SchedQKVO S; S.s.init(0, 816, bid, G); S.ws = WSP; S.j = j; pg8::EpiStore E;
                pg8::gemm_phase<pg8::EpiStore, SchedQKVO, false>(lds, 1024, S, E);
                if (rep == 0) cv_tail(lds, l, 0, 816, bid, G);
            }
        }
        TS(1); SEAM(pb + 0);
        if (IN(pb + 1)) for (int rep = 0; rep < ((l & 1) ? REP_BO : REP_B); ++rep) {
            __syncthreads();
            const bf16_t* QB = (const bf16_t*)(WSP + WS_QB); const bf16_t* KB = (const bf16_t*)(WSP + WS_KB); const bf16_t* VB = (const bf16_t*)(WSP + WS_VB); bf16_t* O = (bf16_t*)(WSP + WS_O);
            if ((l & 1) == 0) {
                SITE(4) { SchedDFT S; S.s.init(0, 64, bid, G); S.ws = WSP; pg8::EpiStore E; pg8::gemm_phase<pg8::EpiStore, SchedDFT, false>(lds, 8192, S, E); }
                SITE(5) { SchedDFTC S; S.s.init(28, 4, bid, G); S.ws = WSP; pg8::EpiStore E; pg8::gemm_phase<pg8::EpiStore, SchedDFTC, false>(lds, 512, S, E); }
                __syncthreads();
                if (bid < 64 && rep == 0) { const CvSlice c = cv_slice(l, 1); if (c.i1 > c.i0) { __syncthreads(); convert_items(lds, c.l, c.i0, c.i1, bid, 64); __syncthreads(); } }
                SITE(6) {
                    int u = (bid < 24) ? bid : (bid >= 64 ? bid - 40 : 408);
                    while (u < 408) {
                        const bf16_t *q, *k, *v; bf16_t* o; int ntile;
                        if (u < 24) { const int b = u / 6, h = u % 6; q = QB + (TLAT + b * 256) * 768 + h * 128; k = KB + ((h / 3) * NB * KVR + b * KVR + LSEQ) * 128; v = VB + ((h / 3) * NB * KVR + b * KVR + LSEQ) * 128;
                            o = O + (TLAT + b * 256) * 1024 + 256 + h * 128; ntile = 4; u = 408; }
                        else { const int uu = u - 24, bk = uu / 48, x = uu % 48, b = bk >> 1, kvh = bk & 1, h = kvh * 3 + x / 16, qb = x & 15;
                            q = QB + (b * LSEQ + qb * 256) * 768 + h * 128; k = KB + (kvh * NB * KVR + b * KVR) * 128; v = VB + (kvh * NB * KVR + b * KVR) * 128;
                            o = O + (b * LSEQ + qb * 256) * 1024 + 256 + h * 128; ntile = 68; u += 192; }
                        att::attn_body<false, 768, 128, 1024>(q, k, v, o, ntile, 0, 0, 0, (char*)lds_raw);
                    }
                }
            } else {
                const float* rpb = a.in(I_NARPB) + (size_t)j * 8 * 465;
                LAS float* bt = (LAS float*)(lds + att::LDS_BIAS);
                SITE(7) for (int u = bid; u < ((l == DEPTH - 1) ? 512 : 544); u += G) {
                    const bf16_t *q, *k, *v; bf16_t* o; int ntile, nloc, bs, q0r, h;
                    if (u < 512) { const int bh = u >> 4, blk = u & 15, b = bh >> 3; h = bh & 7; bs = min(max(4 * blk - 4, 0), 52); q0r = 4 * blk; ntile = 16; nloc = 12;
                        q = QB + (b * LSEQ + blk * 256) * 1024 + h * 128; k = KB + b * KVR * 1024 + h * 128; v = VB + b * KVR * 1024 + h * 128; o = O + (b * LSEQ + blk * 256) * 1024 + h * 128; }
                    else { const int b = (u - 512) >> 3; h = u & 7; bs = 0; q0r = 0; ntile = 4; nloc = 0;
                        q = QB + (TLAT + b * 256) * 1024 + h * 128; k = KB + b * KVR * 1024 + h * 128; v = VB + b * KVR * 1024 + h * 128; o = O + (TLAT + b * 256) * 1024 + h * 128; }
                    for (int i = tid; i < 465; i += 512) bt[64 + i] = rpb[h * 465 + i] * (1.0f / ATT_SCALE);
                    att::attn_body<true, 1024, 1024, 1024>(q, k, v, o, ntile, nloc, bs, q0r, (char*)lds_raw);
                }
            }
        }
        TS(2); SEAM(pb + 1);
        if (IN(pb + 2)) SITE(9) for (int rep = 0; rep < REP_C; ++rep) { const int nm = (l == DEPTH - 1) ? 64 : 68;
            SchedOUT S; S.s.init(0, nm * 4, bid, G); S.ws = WSP; S.l = l; S.nm = nm; pg8::EpiStore E; pg8::gemm_phase<pg8::EpiStore, SchedOUT, false>(lds, 1024, S, E);
            if (rep == 0) cv_tail(lds, l, 2, nm * 4, bid, G); }
        TS(3); SEAM(pb + 2);
        if (IN(pb + 3)) SITE(10) for (int rep = 0; rep < REP_D; ++rep) { __syncthreads(); phase_ln1_router(args, lds, l, bid, tid, wave, lane, rep + 1 < REP_D); }
        TS(6); SEAM(pb + 3);
#if EF_FUSED
        if (IN(pb + 4)) SITE(11) for (int rep = 0; rep < REP_E; ++rep) { build_expert_tables(args, lds, l, tid);
            const LAS int* tab = (const LAS int*)(lds + LDS_TAB);
            const int nsu = tab[65]; int ecur = 0;
            for (int su = bid; su < nsu; su += G) {
                { SchedGU S; S.s.init(0, 0, bid, G); S.ws = WSP; S.l = l; S.tab = tab; S.e = ecur; S.L0 = su * 2; S.cnt = 2; S.probe = 0; pg8::EpiSwiGLU E;
                  pg8::gemm_phase<pg8::EpiSwiGLU, SchedGU, true>(lds, 1024, S, E); ecur = S.e; }
                VM_WAIT(); __syncthreads();
                __builtin_amdgcn_fence(__ATOMIC_ACQUIRE, "agent"); VM_WAIT();
                { SchedDN S; S.s.init(0, 0, bid, G); S.ws = WSP; S.l = l; S.tab = tab; S.e = ecur; S.probe = 0; S.L0 = su * 4; S.cnt = 4; pg8::EpiStoreF8 E;
                  int k256 = 256; asm volatile("" : "+s"(k256));
                  pg8::gemm_phase<pg8::EpiStoreF8, SchedDN, false>(lds, k256, S, E); }
            }
            if (rep == 0) { cv_tail(lds, l, 4, nsu, bid, G); cv_tail(lds, l, 5, nsu, bid, G); } }
        TS(7); SEAM(pb + 4);
        if (IN(pb + 5) && !IN(pb + 4)) {}
#else
        if (IN(pb + 4)) SITE(11) for (int rep = 0; rep < REP_E; ++rep) { build_expert_tables(args, lds, l, tid);
            const LAS int* tab = (const LAS int*)(lds + LDS_TAB);
            if (E_STAGGER && (bid & 1) && bid >= 8) { const unsigned long long t0s = __builtin_amdgcn_s_memrealtime(); while (__builtin_amdgcn_s_memrealtime() - t0s < (unsigned long long)E_STAGGER) __builtin_amdgcn_s_sleep(16); }
            SchedGU S; S.s.init(0, tab[65] * 2, bid, G); S.ws = WSP; S.l = l; S.tab = tab; S.e = 0; S.L0 = 0; S.cnt = 0; S.probe = (rep + 1 < REP_E) ? PROBE_E : 0; pg8::EpiSwiGLU E;
            pg8::gemm_phase<pg8::EpiSwiGLU, SchedGU, true>(lds, 1024, S, E);
            if (rep == 0) cv_tail(lds, l, 4, tab[65] * 2, bid, G); }
        TS(7); SEAM(pb + 4);
        if (IN(pb + 5)) SITE(12) for (int rep = 0; rep < REP_F; ++rep) { build_expert_tables(args, lds, l, tid);
            const LAS int* tab = (const LAS int*)(lds + LDS_TAB);
            SchedDN S; S.s.init(0, tab[65] * 4, bid, G); S.ws = WSP; S.l = l; S.tab = tab; S.e = 0; S.probe = (rep + 1 < REP_F) ? PROBE_F : 0; S.L0 = 0; S.cnt = 0; pg8::EpiStoreF8 E;
            int k256 = 256; asm volatile("" : "+s"(k256));
            pg8::gemm_phase<pg8::EpiStoreF8, SchedDN, false>(lds, k256, S, E);
            if (rep == 0) cv_tail(lds, l, 5, tab[65] * 4, bid, G); }
        TS(8); SEAM(pb + 5);
#endif
        if (IN(pb + 6)) SITE(13) for (int rep = 0; rep < REP_G; ++rep) { build_expert_tables(args, lds, l, tid); phase_combine_ln2(args, lds, l, gw, NGW, tid, lane, rep + 1 < REP_G); }
        TS(9); SEAM(pb + 6);
    }
    if (PROBE_TS) { volatile LAS float* ta_ = (volatile LAS float*)(lds + LDS_MISC + 64);
        float* tsw = (float*)(WSP + WS_CTL) + 32;
        if (blockIdx.x == 0 && threadIdx.x == 0) __hip_atomic_store(tsw, ta_[PROBE_TS_A] * 0.01f * PROBE_TS_SCALE, __ATOMIC_RELAXED, __HIP_MEMORY_SCOPE_AGENT);
        xcd_barrier(bar);
        const float va0_unused = 0.f; (void)va0_unused; const float va = __hip_atomic_load(tsw, __ATOMIC_RELAXED, __HIP_MEMORY_SCOPE_AGENT); float* o_ = a.out();
        for (int i = blockIdx.x * 512 + threadIdx.x; i < TLAT * DM; i += G * 512) o_[i] += va; }
#undef IN
#undef SEAM
#undef lo
#undef hi
#undef lane
#undef wave
#undef gw
#undef tid
#undef WSP
#undef args
}

extern "C" void kernel_launch(void* const* d_in, const int* in_sizes, int n_in, void* d_out, int out_size, void* d_ws, size_t ws_size, hipStream_t stream) {
    static int ok = 0;
    if (ok == 0) {
        if (n_in != N_IN || ws_size < WS_END) { fprintf(stderr, "kernel_launch: n_in %d (want %d), ws %zu (want >= %zu)\n", n_in, (int)N_IN, ws_size, (size_t)WS_END); return; }
        if (hipFuncSetAttribute((const void*)fwd, hipFuncAttributeMaxDynamicSharedMemorySize, LDS_BYTES) != hipSuccess) { fprintf(stderr, "kernel_launch: hipFuncSetAttribute failed\n"); return; }
        int per_cu = 0;
        if (hipOccupancyMaxActiveBlocksPerMultiprocessor(&per_cu, (const void*)fwd, 512, LDS_BYTES) != hipSuccess || per_cu < 1) fprintf(stderr, "kernel_launch: occupancy query reports %d\n", per_cu);
        ok = 1;
    }
    Args a;
    memset(&a, 0, sizeof(a));
    for (int i = 0; i < N_IN; ++i) a.in[i] = (const float*)d_in[i];
    a.out = (float*)d_out; a.ws = (unsigned char*)d_ws;
    hipMemsetAsync((char*)d_ws + WS_CTL, 0, CTL_BYTES, stream);
#if MK_ONE_LAUNCH
    a.ph_lo = 0; a.ph_hi = NPHASE;
    hipLaunchKernelGGL(fwd, dim3(256), dim3(512), LDS_BYTES, stream, a);
#else
    for (int p = 0; p < NPHASE; ++p) { a.ph_lo = p; a.ph_hi = p + 1; hipLaunchKernelGGL(fwd, dim3(256), dim3(512), LDS_BYTES, stream, a); }
#endif
    const hipError_t le = hipPeekAtLastError();
    if (le != hipSuccess) fprintf(stderr, "kernel_launch: launch failed: %s\n", hipGetErrorName(le));
}
```

```cpp
#include <hip/hip_runtime.h>
#include <cstdio>
#include <cstdint>
#include <cstring>

#define LAS __attribute__((address_space(3)))
#define GAS __attribute__((address_space(1)))
typedef unsigned short bf16_t;
typedef short bf16x8 __attribute__((ext_vector_type(8)));
typedef short s16x4 __attribute__((ext_vector_type(4)));
typedef float f32x2 __attribute__((ext_vector_type(2)));
typedef float f32x4 __attribute__((ext_vector_type(4)));
typedef float f32x16 __attribute__((ext_vector_type(16)));
typedef unsigned u32x2 __attribute__((ext_vector_type(2)));
typedef unsigned u32x4 __attribute__((ext_vector_type(4)));

#ifndef MK_ONE_LAUNCH
#define MK_ONE_LAUNCH 1
#endif

constexpr int NB = 4, LSEQ = 4096, DM = 1024, NCTX = 256, DEPTH = 4;
constexpr int TLAT = NB * LSEQ, TCTX = NB * NCTX, TT = TLAT + TCTX;
constexpr int KVR = LSEQ + NCTX;
constexpr int NEXP = 64, TOPK = 8, EDIM = 256;
constexpr int NPAIR = TT * TOPK, NSLOT = NPAIR + TT;
constexpr float DN_ALPHA = 1.681792830507429f;
constexpr float LN_EPS = 1e-6f, RMS_EPS = 1e-6f, ROUTE_SCALE = 2.5f;
constexpr float ATT_SCALE = 0.088388347648318440f;

constexpr size_t al256(size_t x) { return (x + 255) / 256 * 256; }
constexpr size_t WS_CTL = 0, CTL_BYTES = 65536;
constexpr size_t WS_MOD = WS_CTL + CTL_BYTES;
constexpr size_t WS_GAINP = WS_MOD + al256((size_t)DEPTH * 5 * 6 * DM * 4);
constexpr size_t WS_ROPE = WS_GAINP + 2048;
constexpr size_t WS_WRHI = WS_ROPE + 16384;
constexpr size_t WS_WRLO = WS_WRHI + (size_t)DEPTH * 64 * DM * 2;
constexpr size_t WS_WF = WS_WRLO + (size_t)DEPTH * 64 * DM * 2;
constexpr size_t WS_WINE = WS_WF + (size_t)2 * 512 * DM * 2;
constexpr size_t WS_WINO = WS_WINE + (size_t)2 * 1280 * DM * 2;
constexpr size_t WS_WOUT = WS_WINO + (size_t)2 * 3072 * DM * 2;
constexpr size_t WS_WGU = WS_WOUT + (size_t)DEPTH * DM * DM * 2;
constexpr size_t WS_WD = WS_WGU + (size_t)DEPTH * 65 * 512 * DM * 2;
constexpr size_t WS_TW = WS_WD + (size_t)DEPTH * 65 * DM * 256 * 2;
constexpr size_t WS_TWC = WS_TW + (size_t)4096 * 8192 * 2;
constexpr size_t WS_XS = WS_TWC + (size_t)256 * 512 * 2;
constexpr size_t WS_H = WS_XS + (size_t)TT * DM * 4;
constexpr size_t WS_TKE = WS_H + (size_t)TT * DM * 2;
constexpr size_t WS_TKW = WS_TKE + (size_t)NPAIR * 4;
constexpr size_t WS_TKP = WS_TKW + (size_t)NPAIR * 4;
constexpr size_t WS_LIST = WS_TKP + (size_t)NPAIR * 4;
constexpr size_t WS_ACT = WS_LIST + (size_t)(NEXP + 1) * TT * 4;
constexpr size_t WS_YB = WS_ACT + (size_t)(NSLOT + 256) * EDIM * 2;
constexpr size_t WS_QB = WS_YB;
constexpr size_t WS_KB = WS_QB + (size_t)TT * DM * 2;
constexpr size_t WS_VB = WS_KB + (size_t)NB * KVR * DM * 2;
constexpr size_t WS_O = WS_VB + (size_t)NB * KVR * DM * 2;
constexpr size_t WS_Y = WS_O + (size_t)TT * DM * 2;
constexpr size_t WS_ZT = WS_Y + (size_t)TT * DM * 2;
constexpr size_t WS_ZCT = WS_ZT + (size_t)1024 * 8192 * 2;
constexpr size_t WS_OVL_END = WS_ZCT + (size_t)1024 * 512 * 2;
constexpr size_t WS_HL = WS_YB + (size_t)NSLOT * DM * 2;
constexpr size_t WS_TRASH = WS_HL + (size_t)TT * DM * 2;
constexpr size_t WS_END = WS_TRASH + (size_t)256 * 16384;
static_assert(WS_OVL_END <= WS_HL, "overlay fits in YB");
static_assert(WS_END <= (size_t)1 << 30, "workspace must fit 1 GiB");
constexpr int CW_TMO = 0, CW_CNT = 64  , CW_BAR = 1024;

constexpr int LDS_BYTES = 147456;
constexpr int LDS_STAGE = 0;
constexpr int LDS_EPI = 131072;
constexpr int LDS_RIDX = 139264;
constexpr int LDS_TAB = 141312;
constexpr int LDS_MISC = 147456 - 256;

__device__ __forceinline__ unsigned cvt_pk_bf16(float lo, float hi) { unsigned r; asm volatile("v_cvt_pk_bf16_f32 %0, %1, %2" : "=v"(r) : "v"(lo), "v"(hi)); return r; }
__device__ __forceinline__ float bf_lo(unsigned u) { return __uint_as_float(u << 16); }
__device__ __forceinline__ float bf_hi(unsigned u) { return __uint_as_float(u & 0xffff0000u); }
__device__ __forceinline__ float wave_sum(float v) {
#pragma unroll
    for (int o = 1; o < 64; o <<= 1) v += __shfl_xor(v, o);
    return v;
}
__device__ __forceinline__ float wave_max(float v) {
#pragma unroll
    for (int o = 1; o < 64; o <<= 1) v = fmaxf(v, __shfl_xor(v, o));
    return v;
}
#define LDS_WAIT() asm volatile("s_waitcnt lgkmcnt(0)" ::: "memory")
#define VM_WAIT() asm volatile("s_waitcnt vmcnt(0)" ::: "memory")

#ifndef PROBE_TS
#define PROBE_TS 0
#endif
#define TS(k) do { if (PROBE_TS && blockIdx.x == 0 && threadIdx.x == 0) { const unsigned long long now_ = __builtin_amdgcn_s_memrealtime(); volatile LAS float* ta_ = (volatile LAS float*)(lds + LDS_MISC + 64); \
    ta_[k] = ta_[k] + (float)(now_ - *(volatile LAS unsigned long long*)(lds + LDS_MISC + 192)); *(volatile LAS unsigned long long*)(lds + LDS_MISC + 192) = now_; } } while (0)

__device__ __forceinline__ int opaque_tid() { int t = threadIdx.x; asm volatile("" : "+v"(t)); return t; }
namespace pg8 {
constexpr int BM = 256, BK = 64, HALF = 128, HTB = HALF * BK * 2  , STAGE_BYTES = 8 * HTB;

__host__ __device__ __forceinline__ int lds_byte(int r, int c) { const int st = (r >> 4) * 2 + (c >> 5), rr = r & 15, cc = c & 31, ob = rr * 64 + cc * 2; return st * 1024 + (ob ^ (((ob >> 9) & 1) << 5)); }
__host__ __device__ __forceinline__ void stage_rc(int b, int& R, int& C) { const int st = b / 1024, sb = b % 1024, swz = sb ^ (((sb >> 9) & 1) << 5); R = (st >> 1) * 16 + swz / 64; C = (st & 1) * 32 + (swz % 64) / 2; }
__host__ __device__ __forceinline__ int perm32(int rho) { const int n = rho >> 4, i = rho & 15; return 8 * (i >> 2) + 4 * n + (i & 3); }

struct Unit { const char* A; const char* B; char* C; const int* rows; int ldc, nvalid, x0, x1; };

struct EpiStore {
    __device__ __forceinline__ void operator()(const f32x4 (&acc)[2][2][4][2], const Unit& u) const {
        const int tid = opaque_tid(), wid = tid >> 6, lane = tid & 63, wr = wid >> 2, wc = wid & 3, fr = lane & 15, fq = lane >> 4;
        const int row0 = wr * 64 + fr, col0 = wc * 32 + 8 * fq;
#pragma unroll
        for (int ai = 0; ai < 2; ++ai)
#pragma unroll
            for (int m = 0; m < 4; ++m) {
                const int r = row0 + ai * HALF + m * 16;
                if (r < u.nvalid) {
                    bf16_t* rowp = (bf16_t*)u.C + (size_t)r * u.ldc + col0;
#pragma unroll
                    for (int bj = 0; bj < 2; ++bj) { const f32x4 v0 = acc[ai][bj][m][0], v1 = acc[ai][bj][m][1];
                        u32x4 w; w.x = cvt_pk_bf16(v0[0], v0[1]); w.y = cvt_pk_bf16(v0[2], v0[3]); w.z = cvt_pk_bf16(v1[0], v1[1]); w.w = cvt_pk_bf16(v1[2], v1[3]);
                        *(u32x4*)(rowp + bj * HALF) = w; }
                }
            }
    }
};
constexpr float YB_SCALE = 32.0f;
struct EpiStoreF8 {
    __device__ __forceinline__ void operator()(const f32x4 (&acc)[2][2][4][2], const Unit& u) const {
        const int tid = opaque_tid(), wid = tid >> 6, lane = tid & 63, wr = wid >> 2, wc = wid & 3, fr = lane & 15, fq = lane >> 4;
        const int row0 = wr * 64 + fr, col0 = wc * 32 + 8 * fq;
#pragma unroll
        for (int ai = 0; ai < 2; ++ai)
#pragma unroll
            for (int m = 0; m < 4; ++m) {
                const int r = row0 + ai * HALF + m * 16;
                if (r < u.nvalid) {
                    unsigned char* rowp = (unsigned char*)u.C + (size_t)r * u.ldc + col0;
#pragma unroll
                    for (int bj = 0; bj < 2; ++bj) { f32x4 v0 = acc[ai][bj][m][0] * YB_SCALE, v1 = acc[ai][bj][m][1] * YB_SCALE;
#pragma unroll
                        for (int t = 0; t < 4; ++t) { v0[t] = __builtin_amdgcn_fmed3f(v0[t], -448.0f, 448.0f); v1[t] = __builtin_amdgcn_fmed3f(v1[t], -448.0f, 448.0f); }
                        int w0 = 0, w1 = 0;
                        w0 = __builtin_amdgcn_cvt_pk_fp8_f32(v0[0], v0[1], w0, false); w0 = __builtin_amdgcn_cvt_pk_fp8_f32(v0[2], v0[3], w0, true);
                        w1 = __builtin_amdgcn_cvt_pk_fp8_f32(v1[0], v1[1], w1, false); w1 = __builtin_amdgcn_cvt_pk_fp8_f32(v1[2], v1[3], w1, true);
                        *(u32x2*)(rowp + bj * HALF) = (u32x2){(unsigned)w0, (unsigned)w1}; }
                }
            }
    }
};
struct EpiSwiGLU {
    __device__ __forceinline__ void operator()(const f32x4 (&acc)[2][2][4][2], const Unit& u) const {
        const int tid = opaque_tid(), wid = tid >> 6, lane = tid & 63, wr = wid >> 2, wc = wid & 3, fr = lane & 15, fq = lane >> 4;
        const int row0 = wr * 64 + fr, col0 = wc * 32 + 8 * fq;
#pragma unroll
        for (int ai = 0; ai < 2; ++ai)
#pragma unroll
            for (int m = 0; m < 4; ++m) {
                const int r = row0 + ai * HALF + m * 16;
                if (r < u.nvalid) {
                    float o[8];
#pragma unroll
                    for (int n = 0; n < 2; ++n)
#pragma unroll
                        for (int j = 0; j < 4; ++j) { const float g = acc[ai][0][m][n][j], up = acc[ai][1][m][n][j];
                            o[n * 4 + j] = g * __builtin_amdgcn_rcpf(1.0f + __builtin_amdgcn_exp2f(-1.4426950408889634f * g)) * up; }
                    u32x4 w; w.x = cvt_pk_bf16(o[0], o[1]); w.y = cvt_pk_bf16(o[2], o[3]); w.z = cvt_pk_bf16(o[4], o[5]); w.w = cvt_pk_bf16(o[6], o[7]);
                    *(u32x4*)((bf16_t*)u.C + (size_t)r * u.ldc + col0) = w;
                }
            }
    }
};
struct EpiQKVE {
    LAS float* P;
    const float* gainp;
    const f32x2* rope;
    __device__ __forceinline__ void operator()(const f32x4 (&acc)[2][2][4][2], const Unit& u) const {
        const int tid = opaque_tid(), wid = tid >> 6, lane = tid & 63, wr = wid >> 2, wc = wid & 3, fr = lane & 15, fq = lane >> 4;
        const int row0 = wr * 64 + fr, col0 = wc * 32 + 8 * fq;
        if (u.x0 >= 2) {
            const size_t bjs = (u.x0 == 2) ? (size_t)NB * KVR * 128 : (size_t)HALF;
#pragma unroll
            for (int ai = 0; ai < 2; ++ai)
#pragma unroll
                for (int m = 0; m < 4; ++m) { bf16_t* rowp = (bf16_t*)u.C + (size_t)(row0 + ai * HALF + m * 16) * u.ldc + col0;
#pragma unroll
                    for (int bj = 0; bj < 2; ++bj) { const f32x4 v0 = acc[ai][bj][m][0], v1 = acc[ai][bj][m][1];
                        u32x4 w; w.x = cvt_pk_bf16(v0[0], v0[1]); w.y = cvt_pk_bf16(v0[2], v0[3]); w.z = cvt_pk_bf16(v1[0], v1[1]); w.w = cvt_pk_bf16(v1[2], v1[3]);
                        *(u32x4*)(rowp + bj * bjs) = w; } }
            asm volatile("" ::: "memory"); __builtin_amdgcn_s_barrier(); asm volatile("" ::: "memory");
            return;
        }
#pragma unroll
        for (int ai = 0; ai < 2; ++ai)
#pragma unroll
            for (int m = 0; m < 4; ++m)
#pragma unroll
                for (int bj = 0; bj < 2; ++bj) { const f32x4 a = acc[ai][bj][m][0], b = acc[ai][bj][m][1];
                    float s = (a[0] * a[0] + a[1] * a[1]) + (a[2] * a[2] + a[3] * a[3]) + (b[0] * b[0] + b[1] * b[1]) + (b[2] * b[2] + b[3] * b[3]);
                    s += __shfl_xor(s, 16); s += __shfl_xor(s, 32);
                    if (fq == 0) P[(bj * 256 + row0 + ai * HALF + m * 16) * 4 + wc] = s; }
        asm volatile("s_waitcnt lgkmcnt(0)" ::: "memory"); __builtin_amdgcn_s_barrier(); asm volatile("" ::: "memory");
        const f32x4 g0 = *(const f32x4*)(gainp + u.x0 * 128 + col0), g1 = *(const f32x4*)(gainp + u.x0 * 128 + col0 + 4);
        const int half = wc >> 1, fi = ((wc & 1) * 4 + fq) * 4;
#pragma unroll
        for (int ai = 0; ai < 2; ++ai)
#pragma unroll
            for (int m = 0; m < 4; ++m) {
                const int r = row0 + ai * HALF + m * 16;
                int pos = 0;
                if (u.x1 >= 0) { const int t = u.x1 + r; pos = half ? (t & 63) : (t >> 6); }
                const f32x4 cs0 = *(const f32x4*)(rope + pos * 32 + fi), cs1 = *(const f32x4*)(rope + pos * 32 + fi + 2);
                const float cc[4] = {cs0[0], cs0[2], cs1[0], cs1[2]}, ss[4] = {cs0[1], cs0[3], cs1[1], cs1[3]};
                bf16_t* rowp = (bf16_t*)u.C + (size_t)r * u.ldc + col0;
#pragma unroll
                for (int bj = 0; bj < 2; ++bj) {
                    const f32x4 pp = *(const LAS f32x4*)(P + (bj * 256 + r) * 4);
                    const float rs = __builtin_amdgcn_rsqf(((pp[0] + pp[1]) + (pp[2] + pp[3])) * (1.0f / 128.0f) + RMS_EPS);
                    float o1[4], o2[4];
#pragma unroll
                    for (int j = 0; j < 4; ++j) { const float v1 = acc[ai][bj][m][0][j] * rs * g0[j], v2 = acc[ai][bj][m][1][j] * rs * g1[j];
                        o1[j] = v1 * cc[j] - v2 * ss[j]; o2[j] = v1 * ss[j] + v2 * cc[j]; }
                    u32x4 w; w.x = cvt_pk_bf16(o1[0], o1[1]); w.y = cvt_pk_bf16(o1[2], o1[3]); w.z = cvt_pk_bf16(o2[0], o2[1]); w.w = cvt_pk_bf16(o2[2], o2[3]);
                    *(u32x4*)(rowp + bj * ((u.x0 == 0) ? (size_t)HALF : (size_t)NB * KVR * 128)) = w;
                }
            }
    }
};

template <class Epi, class Sched, bool GATHER>
__device__ __forceinline__ void gemm_phase(LAS unsigned char* lds, const int K_, Sched& S, const Epi& E) {
    const int K = K_;
    const int tid = opaque_tid(), wid = __builtin_amdgcn_readfirstlane(tid >> 6), lane = tid & 63, wr = wid >> 2, wc = wid & 3, fr = lane & 15, fq = lane >> 4;
    const int nt = K / BK;
    Unit cur, nxt; int ui = 0;
    if (!S.next(0, cur)) return;
    unsigned voffB[2], offA[2][2];
#pragma unroll
    for (int i = 0; i < 2; ++i) { int R, C; stage_rc(tid * 16 + i * 8192, R, C); const int Rb = (R & ~31) + perm32(R & 31);
        voffB[i] = (unsigned)(Rb * K + C) * 2u; }
    LAS int* ridx = (LAS int*)(lds + LDS_RIDX);
    if (GATHER) {
        if (tid < 256) ridx[tid] = (tid < cur.nvalid) ? cur.rows[tid] : 0;
        __syncthreads();
#pragma unroll
        for (int h = 0; h < 2; ++h)
#pragma unroll
            for (int i = 0; i < 2; ++i) { int R, C; stage_rc(tid * 16 + i * 8192, R, C); offA[h][i] = (unsigned)ridx[h * HALF + R] * (unsigned)(K * 2) + (unsigned)C * 2u; }
    } else {
#pragma unroll
        for (int h = 0; h < 2; ++h)
#pragma unroll
            for (int i = 0; i < 2; ++i) { int R, C; stage_rc(tid * 16 + i * 8192, R, C); offA[h][i] = (unsigned)((h * HALF + R) * K + C) * 2u; }
    }
    const size_t kstep = (size_t)(BK * 2);
    const size_t hstep = (size_t)HALF * K * 2;
    const unsigned ldsw = (unsigned)wid * 1024u;
    const int aoff = lds_byte(wr * 64 + fr, fq * 8), boff = lds_byte(wc * 32 + fr, fq * 8);
#define PG8_SA(b, h) (((b) * 2 + (h)) * HTB)
#define PG8_SB(b, h) ((4 + (b) * 2 + (h)) * HTB)
#define PG8_STAGE(bufoff, gbase, voff) do { _Pragma("unroll") for (int _i = 0; _i < 2; ++_i) \
        __builtin_amdgcn_global_load_lds((const unsigned*)((const char*)(gbase) + (voff)[_i]), (LAS unsigned*)(lds + (bufoff) + ldsw + _i * 8192), 16, 0, 0); } while (0)
#define PG8_LDA(dst, b, h) do { _Pragma("unroll") for (int m = 0; m < 4; ++m) _Pragma("unroll") for (int k = 0; k < 2; ++k) dst[m][k] = *(const LAS bf16x8*)(lds + PG8_SA(b, h) + aoff + m * 2048 + k * 1024); } while (0)
#define PG8_LDB(dst, b, h) do { _Pragma("unroll") for (int n = 0; n < 2; ++n) _Pragma("unroll") for (int k = 0; k < 2; ++k) dst[n][k] = *(const LAS bf16x8*)(lds + PG8_SB(b, h) + boff + n * 2048 + k * 1024); } while (0)
#define PG8_MMA(ai, bj, At, Bt) do { __builtin_amdgcn_s_setprio(1); _Pragma("unroll") for (int m = 0; m < 4; ++m) _Pragma("unroll") for (int n = 0; n < 2; ++n) _Pragma("unroll") for (int k = 0; k < 2; ++k) \
        acc[ai][bj][m][n] = __builtin_amdgcn_mfma_f32_16x16x32_bf16(Bt[n][k], At[m][k], acc[ai][bj][m][n], 0, 0, 0); __builtin_amdgcn_s_setprio(0); } while (0)
#define PG8_WAIT_V(n) asm volatile("s_waitcnt vmcnt(" #n ")" ::: "memory")
#define PG8_WAIT_L(n) asm volatile("s_waitcnt lgkmcnt(" #n ")" ::: "memory")
#define PG8_BAR __builtin_amdgcn_s_barrier()
#define PG8_SCHED __builtin_amdgcn_sched_barrier(0)
    f32x4 acc[2][2][4][2];
#pragma unroll
    for (int a = 0; a < 2; ++a)
#pragma unroll
        for (int b = 0; b < 2; ++b)
#pragma unroll
            for (int m = 0; m < 4; ++m)
#pragma unroll
                for (int n = 0; n < 2; ++n) acc[a][b][m][n] = (f32x4){0.f, 0.f, 0.f, 0.f};
    bf16x8 At[4][2], B0[2][2], B1[2][2];
    const char* cA = cur.A; const char* cB = cur.B;
    PG8_STAGE(PG8_SB(0, 0), cB, voffB); PG8_STAGE(PG8_SA(0, 0), cA, offA[0]); PG8_STAGE(PG8_SB(0, 1), cB + hstep, voffB); PG8_STAGE(PG8_SA(0, 1), cA, offA[1]);
    if (wr == 1) PG8_BAR;
    PG8_WAIT_V(4); PG8_BAR;
    PG8_STAGE(PG8_SB(1, 0), cB + kstep, voffB); PG8_STAGE(PG8_SA(1, 0), cA + kstep, offA[0]); PG8_STAGE(PG8_SB(1, 1), cB + hstep + kstep, voffB);
    PG8_WAIT_V(6); PG8_BAR;
    for (;;) {
        const bool has_next = S.next(ui + 1, nxt);
        const char* nA = has_next ? nxt.A : cA; const char* nB = has_next ? nxt.B : cB;
        if (GATHER && has_next && wid < 4)
            __builtin_amdgcn_global_load_lds((const unsigned*)(nxt.rows + wid * 64 + lane), (LAS unsigned*)(lds + LDS_RIDX + ((ui + 1) & 1) * 1024 + wid * 256), 4, 0, 0);
        for (int t = 0; t < nt; t += 2) {
            const bool last = (t == nt - 2);
            const char* a1 = cA + (size_t)(t + 1) * kstep;
            const char* a2 = last ? nA : cA + (size_t)(t + 2) * kstep; const char* b2 = last ? nB : cB + (size_t)(t + 2) * kstep;
            const char* a3 = a2 + kstep; const char* b3 = b2 + kstep;
            PG8_LDB(B0, 0, 0); PG8_SCHED; PG8_LDA(At, 0, 0); PG8_STAGE(PG8_SA(1, 1), a1, offA[1]);
            PG8_WAIT_L(8); PG8_BAR; PG8_WAIT_L(0); PG8_MMA(0, 0, At, B0); PG8_BAR; PG8_SCHED;
            if (GATHER && last && has_next) {
                LAS int* rn = ridx + ((ui + 1) & 1) * 256;
#pragma unroll
                for (int h = 0; h < 2; ++h)
#pragma unroll
                    for (int i = 0; i < 2; ++i) { int R, C; stage_rc(tid * 16 + i * 8192, R, C); const int rr = h * HALF + R; const int tok = (rr < nxt.nvalid) ? rn[rr] : 0; offA[h][i] = (unsigned)tok * (unsigned)(K * 2) + (unsigned)C * 2u; }
            }
            PG8_LDB(B1, 0, 1); PG8_STAGE(PG8_SB(0, 0), b2, voffB);
            PG8_BAR; PG8_WAIT_L(0); PG8_MMA(0, 1, At, B1); PG8_BAR;
            PG8_LDA(At, 0, 1); PG8_STAGE(PG8_SA(0, 0), a2, offA[0]);
            PG8_BAR; PG8_WAIT_L(0); PG8_MMA(1, 0, At, B0); PG8_BAR; PG8_SCHED;
            PG8_STAGE(PG8_SB(0, 1), b2 + hstep, voffB);
            PG8_WAIT_V(6); PG8_BAR; PG8_MMA(1, 1, At, B1); PG8_BAR;
            PG8_LDB(B0, 1, 0); PG8_SCHED; PG8_LDA(At, 1, 0); PG8_STAGE(PG8_SA(0, 1), a2, offA[1]);
            PG8_WAIT_L(8); PG8_BAR; PG8_WAIT_L(0); PG8_MMA(0, 0, At, B0); PG8_BAR; PG8_SCHED;
            PG8_LDB(B1, 1, 1); PG8_STAGE(PG8_SB(1, 0), b3, voffB);
            PG8_BAR; PG8_WAIT_L(0); PG8_MMA(0, 1, At, B1); PG8_BAR;
            PG8_LDA(At, 1, 1); PG8_STAGE(PG8_SA(1, 0), a3, offA[0]);
            PG8_BAR; PG8_WAIT_L(0); PG8_MMA(1, 0, At, B0); PG8_BAR; PG8_SCHED;
            PG8_STAGE(PG8_SB(1, 1), b3 + hstep, voffB);
            PG8_WAIT_V(6); PG8_BAR; PG8_MMA(1, 1, At, B1); PG8_BAR;
        }
        { Unit eu; S.next(ui, eu); E(acc, eu); }
        if (!has_next) break;
#pragma unroll
        for (int a = 0; a < 2; ++a)
#pragma unroll
            for (int b = 0; b < 2; ++b)
#pragma unroll
                for (int m = 0; m < 4; ++m)
#pragma unroll
                    for (int n = 0; n < 2; ++n) acc[a][b][m][n] = (f32x4){0.f, 0.f, 0.f, 0.f};
        cur = nxt; cA = nA; cB = nB; ++ui;
    }
    PG8_WAIT_V(0);
    if (wr == 0) PG8_BAR;
    PG8_BAR;
#undef PG8_SA
#undef PG8_SB
#undef PG8_STAGE
#undef PG8_LDA
#undef PG8_LDB
#undef PG8_MMA
#undef PG8_WAIT_V
#undef PG8_WAIT_L
#undef PG8_BAR
#undef PG8_SCHED
}
}

namespace att {
constexpr int D = 128, NW = 8, QBLK = 32, KVBLK = 64;
constexpr float SCALE = ATT_SCALE;
constexpr float THR = 8.f;
constexpr float NEGM = -30000.f;
constexpr size_t SHM_V = KVBLK * D * 2, SHM_K = KVBLK * D * 2, SHM_ATTN = 2 * SHM_V + 2 * SHM_K + NW * 64 * 4;
constexpr int LDS_BIAS = 69632;
#define KSWZ(row, colB) ((row) * 256 + ((colB) ^ (((row) & 7) << 4)))
#define SBAR() __builtin_amdgcn_sched_barrier(0)
__device__ __forceinline__ int crow(int r, int hi) { return (r & 3) + 8 * (r >> 2) + 4 * hi; }

__device__ __forceinline__ void partialSM(f32x16& p0, f32x16& p1, float& m_reg, float& mn, float& alpha) {
  constexpr float C = SCALE * 1.4426950408889634f;
  float pmax = p0[0];
#pragma unroll
  for (int r = 1; r < 16; ++r) pmax = fmaxf(pmax, p0[r]);
#pragma unroll
  for (int r = 0; r < 16; ++r) pmax = fmaxf(pmax, p1[r]);
  { auto rr = __builtin_amdgcn_permlane32_swap(__float_as_uint(pmax), __float_as_uint(pmax), false, false);
    pmax = fmaxf(__uint_as_float(rr[0]), __uint_as_float(rr[1])); }
  if (__builtin_expect(__all(pmax - m_reg <= THR / SCALE), 1)) { mn = m_reg; alpha = 1.f; }
  else { mn = fmaxf(m_reg, pmax); alpha = __builtin_amdgcn_exp2f((m_reg - mn) * C); m_reg = mn; }
  float mnC = -mn * C;
#pragma unroll
  for (int r = 0; r < 16; ++r) p0[r] = fmaf(p0[r], C, mnC);
#pragma unroll
  for (int r = 0; r < 16; ++r) p1[r] = fmaf(p1[r], C, mnC);
#pragma unroll
  for (int r = 0; r < 16; ++r) p0[r] = __builtin_amdgcn_exp2f(p0[r]);
}
__device__ __forceinline__ void finishSM(f32x16& p0, f32x16& p1, float alpha, float& l_reg, bf16x8& pa0, bf16x8& pa1, bf16x8& pa2, bf16x8& pa3) {
#pragma unroll
  for (int r = 0; r < 16; ++r) p1[r] = __builtin_amdgcn_exp2f(p1[r]);
  float ps = 0;
#pragma unroll
  for (int r = 0; r < 16; ++r) ps += p0[r];
#pragma unroll
  for (int r = 0; r < 16; ++r) ps += p1[r];
  { auto rr = __builtin_amdgcn_permlane32_swap(__float_as_uint(ps), __float_as_uint(ps), false, false);
    ps = __uint_as_float(rr[0]) + __uint_as_float(rr[1]); }
  l_reg = l_reg * alpha + ps;
#define PK4(P, BASE, OUT) do { unsigned a0 = cvt_pk_bf16(P[BASE + 0], P[BASE + 1]), a1 = cvt_pk_bf16(P[BASE + 2], P[BASE + 3]);   \
    unsigned b0 = cvt_pk_bf16(P[BASE + 4], P[BASE + 5]), b1 = cvt_pk_bf16(P[BASE + 6], P[BASE + 7]);                              \
    auto r0 = __builtin_amdgcn_permlane32_swap(a0, b0, false, false); auto r1 = __builtin_amdgcn_permlane32_swap(a1, b1, false, false); \
    u32x4 w = {r0[0], r1[0], r0[1], r1[1]}; OUT = *reinterpret_cast<bf16x8*>(&w); } while (0)
  PK4(p0, 0, pa0); PK4(p0, 8, pa1); PK4(p1, 0, pa2); PK4(p1, 8, pa3);
#undef PK4
}
__device__ __forceinline__ void qkt(f32x16& p0, f32x16& p1, const char* Ks, const bf16x8* qr, int r32, int hi) {
  p0 = f32x16{}; p1 = f32x16{};
#pragma unroll
  for (int d0 = 0; d0 < 8; ++d0) { int cb = (d0 * 16 + hi * 8) * 2;
    bf16x8 b0 = *reinterpret_cast<const bf16x8*>(Ks + KSWZ(r32, cb));
    bf16x8 b1 = *reinterpret_cast<const bf16x8*>(Ks + KSWZ(32 + r32, cb));
    p0 = __builtin_amdgcn_mfma_f32_32x32x16_bf16(b0, qr[d0], p0, 0, 0, 0);
    p1 = __builtin_amdgcn_mfma_f32_32x32x16_bf16(b1, qr[d0], p1, 0, 0, 0); }
}
__device__ __forceinline__ int v_st(int k, int c) { const int kk = (k & ~0xC) | ((k & 4) << 1) | ((k & 8) >> 1); return ((kk >> 3) * 4 + (c >> 5)) * 512 + ((kk & 7) * 32 + (c & 31)) * 2; }
__device__ __forceinline__ int v_rd_base(int lane) { return ((lane & 3) << 3) | (((lane >> 2) & 3) << 6) | (((lane >> 4) & 1) << 5) | (((lane >> 5) & 1) << 8); }
constexpr int v_rd_off(int d0, int ks, int half) { return d0 * 512 + ks * 4096 + half * 2048; }
template <int OFF> __device__ __forceinline__ s16x4 tr_read(int vb) {
  s16x4 r; asm volatile("ds_read_b64_tr_b16 %0, %1 offset:%2" : "=&v"(r) : "v"(vb), "i"(OFF) : "memory"); return r;
}
template <int D0> __device__ __forceinline__ void pv_one(f32x16& od, int vb, bf16x8 pa0, bf16x8 pa1, bf16x8 pa2, bf16x8 pa3) {
  const s16x4 l0 = tr_read<v_rd_off(D0, 0, 0)>(vb), h0 = tr_read<v_rd_off(D0, 0, 1)>(vb), l1 = tr_read<v_rd_off(D0, 1, 0)>(vb), h1 = tr_read<v_rd_off(D0, 1, 1)>(vb);
  const s16x4 l2 = tr_read<v_rd_off(D0, 2, 0)>(vb), h2 = tr_read<v_rd_off(D0, 2, 1)>(vb), l3 = tr_read<v_rd_off(D0, 3, 0)>(vb), h3 = tr_read<v_rd_off(D0, 3, 1)>(vb);
  asm volatile("s_waitcnt lgkmcnt(0)" ::: "memory"); SBAR();
#define PK(L, H) (bf16x8){L[0], L[1], L[2], L[3], H[0], H[1], H[2], H[3]}
  od = __builtin_amdgcn_mfma_f32_32x32x16_bf16(pa0, PK(l0, h0), od, 0, 0, 0);
  od = __builtin_amdgcn_mfma_f32_32x32x16_bf16(pa1, PK(l1, h1), od, 0, 0, 0);
  od = __builtin_amdgcn_mfma_f32_32x32x16_bf16(pa2, PK(l2, h2), od, 0, 0, 0);
  od = __builtin_amdgcn_mfma_f32_32x32x16_bf16(pa3, PK(l3, h3), od, 0, 0, 0);
#undef PK
}
__device__ __forceinline__ void pv_d0(f32x16* o, int vb, bf16x8 pa0, bf16x8 pa1, bf16x8 pa2, bf16x8 pa3) {
  pv_one<0>(o[0], vb, pa0, pa1, pa2, pa3); pv_one<1>(o[1], vb, pa0, pa1, pa2, pa3); pv_one<2>(o[2], vb, pa0, pa1, pa2, pa3); pv_one<3>(o[3], vb, pa0, pa1, pa2, pa3);
}

template <bool NA, int ldq, int ldk, int ldo>
__device__ __forceinline__ void attn_body(const bf16_t* __restrict__ Qb, const bf16_t* __restrict__ Kh, const bf16_t* __restrict__ Vh,
                                          bf16_t* __restrict__ Ob, const int NT, const int nloc, const int bs, const int q0r, char* lds) {
  const int tid = opaque_tid(), wid = tid >> 6, lane = tid & 63, r32 = lane & 31, hi = lane >> 5;
  char* V_lds = lds; char* K_lds = lds + 2 * SHM_V;
  float* ws = (float*)(lds + 2 * SHM_V + 2 * SHM_K) + wid * 64; float* li_l = ws; float* al_l = ws + 32;
  float m_reg = -1e30f, l_reg = 0; f32x16 o[4] = {}; bf16x8 qr[8];
  const bf16_t* Qw = Qb + (wid * QBLK + r32) * ldq + hi * 8;
#pragma unroll
  for (int d0 = 0; d0 < 8; ++d0) qr[d0] = *reinterpret_cast<const bf16x8*>(Qw + d0 * 16);
  const int sr = tid >> 4, sc = (tid & 15) * 8, vst0 = v_st(sr, sc), vst1 = v_st(32 + sr, sc);
  const int vb0 = (int)(uintptr_t)V_lds + v_rd_base(lane);
  const unsigned kvo = (unsigned)(sr * ldk + sc) * 2u;
  const float* btab = (const float*)(lds + LDS_BIAS) + 64;
  constexpr int SD = NA ? 1 : 2;
  struct { bf16x8 vs0, vs1, ks0, ks1; } sr_[SD];
#define KOFF(j) (NA ? ((j) < nloc ? (bs + (j)) * 64 : LSEQ + ((j) - nloc) * 64) : (j) * 64)
#define SLOAD(i, k0) do { const unsigned _ko = (unsigned)((k0) * ldk * 2) + kvo; sr_[i].vs0 = *reinterpret_cast<const bf16x8*>((const char*)Vh + _ko); sr_[i].vs1 = *reinterpret_cast<const bf16x8*>((const char*)Vh + (_ko + 64u * ldk)); \
    sr_[i].ks0 = *reinterpret_cast<const bf16x8*>((const char*)Kh + _ko); sr_[i].ks1 = *reinterpret_cast<const bf16x8*>((const char*)Kh + (_ko + 64u * ldk)); } while (0)
#define SWRITE(b, i) do { int sr_w = sr, sc_w = sc, v0_w = vst0, v1_w = vst1; \
    if (NA) { const int t_ = opaque_tid(); sr_w = t_ >> 4; sc_w = (t_ & 15) * 8; v0_w = v_st(sr_w, sc_w); v1_w = v_st(32 + sr_w, sc_w); }     \
    *(bf16x8*)(V_lds + (b) * SHM_V + v0_w) = sr_[i].vs0;          \
    *(bf16x8*)(V_lds + (b) * SHM_V + v1_w) = sr_[i].vs1; int kc = sc_w * 2;               \
    *(bf16x8*)(K_lds + (b) * SHM_K + KSWZ(sr_w, kc)) = sr_[i].ks0;                       \
    *(bf16x8*)(K_lds + (b) * SHM_K + KSWZ(32 + sr_w, kc)) = sr_[i].ks1; } while (0)
#define SWAIT() do { if (SD == 2) asm volatile("s_waitcnt vmcnt(4)" ::: "memory"); else asm volatile("s_waitcnt vmcnt(0)" ::: "memory"); } while (0)
#define RESC(a) do { if (__any((a) < 1.f)) { if (hi == 0) al_l[r32] = (a); asm volatile("s_waitcnt lgkmcnt(0)" ::: "memory"); \
    _Pragma("unroll") for (int d = 0; d < 4; ++d) _Pragma("unroll") for (int r = 0; r < 16; ++r) o[d][r] *= al_l[crow(r, hi)]; } } while (0)
#define ACT(j) (!NA || (j) >= nloc || ((bs + (j)) >= min(max(q0r + __builtin_amdgcn_readfirstlane(opaque_tid() >> 7) - 4, 0), 56) && (bs + (j)) < min(max(q0r + __builtin_amdgcn_readfirstlane(opaque_tid() >> 7) - 4, 0), 56) + 8))
#define NAMASK(P0, P1, j) do { if (NA && (j) < nloc) { const int kr = bs + (j); const int t_ = opaque_tid(); \
    const int qrow = q0r + __builtin_amdgcn_readfirstlane(t_ >> 7), qcol = ((t_ >> 6) & 1) * 32 + (t_ & 31), hi_ = (t_ >> 5) & 1; \
    const int cstart = min(max(qcol - 8, 0), 48); \
    const float* bp = btab + (kr - qrow + 7) * 31 + (4 * hi_ - qcol + 15); const int cs = cstart - 4 * hi_; \
    _Pragma("unroll") for (int r = 0; r < 16; ++r) { const int kc = (r & 3) + 8 * (r >> 2); \
        P0[r] = ((unsigned)(kc - cs) < 16u) ? P0[r] + bp[kc] : NEGM; P1[r] = ((unsigned)(kc + 32 - cs) < 16u) ? P1[r] + bp[kc + 32] : NEGM; } } } while (0)
  f32x16 pA0, pA1, pB0, pB1; float mnA, mnB, alA = 1.f, alB = 1.f; bf16x8 pa0, pa1, pa2, pa3;
  bool actA, actB;
  constexpr int SE = 0, SO = SD - 1;
  SLOAD(SE, KOFF(0)); asm volatile("s_waitcnt vmcnt(0)" ::: "memory"); SWRITE(0, SE); __syncthreads();
  actA = ACT(0);
  if (actA) { qkt(pA0, pA1, K_lds, qr, r32, hi); NAMASK(pA0, pA1, 0); partialSM(pA0, pA1, m_reg, mnA, alA); } else alA = 1.f;
  SLOAD(SO, KOFF(1)); if (SD == 2 && 2 < NT) SLOAD(SE, KOFF(2));
  SWAIT(); SWRITE(1, SO); __syncthreads();
  for (int j = 1; j + 1 < NT; j += 2) {
    SBAR(); actB = ACT(j); if (actB) { qkt(pB0, pB1, K_lds + SHM_K, qr, r32, hi); NAMASK(pB0, pB1, j); }
    if (actA) finishSM(pA0, pA1, alA, l_reg, pa0, pa1, pa2, pa3); SBAR();
    SLOAD(SO, KOFF(j + SD)); SBAR();
    if (actA) pv_d0(o, vb0, pa0, pa1, pa2, pa3); if (actB) partialSM(pB0, pB1, m_reg, mnB, alB); else alB = 1.f;
    __syncthreads(); SWAIT(); SWRITE(0, SE);
    RESC(alB); __syncthreads();
    SBAR(); actA = ACT(j + 1); if (actA) { qkt(pA0, pA1, K_lds, qr, r32, hi); NAMASK(pA0, pA1, j + 1); }
    if (actB) finishSM(pB0, pB1, alB, l_reg, pa0, pa1, pa2, pa3); SBAR();
    if (SD == 1 || j + 3 < NT) SLOAD(SE, KOFF(j + 1 + SD)); SBAR();
    if (actB) pv_d0(o, vb0 + (int)SHM_V, pa0, pa1, pa2, pa3); if (actA) partialSM(pA0, pA1, m_reg, mnA, alA); else alA = 1.f;
    __syncthreads(); SWAIT(); SWRITE(1, SO);
    RESC(alA); __syncthreads();
  }
  SBAR(); actB = ACT(NT - 1); if (actB) { qkt(pB0, pB1, K_lds + SHM_K, qr, r32, hi); NAMASK(pB0, pB1, NT - 1); }
  if (actA) finishSM(pA0, pA1, alA, l_reg, pa0, pa1, pa2, pa3); SBAR();
  if (actA) pv_d0(o, vb0, pa0, pa1, pa2, pa3); if (actB) partialSM(pB0, pB1, m_reg, mnB, alB); else alB = 1.f;
  __syncthreads(); RESC(alB);
  if (actB) { finishSM(pB0, pB1, alB, l_reg, pa0, pa1, pa2, pa3); SBAR();
    pv_d0(o, vb0 + (int)SHM_V, pa0, pa1, pa2, pa3); }
  if (hi == 0) li_l[r32] = l_reg; asm volatile("s_waitcnt lgkmcnt(0)" ::: "memory");
  float rli[16];
#pragma unroll
  for (int r = 0; r < 16; ++r) rli[r] = __builtin_amdgcn_rcpf(li_l[crow(r, hi)]);
  bf16_t* Ow = Ob + (wid * QBLK) * ldo + r32;
#pragma unroll
  for (int r = 0; r < 16; ++r) { const int orow = crow(r, hi);
#pragma unroll
    for (int d0 = 0; d0 < 4; ++d0) { const unsigned pk = cvt_pk_bf16(o[d0][r] * rli[r], 0.f); Ow[orow * ldo + d0 * 32] = (bf16_t)(pk & 0xffffu); } }
  __syncthreads();
#undef ACT
#undef KOFF
#undef SLOAD
#undef SWRITE
#undef SWAIT
#undef RESC
#undef NAMASK
}
#undef KSWZ
#undef SBAR
}

#define XB_TMO      128
#define XB_XCNT(j)  (256  + 64 * (j))
#define XB_XSUB(j)  (1280 + 64 * (j))
#define XB_XGEN(j)  (2304 + 64 * (j))
#define XB_TOP      3328
#define XB_TOPGEN   3392
#define XCD_BAR_WORDS 3456
#define XB_SPIN_CAP (1u << 22)
__device__ __forceinline__ unsigned xb_ld(unsigned* p)              { return __hip_atomic_load(p, __ATOMIC_RELAXED, __HIP_MEMORY_SCOPE_AGENT); }
__device__ __forceinline__ unsigned xb_add(unsigned* p, unsigned v) { return __hip_atomic_fetch_add(p, v, __ATOMIC_RELAXED, __HIP_MEMORY_SCOPE_AGENT); }
__device__ __forceinline__ unsigned xb_xcc_id() { return (unsigned)__builtin_amdgcn_s_getreg((3 << 11) | 20) & 0xFu; }
#define XB_SPIN(cond, bar) do { unsigned _sp = 0; while (cond) { __builtin_amdgcn_s_sleep(1); \
    if ((++_sp & 255u) == 0u) { if (xb_ld(&(bar)[XB_TMO])) break; if (_sp > XB_SPIN_CAP) { atomicAdd(&(bar)[XB_TMO], 1u); break; } } } } while (0)
struct XcdBarrier { unsigned* bar; unsigned x; volatile LAS unsigned* st; };
__device__ __forceinline__ XcdBarrier xcd_barrier_post(unsigned* bar, volatile LAS unsigned* st) {
    XcdBarrier b; b.bar = bar; b.x = xb_xcc_id(); b.st = st;
    if (threadIdx.x == 0) (void)xb_add(&bar[XB_XCNT(b.x)], 1u);
    return b;
}
__device__ __forceinline__ void xcd_barrier_complete(unsigned* bar, unsigned x, unsigned& nloc, unsigned& nx) {
    const unsigned G = gridDim.x * gridDim.y * gridDim.z;
    unsigned sum, cnt, mine, sp = 0u;
    for (;;) {
        sum = 0u; cnt = 0u; mine = 0u;
#pragma unroll
        for (unsigned j = 0; j < 16; ++j) { const unsigned c = xb_ld(&bar[XB_XCNT(j)]); sum += c; cnt += (c > 0u) ? 1u : 0u; mine = (j == x) ? c : mine; }
        if (sum == G) break;
        __builtin_amdgcn_s_sleep(1);
        if ((++sp & 255u) == 0u) { if (xb_ld(&bar[XB_TMO])) break; if (sp > XB_SPIN_CAP) { atomicAdd(&bar[XB_TMO], 1u); break; } }
    }
    nloc = mine > 0u ? mine : 1u; nx = cnt > 0u ? cnt : 1u;
}
__device__ __forceinline__ void xcd_barrier(const XcdBarrier& b) {
    asm volatile("s_waitcnt vmcnt(0)" ::: "memory");
    __syncthreads();
    if (threadIdx.x == 0) {
        unsigned* bar = b.bar;
        __builtin_amdgcn_s_waitcnt(0);
        unsigned nloc = b.st[0], nx = b.st[1];
        if (nloc == 0u) { xcd_barrier_complete(bar, b.x, nloc, nx); b.st[0] = nloc; b.st[1] = nx; }
        const unsigned old = xb_add(&bar[XB_XSUB(b.x)], 1u);
        const unsigned gen = old / nloc;
        if (old + 1u == (gen + 1u) * nloc) {
            __builtin_amdgcn_fence(__ATOMIC_RELEASE, "agent");
            asm volatile("s_waitcnt vmcnt(0)" ::: "memory");
            const unsigned og = xb_add(&bar[XB_TOP], 1u);
            const unsigned tg = og / nx;
            if (og + 1u == (tg + 1u) * nx) xb_add(&bar[XB_TOPGEN], 1u);
            else XB_SPIN(xb_ld(&bar[XB_TOPGEN]) == tg, bar);
            __builtin_amdgcn_fence(__ATOMIC_ACQUIRE, "agent");
            xb_add(&bar[XB_XGEN(b.x)], 1u);
            asm volatile("s_waitcnt vmcnt(0)" ::: "memory");
        } else {
            XB_SPIN(xb_ld(&bar[XB_XGEN(b.x)]) == gen, bar);
            __builtin_amdgcn_fence(__ATOMIC_ACQUIRE, "agent");
            asm volatile("s_waitcnt vmcnt(0)" ::: "memory");
        }
    }
    __syncthreads();
}

enum { I_X = 0, I_C, I_CTX, I_CCTX, I_WMOD, I_BMOD, I_LN1G, I_LN1B, I_LN2G, I_LN2B, I_ABWIN, I_ABWF, I_ABQN, I_ABKN, I_ABWOUT, I_NAWIN, I_NARPB, I_NAWOUT,
       I_WR, I_EBIAS, I_WG, I_WU, I_WDN, I_SG, I_SU, I_SD, N_IN };
struct Args { const float* in[N_IN]; float* out; unsigned char* ws; int ph_lo, ph_hi; };
struct KA {
    __device__ __forceinline__ const __attribute__((address_space(4))) char* base() const { const __attribute__((address_space(4))) char* p = (const __attribute__((address_space(4))) char*)__builtin_amdgcn_kernarg_segment_ptr(); asm volatile("" : "+s"(p)); return p; }
    __device__ __forceinline__ const float* in(int i) const { return *(const float* const __attribute__((address_space(4)))*)(base() + 8 * i); }
    __device__ __forceinline__ float* out() const { return *(float* const __attribute__((address_space(4)))*)(base() + 8 * N_IN); }
    __device__ __forceinline__ int ph_lo() const { return *(const int __attribute__((address_space(4)))*)(base() + 8 * N_IN + 16); }
    __device__ __forceinline__ int ph_hi() const { return *(const int __attribute__((address_space(4)))*)(base() + 8 * N_IN + 20); }
    __device__ __forceinline__ unsigned char* ws() const { return *(unsigned char* const __attribute__((address_space(4)))*)(base() + 8 * N_IN + 8); }
};

__device__ __forceinline__ int tok_batchrow(int m) { return m < TLAT ? (m >> 12) : 4; }

__host__ __device__ __forceinline__ int rope_phys(int d) { const int hf = d >> 6, dd = d & 63, i = dd & 31, second = dd >> 5; return hf * 64 + (i >> 2) * 8 + second * 4 + (i & 3); }

constexpr int CV_GU = 65 * 2 * 16, CV_DN = 65 * 16, CV_OUT = 64;
__host__ __device__ constexpr int cv_in(int l) { return (l & 1) ? 192 : 80; }
__host__ __device__ constexpr int cv_items(int l) { return CV_GU + CV_DN + cv_in(l) + CV_OUT; }
struct CvItem { const float* src; bf16_t* dst; int ldw, K, k0, n0, kind, which; };
__device__ __forceinline__ int cv_row(const CvItem& d, int n) {
    if (d.kind == 1) return (n >> 7) * 256 + d.which * 128 + (n & 127);
    if (d.kind == 2) { const int c = n - 256; return c < 1024 ? (c & ~127) + rope_phys(c & 127) : c; }
    return n;
}
__device__ __forceinline__ CvItem cv_decode(const KA& a, int l, int it) {
    CvItem d; unsigned char* ws = a.ws(); const int j = l >> 1; int r = it; d.which = 0;
    if (r < CV_GU) { const int mat = r >> 4, kb = r & 15, which = mat & 1, e = mat >> 1;
        d.src = (e < 64) ? a.in(which ? I_WU : I_WG) + ((size_t)(l * 64 + e) * DM * EDIM) : a.in(which ? I_SU : I_SG) + (size_t)l * DM * EDIM;
        d.dst = (bf16_t*)(ws + WS_WGU) + (size_t)(l * 65 + e) * 512 * DM; d.ldw = EDIM; d.K = DM; d.k0 = 64 * kb; d.n0 = 0; d.kind = 1; d.which = which; return d; }
    r -= CV_GU;
    if (r < CV_DN) { const int e = r >> 4, item = r & 15;
        d.src = (e < 64) ? a.in(I_WDN) + ((size_t)(l * 64 + e) * EDIM * DM) : a.in(I_SD) + (size_t)l * EDIM * DM;
        d.dst = (bf16_t*)(ws + WS_WD) + (size_t)(l * 65 + e) * DM * EDIM; d.ldw = DM; d.K = EDIM; d.k0 = 64 * (item >> 2); d.n0 = 256 * (item & 3); d.kind = 0; return d; }
    r -= CV_DN;
    if (r < cv_in(l)) {
        if ((l & 1) == 0) { d.src = a.in(I_ABWIN) + (size_t)j * DM * 1536; d.dst = (bf16_t*)(ws + WS_WINE) + (size_t)j * 1280 * DM; d.ldw = 1536; d.K = DM; d.k0 = 64 * (r / 5); d.n0 = 256 + 256 * (r % 5); d.kind = 2; }
        else { d.src = a.in(I_NAWIN) + (size_t)j * DM * 3072; d.dst = (bf16_t*)(ws + WS_WINO) + (size_t)j * 3072 * DM; d.ldw = 3072; d.K = DM; d.k0 = 64 * (r / 12); d.n0 = 256 * (r % 12); d.kind = 0; }
        return d; }
    r -= cv_in(l);
    d.src = ((l & 1) ? a.in(I_NAWOUT) : a.in(I_ABWOUT)) + (size_t)j * DM * DM; d.dst = (bf16_t*)(ws + WS_WOUT) + (size_t)l * DM * DM; d.ldw = DM; d.K = DM; d.k0 = 64 * (r >> 2); d.n0 = 256 * (r & 3); d.kind = 0;
    return d;
}
constexpr int CV_LS = 260;
__device__ __forceinline__ void cv_load(const CvItem& d, f32x4 (&v)[8], int t) {
    const float* p = d.src + (size_t)(d.k0 + (t >> 6)) * d.ldw + d.n0 + (t & 63) * 4;
#pragma unroll
    for (int i = 0; i < 8; ++i) v[i] = *(const f32x4*)(p + (size_t)(8 * i) * d.ldw);
}
__device__ __forceinline__ void convert_items(LAS unsigned char* lds, int l, int lo, int hi, int worker, int nworkers) {
    const KA a;
    const int t = opaque_tid();
    LAS float* img = (LAS float*)lds;
    int it = lo + worker;
    if (it >= hi) return;
    CvItem d0 = cv_decode(a, l, it); f32x4 v[8]; cv_load(d0, v, t);
    for (;;) {
        { LAS float* w = img + (t >> 6) * CV_LS + (t & 63) * 4;
#pragma unroll
          for (int i = 0; i < 8; ++i) *(LAS f32x4*)(w + i * 8 * CV_LS) = v[i]; }
        __syncthreads();
        const int itn = it + nworkers; const bool more = itn < hi;
        CvItem d1 = d0;
        if (more) { d1 = cv_decode(a, l, itn); cv_load(d1, v, t); }
        { const int n = (t >> 6) * 32 + (t & 31), qh = (t >> 5) & 1; bf16_t* orow = d0.dst + (size_t)cv_row(d0, d0.n0 + n) * d0.K + d0.k0;
#pragma unroll
          for (int p = 0; p < 4; ++p) { const int q = 2 * p + qh; const LAS float* s = img + (8 * q) * CV_LS + n;
              u32x4 o; o.x = cvt_pk_bf16(s[0 * CV_LS], s[1 * CV_LS]); o.y = cvt_pk_bf16(s[2 * CV_LS], s[3 * CV_LS]); o.z = cvt_pk_bf16(s[4 * CV_LS], s[5 * CV_LS]); o.w = cvt_pk_bf16(s[6 * CV_LS], s[7 * CV_LS]);
              *(u32x4*)(orow + 8 * q) = o; } }
        __syncthreads();
        if (!more) break;
        d0 = d1; it = itn;
    }
}
struct CvSlice { int l, i0, i1, l2, j0, j1; };
constexpr int CV_EX = CV_GU + CV_DN;
#ifndef CV_MODE
#define CV_MODE 1
#endif
__device__ __forceinline__ CvSlice cv_slice(int l, int phase  ) {
    const CvSlice none = {0, 0, 0, 0, 0, 0};
    if (CV_MODE == 0) return none;
    if (l == 0) { if (phase == 1) return {0, 0, 2000, 0, 0, 0}; if (phase == 2) return {0, 2000, 3000, 0, 0, 0};
                  if (phase == 4) return {1, CV_EX, cv_items(1), 1, 0, 744}; if (phase == 5) return {1, 744, 1144, 0, 0, 0}; }
    if (l == 1) { if (phase == 0) return {1, 1144, 2120, 0, 0, 0}; if (phase == 2) return {1, 2120, CV_EX, 0, 0, 0};
                  if (phase == 4) return {2, CV_EX, cv_items(2), 2, 0, 856}; if (phase == 5) return {2, 856, 1256, 0, 0, 0}; }
    if (l == 2) { if (phase == 1) return {2, 1256, CV_EX, 0, 0, 0}; if (phase == 2) return {3, CV_EX, cv_items(3), 3, 0, 744};
                  if (phase == 4) return {3, 744, 1744, 0, 0, 0}; if (phase == 5) return {3, 1744, 2144, 0, 0, 0}; }
    if (l == 3) { if (phase == 0) return {3, 2144, 3044, 0, 0, 0}; if (phase == 2) return {3, 3044, CV_EX, 0, 0, 0}; }
    return none;
}
__device__ __forceinline__ void cv_tail(LAS unsigned char* lds, int l, int phase, int n_units, int bid, int G) {
    const CvSlice c = cv_slice(l, phase);
    if (c.i1 <= c.i0 && c.j1 <= c.j0) return;
    const int rem = n_units % G, nw = (rem == 0) ? G : G - rem, w = (rem == 0) ? bid : bid - rem;
    if (w < 0) return;
    __syncthreads();
    if (c.i1 > c.i0) convert_items(lds, c.l, c.i0, c.i1, w, nw);
    if (c.j1 > c.j0) convert_items(lds, c.l2, c.j0, c.j1, w, nw);
}

__device__ __forceinline__ void p0_mod(const KA& a, LAS unsigned char* lds, int bid, int G, int tid, int wave, int lane) {
    LAS float* sl = (LAS float*)(lds + 69632);
    LAS float* part = (LAS float*)(lds + 69632 + 20480);
    for (int i = tid; i < 5 * DM; i += 512) { const int r = i >> 10, k = i & 1023; const float v = (r < 4) ? a.in(I_C)[r * DM + k] : a.in(I_CCTX)[k]; sl[i] = v / (1.0f + __expf(-v)); }
    __syncthreads();
    float* mod = (float*)(a.ws() + WS_MOD);
    for (int task = bid; task < DEPTH * 48; task += G) {
        const int l = task / 48, c0 = (task % 48) * 128;
        const float* w = a.in(I_WMOD) + (size_t)l * DM * 6144 + c0 + 2 * lane;
        f32x2 acc[5];
#pragma unroll
        for (int r = 0; r < 5; ++r) acc[r] = (f32x2){0.f, 0.f};
#pragma unroll 16
        for (int k = wave * 128; k < wave * 128 + 128; ++k) { const f32x2 wv = *(const f32x2*)(w + (size_t)k * 6144);
#pragma unroll
            for (int r = 0; r < 5; ++r) acc[r] += wv * sl[r * DM + k]; }
#pragma unroll
        for (int r = 0; r < 5; ++r) *(LAS f32x2*)(part + (wave * 5 + r) * 128 + 2 * lane) = acc[r];
        __syncthreads();
        for (int i = tid; i < 640; i += 512) { const int r = i >> 7, c = i & 127; float s = a.in(I_BMOD)[l * 6144 + c0 + c];
#pragma unroll
            for (int w8 = 0; w8 < 8; ++w8) s += part[(w8 * 5 + r) * 128 + c];
            mod[((size_t)l * 5 + r) * 6144 + c0 + c] = s; }
        __syncthreads();
    }
}

__device__ __forceinline__ void p0_fourier_fold(const KA& a, LAS unsigned char* lds, int task, int tid, int wave, int lane) {
    const int kq = task & 3, g = (task >> 2) & 3, q = (task >> 4) & 1, j = task >> 5;
    LAS float* M = (LAS float*)(lds + 100352);
    LAS float* trg = M + 4096;
    const float* Wf = a.in(I_ABWF) + (size_t)(j * 4 + g) * 64 * 64;
    LAS float* Wl = trg + 64;
    __syncthreads();
    if (tid < 64) { const float ang = (float)tid * (1.0f / 32.0f); trg[tid] = q ? sinpif(ang) : cospif(ang); }
    for (int i = tid; i < 1024; i += 512) *(LAS f32x4*)(Wl + 4 * i) = *(const f32x4*)(Wf + 4 * i);
    __syncthreads();
    for (int i = tid; i < 4096; i += 512) { const int c = i >> 6, d = i & 63; float s = 0.f;
#pragma unroll 8
        for (int m = 0; m < 64; ++m) s += trg[(m * c) & 63] * Wl[m * 64 + d];
        M[i] = s; }
    __syncthreads();
    float mcol[64];
#pragma unroll
    for (int c = 0; c < 64; ++c) mcol[c] = M[c * 64 + lane];
    bf16_t* dst = (bf16_t*)(a.ws() + WS_WF) + ((size_t)j * 512 + q * 256 + g * 64 + lane) * DM;
    const float* win = a.in(I_ABWIN) + (size_t)j * DM * 1536 + g * 64 + lane;
    const int kbeg = kq * 256 + wave * 32;
    float wv[32];
#pragma unroll
    for (int i = 0; i < 32; ++i) wv[i] = win[(size_t)(kbeg + i) * 1536];
#pragma unroll
    for (int i = 0; i < 32; ++i) { float s = 0.f;
#pragma unroll
        for (int c = 0; c < 64; ++c) s += __int_as_float(__builtin_amdgcn_readlane(__float_as_int(wv[i]), c)) * mcol[c];
        dst[kbeg + i] = (bf16_t)(cvt_pk_bf16(s, 0.f) & 0xffffu); }
}


__device__ __forceinline__ void p0_tables(const KA& a, LAS unsigned char* lds, int gtid, int NGT, int tid) {
    LAS float* ctab = (LAS float*)(lds + 116736);
    for (int i = tid; i < 4096; i += 512) ctab[i] = cospif((float)i * (1.0f / 2048.0f));
    __syncthreads();
    bf16_t* TW = (bf16_t*)(a.ws() + WS_TW);
    for (int it = gtid; it < 4096 * 1024; it += NGT) {
        const int k = it >> 10, c8 = (it & 1023) * 8, n0 = c8 & 4095, sh = (c8 >> 12) ? 1024 : 0; const float sg = (c8 >> 12) ? (-1.0f / 512.0f) : (1.0f / 512.0f);
        float v[8];
#pragma unroll
        for (int j = 0; j < 8; ++j) v[j] = ctab[(k * (n0 + j) - sh) & 4095] * sg;
        u32x4 o; o.x = cvt_pk_bf16(v[0], v[1]); o.y = cvt_pk_bf16(v[2], v[3]); o.z = cvt_pk_bf16(v[4], v[5]); o.w = cvt_pk_bf16(v[6], v[7]);
        *(u32x4*)(TW + (size_t)k * 8192 + c8) = o;
    }
    bf16_t* TWC = (bf16_t*)(a.ws() + WS_TWC);
    for (int it = gtid; it < 256 * 64; it += NGT) {
        const int k = it >> 6, c8 = (it & 63) * 8, n0 = c8 & 255, sh = (c8 >> 8) ? 1024 : 0; const float sg = (c8 >> 8) ? (-1.0f / 128.0f) : (1.0f / 128.0f);
        float v[8];
#pragma unroll
        for (int j = 0; j < 8; ++j) v[j] = ctab[(((k * (n0 + j)) & 255) * 16 - sh) & 4095] * sg;
        u32x4 o; o.x = cvt_pk_bf16(v[0], v[1]); o.y = cvt_pk_bf16(v[2], v[3]); o.z = cvt_pk_bf16(v[4], v[5]); o.w = cvt_pk_bf16(v[6], v[7]);
        *(u32x4*)(TWC + (size_t)k * 512 + c8) = o;
    }
    bf16_t* WH = (bf16_t*)(a.ws() + WS_WRHI); bf16_t* WL = (bf16_t*)(a.ws() + WS_WRLO);
    for (int it = gtid; it < DEPTH * 64 * DM; it += NGT) {
        const int i = it & 7, ln = (it >> 3) & 63, ks = (it >> 9) & 31, nt4 = (it >> 14) & 3, l = it >> 16, e = nt4 * 16 + (ln & 15), k = ks * 32 + (ln >> 4) * 8 + i;
        const float w = a.in(I_WR)[((size_t)l * DM + k) * 64 + e];
        const unsigned h = cvt_pk_bf16(w, 0.f) & 0xffffu; const float r = w - __uint_as_float(h << 16);
        WH[it] = (bf16_t)h; WL[it] = (bf16_t)(cvt_pk_bf16(r, 0.f) & 0xffffu);
    }
    float* gp = (float*)(a.ws() + WS_GAINP);
    for (int it = gtid; it < 2 * 2 * 128; it += NGT) { const int j = it >> 8, qk = (it >> 7) & 1, d = it & 127; gp[(j * 2 + qk) * 128 + rope_phys(d)] = a.in(qk ? I_ABKN : I_ABQN)[j * 128 + d]; }
    f32x2* rp = (f32x2*)(a.ws() + WS_ROPE);
    for (int it = gtid; it < 64 * 32; it += NGT) { const int pos = it >> 5, i = it & 31; const float inv = exp2f(-(float)i * (13.287712379549449f / 32.0f));
        const float ang = (float)pos * inv; rp[it] = (f32x2){cosf(ang), sinf(ang)}; }
}

__device__ __forceinline__ const float* xrow_in(const KA& a, int l, int m) {
    if (l == 0) return m < TLAT ? a.in(I_X) + (size_t)m * DM : a.in(I_CTX) + (size_t)(m - TLAT) * DM;
    return (const float*)(a.ws() + WS_XS) + (size_t)m * DM;
}
__device__ __forceinline__ void p0b_modulate(const KA& a, int gw, int NGW, int lane) {
    const float* mod = (const float*)(a.ws() + WS_MOD);
    bf16_t* H = (bf16_t*)(a.ws() + WS_H);
    for (int m = gw; m < TT; m += NGW) {
        const f32x4* xr = (const f32x4*)xrow_in(a, 0, m) + lane; const float* md = mod + (size_t)tok_batchrow(m) * 6144;
        u32x2* o = (u32x2*)(H + (size_t)m * DM) + lane;
#pragma unroll
        for (int j = 0; j < 4; ++j) { const f32x4 x = xr[64 * j], sh = *((const f32x4*)md + lane + 64 * j), sc = *((const f32x4*)(md + DM) + lane + 64 * j);
            const f32x4 h = x * (sc + 1.0f) + sh; o[64 * j] = (u32x2){cvt_pk_bf16(h[0], h[1]), cvt_pk_bf16(h[2], h[3])}; }
    }
}

#ifndef D_DELAY
#define D_DELAY 0
#endif
#ifndef PROBE_D
#define PROBE_D 7
#endif
__device__ __forceinline__ void phase_ln1_router(const KA& a, LAS unsigned char* lds, int l, int bid, int tid, int wave, int lane, const bool dry) {
    LAS float* lg = (LAS float*)lds;
    LAS int* hist = (LAS int*)(lds + 96 * 64 * 4);
    LAS int* pend = hist + 128;
    const float* mod = (const float*)(a.ws() + WS_MOD) + (size_t)l * 5 * 6144;
    const bf16_t* Y = (const bf16_t*)(a.ws() + WS_Y);
    float* XS = (float*)(a.ws() + (dry ? WS_ACT : WS_XS)); bf16_t* H = (bf16_t*)(a.ws() + (dry ? WS_YB + ((size_t)200 << 20) : WS_H)); bf16_t* HL = (bf16_t*)(a.ws() + (dry ? WS_YB + ((size_t)240 << 20) : WS_HL));
    if (tid < 64) hist[tid] = 0;
    const int NTOK = (l == DEPTH - 1) ? 64 : 68;
    const int tok0 = bid * NTOK;
    if (!dry || (PROBE_D & 1)) {
        f32x4 lng[4], lnb[4], g1[4], sc2[4], sh2[4];
        { const f32x4* pg = (const f32x4*)(a.in(I_LN1G) + l * DM) + lane; const f32x4* pb = (const f32x4*)(a.in(I_LN1B) + l * DM) + lane;
#pragma unroll
          for (int j = 0; j < 4; ++j) { lng[j] = pg[64 * j]; lnb[j] = pb[64 * j]; } }
        int cur_br = -1;
        f32x4 xn[4]; u32x2 yn[4];
        { const int m = tok0 + wave; const f32x4* xr = (const f32x4*)xrow_in(a, l, m) + lane; const u32x2* yr = (const u32x2*)(Y + (size_t)m * DM) + lane;
#pragma unroll
          for (int j = 0; j < 4; ++j) { xn[j] = xr[64 * j]; yn[j] = yr[64 * j]; } }
        for (int r = wave; r < NTOK; r += 8) {
            const int m = tok0 + r, br = tok_batchrow(m);
            if (br != cur_br) { cur_br = br; const float* md = mod + (size_t)br * 6144;
#pragma unroll
                for (int j = 0; j < 4; ++j) { g1[j] = *((const f32x4*)(md + 2 * DM) + lane + 64 * j); sh2[j] = *((const f32x4*)(md + 3 * DM) + lane + 64 * j); sc2[j] = *((const f32x4*)(md + 4 * DM) + lane + 64 * j) + 1.0f; } }
            f32x4 v[4]; float s = 0.f;
#pragma unroll
            for (int j = 0; j < 4; ++j) { const f32x4 y = {bf_lo(yn[j].x), bf_hi(yn[j].x), bf_lo(yn[j].y), bf_hi(yn[j].y)}; v[j] = xn[j] * DN_ALPHA + g1[j] * y; s += (v[j][0] + v[j][1]) + (v[j][2] + v[j][3]); }
            if (r + 8 < NTOK) { const int mn = m + 8; const f32x4* xr = (const f32x4*)xrow_in(a, l, mn) + lane; const u32x2* yr = (const u32x2*)(Y + (size_t)mn * DM) + lane;
#pragma unroll
                for (int j = 0; j < 4; ++j) { xn[j] = xr[64 * j]; yn[j] = yr[64 * j]; } }
            const float mean = wave_sum(s) * (1.0f / DM); float s2 = 0.f;
#pragma unroll
            for (int j = 0; j < 4; ++j) { v[j] = v[j] - mean; s2 += (v[j][0] * v[j][0] + v[j][1] * v[j][1]) + (v[j][2] * v[j][2] + v[j][3] * v[j][3]); }
            const float rstd = __builtin_amdgcn_rsqf(wave_sum(s2) * (1.0f / DM) + LN_EPS);
            f32x4* xo = (f32x4*)(XS + (size_t)m * DM) + lane; u32x2* ho = (u32x2*)(H + (size_t)m * DM) + lane; u32x2* hl = (u32x2*)(HL + (size_t)m * DM) + lane;
#pragma unroll
            for (int j = 0; j < 4; ++j) { const f32x4 x1 = v[j] * rstd * lng[j] + lnb[j]; xo[64 * j] = x1;
                const f32x4 h = x1 * sc2[j] + sh2[j];
                const unsigned h01 = cvt_pk_bf16(h[0], h[1]), h23 = cvt_pk_bf16(h[2], h[3]);
                ho[64 * j] = (u32x2){h01, h23};
                hl[64 * j] = (u32x2){cvt_pk_bf16(h[0] - bf_lo(h01), h[1] - bf_hi(h01)), cvt_pk_bf16(h[2] - bf_lo(h23), h[3] - bf_hi(h23))}; }
        }
    }
    VM_WAIT(); __syncthreads();
    if (D_DELAY) { const unsigned long long t0d = __builtin_amdgcn_s_memrealtime(); while (__builtin_amdgcn_s_memrealtime() - t0d < (unsigned long long)D_DELAY) __builtin_amdgcn_s_sleep(16); }
    TS(4);
    __builtin_amdgcn_fence(__ATOMIC_ACQUIRE, "agent"); VM_WAIT();
    if (!dry || (PROBE_D & 2)) {
        const bf16_t* WH = (const bf16_t*)(a.ws() + WS_WRHI) + (size_t)l * 64 * DM; const bf16_t* WL = (const bf16_t*)(a.ws() + WS_WRLO) + (size_t)l * 64 * DM;
        const int ntile = wave & 3, mt0 = wave >> 2, fr = lane & 15, fq = lane >> 4;
        constexpr int AQ = 264;
        LAS bf16_t* Ahi = (LAS bf16_t*)(lds + 32768); LAS bf16_t* Alo = Ahi + 80 * AQ;
        f32x4 acc[3];
#pragma unroll
        for (int i = 0; i < 3; ++i) acc[i] = (f32x4){0.f, 0.f, 0.f, 0.f};
        bf16x8 rh[5], rl[5];
#define D_FETCH(KQ) do { _Pragma("unroll") for (int ii = 0; ii < 5; ++ii) { const int p = tid + 512 * ii; if (p < NTOK * 32) { const size_t g = (size_t)(tok0 + (p >> 5)) * DM + (KQ) * 256 + (p & 31) * 8; \
            rh[ii] = *(const bf16x8*)(H + g); rl[ii] = *(const bf16x8*)(HL + g); } } } while (0)
        D_FETCH(0);
#pragma unroll 1
        for (int kq = 0; kq < 4; ++kq) {
            bf16x8 bh[8], bl[8];
#pragma unroll
            for (int q = 0; q < 8; ++q) { const size_t fo = (((size_t)ntile * 32 + kq * 8 + q) * 64 + lane) * 8; bh[q] = *(const bf16x8*)(WH + fo); bl[q] = *(const bf16x8*)(WL + fo); }
            __syncthreads();
#pragma unroll
            for (int ii = 0; ii < 5; ++ii) { const int p = tid + 512 * ii; if (p < NTOK * 32) { *(LAS bf16x8*)(Ahi + (p >> 5) * AQ + (p & 31) * 8) = rh[ii]; *(LAS bf16x8*)(Alo + (p >> 5) * AQ + (p & 31) * 8) = rl[ii]; } }
            __syncthreads();
            if (kq < 3) D_FETCH(kq + 1);
#pragma unroll
            for (int q = 0; q < 8; ++q)
#pragma unroll
                for (int i = 0; i < 3; ++i) if (i < 2 || mt0 == 0) {
                    const bf16x8 ahv = *(const LAS bf16x8*)(Ahi + ((mt0 + 2 * i) * 16 + fr) * AQ + q * 32 + fq * 8), alv = *(const LAS bf16x8*)(Alo + ((mt0 + 2 * i) * 16 + fr) * AQ + q * 32 + fq * 8);
                    acc[i] = __builtin_amdgcn_mfma_f32_16x16x32_bf16(ahv, bh[q], acc[i], 0, 0, 0);
                    acc[i] = __builtin_amdgcn_mfma_f32_16x16x32_bf16(ahv, bl[q], acc[i], 0, 0, 0);
                    acc[i] = __builtin_amdgcn_mfma_f32_16x16x32_bf16(alv, bh[q], acc[i], 0, 0, 0); }
        }
#undef D_FETCH
#pragma unroll
        for (int i = 0; i < 3; ++i) if (i < 2 || mt0 == 0)
#pragma unroll
            for (int q = 0; q < 4; ++q) lg[((mt0 + 2 * i) * 16 + fq * 4 + q) * 64 + ntile * 16 + fr] = acc[i][q];
    }
    __syncthreads(); TS(5);
    if (!dry || (PROBE_D & 4)) {
        int* tke = (int*)(a.ws() + WS_TKE); float* tkw = (float*)(a.ws() + WS_TKW);
        const float ebias = a.in(I_EBIAS)[l * 64 + lane];
        for (int r = wave; r < NTOK; r += 8) {
            const int m = tok0 + r;
            const float score = 1.0f / (1.0f + __expf(-lg[r * 64 + lane]));
            const float sel = score + ebias; int rank = 0;
#pragma unroll
            for (int c = 0; c < 64; ++c) { const float o = __int_as_float(__builtin_amdgcn_readlane(__float_as_int(sel), c)); rank += (o > sel || (o == sel && c < lane)) ? 1 : 0; }
            const bool mine = rank < TOPK;
            const unsigned long long taken = __ballot(mine);
            const float wsum = wave_sum(mine ? score : 0.f);
            if (mine) { const int k = __popcll(taken & ((1ull << lane) - 1ull)); const int lr = __hip_atomic_fetch_add(&hist[lane], 1, __ATOMIC_RELAXED, __HIP_MEMORY_SCOPE_WORKGROUP);
                if (!dry) { tke[m * 8 + k] = lane; tkw[m * 8 + k] = score / wsum * ROUTE_SCALE; } pend[r * 8 + k] = (lane << 16) | lr; }
        }
    }
    __syncthreads();
    if (dry) return;
    { unsigned* cnt = (unsigned*)(a.ws() + WS_CTL) + CW_CNT + l * 64;
      if (tid < 64) hist[64 + tid] = (int)atomicAdd(&cnt[tid], (unsigned)hist[tid]); }
    __syncthreads();
    { int* tkp = (int*)(a.ws() + WS_TKP); int* list = (int*)(a.ws() + WS_LIST);
      for (int i = tid; i < NTOK * 8; i += 512) { const int pe = pend[i], e = pe >> 16, p = hist[64 + e] + (pe & 0xffff); const int m = tok0 + (i >> 3);
        tkp[m * 8 + (i & 7)] = p; list[(size_t)e * TT + p] = m; } }
    __syncthreads();
}

constexpr float YB_SCALE_G = 32.0f;
__device__ __forceinline__ void phase_combine_ln2(const KA& a, LAS unsigned char* lds, int l, int gw, int NGW, int tid, int lane, const bool dry) {
    LAS int* rst = (LAS int*)(lds + LDS_TAB) + 66;
    const float* mod = (const float*)(a.ws() + WS_MOD) + (size_t)l * 5 * 6144;
    const unsigned char* YB = (const unsigned char*)(a.ws() + WS_YB);
    const float* XSi = (const float*)(a.ws() + WS_XS); float* XS = (float*)(a.ws() + (dry ? WS_ACT : WS_XS)); bf16_t* H = (bf16_t*)(a.ws() + (dry ? WS_HL : WS_H));
    const int* tke = (const int*)(a.ws() + WS_TKE); const float* tkw = (const float*)(a.ws() + WS_TKW); const int* tkp = (const int*)(a.ws() + WS_TKP);
    const int mend = (l == DEPTH - 1) ? TLAT : TT;
    const int e0 = 16 * lane;
    f32x4 lng[4], lnb[4];
    { const f32x4* pg = (const f32x4*)(a.in(I_LN2G) + l * DM + e0); const f32x4* pb = (const f32x4*)(a.in(I_LN2B) + l * DM + e0);
#pragma unroll
      for (int j = 0; j < 4; ++j) { lng[j] = pg[j]; lnb[j] = pb[j]; } }
    float* outp = dry ? (float*)(a.ws() + WS_ACT) : a.out();
#define G_SLOTS(M0, SLOT, W) do { _Pragma("unroll") for (int q = 0; q < 2; ++q) { const int mq = (q == 0 || (M0) + NGW < mend) ? (M0) + q * NGW : (M0); SLOT[q] = 0; W[q] = 1.0f / YB_SCALE_G; \
        if ((M0) < mend) { if (lane < 8) { SLOT[q] = rst[tke[mq * 8 + lane]] + tkp[mq * 8 + lane]; W[q] = tkw[mq * 8 + lane] * (1.0f / YB_SCALE_G); } if (lane == 8) SLOT[q] = rst[64] + mq; } } } while (0)
    int slotn[2]; float wn[2];
    G_SLOTS(gw, slotn, wn);
    for (int m0 = gw; m0 < mend; m0 += 2 * NGW) {
        int mm[2]; mm[0] = m0; mm[1] = (m0 + NGW < mend) ? m0 + NGW : m0;
        const bool two = (m0 + NGW < mend);
        int slot[2]; float w[2];
        slot[0] = slotn[0]; slot[1] = slotn[1]; w[0] = wn[0]; w[1] = wn[1];
        G_SLOTS(m0 + 2 * NGW, slotn, wn);
        f32x4 ff[2][4]; f32x4 xv[2][4];
#pragma unroll
        for (int q = 0; q < 2; ++q) { const f32x4* xi = (const f32x4*)(XSi + (size_t)mm[q] * DM + e0);
#pragma unroll
            for (int j = 0; j < 4; ++j) { ff[q][j] = (f32x4){0.f, 0.f, 0.f, 0.f}; xv[q][j] = xi[j]; } }
        u32x4 yy[2][9];
#pragma unroll
        for (int k = 0; k < 9; ++k)
#pragma unroll
            for (int q = 0; q < 2; ++q) { const int sk = __builtin_amdgcn_readlane(slot[q], k); yy[q][k] = *(const u32x4*)(YB + (size_t)sk * DM + e0); }
#pragma unroll
        for (int k = 0; k < 9; ++k)
#pragma unroll
            for (int q = 0; q < 2; ++q) { const float wk = __int_as_float(__builtin_amdgcn_readlane(__float_as_int(w[q]), k));
#pragma unroll
                for (int j = 0; j < 4; ++j) { const f32x2 lo2 = __builtin_amdgcn_cvt_pk_f32_fp8((int)yy[q][k][j], false), hi2 = __builtin_amdgcn_cvt_pk_f32_fp8((int)yy[q][k][j], true);
                    ff[q][j] += (f32x4){lo2.x, lo2.y, hi2.x, hi2.y} * wk; } }
#pragma unroll
        for (int q = 0; q < 2; ++q) {
            if (q == 1 && !two) break;
            const int m = mm[q]; const float* md = mod + (size_t)tok_batchrow(m) * 6144;
            f32x4 v[4]; float s = 0.f;
#pragma unroll
            for (int j = 0; j < 4; ++j) { const f32x4 g2 = *((const f32x4*)(md + 5 * DM + e0) + j);
                v[j] = xv[q][j] * DN_ALPHA + g2 * ff[q][j]; s += (v[j][0] + v[j][1]) + (v[j][2] + v[j][3]); }
            const float mean = wave_sum(s) * (1.0f / DM); float s2 = 0.f;
#pragma unroll
            for (int j = 0; j < 4; ++j) { v[j] = v[j] - mean; s2 += (v[j][0] * v[j][0] + v[j][1] * v[j][1]) + (v[j][2] * v[j][2] + v[j][3] * v[j][3]); }
            const float rstd = __builtin_amdgcn_rsqf(wave_sum(s2) * (1.0f / DM) + LN_EPS);
            if (l == DEPTH - 1) {
                f32x4* oo = (f32x4*)(outp + (size_t)m * DM + e0);
#pragma unroll
                for (int j = 0; j < 4; ++j) oo[j] = v[j] * rstd * lng[j] + lnb[j];
            } else {
                const float* mdn = md + 5 * 6144;
                f32x4* xio = (f32x4*)(XS + (size_t)m * DM + e0); u32x4* ho = (u32x4*)(H + (size_t)m * DM + e0);
                unsigned hp[8];
#pragma unroll
                for (int j = 0; j < 4; ++j) { const f32x4 x2 = v[j] * rstd * lng[j] + lnb[j]; xio[j] = x2;
                    const f32x4 sh = *((const f32x4*)(mdn + e0) + j), sc = *((const f32x4*)(mdn + DM + e0) + j);
                    const f32x4 h = x2 * (sc + 1.0f) + sh; hp[2 * j] = cvt_pk_bf16(h[0], h[1]); hp[2 * j + 1] = cvt_pk_bf16(h[2], h[3]); }
                ho[0] = (u32x4){hp[0], hp[1], hp[2], hp[3]}; ho[1] = (u32x4){hp[4], hp[5], hp[6], hp[7]};
            }
        }
    }
#undef G_SLOTS
}

__device__ __forceinline__ void build_expert_tables(const KA& a, LAS unsigned char* lds, int l, int tid) {
    LAS int* tst = (LAS int*)(lds + LDS_TAB); LAS int* rst = tst + 66; LAS int* cn = rst + 66;
    __syncthreads();
    if (tid < 64) {
        const unsigned* cnt = (const unsigned*)(a.ws() + WS_CTL) + CW_CNT + l * 64;
        const int c = (int)__hip_atomic_load(cnt + tid, __ATOMIC_RELAXED, __HIP_MEMORY_SCOPE_AGENT);
        int t = (c + 255) >> 8, r = c;
#pragma unroll
        for (int o = 1; o < 64; o <<= 1) { const int t2 = __shfl_up(t, o), r2 = __shfl_up(r, o); if (tid >= o) { t += t2; r += r2; } }
        tst[tid] = t - ((c + 255) >> 8); rst[tid] = r - c; cn[tid] = c;
        const int nsh = (l == DEPTH - 1) ? TLAT : TT;
        if (tid == 63) { tst[64] = t; rst[64] = r; cn[64] = nsh; tst[65] = t + (nsh >> 8); rst[65] = r + nsh; }
    }
    __syncthreads();
}

struct Seg {
    int i0, c, G, first, n;
    __device__ __forceinline__ void init(int first_, int n_, int c_, int G_) { first = first_; n = n_; c = c_; G = G_; i0 = (first_ <= c_) ? 0 : (first_ - c_ + G_ - 1) / G_; }
    __device__ __forceinline__ int idx(int i) const { const int L = (i0 + i) * G + c - first; return L < n ? L : -1; }
};
__device__ __forceinline__ int kv_row0(int pm) { return pm < 64 ? (pm >> 4) * KVR + (pm & 15) * 256 : (pm - 64) * KVR + LSEQ; }

struct SchedQKVE { Seg s; unsigned char* ws; int j;
    __device__ __forceinline__ bool next(int i, pg8::Unit& u) { const int L0 = s.idx(i); if (L0 < 0) return false;
        size_t offA, offB, offC; int ldc, x0, x1 = 0;
        if (L0 >= 340) { const int L = L0 - 340; x0 = 3;
            if (L < 128) { const int q = L >> 6, mt = L & 63, b = mt >> 4;
                offA = WS_WF + ((size_t)j * 512 + q * 256) * 2048; offB = WS_H + (size_t)mt * 256 * 2048; offC = WS_ZT + ((size_t)b * 256 * 8192 + q * 4096 + (mt & 15) * 256) * 2; ldc = 8192; }
            else { const int q = (L - 128) >> 2, b = (L - 128) & 3;
                offA = WS_WF + ((size_t)j * 512 + q * 256) * 2048; offB = WS_H + (size_t)(TLAT + b * 256) * 2048; offC = WS_ZCT + ((size_t)b * 256 * 512 + q * 256) * 2; ldc = 512; }
        } else { const int pm = L0 % 68, pn = L0 / 68;
            offA = WS_H + (size_t)pm * 256 * 2048; offB = WS_WINE + ((size_t)j * 1280 + pn * 256) * 2048; x1 = pm < 64 ? (pm & 15) * 256 : -1;
            if (pn < 3) { offC = WS_QB + ((size_t)pm * 256 * 768 + pn * 256) * 2; ldc = 768; x0 = 0; }
            else { offC = (pn == 3 ? WS_KB : WS_VB) + (size_t)kv_row0(pm) * 128 * 2; ldc = 128; x0 = pn - 2; } }
        u.A = (const char*)(ws + offA); u.B = (const char*)(ws + offB); u.C = (char*)(ws + offC); u.ldc = ldc; u.x0 = x0; u.x1 = x1; u.rows = nullptr; u.nvalid = 256;
        return true; } };
struct SchedQKVO { Seg s; unsigned char* ws; int j;
    __device__ __forceinline__ bool next(int i, pg8::Unit& u) { const int L = s.idx(i); if (L < 0) return false; const int pm = L % 68, pn = L / 68;
        u.A = (const char*)(ws + WS_H) + (size_t)pm * 256 * 2048; u.B = (const char*)(ws + WS_WINO) + ((size_t)j * 3072 + pn * 256) * 2048; u.rows = nullptr; u.nvalid = 256; u.x0 = 0; u.x1 = 0; u.ldc = 1024;
        if (pn < 4) u.C = (char*)(ws + WS_QB) + ((size_t)pm * 256 * 1024 + pn * 256) * 2;
        else u.C = (char*)(ws + (pn < 8 ? WS_KB : WS_VB)) + ((size_t)kv_row0(pm) * 1024 + (pn & 3) * 256) * 2;
        return true; } };
struct SchedDFT { Seg s; unsigned char* ws;
    __device__ __forceinline__ bool next(int i, pg8::Unit& u) { const int L = s.idx(i); if (L < 0) return false; const int pm = L & 15, b = L >> 4;
        u.A = (const char*)(ws + WS_TW) + (size_t)pm * 256 * 16384; u.B = (const char*)(ws + WS_ZT) + (size_t)b * 256 * 16384;
        u.C = (char*)(ws + WS_O) + (size_t)(b * LSEQ + pm * 256) * 1024 * 2; u.ldc = 1024; u.rows = nullptr; u.nvalid = 256; u.x0 = 0; u.x1 = 0; return true; } };
struct SchedDFTC { Seg s; unsigned char* ws;
    __device__ __forceinline__ bool next(int i, pg8::Unit& u) { const int b = s.idx(i); if (b < 0) return false;
        u.A = (const char*)(ws + WS_TWC); u.B = (const char*)(ws + WS_ZCT) + (size_t)b * 256 * 1024;
        u.C = (char*)(ws + WS_O) + (size_t)(TLAT + b * 256) * 1024 * 2; u.ldc = 1024; u.rows = nullptr; u.nvalid = 256; u.x0 = 0; u.x1 = 0; return true; } };
struct SchedOUT { Seg s; unsigned char* ws; int l, nm;
    __device__ __forceinline__ bool next(int i, pg8::Unit& u) { const int L = s.idx(i); if (L < 0) return false; const int pm = L % nm, pn = L / nm;
        u.A = (const char*)(ws + WS_O) + (size_t)pm * 256 * 2048; u.B = (const char*)(ws + WS_WOUT) + ((size_t)l * 1024 + pn * 256) * 2048;
        u.C = (char*)(ws + WS_Y) + ((size_t)pm * 256 * 1024 + pn * 256) * 2; u.ldc = 1024; u.rows = nullptr; u.nvalid = 256; u.x0 = 0; u.x1 = 0; return true; } };
struct SchedGU { Seg s; unsigned char* ws; int l; const LAS int* tab; int e; int L0, cnt; int probe;
    __device__ __forceinline__ bool next(int i, pg8::Unit& u) { const int L = cnt > 0 ? (i < cnt ? L0 + i : -1) : s.idx(i); if (L < 0) return false; const int mtg = L >> 1, nt = L & 1;
        while (tab[e + 1] <= mtg) ++e;
        while (tab[e] > mtg) --e;
        const int mt = mtg - tab[e], r0 = tab[66 + e] + mt * 256;
        u.A = (const char*)(ws + WS_H); u.rows = (const int*)(ws + WS_LIST) + (size_t)e * TT + mt * 256; u.nvalid = min(256, tab[132 + e] - mt * 256);
        u.B = (const char*)(ws + WS_WGU) + ((size_t)(l * 65 + e) * 512 + nt * 256) * 2048;
        u.C = (char*)(ws + WS_ACT) + ((size_t)r0 * 256 + nt * 128) * 2; u.ldc = 256; u.x0 = 0; u.x1 = 0;
        if (probe & 1) u.rows = (const int*)(ws + WS_LIST) + (size_t)64 * TT + (mtg & 63) * 256;
        if (probe & 2) u.nvalid = 0;
        return true; } };
struct SchedDN { Seg s; unsigned char* ws; int l; const LAS int* tab; int e; int probe; int L0, cnt;
    __device__ __forceinline__ bool next(int i, pg8::Unit& u) { const int L = cnt > 0 ? (i < cnt ? L0 + i : -1) : s.idx(i); if (L < 0) return false; const int mtg = L >> 2, nt = L & 3;
        while (tab[e + 1] <= mtg) ++e;
        while (tab[e] > mtg) --e;
        const int mt = mtg - tab[e], r0 = tab[66 + e] + mt * 256;
        u.A = (const char*)(ws + WS_ACT) + (size_t)r0 * 512; u.rows = nullptr; u.nvalid = min(256, tab[132 + e] - mt * 256);
        u.B = (const char*)(ws + WS_WD) + ((size_t)(l * 65 + e) * 1024 + nt * 256) * 512;
        u.C = (char*)(ws + WS_YB) + ((size_t)r0 * 1024 + nt * 256); u.ldc = 1024; u.x0 = 0; u.x1 = 0;
        if (probe & 1) u.nvalid = 0;
        if (probe & 2) { u.A = (const char*)(ws + WS_ACT); u.B = (const char*)(ws + WS_WD) + (size_t)(l * 65) * 1024 * 512; }
        return true; } };

constexpr int NPHASE = 2 + 7 * DEPTH;
#ifndef PHMASK
#define PHMASK 0xFFFFF
#endif
#define SITE(b) if constexpr ((PHMASK >> (b)) & 1)
#ifndef REP_A
#define REP_A 1
#endif
#ifndef REP_B
#define REP_B 1
#endif
#ifndef REP_BO
#define REP_BO 1
#endif
#ifndef REP_C
#define REP_C 1
#endif
#ifndef REP_E
#define REP_E 1
#endif
#ifndef REP_F
#define REP_F 1
#endif
#ifndef REP_D
#define REP_D 1
#endif
#ifndef REP_G
#define REP_G 1
#endif
#ifndef REP_BAR
#define REP_BAR 1
#endif
#ifndef PROBE_TS_SCALE
#define PROBE_TS_SCALE 0.0002f
#endif
#ifndef PROBE_TS_A
#define PROBE_TS_A 0
#endif
#ifndef PROBE_TS_B
#define PROBE_TS_B 1
#endif
#ifndef EF_FUSED
#define EF_FUSED 0
#endif
#ifndef E_STAGGER
#define E_STAGGER 0
#endif
#ifndef PROBE_E
#define PROBE_E 0
#endif
#ifndef PROBE_F
#define PROBE_F 0
#endif
#ifndef REP_P0
#define REP_P0 1
#endif
__global__ void __launch_bounds__(512, 2) fwd(Args args_) {
    extern __shared__ __attribute__((aligned(16))) unsigned char lds_raw[];
    LAS unsigned char* lds = (LAS unsigned char*)lds_raw;
    const int G = gridDim.x, bid = ((G & 7) == 0) ? (int)(blockIdx.x & 7) * (G >> 3) + (int)(blockIdx.x >> 3) : (int)blockIdx.x;
#define tid (opaque_tid())
#define lane (opaque_tid() & 63)
#define wave (__builtin_amdgcn_readfirstlane(opaque_tid() >> 6))
    const KA a;
#define WSP (a.ws())
#define args a
    volatile LAS unsigned* MISC = (volatile LAS unsigned*)(lds + LDS_MISC);
    { const int t0 = threadIdx.x; if (t0 < 64) MISC[t0] = 0u; }
    __syncthreads();
    if (PROBE_TS && threadIdx.x == 0) *(volatile LAS unsigned long long*)(lds + LDS_MISC + 192) = __builtin_amdgcn_s_memrealtime();
#define lo (a.ph_lo())
#define hi (a.ph_hi())
    XcdBarrier bar; bar.bar = (unsigned*)(WSP + WS_CTL) + CW_BAR; bar.x = 0; bar.st = MISC + 8;
    if (hi - lo > 1) bar = xcd_barrier_post((unsigned*)(WSP + WS_CTL) + CW_BAR, MISC + 8);
#define IN(k) (lo <= (k) && (k) < hi)
#define SEAM(k) do { if (IN(k) && IN((k) + 1)) for (int rb = 0; rb < REP_BAR; ++rb) xcd_barrier(bar); TS(((k) < 2) ? 16 : 17 + ((k) - 2) % 7); } while (0)
    const int NGW = G * 8;
#define gw (bid * 8 + wave)

    if (IN(0)) SITE(0) for (int rep = 0; rep < REP_P0; ++rep) {
        __syncthreads();
        p0_mod(args, lds, bid, G, tid, wave, lane);
        if (bid >= G - 64) p0_fourier_fold(args, lds, G - 1 - bid, tid, wave, lane);
        p0_tables(args, lds, bid * 512 + tid, G * 512, tid);
        { int* ident = (int*)(WSP + WS_LIST) + (size_t)NEXP * TT; for (int i = bid * 512 + tid; i < TT; i += G * 512) ident[i] = i; }
        __syncthreads();
        if (CV_MODE == 0) convert_items(lds, 0, 0, cv_items(0), bid, G);
        else { convert_items(lds, 0, CV_EX, cv_items(0), bid, G); convert_items(lds, 0, 3000, CV_EX, bid, G); }
        if (CV_MODE == 0) { for (int lq = 1; lq < DEPTH; ++lq) convert_items(lds, lq, 0, cv_items(lq), bid, G); }
    }
    TS(0); SEAM(0);
    if (IN(1)) SITE(0) p0b_modulate(args, gw, NGW, lane);
    TS(0); SEAM(1);

    for (int l = 0; l < DEPTH; ++l) {
        const int pb = 2 + 7 * l, j = l >> 1;
        if (IN(pb + 0)) for (int rep = 0; rep < REP_A; ++rep) {
            if ((l & 1) == 0) {
                SITE(1) { SchedQKVE S; S.s.init(0, 476, bid, G); S.ws = WSP; S.j = j;
                  pg8::EpiQKVE E; E.P = (LAS float*)(lds + LDS_EPI); E.gainp = (const float*)(WSP + WS_GAINP) + j * 256; E.rope = (const f32x2*)(WSP + WS_ROPE);
                  pg8::gemm_phase<pg8::EpiQKVE, SchedQKVE, false>(lds, 1024, S, E); }
            } else SITE(3) {
                SchedQKVO S; S.s.init(0, 816, bid, G); S.ws = WSP; S.j = j; pg8::EpiStore E;
                pg8::gemm_phase<pg8::EpiStore, SchedQKVO, false>(lds, 1024, S, E);
                if (rep == 0) cv_tail(lds, l, 0, 816, bid, G);
            }
        }
        TS(1); SEAM(pb + 0);
        if (IN(pb + 1)) for (int rep = 0; rep < ((l & 1) ? REP_BO : REP_B); ++rep) {
            __syncthreads();
            const bf16_t* QB = (const bf16_t*)(WSP + WS_QB); const bf16_t* KB = (const bf16_t*)(WSP + WS_KB); const bf16_t* VB = (const bf16_t*)(WSP + WS_VB); bf16_t* O = (bf16_t*)(WSP + WS_O);
            if ((l & 1) == 0) {
                SITE(4) { SchedDFT S; S.s.init(0, 64, bid, G); S.ws = WSP; pg8::EpiStore E; pg8::gemm_phase<pg8::EpiStore, SchedDFT, false>(lds, 8192, S, E); }
                SITE(5) { SchedDFTC S; S.s.init(28, 4, bid, G); S.ws = WSP; pg8::EpiStore E; pg8::gemm_phase<pg8::EpiStore, SchedDFTC, false>(lds, 512, S, E); }
                __syncthreads();
                if (bid < 64 && rep == 0) { const CvSlice c = cv_slice(l, 1); if (c.i1 > c.i0) { __syncthreads(); convert_items(lds, c.l, c.i0, c.i1, bid, 64); __syncthreads(); } }
                SITE(6) {
                    int u = (bid < 24) ? bid : (bid >= 64 ? bid - 40 : 408);
                    while (u < 408) {
                        const bf16_t *q, *k, *v; bf16_t* o; int ntile;
                        if (u < 24) { const int b = u / 6, h = u % 6; q = QB + (TLAT + b * 256) * 768 + h * 128; k = KB + ((h / 3) * NB * KVR + b * KVR + LSEQ) * 128; v = VB + ((h / 3) * NB * KVR + b * KVR + LSEQ) * 128;
                            o = O + (TLAT + b * 256) * 1024 + 256 + h * 128; ntile = 4; u = 408; }
                        else { const int uu = u - 24, bk = uu / 48, x = uu % 48, b = bk >> 1, kvh = bk & 1, h = kvh * 3 + x / 16, qb = x & 15;
                            q = QB + (b * LSEQ + qb * 256) * 768 + h * 128; k = KB + (kvh * NB * KVR + b * KVR) * 128; v = VB + (kvh * NB * KVR + b * KVR) * 128;
                            o = O + (b * LSEQ + qb * 256) * 1024 + 256 + h * 128; ntile = 68; u += 192; }
                        att::attn_body<false, 768, 128, 1024>(q, k, v, o, ntile, 0, 0, 0, (char*)lds_raw);
                    }
                }
            } else {
                const float* rpb = a.in(I_NARPB) + (size_t)j * 8 * 465;
                LAS float* bt = (LAS float*)(lds + att::LDS_BIAS);
                SITE(7) for (int u = bid; u < ((l == DEPTH - 1) ? 512 : 544); u += G) {
                    const bf16_t *q, *k, *v; bf16_t* o; int ntile, nloc, bs, q0r, h;
                    if (u < 512) { const int bh = u >> 4, blk = u & 15, b = bh >> 3; h = bh & 7; bs = min(max(4 * blk - 4, 0), 52); q0r = 4 * blk; ntile = 16; nloc = 12;
                        q = QB + (b * LSEQ + blk * 256) * 1024 + h * 128; k = KB + b * KVR * 1024 + h * 128; v = VB + b * KVR * 1024 + h * 128; o = O + (b * LSEQ + blk * 256) * 1024 + h * 128; }
                    else { const int b = (u - 512) >> 3; h = u & 7; bs = 0; q0r = 0; ntile = 4; nloc = 0;
                        q = QB + (TLAT + b * 256) * 1024 + h * 128; k = KB + b * KVR * 1024 + h * 128; v = VB + b * KVR * 1024 + h * 128; o = O + (TLAT + b * 256) * 1024 + h * 128; }
                    for (int i = tid; i < 465; i += 512) bt[64 + i] = rpb[h * 465 + i] * (1.0f / ATT_SCALE);
                    att::attn_body<true, 1024, 1024, 1024>(q, k, v, o, ntile, nloc, bs, q0r, (char*)lds_raw);
                }
            }
        }
        TS(2); SEAM(pb + 1);
        if (IN(pb + 2)) SITE(9) for (int rep = 0; rep < REP_C; ++rep) { const int nm = (l == DEPTH - 1) ? 64 : 68;
            SchedOUT S; S.s.init(0, nm * 4, bid, G); S.ws = WSP; S.l = l; S.nm = nm; pg8::EpiStore E; pg8::gemm_phase<pg8::EpiStore, SchedOUT, false>(lds, 1024, S, E);
            if (rep == 0) cv_tail(lds, l, 2, nm * 4, bid, G); }
        TS(3); SEAM(pb + 2);
        if (IN(pb + 3)) SITE(10) for (int rep = 0; rep < REP_D; ++rep) { __syncthreads(); phase_ln1_router(args, lds, l, bid, tid, wave, lane, rep + 1 < REP_D); }
        TS(6); SEAM(pb + 3);
#if EF_FUSED
        if (IN(pb + 4)) SITE(11) for (int rep = 0; rep < REP_E; ++rep) { build_expert_tables(args, lds, l, tid);
            const LAS int* tab = (const LAS int*)(lds + LDS_TAB);
            const int nsu = tab[65]; int ecur = 0;
            for (int su = bid; su < nsu; su += G) {
                { SchedGU S; S.s.init(0, 0, bid, G); S.ws = WSP; S.l = l; S.tab = tab; S.e = ecur; S.L0 = su * 2; S.cnt = 2; S.probe = 0; pg8::EpiSwiGLU E;
                  pg8::gemm_phase<pg8::EpiSwiGLU, SchedGU, true>(lds, 1024, S, E); ecur = S.e; }
                VM_WAIT(); __syncthreads();
                __builtin_amdgcn_fence(__ATOMIC_ACQUIRE, "agent"); VM_WAIT();
                { SchedDN S; S.s.init(0, 0, bid, G); S.ws = WSP; S.l = l; S.tab = tab; S.e = ecur; S.probe = 0; S.L0 = su * 4; S.cnt = 4; pg8::EpiStoreF8 E;
                  int k256 = 256; asm volatile("" : "+s"(k256));
                  pg8::gemm_phase<pg8::EpiStoreF8, SchedDN, false>(lds, k256, S, E); }
            }
            if (rep == 0) { cv_tail(lds, l, 4, nsu, bid, G); cv_tail(lds, l, 5, nsu, bid, G); } }
        TS(7); SEAM(pb + 4);
        if (IN(pb + 5) && !IN(pb + 4)) {}
#else
        if (IN(pb + 4)) SITE(11) for (int rep = 0; rep < REP_E; ++rep) { build_expert_tables(args, lds, l, tid);
            const LAS int* tab = (const LAS int*)(lds + LDS_TAB);
            if (E_STAGGER && (bid & 1) && bid >= 8) { const unsigned long long t0s = __builtin_amdgcn_s_memrealtime(); while (__builtin_amdgcn_s_memrealtime() - t0s < (unsigned long long)E_STAGGER) __builtin_amdgcn_s_sleep(16); }
            SchedGU S; S.s.init(0, tab[65] * 2, bid, G); S.ws = WSP; S.l = l; S.tab = tab; S.e = 0; S.L0 = 0; S.cnt = 0; S.probe = (rep + 1 < REP_E) ? PROBE_E : 0; pg8::EpiSwiGLU E;
            pg8::gemm_phase<pg8::EpiSwiGLU, SchedGU, true>(lds, 1024, S, E);
            if (rep == 0) cv_tail(lds, l, 4, tab[65] * 2, bid, G); }
        TS(7); SEAM(pb + 4);
        if (IN(pb + 5)) SITE(12) for (int rep = 0; rep < REP_F; ++rep) { build_expert_tables(args, lds, l, tid);
            const LAS int* tab = (const LAS int*)(lds + LDS_TAB);
            SchedDN S; S.s.init(0, tab[65] * 4, bid, G); S.ws = WSP; S.l = l; S.tab = tab; S.e = 0; S.probe = (rep + 1 < REP_F) ? PROBE_F : 0; S.L0 = 0; S.cnt = 0; pg8::EpiStoreF8 E;
            int k256 = 256; asm volatile("" : "+s"(k256));
            pg8::gemm_phase<pg8::EpiStoreF8, SchedDN, false>(lds, k256, S, E);
            if (rep == 0) cv_tail(lds, l, 5, tab[65] * 4, bid, G); }
        TS(8); SEAM(pb + 5);
#endif
        if (IN(pb + 6)) SITE(13) for (int rep = 0; rep < REP_G; ++rep) { build_expert_tables(args, lds, l, tid); phase_combine_ln2(args, lds, l, gw, NGW, tid, lane, rep + 1 < REP_G); }
        TS(9); SEAM(pb + 6);
    }
    if (PROBE_TS) { volatile LAS float* ta_ = (volatile LAS float*)(lds + LDS_MISC + 64);
        float* tsw = (float*)(WSP + WS_CTL) + 32;
        if (blockIdx.x == 0 && threadIdx.x == 0) __hip_atomic_store(tsw, ta_[PROBE_TS_A] * 0.01f * PROBE_TS_SCALE, __ATOMIC_RELAXED, __HIP_MEMORY_SCOPE_AGENT);
        xcd_barrier(bar);
        const float va0_unused = 0.f; (void)va0_unused; const float va = __hip_atomic_load(tsw, __ATOMIC_RELAXED, __HIP_MEMORY_SCOPE_AGENT); float* o_ = a.out();
        for (int i = blockIdx.x * 512 + threadIdx.x; i < TLAT * DM; i += G * 512) o_[i] += va; }
#undef IN
#undef SEAM
#undef lo
#undef hi
#undef lane
#undef wave
#undef gw
#undef tid
#undef WSP
#undef args
}

extern "C" void kernel_launch(void* const* d_in, const int* in_sizes, int n_in, void* d_out, int out_size, void* d_ws, size_t ws_size, hipStream_t stream) {
    static int ok = 0;
    if (ok == 0) {
        if (n_in != N_IN || ws_size < WS_END) { fprintf(stderr, "kernel_launch: n_in %d (want %d), ws %zu (want >= %zu)\n", n_in, (int)N_IN, ws_size, (size_t)WS_END); return; }
        if (hipFuncSetAttribute((const void*)fwd, hipFuncAttributeMaxDynamicSharedMemorySize, LDS_BYTES) != hipSuccess) { fprintf(stderr, "kernel_launch: hipFuncSetAttribute failed\n"); return; }
        int per_cu = 0;
        if (hipOccupancyMaxActiveBlocksPerMultiprocessor(&per_cu, (const void*)fwd, 512, LDS_BYTES) != hipSuccess || per_cu < 1) fprintf(stderr, "kernel_launch: occupancy query reports %d\n", per_cu);
        ok = 1;
    }
    Args a;
    memset(&a, 0, sizeof(a));
    for (int i = 0; i < N_IN; ++i) a.in[i] = (const float*)d_in[i];
    a.out = (float*)d_out; a.ws = (unsigned char*)d_ws;
    hipMemsetAsync((char*)d_ws + WS_CTL, 0, CTL_BYTES, stream);
#if MK_ONE_LAUNCH
    a.ph_lo = 0; a.ph_hi = NPHASE;
    hipLaunchKernelGGL(fwd, dim3(256), dim3(512), LDS_BYTES, stream, a);
#else
    for (int p = 0; p < NPHASE; ++p) { a.ph_lo = p; a.ph_hi = p + 1; hipLaunchKernelGGL(fwd, dim3(256), dim3(512), LDS_BYTES, stream, a); }
#endif
    const hipError_t le = hipPeekAtLastError();
    if (le != hipSuccess) fprintf(stderr, "kernel_launch: launch failed: %s\n", hipGetErrorName(le));
}
```

```cpp
#include <hip/hip_runtime.h>
#include <cstdio>
#include <cstdint>
#include <cstring>

#define LAS __attribute__((address_space(3)))
#define GAS __attribute__((address_space(1)))
typedef unsigned short bf16_t;
typedef short bf16x8 __attribute__((ext_vector_type(8)));
typedef short s16x4 __attribute__((ext_vector_type(4)));
typedef float f32x2 __attribute__((ext_vector_type(2)));
typedef float f32x4 __attribute__((ext_vector_type(4)));
typedef float f32x16 __attribute__((ext_vector_type(16)));
typedef unsigned u32x2 __attribute__((ext_vector_type(2)));
typedef unsigned u32x4 __attribute__((ext_vector_type(4)));

#ifndef MK_ONE_LAUNCH
#define MK_ONE_LAUNCH 1
#endif

constexpr int NB = 4, LSEQ = 4096, DM = 1024, NCTX = 256, DEPTH = 4;
constexpr int TLAT = NB * LSEQ, TCTX = NB * NCTX, TT = TLAT + TCTX;
constexpr int KVR = LSEQ + NCTX;
constexpr int NEXP = 64, TOPK = 8, EDIM = 256;
constexpr int NPAIR = TT * TOPK, NSLOT = NPAIR + TT;
constexpr float DN_ALPHA = 1.681792830507429f;
constexpr float LN_EPS = 1e-6f, RMS_EPS = 1e-6f, ROUTE_SCALE = 2.5f;
constexpr float ATT_SCALE = 0.088388347648318440f;

constexpr size_t al256(size_t x) { return (x + 255) / 256 * 256; }
constexpr size_t WS_CTL = 0, CTL_BYTES = 65536;
constexpr size_t WS_MOD = WS_CTL + CTL_BYTES;
constexpr size_t WS_GAINP = WS_MOD + al256((size_t)DEPTH * 5 * 6 * DM * 4);
constexpr size_t WS_ROPE = WS_GAINP + 2048;
constexpr size_t WS_WRHI = WS_ROPE + 16384;
constexpr size_t WS_WRLO = WS_WRHI + (size_t)DEPTH * 64 * DM * 2;
constexpr size_t WS_WF = WS_WRLO + (size_t)DEPTH * 64 * DM * 2;
constexpr size_t WS_WINE = WS_WF + (size_t)2 * 512 * DM * 2;
constexpr size_t WS_WINO = WS_WINE + (size_t)2 * 1280 * DM * 2;
constexpr size_t WS_WOUT = WS_WINO + (size_t)2 * 3072 * DM * 2;
constexpr size_t WS_WGU = WS_WOUT + (size_t)DEPTH * DM * DM * 2;
constexpr size_t WS_WD = WS_WGU + (size_t)DEPTH * 65 * 512 * DM * 2;
constexpr size_t WS_TW = WS_WD + (size_t)DEPTH * 65 * DM * 256 * 2;
constexpr size_t WS_TWC = WS_TW + (size_t)4096 * 8192 * 2;
constexpr size_t WS_XS = WS_TWC + (size_t)256 * 512 * 2;
constexpr size_t WS_H = WS_XS + (size_t)TT * DM * 4;
constexpr size_t WS_TKE = WS_H + (size_t)TT * DM * 2;
constexpr size_t WS_TKW = WS_TKE + (size_t)NPAIR * 4;
constexpr size_t WS_TKP = WS_TKW + (size_t)NPAIR * 4;
constexpr size_t WS_LIST = WS_TKP + (size_t)NPAIR * 4;
constexpr size_t WS_ACT = WS_LIST + (size_t)(NEXP + 1) * TT * 4;
constexpr size_t WS_YB = WS_ACT + (size_t)(NSLOT + 256) * EDIM * 2;
constexpr size_t WS_QB = WS_YB;
constexpr size_t WS_KB = WS_QB + (size_t)TT * DM * 2;
constexpr size_t WS_VB = WS_KB + (size_t)NB * KVR * DM * 2;
constexpr size_t WS_O = WS_VB + (size_t)NB * KVR * DM * 2;
constexpr size_t WS_Y = WS_O + (size_t)TT * DM * 2;
constexpr size_t WS_ZT = WS_Y + (size_t)TT * DM * 2;
constexpr size_t WS_ZCT = WS_ZT + (size_t)1024 * 8192 * 2;
constexpr size_t WS_OVL_END = WS_ZCT + (size_t)1024 * 512 * 2;
constexpr size_t WS_HL = WS_YB + (size_t)NSLOT * DM * 2;
constexpr size_t WS_TRASH = WS_HL + (size_t)TT * DM * 2;
constexpr size_t WS_END = WS_TRASH + (size_t)256 * 16384;
static_assert(WS_OVL_END <= WS_HL, "overlay fits in YB");
static_assert(WS_END <= (size_t)1 << 30, "workspace must fit 1 GiB");
constexpr int CW_TMO = 0, CW_CNT = 64  , CW_BAR = 1024;

constexpr int LDS_BYTES = 147456;
constexpr int LDS_STAGE = 0;
constexpr int LDS_EPI = 131072;
constexpr int LDS_RIDX = 139264;
constexpr int LDS_TAB = 141312;
constexpr int LDS_MISC = 147456 - 256;

__device__ __forceinline__ unsigned cvt_pk_bf16(float lo, float hi) { unsigned r; asm volatile("v_cvt_pk_bf16_f32 %0, %1, %2" : "=v"(r) : "v"(lo), "v"(hi)); return r; }
__device__ __forceinline__ float bf_lo(unsigned u) { return __uint_as_float(u << 16); }
__device__ __forceinline__ float bf_hi(unsigned u) { return __uint_as_float(u & 0xffff0000u); }
__device__ __forceinline__ float wave_sum(float v) {
#pragma unroll
    for (int o = 1; o < 64; o <<= 1) v += __shfl_xor(v, o);
    return v;
}
__device__ __forceinline__ float wave_max(float v) {
#pragma unroll
    for (int o = 1; o < 64; o <<= 1) v = fmaxf(v, __shfl_xor(v, o));
    return v;
}
#define LDS_WAIT() asm volatile("s_waitcnt lgkmcnt(0)" ::: "memory")
#define VM_WAIT() asm volatile("s_waitcnt vmcnt(0)" ::: "memory")

#ifndef PROBE_TS
#define PROBE_TS 0
#endif
#ifndef PROBE_TS_BLK
#define PROBE_TS_BLK 0
#endif
#define TS(k) do { if (PROBE_TS && blockIdx.x == PROBE_TS_BLK && threadIdx.x == 0) { const unsigned long long now_ = __builtin_amdgcn_s_memrealtime(); volatile LAS float* ta_ = (volatile LAS float*)(lds + LDS_MISC + 64); \
    ta_[k] = ta_[k] + (float)(now_ - *(volatile LAS unsigned long long*)(lds + LDS_MISC + 192)); *(volatile LAS unsigned long long*)(lds + LDS_MISC + 192) = now_; } } while (0)

__device__ __forceinline__ int opaque_tid() { int t = threadIdx.x; asm volatile("" : "+v"(t)); return t; }
namespace pg8 {
constexpr int BM = 256, BK = 64, HALF = 128, HTB = HALF * BK * 2  , STAGE_BYTES = 8 * HTB;

__host__ __device__ __forceinline__ int lds_byte(int r, int c) { const int st = (r >> 4) * 2 + (c >> 5), rr = r & 15, cc = c & 31, ob = rr * 64 + cc * 2; return st * 1024 + (ob ^ (((ob >> 9) & 1) << 5)); }
__host__ __device__ __forceinline__ void stage_rc(int b, int& R, int& C) { const int st = b / 1024, sb = b % 1024, swz = sb ^ (((sb >> 9) & 1) << 5); R = (st >> 1) * 16 + swz / 64; C = (st & 1) * 32 + (swz % 64) / 2; }
__host__ __device__ __forceinline__ int perm32(int rho) { const int n = rho >> 4, i = rho & 15; return 8 * (i >> 2) + 4 * n + (i & 3); }

struct Unit { const char* A; const char* B; char* C; const int* rows; int ldc, nvalid, x0, x1; };

struct EpiStore {
    __device__ __forceinline__ void operator()(const f32x4 (&acc)[2][2][4][2], const Unit& u) const {
        const int tid = opaque_tid(), wid = tid >> 6, lane = tid & 63, wr = wid >> 2, wc = wid & 3, fr = lane & 15, fq = lane >> 4;
        const int row0 = wr * 64 + fr, col0 = wc * 32 + 8 * fq;
#pragma unroll
        for (int ai = 0; ai < 2; ++ai)
#pragma unroll
            for (int m = 0; m < 4; ++m) {
                const int r = row0 + ai * HALF + m * 16;
                if (r < u.nvalid) {
                    bf16_t* rowp = (bf16_t*)u.C + (size_t)r * u.ldc + col0;
#pragma unroll
                    for (int bj = 0; bj < 2; ++bj) { const f32x4 v0 = acc[ai][bj][m][0], v1 = acc[ai][bj][m][1];
                        u32x4 w; w.x = cvt_pk_bf16(v0[0], v0[1]); w.y = cvt_pk_bf16(v0[2], v0[3]); w.z = cvt_pk_bf16(v1[0], v1[1]); w.w = cvt_pk_bf16(v1[2], v1[3]);
                        *(u32x4*)(rowp + bj * HALF) = w; }
                }
            }
    }
};
constexpr float YB_SCALE = 32.0f;
struct EpiStoreF8 {
    __device__ __forceinline__ void operator()(const f32x4 (&acc)[2][2][4][2], const Unit& u) const {
        const int tid = opaque_tid(), wid = tid >> 6, lane = tid & 63, wr = wid >> 2, wc = wid & 3, fr = lane & 15, fq = lane >> 4;
        const int row0 = wr * 64 + fr, col0 = wc * 32 + 8 * fq;
#pragma unroll
        for (int ai = 0; ai < 2; ++ai)
#pragma unroll
            for (int m = 0; m < 4; ++m) {
                const int r = row0 + ai * HALF + m * 16;
                if (r < u.nvalid) {
                    unsigned char* rowp = (unsigned char*)u.C + (size_t)r * u.ldc + col0;
#pragma unroll
                    for (int bj = 0; bj < 2; ++bj) { f32x4 v0 = acc[ai][bj][m][0] * YB_SCALE, v1 = acc[ai][bj][m][1] * YB_SCALE;
#pragma unroll
                        for (int t = 0; t < 4; ++t) { v0[t] = __builtin_amdgcn_fmed3f(v0[t], -448.0f, 448.0f); v1[t] = __builtin_amdgcn_fmed3f(v1[t], -448.0f, 448.0f); }
                        int w0 = 0, w1 = 0;
                        w0 = __builtin_amdgcn_cvt_pk_fp8_f32(v0[0], v0[1], w0, false); w0 = __builtin_amdgcn_cvt_pk_fp8_f32(v0[2], v0[3], w0, true);
                        w1 = __builtin_amdgcn_cvt_pk_fp8_f32(v1[0], v1[1], w1, false); w1 = __builtin_amdgcn_cvt_pk_fp8_f32(v1[2], v1[3], w1, true);
                        *(u32x2*)(rowp + bj * HALF) = (u32x2){(unsigned)w0, (unsigned)w1}; }
                }
            }
    }
};
struct EpiSwiGLU {
    __device__ __forceinline__ void operator()(const f32x4 (&acc)[2][2][4][2], const Unit& u) const {
        const int tid = opaque_tid(), wid = tid >> 6, lane = tid & 63, wr = wid >> 2, wc = wid & 3, fr = lane & 15, fq = lane >> 4;
        const int row0 = wr * 64 + fr, col0 = wc * 32 + 8 * fq;
#pragma unroll
        for (int ai = 0; ai < 2; ++ai)
#pragma unroll
            for (int m = 0; m < 4; ++m) {
                const int r = row0 + ai * HALF + m * 16;
                if (r < u.nvalid) {
                    float o[8];
#pragma unroll
                    for (int n = 0; n < 2; ++n)
#pragma unroll
                        for (int j = 0; j < 4; ++j) { const float g = acc[ai][0][m][n][j], up = acc[ai][1][m][n][j];
                            o[n * 4 + j] = g * __builtin_amdgcn_rcpf(1.0f + __builtin_amdgcn_exp2f(-1.4426950408889634f * g)) * up; }
                    u32x4 w; w.x = cvt_pk_bf16(o[0], o[1]); w.y = cvt_pk_bf16(o[2], o[3]); w.z = cvt_pk_bf16(o[4], o[5]); w.w = cvt_pk_bf16(o[6], o[7]);
                    *(u32x4*)((bf16_t*)u.C + (size_t)r * u.ldc + col0) = w;
                }
            }
    }
};
struct EpiQKVE {
    LAS float* P;
    const float* gainp;
    const f32x2* rope;
    __device__ __forceinline__ void operator()(const f32x4 (&acc)[2][2][4][2], const Unit& u) const {
        const int tid = opaque_tid(), wid = tid >> 6, lane = tid & 63, wr = wid >> 2, wc = wid & 3, fr = lane & 15, fq = lane >> 4;
        const int row0 = wr * 64 + fr, col0 = wc * 32 + 8 * fq;
        if (u.x0 >= 2) {
            const size_t bjs = (u.x0 == 2) ? (size_t)NB * KVR * 128 : (size_t)HALF;
#pragma unroll
            for (int ai = 0; ai < 2; ++ai)
#pragma unroll
                for (int m = 0; m < 4; ++m) { bf16_t* rowp = (bf16_t*)u.C + (size_t)(row0 + ai * HALF + m * 16) * u.ldc + col0;
#pragma unroll
                    for (int bj = 0; bj < 2; ++bj) { const f32x4 v0 = acc[ai][bj][m][0], v1 = acc[ai][bj][m][1];
                        u32x4 w; w.x = cvt_pk_bf16(v0[0], v0[1]); w.y = cvt_pk_bf16(v0[2], v0[3]); w.z = cvt_pk_bf16(v1[0], v1[1]); w.w = cvt_pk_bf16(v1[2], v1[3]);
                        *(u32x4*)(rowp + bj * bjs) = w; } }
            asm volatile("" ::: "memory"); __builtin_amdgcn_s_barrier(); asm volatile("" ::: "memory");
            return;
        }
#pragma unroll
        for (int ai = 0; ai < 2; ++ai)
#pragma unroll
            for (int m = 0; m < 4; ++m)
#pragma unroll
                for (int bj = 0; bj < 2; ++bj) { const f32x4 a = acc[ai][bj][m][0], b = acc[ai][bj][m][1];
                    float s = (a[0] * a[0] + a[1] * a[1]) + (a[2] * a[2] + a[3] * a[3]) + (b[0] * b[0] + b[1] * b[1]) + (b[2] * b[2] + b[3] * b[3]);
                    s += __shfl_xor(s, 16); s += __shfl_xor(s, 32);
                    if (fq == 0) P[(bj * 256 + row0 + ai * HALF + m * 16) * 4 + wc] = s; }
        asm volatile("s_waitcnt lgkmcnt(0)" ::: "memory"); __builtin_amdgcn_s_barrier(); asm volatile("" ::: "memory");
        const f32x4 g0 = *(const f32x4*)(gainp + u.x0 * 128 + col0), g1 = *(const f32x4*)(gainp + u.x0 * 128 + col0 + 4);
        const int half = wc >> 1, fi = ((wc & 1) * 4 + fq) * 4;
#pragma unroll
        for (int ai = 0; ai < 2; ++ai)
#pragma unroll
            for (int m = 0; m < 4; ++m) {
                const int r = row0 + ai * HALF + m * 16;
                int pos = 0;
                if (u.x1 >= 0) { const int t = u.x1 + r; pos = half ? (t & 63) : (t >> 6); }
                const f32x4 cs0 = *(const f32x4*)(rope + pos * 32 + fi), cs1 = *(const f32x4*)(rope + pos * 32 + fi + 2);
                const float cc[4] = {cs0[0], cs0[2], cs1[0], cs1[2]}, ss[4] = {cs0[1], cs0[3], cs1[1], cs1[3]};
                bf16_t* rowp = (bf16_t*)u.C + (size_t)r * u.ldc + col0;
#pragma unroll
                for (int bj = 0; bj < 2; ++bj) {
                    const f32x4 pp = *(const LAS f32x4*)(P + (bj * 256 + r) * 4);
                    const float rs = __builtin_amdgcn_rsqf(((pp[0] + pp[1]) + (pp[2] + pp[3])) * (1.0f / 128.0f) + RMS_EPS);
                    float o1[4], o2[4];
#pragma unroll
                    for (int j = 0; j < 4; ++j) { const float v1 = acc[ai][bj][m][0][j] * rs * g0[j], v2 = acc[ai][bj][m][1][j] * rs * g1[j];
                        o1[j] = v1 * cc[j] - v2 * ss[j]; o2[j] = v1 * ss[j] + v2 * cc[j]; }
                    u32x4 w; w.x = cvt_pk_bf16(o1[0], o1[1]); w.y = cvt_pk_bf16(o1[2], o1[3]); w.z = cvt_pk_bf16(o2[0], o2[1]); w.w = cvt_pk_bf16(o2[2], o2[3]);
                    *(u32x4*)(rowp + bj * ((u.x0 == 0) ? (size_t)HALF : (size_t)NB * KVR * 128)) = w;
                }
            }
    }
};

template <class Epi, class Sched, bool GATHER>
__device__ __forceinline__ void gemm_phase(LAS unsigned char* lds, const int K_, Sched& S, const Epi& E) {
    const int K = K_;
    const int tid = opaque_tid(), wid = __builtin_amdgcn_readfirstlane(tid >> 6), lane = tid & 63, wr = wid >> 2, wc = wid & 3, fr = lane & 15, fq = lane >> 4;
    const int nt = K / BK;
    Unit cur, nxt; int ui = 0;
    if (!S.next(0, cur)) return;
    unsigned voffB[2], offA[2][2];
#pragma unroll
    for (int i = 0; i < 2; ++i) { int R, C; stage_rc(tid * 16 + i * 8192, R, C); const int Rb = (R & ~31) + perm32(R & 31);
        voffB[i] = (unsigned)(Rb * K + C) * 2u; }
    LAS int* ridx = (LAS int*)(lds + LDS_RIDX);
    if (GATHER) {
        if (tid < 256) ridx[tid] = (tid < cur.nvalid) ? cur.rows[tid] : 0;
        __syncthreads();
#pragma unroll
        for (int h = 0; h < 2; ++h)
#pragma unroll
            for (int i = 0; i < 2; ++i) { int R, C; stage_rc(tid * 16 + i * 8192, R, C); offA[h][i] = (unsigned)ridx[h * HALF + R] * (unsigned)(K * 2) + (unsigned)C * 2u; }
    } else {
#pragma unroll
        for (int h = 0; h < 2; ++h)
#pragma unroll
            for (int i = 0; i < 2; ++i) { int R, C; stage_rc(tid * 16 + i * 8192, R, C); offA[h][i] = (unsigned)((h * HALF + R) * K + C) * 2u; }
    }
    const size_t kstep = (size_t)(BK * 2);
    const size_t hstep = (size_t)HALF * K * 2;
    const unsigned ldsw = (unsigned)wid * 1024u;
    const int aoff = lds_byte(wr * 64 + fr, fq * 8), boff = lds_byte(wc * 32 + fr, fq * 8);
#define PG8_SA(b, h) (((b) * 2 + (h)) * HTB)
#define PG8_SB(b, h) ((4 + (b) * 2 + (h)) * HTB)
#define PG8_STAGE(bufoff, gbase, voff) do { _Pragma("unroll") for (int _i = 0; _i < 2; ++_i) \
        __builtin_amdgcn_global_load_lds((const unsigned*)((const char*)(gbase) + (voff)[_i]), (LAS unsigned*)(lds + (bufoff) + ldsw + _i * 8192), 16, 0, 0); } while (0)
#define PG8_LDA(dst, b, h) do { _Pragma("unroll") for (int m = 0; m < 4; ++m) _Pragma("unroll") for (int k = 0; k < 2; ++k) dst[m][k] = *(const LAS bf16x8*)(lds + PG8_SA(b, h) + aoff + m * 2048 + k * 1024); } while (0)
#define PG8_LDB(dst, b, h) do { _Pragma("unroll") for (int n = 0; n < 2; ++n) _Pragma("unroll") for (int k = 0; k < 2; ++k) dst[n][k] = *(const LAS bf16x8*)(lds + PG8_SB(b, h) + boff + n * 2048 + k * 1024); } while (0)
#define PG8_MMA(ai, bj, At, Bt) do { __builtin_amdgcn_s_setprio(1); _Pragma("unroll") for (int m = 0; m < 4; ++m) _Pragma("unroll") for (int n = 0; n < 2; ++n) _Pragma("unroll") for (int k = 0; k < 2; ++k) \
        acc[ai][bj][m][n] = __builtin_amdgcn_mfma_f32_16x16x32_bf16(Bt[n][k], At[m][k], acc[ai][bj][m][n], 0, 0, 0); __builtin_amdgcn_s_setprio(0); } while (0)
#define PG8_WAIT_V(n) asm volatile("s_waitcnt vmcnt(" #n ")" ::: "memory")
#define PG8_WAIT_L(n) asm volatile("s_waitcnt lgkmcnt(" #n ")" ::: "memory")
#define PG8_BAR __builtin_amdgcn_s_barrier()
#define PG8_SCHED __builtin_amdgcn_sched_barrier(0)
    f32x4 acc[2][2][4][2];
#pragma unroll
    for (int a = 0; a < 2; ++a)
#pragma unroll
        for (int b = 0; b < 2; ++b)
#pragma unroll
            for (int m = 0; m < 4; ++m)
#pragma unroll
                for (int n = 0; n < 2; ++n) acc[a][b][m][n] = (f32x4){0.f, 0.f, 0.f, 0.f};
    bf16x8 At[4][2], B0[2][2], B1[2][2];
    const char* cA = cur.A; const char* cB = cur.B;
    PG8_STAGE(PG8_SB(0, 0), cB, voffB); PG8_STAGE(PG8_SA(0, 0), cA, offA[0]); PG8_STAGE(PG8_SB(0, 1), cB + hstep, voffB); PG8_STAGE(PG8_SA(0, 1), cA, offA[1]);
    if (wr == 1) PG8_BAR;
    PG8_WAIT_V(4); PG8_BAR;
    PG8_STAGE(PG8_SB(1, 0), cB + kstep, voffB); PG8_STAGE(PG8_SA(1, 0), cA + kstep, offA[0]); PG8_STAGE(PG8_SB(1, 1), cB + hstep + kstep, voffB);
    PG8_WAIT_V(6); PG8_BAR;
    for (;;) {
        const bool has_next = S.next(ui + 1, nxt);
        const char* nA = has_next ? nxt.A : cA; const char* nB = has_next ? nxt.B : cB;
        if (GATHER && has_next && wid < 4)
            __builtin_amdgcn_global_load_lds((const unsigned*)(nxt.rows + wid * 64 + lane), (LAS unsigned*)(lds + LDS_RIDX + ((ui + 1) & 1) * 1024 + wid * 256), 4, 0, 0);
        for (int t = 0; t < nt; t += 2) {
            const bool last = (t == nt - 2);
            const char* a1 = cA + (size_t)(t + 1) * kstep;
            const char* a2 = last ? nA : cA + (size_t)(t + 2) * kstep; const char* b2 = last ? nB : cB + (size_t)(t + 2) * kstep;
            const char* a3 = a2 + kstep; const char* b3 = b2 + kstep;
            PG8_LDB(B0, 0, 0); PG8_SCHED; PG8_LDA(At, 0, 0); PG8_STAGE(PG8_SA(1, 1), a1, offA[1]);
            PG8_WAIT_L(8); PG8_BAR; PG8_WAIT_L(0); PG8_MMA(0, 0, At, B0); PG8_BAR; PG8_SCHED;
            if (GATHER && last && has_next) {
                LAS int* rn = ridx + ((ui + 1) & 1) * 256;
#pragma unroll
                for (int h = 0; h < 2; ++h)
#pragma unroll
                    for (int i = 0; i < 2; ++i) { int R, C; stage_rc(tid * 16 + i * 8192, R, C); const int rr = h * HALF + R; const int tok = (rr < nxt.nvalid) ? rn[rr] : 0; offA[h][i] = (unsigned)tok * (unsigned)(K * 2) + (unsigned)C * 2u; }
            }
            PG8_LDB(B1, 0, 1); PG8_STAGE(PG8_SB(0, 0), b2, voffB);
            PG8_BAR; PG8_WAIT_L(0); PG8_MMA(0, 1, At, B1); PG8_BAR;
            PG8_LDA(At, 0, 1); PG8_STAGE(PG8_SA(0, 0), a2, offA[0]);
            PG8_BAR; PG8_WAIT_L(0); PG8_MMA(1, 0, At, B0); PG8_BAR; PG8_SCHED;
            PG8_STAGE(PG8_SB(0, 1), b2 + hstep, voffB);
            PG8_WAIT_V(6); PG8_BAR; PG8_MMA(1, 1, At, B1); PG8_BAR;
            PG8_LDB(B0, 1, 0); PG8_SCHED; PG8_LDA(At, 1, 0); PG8_STAGE(PG8_SA(0, 1), a2, offA[1]);
            PG8_WAIT_L(8); PG8_BAR; PG8_WAIT_L(0); PG8_MMA(0, 0, At, B0); PG8_BAR; PG8_SCHED;
            PG8_LDB(B1, 1, 1); PG8_STAGE(PG8_SB(1, 0), b3, voffB);
            PG8_BAR; PG8_WAIT_L(0); PG8_MMA(0, 1, At, B1); PG8_BAR;
            PG8_LDA(At, 1, 1); PG8_STAGE(PG8_SA(1, 0), a3, offA[0]);
            PG8_BAR; PG8_WAIT_L(0); PG8_MMA(1, 0, At, B0); PG8_BAR; PG8_SCHED;
            PG8_STAGE(PG8_SB(1, 1), b3 + hstep, voffB);
            PG8_WAIT_V(6); PG8_BAR; PG8_MMA(1, 1, At, B1); PG8_BAR;
        }
        { Unit eu; S.next(ui, eu); E(acc, eu); }
        if (!has_next) break;
#pragma unroll
        for (int a = 0; a < 2; ++a)
#pragma unroll
            for (int b = 0; b < 2; ++b)
#pragma unroll
                for (int m = 0; m < 4; ++m)
#pragma unroll
                    for (int n = 0; n < 2; ++n) acc[a][b][m][n] = (f32x4){0.f, 0.f, 0.f, 0.f};
        cur = nxt; cA = nA; cB = nB; ++ui;
    }
    PG8_WAIT_V(0);
    if (wr == 0) PG8_BAR;
    PG8_BAR;
#undef PG8_SA
#undef PG8_SB
#undef PG8_STAGE
#undef PG8_LDA
#undef PG8_LDB
#undef PG8_MMA
#undef PG8_WAIT_V
#undef PG8_WAIT_L
#undef PG8_BAR
#undef PG8_SCHED
}
}

namespace att {
constexpr int D = 128, NW = 8, QBLK = 32, KVBLK = 64;
constexpr float SCALE = ATT_SCALE;
constexpr float THR = 8.f;
constexpr float NEGM = -30000.f;
constexpr size_t SHM_V = KVBLK * D * 2, SHM_K = KVBLK * D * 2, SHM_ATTN = 2 * SHM_V + 2 * SHM_K + NW * 64 * 4;
constexpr int LDS_BIAS = 69632;
#define KSWZ(row, colB) ((row) * 256 + ((colB) ^ (((row) & 7) << 4)))
#define SBAR() __builtin_amdgcn_sched_barrier(0)
__device__ __forceinline__ int crow(int r, int hi) { return (r & 3) + 8 * (r >> 2) + 4 * hi; }

__device__ __forceinline__ void partialSM(f32x16& p0, f32x16& p1, float& m_reg, float& mn, float& alpha) {
  constexpr float C = SCALE * 1.4426950408889634f;
  float pmax = p0[0];
#pragma unroll
  for (int r = 1; r < 16; ++r) pmax = fmaxf(pmax, p0[r]);
#pragma unroll
  for (int r = 0; r < 16; ++r) pmax = fmaxf(pmax, p1[r]);
  { auto rr = __builtin_amdgcn_permlane32_swap(__float_as_uint(pmax), __float_as_uint(pmax), false, false);
    pmax = fmaxf(__uint_as_float(rr[0]), __uint_as_float(rr[1])); }
  if (__builtin_expect(__all(pmax - m_reg <= THR / SCALE), 1)) { mn = m_reg; alpha = 1.f; }
  else { mn = fmaxf(m_reg, pmax); alpha = __builtin_amdgcn_exp2f((m_reg - mn) * C); m_reg = mn; }
  float mnC = -mn * C;
#pragma unroll
  for (int r = 0; r < 16; ++r) p0[r] = fmaf(p0[r], C, mnC);
#pragma unroll
  for (int r = 0; r < 16; ++r) p1[r] = fmaf(p1[r], C, mnC);
#pragma unroll
  for (int r = 0; r < 16; ++r) p0[r] = __builtin_amdgcn_exp2f(p0[r]);
}
__device__ __forceinline__ void finishSM(f32x16& p0, f32x16& p1, float alpha, float& l_reg, bf16x8& pa0, bf16x8& pa1, bf16x8& pa2, bf16x8& pa3) {
#pragma unroll
  for (int r = 0; r < 16; ++r) p1[r] = __builtin_amdgcn_exp2f(p1[r]);
  float ps = 0;
#pragma unroll
  for (int r = 0; r < 16; ++r) ps += p0[r];
#pragma unroll
  for (int r = 0; r < 16; ++r) ps += p1[r];
  { auto rr = __builtin_amdgcn_permlane32_swap(__float_as_uint(ps), __float_as_uint(ps), false, false);
    ps = __uint_as_float(rr[0]) + __uint_as_float(rr[1]); }
  l_reg = l_reg * alpha + ps;
#define PK4(P, BASE, OUT) do { unsigned a0 = cvt_pk_bf16(P[BASE + 0], P[BASE + 1]), a1 = cvt_pk_bf16(P[BASE + 2], P[BASE + 3]);   \
    unsigned b0 = cvt_pk_bf16(P[BASE + 4], P[BASE + 5]), b1 = cvt_pk_bf16(P[BASE + 6], P[BASE + 7]);                              \
    auto r0 = __builtin_amdgcn_permlane32_swap(a0, b0, false, false); auto r1 = __builtin_amdgcn_permlane32_swap(a1, b1, false, false); \
    u32x4 w = {r0[0], r1[0], r0[1], r1[1]}; OUT = *reinterpret_cast<bf16x8*>(&w); } while (0)
  PK4(p0, 0, pa0); PK4(p0, 8, pa1); PK4(p1, 0, pa2); PK4(p1, 8, pa3);
#undef PK4
}
__device__ __forceinline__ void qkt(f32x16& p0, f32x16& p1, const char* Ks, const bf16x8* qr, int r32, int hi) {
  p0 = f32x16{}; p1 = f32x16{};
#pragma unroll
  for (int d0 = 0; d0 < 8; ++d0) { int cb = (d0 * 16 + hi * 8) * 2;
    bf16x8 b0 = *reinterpret_cast<const bf16x8*>(Ks + KSWZ(r32, cb));
    bf16x8 b1 = *reinterpret_cast<const bf16x8*>(Ks + KSWZ(32 + r32, cb));
    p0 = __builtin_amdgcn_mfma_f32_32x32x16_bf16(b0, qr[d0], p0, 0, 0, 0);
    p1 = __builtin_amdgcn_mfma_f32_32x32x16_bf16(b1, qr[d0], p1, 0, 0, 0); }
}
__device__ __forceinline__ int v_st(int k, int c) { const int kk = (k & ~0xC) | ((k & 4) << 1) | ((k & 8) >> 1); return ((kk >> 3) * 4 + (c >> 5)) * 512 + ((kk & 7) * 32 + (c & 31)) * 2; }
__device__ __forceinline__ int v_rd_base(int lane) { return ((lane & 3) << 3) | (((lane >> 2) & 3) << 6) | (((lane >> 4) & 1) << 5) | (((lane >> 5) & 1) << 8); }
constexpr int v_rd_off(int d0, int ks, int half) { return d0 * 512 + ks * 4096 + half * 2048; }
template <int OFF> __device__ __forceinline__ s16x4 tr_read(int vb) {
  s16x4 r; asm volatile("ds_read_b64_tr_b16 %0, %1 offset:%2" : "=&v"(r) : "v"(vb), "i"(OFF) : "memory"); return r;
}
template <int D0> __device__ __forceinline__ void pv_one(f32x16& od, int vb, bf16x8 pa0, bf16x8 pa1, bf16x8 pa2, bf16x8 pa3) {
  const s16x4 l0 = tr_read<v_rd_off(D0, 0, 0)>(vb), h0 = tr_read<v_rd_off(D0, 0, 1)>(vb), l1 = tr_read<v_rd_off(D0, 1, 0)>(vb), h1 = tr_read<v_rd_off(D0, 1, 1)>(vb);
  const s16x4 l2 = tr_read<v_rd_off(D0, 2, 0)>(vb), h2 = tr_read<v_rd_off(D0, 2, 1)>(vb), l3 = tr_read<v_rd_off(D0, 3, 0)>(vb), h3 = tr_read<v_rd_off(D0, 3, 1)>(vb);
  asm volatile("s_waitcnt lgkmcnt(0)" ::: "memory"); SBAR();
#define PK(L, H) (bf16x8){L[0], L[1], L[2], L[3], H[0], H[1], H[2], H[3]}
  od = __builtin_amdgcn_mfma_f32_32x32x16_bf16(pa0, PK(l0, h0), od, 0, 0, 0);
  od = __builtin_amdgcn_mfma_f32_32x32x16_bf16(pa1, PK(l1, h1), od, 0, 0, 0);
  od = __builtin_amdgcn_mfma_f32_32x32x16_bf16(pa2, PK(l2, h2), od, 0, 0, 0);
  od = __builtin_amdgcn_mfma_f32_32x32x16_bf16(pa3, PK(l3, h3), od, 0, 0, 0);
#undef PK
}
__device__ __forceinline__ void pv_d0(f32x16* o, int vb, bf16x8 pa0, bf16x8 pa1, bf16x8 pa2, bf16x8 pa3) {
  pv_one<0>(o[0], vb, pa0, pa1, pa2, pa3); pv_one<1>(o[1], vb, pa0, pa1, pa2, pa3); pv_one<2>(o[2], vb, pa0, pa1, pa2, pa3); pv_one<3>(o[3], vb, pa0, pa1, pa2, pa3);
}

template <bool NA, int ldq, int ldk, int ldo>
__device__ __forceinline__ void attn_body(const bf16_t* __restrict__ Qb, const bf16_t* __restrict__ Kh, const bf16_t* __restrict__ Vh,
                                          bf16_t* __restrict__ Ob, const int NT, const int nloc, const int bs, const int q0r, char* lds) {
  const int tid = opaque_tid(), wid = tid >> 6, lane = tid & 63, r32 = lane & 31, hi = lane >> 5;
  char* V_lds = lds; char* K_lds = lds + 2 * SHM_V;
  float* ws = (float*)(lds + 2 * SHM_V + 2 * SHM_K) + wid * 64; float* li_l = ws; float* al_l = ws + 32;
  float m_reg = -1e30f, l_reg = 0; f32x16 o[4] = {}; bf16x8 qr[8];
  const bf16_t* Qw = Qb + (wid * QBLK + r32) * ldq + hi * 8;
#pragma unroll
  for (int d0 = 0; d0 < 8; ++d0) qr[d0] = *reinterpret_cast<const bf16x8*>(Qw + d0 * 16);
  const int sr = tid >> 4, sc = (tid & 15) * 8, vst0 = v_st(sr, sc), vst1 = v_st(32 + sr, sc);
  const int vb0 = (int)(uintptr_t)V_lds + v_rd_base(lane);
  const unsigned kvo = (unsigned)(sr * ldk + sc) * 2u;
  const float* btab = (const float*)(lds + LDS_BIAS) + 64;
  constexpr int SD = NA ? 1 : 2;
  struct { bf16x8 vs0, vs1, ks0, ks1; } sr_[SD];
#define KOFF(j) (NA ? ((j) < nloc ? (bs + (j)) * 64 : LSEQ + ((j) - nloc) * 64) : (j) * 64)
#define SLOAD(i, k0) do { const unsigned _ko = (unsigned)((k0) * ldk * 2) + kvo; sr_[i].vs0 = *reinterpret_cast<const bf16x8*>((const char*)Vh + _ko); sr_[i].vs1 = *reinterpret_cast<const bf16x8*>((const char*)Vh + (_ko + 64u * ldk)); \
    sr_[i].ks0 = *reinterpret_cast<const bf16x8*>((const char*)Kh + _ko); sr_[i].ks1 = *reinterpret_cast<const bf16x8*>((const char*)Kh + (_ko + 64u * ldk)); } while (0)
#define SWRITE(b, i) do { int sr_w = sr, sc_w = sc, v0_w = vst0, v1_w = vst1; \
    if (NA) { const int t_ = opaque_tid(); sr_w = t_ >> 4; sc_w = (t_ & 15) * 8; v0_w = v_st(sr_w, sc_w); v1_w = v_st(32 + sr_w, sc_w); }     \
    *(bf16x8*)(V_lds + (b) * SHM_V + v0_w) = sr_[i].vs0;          \
    *(bf16x8*)(V_lds + (b) * SHM_V + v1_w) = sr_[i].vs1; int kc = sc_w * 2;               \
    *(bf16x8*)(K_lds + (b) * SHM_K + KSWZ(sr_w, kc)) = sr_[i].ks0;                       \
    *(bf16x8*)(K_lds + (b) * SHM_K + KSWZ(32 + sr_w, kc)) = sr_[i].ks1; } while (0)
#define SWAIT() do { if (SD == 2) asm volatile("s_waitcnt vmcnt(4)" ::: "memory"); else asm volatile("s_waitcnt vmcnt(0)" ::: "memory"); } while (0)
#define RESC(a) do { if (__any((a) < 1.f)) { if (hi == 0) al_l[r32] = (a); asm volatile("s_waitcnt lgkmcnt(0)" ::: "memory"); \
    _Pragma("unroll") for (int d = 0; d < 4; ++d) _Pragma("unroll") for (int r = 0; r < 16; ++r) o[d][r] *= al_l[crow(r, hi)]; } } while (0)
#define ACT(j) (!NA || (j) >= nloc || ((bs + (j)) >= min(max(q0r + __builtin_amdgcn_readfirstlane(opaque_tid() >> 7) - 4, 0), 56) && (bs + (j)) < min(max(q0r + __builtin_amdgcn_readfirstlane(opaque_tid() >> 7) - 4, 0), 56) + 8))
#define NAMASK(P0, P1, j) do { if (NA && (j) < nloc) { const int kr = bs + (j); const int t_ = opaque_tid(); \
    const int qrow = q0r + __builtin_amdgcn_readfirstlane(t_ >> 7), qcol = ((t_ >> 6) & 1) * 32 + (t_ & 31), hi_ = (t_ >> 5) & 1; \
    const int cstart = min(max(qcol - 8, 0), 48); \
    const float* bp = btab + (kr - qrow + 7) * 31 + (4 * hi_ - qcol + 15); const int cs = cstart - 4 * hi_; \
    _Pragma("unroll") for (int r = 0; r < 16; ++r) { const int kc = (r & 3) + 8 * (r >> 2); \
        P0[r] = ((unsigned)(kc - cs) < 16u) ? P0[r] + bp[kc] : NEGM; P1[r] = ((unsigned)(kc + 32 - cs) < 16u) ? P1[r] + bp[kc + 32] : NEGM; } } } while (0)
  f32x16 pA0, pA1, pB0, pB1; float mnA, mnB, alA = 1.f, alB = 1.f; bf16x8 pa0, pa1, pa2, pa3;
  bool actA, actB;
  constexpr int SE = 0, SO = SD - 1;
  SLOAD(SE, KOFF(0)); asm volatile("s_waitcnt vmcnt(0)" ::: "memory"); SWRITE(0, SE); __syncthreads();
  actA = ACT(0);
  if (actA) { qkt(pA0, pA1, K_lds, qr, r32, hi); NAMASK(pA0, pA1, 0); partialSM(pA0, pA1, m_reg, mnA, alA); } else alA = 1.f;
  SLOAD(SO, KOFF(1)); if (SD == 2 && 2 < NT) SLOAD(SE, KOFF(2));
  SWAIT(); SWRITE(1, SO); __syncthreads();
  for (int j = 1; j + 1 < NT; j += 2) {
    SBAR(); actB = ACT(j); if (actB) { qkt(pB0, pB1, K_lds + SHM_K, qr, r32, hi); NAMASK(pB0, pB1, j); }
    if (actA) finishSM(pA0, pA1, alA, l_reg, pa0, pa1, pa2, pa3); SBAR();
    SLOAD(SO, KOFF(j + SD)); SBAR();
    if (actA) pv_d0(o, vb0, pa0, pa1, pa2, pa3); if (actB) partialSM(pB0, pB1, m_reg, mnB, alB); else alB = 1.f;
    __syncthreads(); SWAIT(); SWRITE(0, SE);
    RESC(alB); __syncthreads();
    SBAR(); actA = ACT(j + 1); if (actA) { qkt(pA0, pA1, K_lds, qr, r32, hi); NAMASK(pA0, pA1, j + 1); }
    if (actB) finishSM(pB0, pB1, alB, l_reg, pa0, pa1, pa2, pa3); SBAR();
    if (SD == 1 || j + 3 < NT) SLOAD(SE, KOFF(j + 1 + SD)); SBAR();
    if (actB) pv_d0(o, vb0 + (int)SHM_V, pa0, pa1, pa2, pa3); if (actA) partialSM(pA0, pA1, m_reg, mnA, alA); else alA = 1.f;
    __syncthreads(); SWAIT(); SWRITE(1, SO);
    RESC(alA); __syncthreads();
  }
  SBAR(); actB = ACT(NT - 1); if (actB) { qkt(pB0, pB1, K_lds + SHM_K, qr, r32, hi); NAMASK(pB0, pB1, NT - 1); }
  if (actA) finishSM(pA0, pA1, alA, l_reg, pa0, pa1, pa2, pa3); SBAR();
  if (actA) pv_d0(o, vb0, pa0, pa1, pa2, pa3); if (actB) partialSM(pB0, pB1, m_reg, mnB, alB); else alB = 1.f;
  __syncthreads(); RESC(alB);
  if (actB) { finishSM(pB0, pB1, alB, l_reg, pa0, pa1, pa2, pa3); SBAR();
    pv_d0(o, vb0 + (int)SHM_V, pa0, pa1, pa2, pa3); }
  if (hi == 0) li_l[r32] = l_reg; asm volatile("s_waitcnt lgkmcnt(0)" ::: "memory");
  float rli[16];
#pragma unroll
  for (int r = 0; r < 16; ++r) rli[r] = __builtin_amdgcn_rcpf(li_l[crow(r, hi)]);
  bf16_t* Ow = Ob + (wid * QBLK) * ldo + r32;
#pragma unroll
  for (int r = 0; r < 16; ++r) { const int orow = crow(r, hi);
#pragma unroll
    for (int d0 = 0; d0 < 4; ++d0) { const unsigned pk = cvt_pk_bf16(o[d0][r] * rli[r], 0.f); Ow[orow * ldo + d0 * 32] = (bf16_t)(pk & 0xffffu); } }
  __syncthreads();
#undef ACT
#undef KOFF
#undef SLOAD
#undef SWRITE
#undef SWAIT
#undef RESC
#undef NAMASK
}
#undef KSWZ
#undef SBAR
}

#define XB_TMO      128
#define XB_XCNT(j)  (256  + 64 * (j))
#define XB_XSUB(j)  (1280 + 64 * (j))
#define XB_XGEN(j)  (2304 + 64 * (j))
#define XB_TOP      3328
#define XB_TOPGEN   3392
#define XCD_BAR_WORDS 3456
#define XB_SPIN_CAP (1u << 22)
__device__ __forceinline__ unsigned xb_ld(unsigned* p)              { return __hip_atomic_load(p, __ATOMIC_RELAXED, __HIP_MEMORY_SCOPE_AGENT); }
__device__ __forceinline__ unsigned xb_add(unsigned* p, unsigned v) { return __hip_atomic_fetch_add(p, v, __ATOMIC_RELAXED, __HIP_MEMORY_SCOPE_AGENT); }
__device__ __forceinline__ unsigned xb_xcc_id() { return (unsigned)__builtin_amdgcn_s_getreg((3 << 11) | 20) & 0xFu; }
#define XB_SPIN(cond, bar) do { unsigned _sp = 0; while (cond) { __builtin_amdgcn_s_sleep(1); \
    if ((++_sp & 255u) == 0u) { if (xb_ld(&(bar)[XB_TMO])) break; if (_sp > XB_SPIN_CAP) { atomicAdd(&(bar)[XB_TMO], 1u); break; } } } } while (0)
struct XcdBarrier { unsigned* bar; unsigned x; volatile LAS unsigned* st; };
__device__ __forceinline__ XcdBarrier xcd_barrier_post(unsigned* bar, volatile LAS unsigned* st) {
    XcdBarrier b; b.bar = bar; b.x = xb_xcc_id(); b.st = st;
    if (threadIdx.x == 0) (void)xb_add(&bar[XB_XCNT(b.x)], 1u);
    return b;
}
__device__ __forceinline__ void xcd_barrier_complete(unsigned* bar, unsigned x, unsigned& nloc, unsigned& nx) {
    const unsigned G = gridDim.x * gridDim.y * gridDim.z;
    unsigned sum, cnt, mine, sp = 0u;
    for (;;) {
        sum = 0u; cnt = 0u; mine = 0u;
#pragma unroll
        for (unsigned j = 0; j < 16; ++j) { const unsigned c = xb_ld(&bar[XB_XCNT(j)]); sum += c; cnt += (c > 0u) ? 1u : 0u; mine = (j == x) ? c : mine; }
        if (sum == G) break;
        __builtin_amdgcn_s_sleep(1);
        if ((++sp & 255u) == 0u) { if (xb_ld(&bar[XB_TMO])) break; if (sp > XB_SPIN_CAP) { atomicAdd(&bar[XB_TMO], 1u); break; } }
    }
    nloc = mine > 0u ? mine : 1u; nx = cnt > 0u ? cnt : 1u;
}
__device__ __forceinline__ void xcd_barrier(const XcdBarrier& b) {
    asm volatile("s_waitcnt vmcnt(0)" ::: "memory");
    __syncthreads();
    if (threadIdx.x == 0) {
        unsigned* bar = b.bar;
        __builtin_amdgcn_s_waitcnt(0);
        unsigned nloc = b.st[0], nx = b.st[1];
        if (nloc == 0u) { xcd_barrier_complete(bar, b.x, nloc, nx); b.st[0] = nloc; b.st[1] = nx; }
        const unsigned old = xb_add(&bar[XB_XSUB(b.x)], 1u);
        const unsigned gen = old / nloc;
        if (old + 1u == (gen + 1u) * nloc) {
            __builtin_amdgcn_fence(__ATOMIC_RELEASE, "agent");
            asm volatile("s_waitcnt vmcnt(0)" ::: "memory");
            const unsigned og = xb_add(&bar[XB_TOP], 1u);
            const unsigned tg = og / nx;
            if (og + 1u == (tg + 1u) * nx) xb_add(&bar[XB_TOPGEN], 1u);
            else XB_SPIN(xb_ld(&bar[XB_TOPGEN]) == tg, bar);
            __builtin_amdgcn_fence(__ATOMIC_ACQUIRE, "agent");
            xb_add(&bar[XB_XGEN(b.x)], 1u);
            asm volatile("s_waitcnt vmcnt(0)" ::: "memory");
        } else {
            XB_SPIN(xb_ld(&bar[XB_XGEN(b.x)]) == gen, bar);
            __builtin_amdgcn_fence(__ATOMIC_ACQUIRE, "agent");
            asm volatile("s_waitcnt vmcnt(0)" ::: "memory");
        }
    }
    __syncthreads();
}

enum { I_X = 0, I_C, I_CTX, I_CCTX, I_WMOD, I_BMOD, I_LN1G, I_LN1B, I_LN2G, I_LN2B, I_ABWIN, I_ABWF, I_ABQN, I_ABKN, I_ABWOUT, I_NAWIN, I_NARPB, I_NAWOUT,
       I_WR, I_EBIAS, I_WG, I_WU, I_WDN, I_SG, I_SU, I_SD, N_IN };
struct Args { const float* in[N_IN]; float* out; unsigned char* ws; int ph_lo, ph_hi; };
struct KA {
    __device__ __forceinline__ const __attribute__((address_space(4))) char* base() const { const __attribute__((address_space(4))) char* p = (const __attribute__((address_space(4))) char*)__builtin_amdgcn_kernarg_segment_ptr(); asm volatile("" : "+s"(p)); return p; }
    __device__ __forceinline__ const float* in(int i) const { return *(const float* const __attribute__((address_space(4)))*)(base() + 8 * i); }
    __device__ __forceinline__ float* out() const { return *(float* const __attribute__((address_space(4)))*)(base() + 8 * N_IN); }
    __device__ __forceinline__ int ph_lo() const { return *(const int __attribute__((address_space(4)))*)(base() + 8 * N_IN + 16); }
    __device__ __forceinline__ int ph_hi() const { return *(const int __attribute__((address_space(4)))*)(base() + 8 * N_IN + 20); }
    __device__ __forceinline__ unsigned char* ws() const { return *(unsigned char* const __attribute__((address_space(4)))*)(base() + 8 * N_IN + 8); }
};

__device__ __forceinline__ int tok_batchrow(int m) { return m < TLAT ? (m >> 12) : 4; }

__host__ __device__ __forceinline__ int rope_phys(int d) { const int hf = d >> 6, dd = d & 63, i = dd & 31, second = dd >> 5; return hf * 64 + (i >> 2) * 8 + second * 4 + (i & 3); }

constexpr int CV_GU = 65 * 2 * 16, CV_DN = 65 * 16, CV_OUT = 64;
__host__ __device__ constexpr int cv_in(int l) { return (l & 1) ? 192 : 80; }
__host__ __device__ constexpr int cv_items(int l) { return CV_GU + CV_DN + cv_in(l) + CV_OUT; }
struct CvItem { const float* src; bf16_t* dst; int ldw, K, k0, n0, kind, which; };
__device__ __forceinline__ int cv_row(const CvItem& d, int n) {
    if (d.kind == 1) return (n >> 7) * 256 + d.which * 128 + (n & 127);
    if (d.kind == 2) { const int c = n - 256; return c < 1024 ? (c & ~127) + rope_phys(c & 127) : c; }
    return n;
}
__device__ __forceinline__ CvItem cv_decode(const KA& a, int l, int it) {
    CvItem d; unsigned char* ws = a.ws(); const int j = l >> 1; int r = it; d.which = 0;
    if (r < CV_GU) { const int mat = r >> 4, kb = r & 15, which = mat & 1, e = mat >> 1;
        d.src = (e < 64) ? a.in(which ? I_WU : I_WG) + ((size_t)(l * 64 + e) * DM * EDIM) : a.in(which ? I_SU : I_SG) + (size_t)l * DM * EDIM;
        d.dst = (bf16_t*)(ws + WS_WGU) + (size_t)(l * 65 + e) * 512 * DM; d.ldw = EDIM; d.K = DM; d.k0 = 64 * kb; d.n0 = 0; d.kind = 1; d.which = which; return d; }
    r -= CV_GU;
    if (r < CV_DN) { const int e = r >> 4, item = r & 15;
        d.src = (e < 64) ? a.in(I_WDN) + ((size_t)(l * 64 + e) * EDIM * DM) : a.in(I_SD) + (size_t)l * EDIM * DM;
        d.dst = (bf16_t*)(ws + WS_WD) + (size_t)(l * 65 + e) * DM * EDIM; d.ldw = DM; d.K = EDIM; d.k0 = 64 * (item >> 2); d.n0 = 256 * (item & 3); d.kind = 0; return d; }
    r -= CV_DN;
    if (r < cv_in(l)) {
        if ((l & 1) == 0) { d.src = a.in(I_ABWIN) + (size_t)j * DM * 1536; d.dst = (bf16_t*)(ws + WS_WINE) + (size_t)j * 1280 * DM; d.ldw = 1536; d.K = DM; d.k0 = 64 * (r / 5); d.n0 = 256 + 256 * (r % 5); d.kind = 2; }
        else { d.src = a.in(I_NAWIN) + (size_t)j * DM * 3072; d.dst = (bf16_t*)(ws + WS_WINO) + (size_t)j * 3072 * DM; d.ldw = 3072; d.K = DM; d.k0 = 64 * (r / 12); d.n0 = 256 * (r % 12); d.kind = 0; }
        return d; }
    r -= cv_in(l);
    d.src = ((l & 1) ? a.in(I_NAWOUT) : a.in(I_ABWOUT)) + (size_t)j * DM * DM; d.dst = (bf16_t*)(ws + WS_WOUT) + (size_t)l * DM * DM; d.ldw = DM; d.K = DM; d.k0 = 64 * (r >> 2); d.n0 = 256 * (r & 3); d.kind = 0;
    return d;
}
constexpr int CV_LS = 260;
__device__ __forceinline__ void cv_load(const CvItem& d, f32x4 (&v)[8], int t) {
    const float* p = d.src + (size_t)(d.k0 + (t >> 6)) * d.ldw + d.n0 + (t & 63) * 4;
#pragma unroll
    for (int i = 0; i < 8; ++i) v[i] = *(const f32x4*)(p + (size_t)(8 * i) * d.ldw);
}
__device__ __forceinline__ void convert_items(LAS unsigned char* lds, int l, int lo, int hi, int worker, int nworkers) {
    const KA a;
    const int t = opaque_tid();
    LAS float* img = (LAS float*)lds;
    int it = lo + worker;
    if (it >= hi) return;
    CvItem d0 = cv_decode(a, l, it); f32x4 v[8]; cv_load(d0, v, t);
    for (;;) {
        { LAS float* w = img + (t >> 6) * CV_LS + (t & 63) * 4;
#pragma unroll
          for (int i = 0; i < 8; ++i) *(LAS f32x4*)(w + i * 8 * CV_LS) = v[i]; }
        __syncthreads();
        const int itn = it + nworkers; const bool more = itn < hi;
        CvItem d1 = d0;
        if (more) { d1 = cv_decode(a, l, itn); cv_load(d1, v, t); }
        { const int n = (t >> 6) * 32 + (t & 31), qh = (t >> 5) & 1; bf16_t* orow = d0.dst + (size_t)cv_row(d0, d0.n0 + n) * d0.K + d0.k0;
#pragma unroll
          for (int p = 0; p < 4; ++p) { const int q = 2 * p + qh; const LAS float* s = img + (8 * q) * CV_LS + n;
              u32x4 o; o.x = cvt_pk_bf16(s[0 * CV_LS], s[1 * CV_LS]); o.y = cvt_pk_bf16(s[2 * CV_LS], s[3 * CV_LS]); o.z = cvt_pk_bf16(s[4 * CV_LS], s[5 * CV_LS]); o.w = cvt_pk_bf16(s[6 * CV_LS], s[7 * CV_LS]);
              *(u32x4*)(orow + 8 * q) = o; } }
        __syncthreads();
        if (!more) break;
        d0 = d1; it = itn;
    }
}
struct CvSlice { int l, i0, i1, l2, j0, j1; };
constexpr int CV_EX = CV_GU + CV_DN;
#ifndef CV_MODE
#define CV_MODE 1
#endif
__device__ __forceinline__ CvSlice cv_slice(int l, int phase  ) {
    const CvSlice none = {0, 0, 0, 0, 0, 0};
    if (CV_MODE == 0) return none;
    if (l == 0) { if (phase == 1) return {0, 0, 2000, 0, 0, 0}; if (phase == 2) return {0, 2000, 3000, 0, 0, 0};
                  if (phase == 4) return {1, CV_EX, cv_items(1), 1, 0, 744}; if (phase == 5) return {1, 744, 1144, 0, 0, 0}; }
    if (l == 1) { if (phase == 0) return {1, 1144, 2120, 0, 0, 0}; if (phase == 2) return {1, 2120, CV_EX, 0, 0, 0};
                  if (phase == 4) return {2, CV_EX, cv_items(2), 2, 0, 856}; if (phase == 5) return {2, 856, 1256, 0, 0, 0}; }
    if (l == 2) { if (phase == 1) return {2, 1256, CV_EX, 0, 0, 0}; if (phase == 2) return {3, CV_EX, cv_items(3), 3, 0, 744};
                  if (phase == 4) return {3, 744, 1744, 0, 0, 0}; if (phase == 5) return {3, 1744, 2144, 0, 0, 0}; }
    if (l == 3) { if (phase == 0) return {3, 2144, 3044, 0, 0, 0}; if (phase == 2) return {3, 3044, CV_EX, 0, 0, 0}; }
    return none;
}
__device__ __forceinline__ void cv_tail(LAS unsigned char* lds, int l, int phase, int n_units, int bid, int G) {
    const CvSlice c = cv_slice(l, phase);
    if (c.i1 <= c.i0 && c.j1 <= c.j0) return;
    const int rem = n_units % G, nw = (rem == 0) ? G : G - rem, w = (rem == 0) ? bid : bid - rem;
    if (w < 0) return;
    __syncthreads();
    if (c.i1 > c.i0) convert_items(lds, c.l, c.i0, c.i1, w, nw);
    if (c.j1 > c.j0) convert_items(lds, c.l2, c.j0, c.j1, w, nw);
}

__device__ __forceinline__ void p0_mod(const KA& a, LAS unsigned char* lds, int bid, int G, int tid, int wave, int lane) {
    LAS float* sl = (LAS float*)(lds + 69632);
    LAS float* part = (LAS float*)(lds + 69632 + 20480);
    for (int i = tid; i < 5 * DM; i += 512) { const int r = i >> 10, k = i & 1023; const float v = (r < 4) ? a.in(I_C)[r * DM + k] : a.in(I_CCTX)[k]; sl[i] = v / (1.0f + __expf(-v)); }
    __syncthreads();
    float* mod = (float*)(a.ws() + WS_MOD);
    for (int task = bid; task < DEPTH * 48; task += G) {
        const int l = task / 48, c0 = (task % 48) * 128;
        const float* w = a.in(I_WMOD) + (size_t)l * DM * 6144 + c0 + 2 * lane;
        f32x2 acc[5];
#pragma unroll
        for (int r = 0; r < 5; ++r) acc[r] = (f32x2){0.f, 0.f};
#pragma unroll 16
        for (int k = wave * 128; k < wave * 128 + 128; ++k) { const f32x2 wv = *(const f32x2*)(w + (size_t)k * 6144);
#pragma unroll
            for (int r = 0; r < 5; ++r) acc[r] += wv * sl[r * DM + k]; }
#pragma unroll
        for (int r = 0; r < 5; ++r) *(LAS f32x2*)(part + (wave * 5 + r) * 128 + 2 * lane) = acc[r];
        __syncthreads();
        for (int i = tid; i < 640; i += 512) { const int r = i >> 7, c = i & 127; float s = a.in(I_BMOD)[l * 6144 + c0 + c];
#pragma unroll
            for (int w8 = 0; w8 < 8; ++w8) s += part[(w8 * 5 + r) * 128 + c];
            mod[((size_t)l * 5 + r) * 6144 + c0 + c] = s; }
        __syncthreads();
    }
}

__device__ __forceinline__ void p0_fourier_fold(const KA& a, LAS unsigned char* lds, int task, int tid, int wave, int lane) {
    const int kq = task & 3, g = (task >> 2) & 3, q = (task >> 4) & 1, j = task >> 5;
    LAS float* M = (LAS float*)(lds + 100352);
    LAS float* trg = M + 4096;
    const float* Wf = a.in(I_ABWF) + (size_t)(j * 4 + g) * 64 * 64;
    LAS float* Wl = trg + 64;
    __syncthreads();
    if (tid < 64) { const float ang = (float)tid * (1.0f / 32.0f); trg[tid] = q ? sinpif(ang) : cospif(ang); }
    for (int i = tid; i < 1024; i += 512) *(LAS f32x4*)(Wl + 4 * i) = *(const f32x4*)(Wf + 4 * i);
    __syncthreads();
    for (int i = tid; i < 4096; i += 512) { const int c = i >> 6, d = i & 63; float s = 0.f;
#pragma unroll 8
        for (int m = 0; m < 64; ++m) s += trg[(m * c) & 63] * Wl[m * 64 + d];
        M[i] = s; }
    __syncthreads();
    float mcol[64];
#pragma unroll
    for (int c = 0; c < 64; ++c) mcol[c] = M[c * 64 + lane];
    bf16_t* dst = (bf16_t*)(a.ws() + WS_WF) + ((size_t)j * 512 + q * 256 + g * 64 + lane) * DM;
    const float* win = a.in(I_ABWIN) + (size_t)j * DM * 1536 + g * 64 + lane;
    const int kbeg = kq * 256 + wave * 32;
    float wv[32];
#pragma unroll
    for (int i = 0; i < 32; ++i) wv[i] = win[(size_t)(kbeg + i) * 1536];
#pragma unroll
    for (int i = 0; i < 32; ++i) { float s = 0.f;
#pragma unroll
        for (int c = 0; c < 64; ++c) s += __int_as_float(__builtin_amdgcn_readlane(__float_as_int(wv[i]), c)) * mcol[c];
        dst[kbeg + i] = (bf16_t)(cvt_pk_bf16(s, 0.f) & 0xffffu); }
}


__device__ __forceinline__ void p0_tables(const KA& a, LAS unsigned char* lds, int gtid, int NGT, int tid) {
    LAS float* ctab = (LAS float*)(lds + 116736);
    for (int i = tid; i < 4096; i += 512) ctab[i] = cospif((float)i * (1.0f / 2048.0f));
    __syncthreads();
    bf16_t* TW = (bf16_t*)(a.ws() + WS_TW);
    for (int it = gtid; it < 4096 * 1024; it += NGT) {
        const int k = it >> 10, c8 = (it & 1023) * 8, n0 = c8 & 4095, sh = (c8 >> 12) ? 1024 : 0; const float sg = (c8 >> 12) ? (-1.0f / 512.0f) : (1.0f / 512.0f);
        float v[8];
#pragma unroll
        for (int j = 0; j < 8; ++j) v[j] = ctab[(k * (n0 + j) - sh) & 4095] * sg;
        u32x4 o; o.x = cvt_pk_bf16(v[0], v[1]); o.y = cvt_pk_bf16(v[2], v[3]); o.z = cvt_pk_bf16(v[4], v[5]); o.w = cvt_pk_bf16(v[6], v[7]);
        *(u32x4*)(TW + (size_t)k * 8192 + c8) = o;
    }
    bf16_t* TWC = (bf16_t*)(a.ws() + WS_TWC);
    for (int it = gtid; it < 256 * 64; it += NGT) {
        const int k = it >> 6, c8 = (it & 63) * 8, n0 = c8 & 255, sh = (c8 >> 8) ? 1024 : 0; const float sg = (c8 >> 8) ? (-1.0f / 128.0f) : (1.0f / 128.0f);
        float v[8];
#pragma unroll
        for (int j = 0; j < 8; ++j) v[j] = ctab[(((k * (n0 + j)) & 255) * 16 - sh) & 4095] * sg;
        u32x4 o; o.x = cvt_pk_bf16(v[0], v[1]); o.y = cvt_pk_bf16(v[2], v[3]); o.z = cvt_pk_bf16(v[4], v[5]); o.w = cvt_pk_bf16(v[6], v[7]);
        *(u32x4*)(TWC + (size_t)k * 512 + c8) = o;
    }
    bf16_t* WH = (bf16_t*)(a.ws() + WS_WRHI); bf16_t* WL = (bf16_t*)(a.ws() + WS_WRLO);
    for (int it = gtid; it < DEPTH * 64 * DM; it += NGT) {
        const int i = it & 7, ln = (it >> 3) & 63, ks = (it >> 9) & 31, nt4 = (it >> 14) & 3, l = it >> 16, e = nt4 * 16 + (ln & 15), k = ks * 32 + (ln >> 4) * 8 + i;
        const float w = a.in(I_WR)[((size_t)l * DM + k) * 64 + e];
        const unsigned h = cvt_pk_bf16(w, 0.f) & 0xffffu; const float r = w - __uint_as_float(h << 16);
        WH[it] = (bf16_t)h; WL[it] = (bf16_t)(cvt_pk_bf16(r, 0.f) & 0xffffu);
    }
    float* gp = (float*)(a.ws() + WS_GAINP);
    for (int it = gtid; it < 2 * 2 * 128; it += NGT) { const int j = it >> 8, qk = (it >> 7) & 1, d = it & 127; gp[(j * 2 + qk) * 128 + rope_phys(d)] = a.in(qk ? I_ABKN : I_ABQN)[j * 128 + d]; }
    f32x2* rp = (f32x2*)(a.ws() + WS_ROPE);
    for (int it = gtid; it < 64 * 32; it += NGT) { const int pos = it >> 5, i = it & 31; const float inv = exp2f(-(float)i * (13.287712379549449f / 32.0f));
        const float ang = (float)pos * inv; rp[it] = (f32x2){cosf(ang), sinf(ang)}; }
}

__device__ __forceinline__ const float* xrow_in(const KA& a, int l, int m) {
    if (l == 0) return m < TLAT ? a.in(I_X) + (size_t)m * DM : a.in(I_CTX) + (size_t)(m - TLAT) * DM;
    return (const float*)(a.ws() + WS_XS) + (size_t)m * DM;
}
__device__ __forceinline__ void p0b_modulate(const KA& a, int gw, int NGW, int lane) {
    const float* mod = (const float*)(a.ws() + WS_MOD);
    bf16_t* H = (bf16_t*)(a.ws() + WS_H);
    for (int m = gw; m < TT; m += NGW) {
        const f32x4* xr = (const f32x4*)xrow_in(a, 0, m) + lane; const float* md = mod + (size_t)tok_batchrow(m) * 6144;
        u32x2* o = (u32x2*)(H + (size_t)m * DM) + lane;
#pragma unroll
        for (int j = 0; j < 4; ++j) { const f32x4 x = xr[64 * j], sh = *((const f32x4*)md + lane + 64 * j), sc = *((const f32x4*)(md + DM) + lane + 64 * j);
            const f32x4 h = x * (sc + 1.0f) + sh; o[64 * j] = (u32x2){cvt_pk_bf16(h[0], h[1]), cvt_pk_bf16(h[2], h[3])}; }
    }
}

#ifndef D_DELAY
#define D_DELAY 0
#endif
#ifndef PROBE_D
#define PROBE_D 7
#endif
__device__ __forceinline__ void phase_ln1_router(const KA& a, LAS unsigned char* lds, int l, int bid, int tid, int wave, int lane, const bool dry) {
    LAS float* lg = (LAS float*)lds;
    LAS int* hist = (LAS int*)(lds + 96 * 64 * 4);
    LAS int* pend = hist + 128;
    const float* mod = (const float*)(a.ws() + WS_MOD) + (size_t)l * 5 * 6144;
    const bf16_t* Y = (const bf16_t*)(a.ws() + WS_Y);
    float* XS = (float*)(a.ws() + (dry ? WS_ACT : WS_XS)); bf16_t* H = (bf16_t*)(a.ws() + (dry ? WS_YB + ((size_t)200 << 20) : WS_H)); bf16_t* HL = (bf16_t*)(a.ws() + (dry ? WS_YB + ((size_t)240 << 20) : WS_HL));
    if (tid < 64) hist[tid] = 0;
    const int NTOK = (l == DEPTH - 1) ? 64 : 68;
    const int tok0 = bid * NTOK;
    if (!dry || (PROBE_D & 1)) {
        f32x4 lng[4], lnb[4], g1[4], sc2[4], sh2[4];
        { const f32x4* pg = (const f32x4*)(a.in(I_LN1G) + l * DM) + lane; const f32x4* pb = (const f32x4*)(a.in(I_LN1B) + l * DM) + lane;
#pragma unroll
          for (int j = 0; j < 4; ++j) { lng[j] = pg[64 * j]; lnb[j] = pb[64 * j]; } }
        int cur_br = -1;
        f32x4 xn[4]; u32x2 yn[4];
        { const int m = tok0 + wave; const f32x4* xr = (const f32x4*)xrow_in(a, l, m) + lane; const u32x2* yr = (const u32x2*)(Y + (size_t)m * DM) + lane;
#pragma unroll
          for (int j = 0; j < 4; ++j) { xn[j] = xr[64 * j]; yn[j] = yr[64 * j]; } }
        for (int r = wave; r < NTOK; r += 8) {
            const int m = tok0 + r, br = tok_batchrow(m);
            if (br != cur_br) { cur_br = br; const float* md = mod + (size_t)br * 6144;
#pragma unroll
                for (int j = 0; j < 4; ++j) { g1[j] = *((const f32x4*)(md + 2 * DM) + lane + 64 * j); sh2[j] = *((const f32x4*)(md + 3 * DM) + lane + 64 * j); sc2[j] = *((const f32x4*)(md + 4 * DM) + lane + 64 * j) + 1.0f; } }
            f32x4 v[4]; float s = 0.f;
#pragma unroll
            for (int j = 0; j < 4; ++j) { const f32x4 y = {bf_lo(yn[j].x), bf_hi(yn[j].x), bf_lo(yn[j].y), bf_hi(yn[j].y)}; v[j] = xn[j] * DN_ALPHA + g1[j] * y; s += (v[j][0] + v[j][1]) + (v[j][2] + v[j][3]); }
            if (r + 8 < NTOK) { const int mn = m + 8; const f32x4* xr = (const f32x4*)xrow_in(a, l, mn) + lane; const u32x2* yr = (const u32x2*)(Y + (size_t)mn * DM) + lane;
#pragma unroll
                for (int j = 0; j < 4; ++j) { xn[j] = xr[64 * j]; yn[j] = yr[64 * j]; } }
            const float mean = wave_sum(s) * (1.0f / DM); float s2 = 0.f;
#pragma unroll
            for (int j = 0; j < 4; ++j) { v[j] = v[j] - mean; s2 += (v[j][0] * v[j][0] + v[j][1] * v[j][1]) + (v[j][2] * v[j][2] + v[j][3] * v[j][3]); }
            const float rstd = __builtin_amdgcn_rsqf(wave_sum(s2) * (1.0f / DM) + LN_EPS);
            f32x4* xo = (f32x4*)(XS + (size_t)m * DM) + lane; u32x2* ho = (u32x2*)(H + (size_t)m * DM) + lane; u32x2* hl = (u32x2*)(HL + (size_t)m * DM) + lane;
#pragma unroll
            for (int j = 0; j < 4; ++j) { const f32x4 x1 = v[j] * rstd * lng[j] + lnb[j]; xo[64 * j] = x1;
                const f32x4 h = x1 * sc2[j] + sh2[j];
                const unsigned h01 = cvt_pk_bf16(h[0], h[1]), h23 = cvt_pk_bf16(h[2], h[3]);
                ho[64 * j] = (u32x2){h01, h23};
                hl[64 * j] = (u32x2){cvt_pk_bf16(h[0] - bf_lo(h01), h[1] - bf_hi(h01)), cvt_pk_bf16(h[2] - bf_lo(h23), h[3] - bf_hi(h23))}; }
        }
    }
    VM_WAIT(); __syncthreads();
    if (D_DELAY) { const unsigned long long t0d = __builtin_amdgcn_s_memrealtime(); while (__builtin_amdgcn_s_memrealtime() - t0d < (unsigned long long)D_DELAY) __builtin_amdgcn_s_sleep(16); }
    TS(4);
    __builtin_amdgcn_fence(__ATOMIC_ACQUIRE, "agent"); VM_WAIT();
    if (!dry || (PROBE_D & 2)) {
        const bf16_t* WH = (const bf16_t*)(a.ws() + WS_WRHI) + (size_t)l * 64 * DM; const bf16_t* WL = (const bf16_t*)(a.ws() + WS_WRLO) + (size_t)l * 64 * DM;
        const int ntile = wave & 3, mt0 = wave >> 2, fr = lane & 15, fq = lane >> 4;
        constexpr int AQ = 264;
        LAS bf16_t* Ahi = (LAS bf16_t*)(lds + 32768); LAS bf16_t* Alo = Ahi + 80 * AQ;
        f32x4 acc[3];
#pragma unroll
        for (int i = 0; i < 3; ++i) acc[i] = (f32x4){0.f, 0.f, 0.f, 0.f};
        bf16x8 rh[5], rl[5];
#define D_FETCH(KQ) do { _Pragma("unroll") for (int ii = 0; ii < 5; ++ii) { const int p = tid + 512 * ii; if (p < NTOK * 32) { const size_t g = (size_t)(tok0 + (p >> 5)) * DM + (KQ) * 256 + (p & 31) * 8; \
            rh[ii] = *(const bf16x8*)(H + g); rl[ii] = *(const bf16x8*)(HL + g); } } } while (0)
        D_FETCH(0);
#pragma unroll 1
        for (int kq = 0; kq < 4; ++kq) {
            bf16x8 bh[8], bl[8];
#pragma unroll
            for (int q = 0; q < 8; ++q) { const size_t fo = (((size_t)ntile * 32 + kq * 8 + q) * 64 + lane) * 8; bh[q] = *(const bf16x8*)(WH + fo); bl[q] = *(const bf16x8*)(WL + fo); }
            __syncthreads();
#pragma unroll
            for (int ii = 0; ii < 5; ++ii) { const int p = tid + 512 * ii; if (p < NTOK * 32) { *(LAS bf16x8*)(Ahi + (p >> 5) * AQ + (p & 31) * 8) = rh[ii]; *(LAS bf16x8*)(Alo + (p >> 5) * AQ + (p & 31) * 8) = rl[ii]; } }
            __syncthreads();
            if (kq < 3) D_FETCH(kq + 1);
#pragma unroll
            for (int q = 0; q < 8; ++q)
#pragma unroll
                for (int i = 0; i < 3; ++i) if (i < 2 || mt0 == 0) {
                    const bf16x8 ahv = *(const LAS bf16x8*)(Ahi + ((mt0 + 2 * i) * 16 + fr) * AQ + q * 32 + fq * 8), alv = *(const LAS bf16x8*)(Alo + ((mt0 + 2 * i) * 16 + fr) * AQ + q * 32 + fq * 8);
                    acc[i] = __builtin_amdgcn_mfma_f32_16x16x32_bf16(ahv, bh[q], acc[i], 0, 0, 0);
                    acc[i] = __builtin_amdgcn_mfma_f32_16x16x32_bf16(ahv, bl[q], acc[i], 0, 0, 0);
                    acc[i] = __builtin_amdgcn_mfma_f32_16x16x32_bf16(alv, bh[q], acc[i], 0, 0, 0); }
        }
#undef D_FETCH
#pragma unroll
        for (int i = 0; i < 3; ++i) if (i < 2 || mt0 == 0)
#pragma unroll
            for (int q = 0; q < 4; ++q) lg[((mt0 + 2 * i) * 16 + fq * 4 + q) * 64 + ntile * 16 + fr] = acc[i][q];
    }
    __syncthreads(); TS(5);
    if (!dry || (PROBE_D & 4)) {
        int* tke = (int*)(a.ws() + WS_TKE); float* tkw = (float*)(a.ws() + WS_TKW);
        const float ebias = a.in(I_EBIAS)[l * 64 + lane];
        for (int r = wave; r < NTOK; r += 8) {
            const int m = tok0 + r;
            const float score = 1.0f / (1.0f + __expf(-lg[r * 64 + lane]));
            const float sel = score + ebias; int rank = 0;
#pragma unroll
            for (int c = 0; c < 64; ++c) { const float o = __int_as_float(__builtin_amdgcn_readlane(__float_as_int(sel), c)); rank += (o > sel || (o == sel && c < lane)) ? 1 : 0; }
            const bool mine = rank < TOPK;
            const unsigned long long taken = __ballot(mine);
            const float wsum = wave_sum(mine ? score : 0.f);
            if (mine) { const int k = __popcll(taken & ((1ull << lane) - 1ull)); const int lr = __hip_atomic_fetch_add(&hist[lane], 1, __ATOMIC_RELAXED, __HIP_MEMORY_SCOPE_WORKGROUP);
                if (!dry) { tke[m * 8 + k] = lane; tkw[m * 8 + k] = score / wsum * ROUTE_SCALE; } pend[r * 8 + k] = (lane << 16) | lr; }
        }
    }
    __syncthreads();
    if (dry) return;
    { unsigned* cnt = (unsigned*)(a.ws() + WS_CTL) + CW_CNT + l * 64;
      if (tid < 64) hist[64 + tid] = (int)atomicAdd(&cnt[tid], (unsigned)hist[tid]); }
    __syncthreads();
    { int* tkp = (int*)(a.ws() + WS_TKP); int* list = (int*)(a.ws() + WS_LIST);
      for (int i = tid; i < NTOK * 8; i += 512) { const int pe = pend[i], e = pe >> 16, p = hist[64 + e] + (pe & 0xffff); const int m = tok0 + (i >> 3);
        tkp[m * 8 + (i & 7)] = p; list[(size_t)e * TT + p] = m; } }
    __syncthreads();
}

constexpr float YB_SCALE_G = 32.0f;
__device__ __forceinline__ void phase_combine_ln2(const KA& a, LAS unsigned char* lds, int l, int gw, int NGW, int tid, int lane, const bool dry) {
    LAS int* rst = (LAS int*)(lds + LDS_TAB) + 66;
    const float* mod = (const float*)(a.ws() + WS_MOD) + (size_t)l * 5 * 6144;
    const unsigned char* YB = (const unsigned char*)(a.ws() + WS_YB);
    const float* XSi = (const float*)(a.ws() + WS_XS); float* XS = (float*)(a.ws() + (dry ? WS_ACT : WS_XS)); bf16_t* H = (bf16_t*)(a.ws() + (dry ? WS_HL : WS_H));
    const int* tke = (const int*)(a.ws() + WS_TKE); const float* tkw = (const float*)(a.ws() + WS_TKW); const int* tkp = (const int*)(a.ws() + WS_TKP);
    const int mend = (l == DEPTH - 1) ? TLAT : TT;
    const int e0 = 16 * lane;
    f32x4 lng[4], lnb[4];
    { const f32x4* pg = (const f32x4*)(a.in(I_LN2G) + l * DM + e0); const f32x4* pb = (const f32x4*)(a.in(I_LN2B) + l * DM + e0);
#pragma unroll
      for (int j = 0; j < 4; ++j) { lng[j] = pg[j]; lnb[j] = pb[j]; } }
    float* outp = dry ? (float*)(a.ws() + WS_ACT) : a.out();
#define G_SLOTS(M0, SLOT, W) do { _Pragma("unroll") for (int q = 0; q < 2; ++q) { const int mq = (q == 0 || (M0) + NGW < mend) ? (M0) + q * NGW : (M0); SLOT[q] = 0; W[q] = 1.0f / YB_SCALE_G; \
        if ((M0) < mend) { if (lane < 8) { SLOT[q] = rst[tke[mq * 8 + lane]] + tkp[mq * 8 + lane]; W[q] = tkw[mq * 8 + lane] * (1.0f / YB_SCALE_G); } if (lane == 8) SLOT[q] = rst[64] + mq; } } } while (0)
    int slotn[2]; float wn[2];
    G_SLOTS(gw, slotn, wn);
    for (int m0 = gw; m0 < mend; m0 += 2 * NGW) {
        int mm[2]; mm[0] = m0; mm[1] = (m0 + NGW < mend) ? m0 + NGW : m0;
        const bool two = (m0 + NGW < mend);
        int slot[2]; float w[2];
        slot[0] = slotn[0]; slot[1] = slotn[1]; w[0] = wn[0]; w[1] = wn[1];
        G_SLOTS(m0 + 2 * NGW, slotn, wn);
        f32x4 ff[2][4]; f32x4 xv[2][4];
#pragma unroll
        for (int q = 0; q < 2; ++q) { const f32x4* xi = (const f32x4*)(XSi + (size_t)mm[q] * DM + e0);
#pragma unroll
            for (int j = 0; j < 4; ++j) { ff[q][j] = (f32x4){0.f, 0.f, 0.f, 0.f}; xv[q][j] = xi[j]; } }
        u32x4 yy[2][9];
#pragma unroll
        for (int k = 0; k < 9; ++k)
#pragma unroll
            for (int q = 0; q < 2; ++q) { const int sk = __builtin_amdgcn_readlane(slot[q], k); yy[q][k] = *(const u32x4*)(YB + (size_t)sk * DM + e0); }
#pragma unroll
        for (int k = 0; k < 9; ++k)
#pragma unroll
            for (int q = 0; q < 2; ++q) { const float wk = __int_as_float(__builtin_amdgcn_readlane(__float_as_int(w[q]), k));
#pragma unroll
                for (int j = 0; j < 4; ++j) { const f32x2 lo2 = __builtin_amdgcn_cvt_pk_f32_fp8((int)yy[q][k][j], false), hi2 = __builtin_amdgcn_cvt_pk_f32_fp8((int)yy[q][k][j], true);
                    ff[q][j] += (f32x4){lo2.x, lo2.y, hi2.x, hi2.y} * wk; } }
#pragma unroll
        for (int q = 0; q < 2; ++q) {
            if (q == 1 && !two) break;
            const int m = mm[q]; const float* md = mod + (size_t)tok_batchrow(m) * 6144;
            f32x4 v[4]; float s = 0.f;
#pragma unroll
            for (int j = 0; j < 4; ++j) { const f32x4 g2 = *((const f32x4*)(md + 5 * DM + e0) + j);
                v[j] = xv[q][j] * DN_ALPHA + g2 * ff[q][j]; s += (v[j][0] + v[j][1]) + (v[j][2] + v[j][3]); }
            const float mean = wave_sum(s) * (1.0f / DM); float s2 = 0.f;
#pragma unroll
            for (int j = 0; j < 4; ++j) { v[j] = v[j] - mean; s2 += (v[j][0] * v[j][0] + v[j][1] * v[j][1]) + (v[j][2] * v[j][2] + v[j][3] * v[j][3]); }
            const float rstd = __builtin_amdgcn_rsqf(wave_sum(s2) * (1.0f / DM) + LN_EPS);
            if (l == DEPTH - 1) {
                f32x4* oo = (f32x4*)(outp + (size_t)m * DM + e0);
#pragma unroll
                for (int j = 0; j < 4; ++j) oo[j] = v[j] * rstd * lng[j] + lnb[j];
            } else {
                const float* mdn = md + 5 * 6144;
                f32x4* xio = (f32x4*)(XS + (size_t)m * DM + e0); u32x4* ho = (u32x4*)(H + (size_t)m * DM + e0);
                unsigned hp[8];
#pragma unroll
                for (int j = 0; j < 4; ++j) { const f32x4 x2 = v[j] * rstd * lng[j] + lnb[j]; xio[j] = x2;
                    const f32x4 sh = *((const f32x4*)(mdn + e0) + j), sc = *((const f32x4*)(mdn + DM + e0) + j);
                    const f32x4 h = x2 * (sc + 1.0f) + sh; hp[2 * j] = cvt_pk_bf16(h[0], h[1]); hp[2 * j + 1] = cvt_pk_bf16(h[2], h[3]); }
                ho[0] = (u32x4){hp[0], hp[1], hp[2], hp[3]}; ho[1] = (u32x4){hp[4], hp[5], hp[6], hp[7]};
            }
        }
    }
#undef G_SLOTS
}

__device__ __forceinline__ void build_expert_tables(const KA& a, LAS unsigned char* lds, int l, int tid) {
    LAS int* tst = (LAS int*)(lds + LDS_TAB); LAS int* rst = tst + 66; LAS int* cn = rst + 66;
    __syncthreads();
    if (tid < 64) {
        const unsigned* cnt = (const unsigned*)(a.ws() + WS_CTL) + CW_CNT + l * 64;
        const int c = (int)__hip_atomic_load(cnt + tid, __ATOMIC_RELAXED, __HIP_MEMORY_SCOPE_AGENT);
        int t = (c + 255) >> 8, r = c;
#pragma unroll
        for (int o = 1; o < 64; o <<= 1) { const int t2 = __shfl_up(t, o), r2 = __shfl_up(r, o); if (tid >= o) { t += t2; r += r2; } }
        tst[tid] = t - ((c + 255) >> 8); rst[tid] = r - c; cn[tid] = c;
        const int nsh = (l == DEPTH - 1) ? TLAT : TT;
        if (tid == 63) { tst[64] = t; rst[64] = r; cn[64] = nsh; tst[65] = t + (nsh >> 8); rst[65] = r + nsh; }
    }
    __syncthreads();
}

struct Seg {
    int i0, c, G, first, n;
    __device__ __forceinline__ void init(int first_, int n_, int c_, int G_) { first = first_; n = n_; c = c_; G = G_; i0 = (first_ <= c_) ? 0 : (first_ - c_ + G_ - 1) / G_; }
    __device__ __forceinline__ int idx(int i) const { const int L = (i0 + i) * G + c - first; return L < n ? L : -1; }
};
__device__ __forceinline__ int kv_row0(int pm) { return pm < 64 ? (pm >> 4) * KVR + (pm & 15) * 256 : (pm - 64) * KVR + LSEQ; }

struct SchedQKVE { Seg s; unsigned char* ws; int j;
    __device__ __forceinline__ bool next(int i, pg8::Unit& u) { const int L0 = s.idx(i); if (L0 < 0) return false;
        size_t offA, offB, offC; int ldc, x0, x1 = 0;
        if (L0 >= 340) { const int L = L0 - 340; x0 = 3;
            if (L < 128) { const int q = L >> 6, mt = L & 63, b = mt >> 4;
                offA = WS_WF + ((size_t)j * 512 + q * 256) * 2048; offB = WS_H + (size_t)mt * 256 * 2048; offC = WS_ZT + ((size_t)b * 256 * 8192 + q * 4096 + (mt & 15) * 256) * 2; ldc = 8192; }
            else { const int q = (L - 128) >> 2, b = (L - 128) & 3;
                offA = WS_WF + ((size_t)j * 512 + q * 256) * 2048; offB = WS_H + (size_t)(TLAT + b * 256) * 2048; offC = WS_ZCT + ((size_t)b * 256 * 512 + q * 256) * 2; ldc = 512; }
        } else { const int pm = L0 % 68, pn = L0 / 68;
            offA = WS_H + (size_t)pm * 256 * 2048; offB = WS_WINE + ((size_t)j * 1280 + pn * 256) * 2048; x1 = pm < 64 ? (pm & 15) * 256 : -1;
            if (pn < 3) { offC = WS_QB + ((size_t)pm * 256 * 768 + pn * 256) * 2; ldc = 768; x0 = 0; }
            else { offC = (pn == 3 ? WS_KB : WS_VB) + (size_t)kv_row0(pm) * 128 * 2; ldc = 128; x0 = pn - 2; } }
        u.A = (const char*)(ws + offA); u.B = (const char*)(ws + offB); u.C = (char*)(ws + offC); u.ldc = ldc; u.x0 = x0; u.x1 = x1; u.rows = nullptr; u.nvalid = 256;
        return true; } };
struct SchedQKVO { Seg s; unsigned char* ws; int j;
    __device__ __forceinline__ bool next(int i, pg8::Unit& u) { const int L = s.idx(i); if (L < 0) return false; const int pm = L % 68, pn = L / 68;
        u.A = (const char*)(ws + WS_H) + (size_t)pm * 256 * 2048; u.B = (const char*)(ws + WS_WINO) + ((size_t)j * 3072 + pn * 256) * 2048; u.rows = nullptr; u.nvalid = 256; u.x0 = 0; u.x1 = 0; u.ldc = 1024;
        if (pn < 4) u.C = (char*)(ws + WS_QB) + ((size_t)pm * 256 * 1024 + pn * 256) * 2;
        else u.C = (char*)(ws + (pn < 8 ? WS_KB : WS_VB)) + ((size_t)kv_row0(pm) * 1024 + (pn & 3) * 256) * 2;
        return true; } };
struct SchedDFT { Seg s; unsigned char* ws;
    __device__ __forceinline__ bool next(int i, pg8::Unit& u) { const int L = s.idx(i); if (L < 0) return false; const int pm = L & 15, b = L >> 4;
        u.A = (const char*)(ws + WS_TW) + (size_t)pm * 256 * 16384; u.B = (const char*)(ws + WS_ZT) + (size_t)b * 256 * 16384;
        u.C = (char*)(ws + WS_O) + (size_t)(b * LSEQ + pm * 256) * 1024 * 2; u.ldc = 1024; u.rows = nullptr; u.nvalid = 256; u.x0 = 0; u.x1 = 0; return true; } };
struct SchedDFTC { Seg s; unsigned char* ws;
    __device__ __forceinline__ bool next(int i, pg8::Unit& u) { const int b = s.idx(i); if (b < 0) return false;
        u.A = (const char*)(ws + WS_TWC); u.B = (const char*)(ws + WS_ZCT) + (size_t)b * 256 * 1024;
        u.C = (char*)(ws + WS_O) + (size_t)(TLAT + b * 256) * 1024 * 2; u.ldc = 1024; u.rows = nullptr; u.nvalid = 256; u.x0 = 0; u.x1 = 0; return true; } };
struct SchedOUT { Seg s; unsigned char* ws; int l, nm;
    __device__ __forceinline__ bool next(int i, pg8::Unit& u) { const int L = s.idx(i); if (L < 0) return false; const int pm = L % nm, pn = L / nm;
        u.A = (const char*)(ws + WS_O) + (size_t)pm * 256 * 2048; u.B = (const char*)(ws + WS_WOUT) + ((size_t)l * 1024 + pn * 256) * 2048;
        u.C = (char*)(ws + WS_Y) + ((size_t)pm * 256 * 1024 + pn * 256) * 2; u.ldc = 1024; u.rows = nullptr; u.nvalid = 256; u.x0 = 0; u.x1 = 0; return true; } };
struct SchedGU { Seg s; unsigned char* ws; int l; const LAS int* tab; int e; int L0, cnt; int probe;
    __device__ __forceinline__ bool next(int i, pg8::Unit& u) { const int L = cnt > 0 ? (i < cnt ? L0 + i : -1) : s.idx(i); if (L < 0) return false; const int mtg = L >> 1, nt = L & 1;
        while (tab[e + 1] <= mtg) ++e;
        while (tab[e] > mtg) --e;
        const int mt = mtg - tab[e], r0 = tab[66 + e] + mt * 256;
        u.A = (const char*)(ws + WS_H); u.rows = (const int*)(ws + WS_LIST) + (size_t)e * TT + mt * 256; u.nvalid = min(256, tab[132 + e] - mt * 256);
        u.B = (const char*)(ws + WS_WGU) + ((size_t)(l * 65 + e) * 512 + nt * 256) * 2048;
        u.C = (char*)(ws + WS_ACT) + ((size_t)r0 * 256 + nt * 128) * 2; u.ldc = 256; u.x0 = 0; u.x1 = 0;
        if (probe & 1) u.rows = (const int*)(ws + WS_LIST) + (size_t)64 * TT + (mtg & 63) * 256;
        if (probe & 2) u.nvalid = 0;
        return true; } };
struct SchedDN { Seg s; unsigned char* ws; int l; const LAS int* tab; int e; int probe; int L0, cnt;
    __device__ __forceinline__ bool next(int i, pg8::Unit& u) { const int L = cnt > 0 ? (i < cnt ? L0 + i : -1) : s.idx(i); if (L < 0) return false; const int mtg = L >> 2, nt = L & 3;
        while (tab[e + 1] <= mtg) ++e;
        while (tab[e] > mtg) --e;
        const int mt = mtg - tab[e], r0 = tab[66 + e] + mt * 256;
        u.A = (const char*)(ws + WS_ACT) + (size_t)r0 * 512; u.rows = nullptr; u.nvalid = min(256, tab[132 + e] - mt * 256);
        u.B = (const char*)(ws + WS_WD) + ((size_t)(l * 65 + e) * 1024 + nt * 256) * 512;
        u.C = (char*)(ws + WS_YB) + ((size_t)r0 * 1024 + nt * 256); u.ldc = 1024; u.x0 = 0; u.x1 = 0;
        if (probe & 1) u.nvalid = 0;
        if (probe & 2) { u.A = (const char*)(ws + WS_ACT); u.B = (const char*)(ws + WS_WD) + (size_t)(l * 65) * 1024 * 512; }
        return true; } };

constexpr int NPHASE = 2 + 7 * DEPTH;
#ifndef PHMASK
#define PHMASK 0xFFFFF
#endif
#define SITE(b) if constexpr ((PHMASK >> (b)) & 1)
#ifndef REP_A
#define REP_A 1
#endif
#ifndef REP_B
#define REP_B 1
#endif
#ifndef REP_BO
#define REP_BO 1
#endif
#ifndef REP_C
#define REP_C 1
#endif
#ifndef REP_E
#define REP_E 1
#endif
#ifndef REP_F
#define REP_F 1
#endif
#ifndef REP_D
#define REP_D 1
#endif
#ifndef REP_G
#define REP_G 1
#endif
#ifndef REP_BAR
#define REP_BAR 1
#endif
#ifndef PROBE_TS_SCALE
#define PROBE_TS_SCALE 0.0002f
#endif
#ifndef PROBE_TS_A
#define PROBE_TS_A 0
#endif
#ifndef PROBE_TS_B
#define PROBE_TS_B 1
#endif
#ifndef EF_FUSED
#define EF_FUSED 0
#endif
#ifndef E_STAGGER
#define E_STAGGER 0
#endif
#ifndef PROBE_E
#define PROBE_E 0
#endif
#ifndef PROBE_F
#define PROBE_F 0
#endif
#ifndef REP_P0
#define REP_P0 1
#endif
__global__ void __launch_bounds__(512, 2) fwd(Args args_) {
    extern __shared__ __attribute__((aligned(16))) unsigned char lds_raw[];
    LAS unsigned char* lds = (LAS unsigned char*)lds_raw;
    const int G = gridDim.x, bid = ((G & 7) == 0) ? (int)(blockIdx.x & 7) * (G >> 3) + (int)(blockIdx.x >> 3) : (int)blockIdx.x;
#define tid (opaque_tid())
#define lane (opaque_tid() & 63)
#define wave (__builtin_amdgcn_readfirstlane(opaque_tid() >> 6))
    const KA a;
#define WSP (a.ws())
#define args a
    volatile LAS unsigned* MISC = (volatile LAS unsigned*)(lds + LDS_MISC);
    { const int t0 = threadIdx.x; if (t0 < 64) MISC[t0] = 0u; }
    __syncthreads();
    if (PROBE_TS && threadIdx.x == 0) *(volatile LAS unsigned long long*)(lds + LDS_MISC + 192) = __builtin_amdgcn_s_memrealtime();
#define lo (a.ph_lo())
#define hi (a.ph_hi())
    XcdBarrier bar; bar.bar = (unsigned*)(WSP + WS_CTL) + CW_BAR; bar.x = 0; bar.st = MISC + 8;
    if (hi - lo > 1) bar = xcd_barrier_post((unsigned*)(WSP + WS_CTL) + CW_BAR, MISC + 8);
#define IN(k) (lo <= (k) && (k) < hi)
#define SEAM(k) do { if (IN(k) && IN((k) + 1)) for (int rb = 0; rb < REP_BAR; ++rb) xcd_barrier(bar); TS(((k) < 2) ? 16 : 17 + ((k) - 2) % 7); } while (0)
    const int NGW = G * 8;
#define gw (bid * 8 + wave)

    if (IN(0)) SITE(0) for (int rep = 0; rep < REP_P0; ++rep) {
        __syncthreads();
        p0_mod(args, lds, bid, G, tid, wave, lane); TS(11);
        if (bid >= G - 64) p0_fourier_fold(args, lds, G - 1 - bid, tid, wave, lane);
        TS(12); p0_tables(args, lds, bid * 512 + tid, G * 512, tid); TS(13);
        { int* ident = (int*)(WSP + WS_LIST) + (size_t)NEXP * TT; for (int i = bid * 512 + tid; i < TT; i += G * 512) ident[i] = i; }
        __syncthreads();
        if (CV_MODE == 0) convert_items(lds, 0, 0, cv_items(0), bid, G);
        else { convert_items(lds, 0, CV_EX, cv_items(0), bid, G); convert_items(lds, 0, 3000, CV_EX, bid, G); }
        if (CV_MODE == 0) { for (int lq = 1; lq < DEPTH; ++lq) convert_items(lds, lq, 0, cv_items(lq), bid, G); }
        TS(14);
    }
    TS(0); SEAM(0);
    if (IN(1)) SITE(0) p0b_modulate(args, gw, NGW, lane);
    TS(0); SEAM(1);

    for (int l = 0; l < DEPTH; ++l) {
        const int pb = 2 + 7 * l, j = l >> 1;
        if (IN(pb + 0)) for (int rep = 0; rep < REP_A; ++rep) {
            if ((l & 1) == 0) {
                SITE(1) { SchedQKVE S; S.s.init(0, 476, bid, G); S.ws = WSP; S.j = j;
                  pg8::EpiQKVE E; E.P = (LAS float*)(lds + LDS_EPI); E.gainp = (const float*)(WSP + WS_GAINP) + j * 256; E.rope = (const f32x2*)(WSP + WS_ROPE);
                  pg8::gemm_phase<pg8::EpiQKVE, SchedQKVE, false>(lds, 1024, S, E); }
            } else SITE(3) {
                SchedQKVO S; S.s.init(0, 816, bid, G); S.ws = WSP; S.j = j; pg8::EpiStore E;
                pg8::gemm_phase<pg8::EpiStore, SchedQKVO, false>(lds, 1024, S, E);
                if (rep == 0) cv_tail(lds, l, 0, 816, bid, G);
            }
        }
        TS(1); SEAM(pb + 0);
        if (IN(pb + 1)) for (int rep = 0; rep < ((l & 1) ? REP_BO : REP_B); ++rep) {
            __syncthreads();
            const bf16_t* QB = (const bf16_t*)(WSP + WS_QB); const bf16_t* KB = (const bf16_t*)(WSP + WS_KB); const bf16_t* VB = (const bf16_t*)(WSP + WS_VB); bf16_t* O = (bf16_t*)(WSP + WS_O);
            if ((l & 1) == 0) {
                SITE(4) { SchedDFT S; S.s.init(0, 64, bid, G); S.ws = WSP; pg8::EpiStore E; pg8::gemm_phase<pg8::EpiStore, SchedDFT, false>(lds, 8192, S, E); }
                SITE(5) { SchedDFTC S; S.s.init(28, 4, bid, G); S.ws = WSP; pg8::EpiStore E; pg8::gemm_phase<pg8::EpiStore, SchedDFTC, false>(lds, 512, S, E); }
                __syncthreads();
                if (bid < 64 && rep == 0) { const CvSlice c = cv_slice(l, 1); if (c.i1 > c.i0) { __syncthreads(); convert_items(lds, c.l, c.i0, c.i1, bid, 64); __syncthreads(); } }
                SITE(6) {
                    int u = (bid < 24) ? bid : (bid >= 64 ? bid - 40 : 408);
                    while (u < 408) {
                        const bf16_t *q, *k, *v; bf16_t* o; int ntile;
                        if (u < 24) { const int b = u / 6, h = u % 6; q = QB + (TLAT + b * 256) * 768 + h * 128; k = KB + ((h / 3) * NB * KVR + b * KVR + LSEQ) * 128; v = VB + ((h / 3) * NB * KVR + b * KVR + LSEQ) * 128;
                            o = O + (TLAT + b * 256) * 1024 + 256 + h * 128; ntile = 4; u = 408; }
                        else { const int uu = u - 24, bk = uu / 48, x = uu % 48, b = bk >> 1, kvh = bk & 1, h = kvh * 3 + x / 16, qb = x & 15;
                            q = QB + (b * LSEQ + qb * 256) * 768 + h * 128; k = KB + (kvh * NB * KVR + b * KVR) * 128; v = VB + (kvh * NB * KVR + b * KVR) * 128;
                            o = O + (b * LSEQ + qb * 256) * 1024 + 256 + h * 128; ntile = 68; u += 192; }
                        att::attn_body<false, 768, 128, 1024>(q, k, v, o, ntile, 0, 0, 0, (char*)lds_raw);
                    }
                }
            } else {
                const float* rpb = a.in(I_NARPB) + (size_t)j * 8 * 465;
                LAS float* bt = (LAS float*)(lds + att::LDS_BIAS);
                SITE(7) for (int u = bid; u < ((l == DEPTH - 1) ? 512 : 544); u += G) {
                    const bf16_t *q, *k, *v; bf16_t* o; int ntile, nloc, bs, q0r, h;
                    if (u < 512) { const int bh = u >> 4, blk = u & 15, b = bh >> 3; h = bh & 7; bs = min(max(4 * blk - 4, 0), 52); q0r = 4 * blk; ntile = 16; nloc = 12;
                        q = QB + (b * LSEQ + blk * 256) * 1024 + h * 128; k = KB + b * KVR * 1024 + h * 128; v = VB + b * KVR * 1024 + h * 128; o = O + (b * LSEQ + blk * 256) * 1024 + h * 128; }
                    else { const int b = (u - 512) >> 3; h = u & 7; bs = 0; q0r = 0; ntile = 4; nloc = 0;
                        q = QB + (TLAT + b * 256) * 1024 + h * 128; k = KB + b * KVR * 1024 + h * 128; v = VB + b * KVR * 1024 + h * 128; o = O + (TLAT + b * 256) * 1024 + h * 128; }
                    for (int i = tid; i < 465; i += 512) bt[64 + i] = rpb[h * 465 + i] * (1.0f / ATT_SCALE);
                    att::attn_body<true, 1024, 1024, 1024>(q, k, v, o, ntile, nloc, bs, q0r, (char*)lds_raw);
                }
            }
        }
        TS(2); SEAM(pb + 1);
        if (IN(pb + 2)) SITE(9) for (int rep = 0; rep < REP_C; ++rep) { const int nm = (l == DEPTH - 1) ? 64 : 68;
            SchedOUT S; S.s.init(0, nm * 4, bid, G); S.ws = WSP; S.l = l; S.nm = nm; pg8::EpiStore E; pg8::gemm_phase<pg8::EpiStore, SchedOUT, false>(lds, 1024, S, E);
            if (rep == 0) cv_tail(lds, l, 2, nm * 4, bid, G); }
        TS(3); SEAM(pb + 2);
        if (IN(pb + 3)) SITE(10) for (int rep = 0; rep < REP_D; ++rep) { __syncthreads(); phase_ln1_router(args, lds, l, bid, tid, wave, lane, rep + 1 < REP_D); }
        TS(6); SEAM(pb + 3);
#if EF_FUSED
        if (IN(pb + 4)) SITE(11) for (int rep = 0; rep < REP_E; ++rep) { build_expert_tables(args, lds, l, tid);
            const LAS int* tab = (const LAS int*)(lds + LDS_TAB);
            const int nsu = tab[65]; int ecur = 0;
            for (int su = bid; su < nsu; su += G) {
                { SchedGU S; S.s.init(0, 0, bid, G); S.ws = WSP; S.l = l; S.tab = tab; S.e = ecur; S.L0 = su * 2; S.cnt = 2; S.probe = 0; pg8::EpiSwiGLU E;
                  pg8::gemm_phase<pg8::EpiSwiGLU, SchedGU, true>(lds, 1024, S, E); ecur = S.e; }
                VM_WAIT(); __syncthreads();
                __builtin_amdgcn_fence(__ATOMIC_ACQUIRE, "agent"); VM_WAIT();
                { SchedDN S; S.s.init(0, 0, bid, G); S.ws = WSP; S.l = l; S.tab = tab; S.e = ecur; S.probe = 0; S.L0 = su * 4; S.cnt = 4; pg8::EpiStoreF8 E;
                  int k256 = 256; asm volatile("" : "+s"(k256));
                  pg8::gemm_phase<pg8::EpiStoreF8, SchedDN, false>(lds, k256, S, E); }
            }
            if (rep == 0) { cv_tail(lds, l, 4, nsu, bid, G); cv_tail(lds, l, 5, nsu, bid, G); } }
        TS(7); SEAM(pb + 4);
        if (IN(pb + 5) && !IN(pb + 4)) {}
#else
        if (IN(pb + 4)) SITE(11) for (int rep = 0; rep < REP_E; ++rep) { build_expert_tables(args, lds, l, tid);
            const LAS int* tab = (const LAS int*)(lds + LDS_TAB);
            if (E_STAGGER && (bid & 1) && bid >= 8) { const unsigned long long t0s = __builtin_amdgcn_s_memrealtime(); while (__builtin_amdgcn_s_memrealtime() - t0s < (unsigned long long)E_STAGGER) __builtin_amdgcn_s_sleep(16); }
            SchedGU S; S.s.init(0, tab[65] * 2, bid, G); S.ws = WSP; S.l = l; S.tab = tab; S.e = 0; S.L0 = 0; S.cnt = 0; S.probe = (rep + 1 < REP_E) ? PROBE_E : 0; pg8::EpiSwiGLU E;
            pg8::gemm_phase<pg8::EpiSwiGLU, SchedGU, true>(lds, 1024, S, E);
            if (rep == 0) cv_tail(lds, l, 4, tab[65] * 2, bid, G); }
        TS(7); SEAM(pb + 4);
        if (IN(pb + 5)) SITE(12) for (int rep = 0; rep < REP_F; ++rep) { if (!IN(pb + 4)) build_expert_tables(args, lds, l, tid);
            const LAS int* tab = (const LAS int*)(lds + LDS_TAB);
            SchedDN S; S.s.init(0, tab[65] * 4, bid, G); S.ws = WSP; S.l = l; S.tab = tab; S.e = 0; S.probe = (rep + 1 < REP_F) ? PROBE_F : 0; S.L0 = 0; S.cnt = 0; pg8::EpiStoreF8 E;
            int k256 = 256; asm volatile("" : "+s"(k256));
            pg8::gemm_phase<pg8::EpiStoreF8, SchedDN, false>(lds, k256, S, E);
            if (rep == 0) cv_tail(lds, l, 5, tab[65] * 4, bid, G); }
        TS(8); SEAM(pb + 5);
#endif
        if (IN(pb + 6)) SITE(13) for (int rep = 0; rep < REP_G; ++rep) { if (!IN(pb + 4)) build_expert_tables(args, lds, l, tid); phase_combine_ln2(args, lds, l, gw, NGW, tid, lane, rep + 1 < REP_G); }
        TS(9); SEAM(pb + 6);
    }
    if (PROBE_TS) { volatile LAS float* ta_ = (volatile LAS float*)(lds + LDS_MISC + 64);
        float* tsw = (float*)(WSP + WS_CTL) + 32;
        if (blockIdx.x == PROBE_TS_BLK && threadIdx.x == 0) __hip_atomic_store(tsw, ta_[PROBE_TS_A] * 0.01f * PROBE_TS_SCALE, __ATOMIC_RELAXED, __HIP_MEMORY_SCOPE_AGENT);
        xcd_barrier(bar);
        const float va0_unused = 0.f; (void)va0_unused; const float va = __hip_atomic_load(tsw, __ATOMIC_RELAXED, __HIP_MEMORY_SCOPE_AGENT); float* o_ = a.out();
        for (int i = blockIdx.x * 512 + threadIdx.x; i < TLAT * DM; i += G * 512) o_[i] += va; }
#undef IN
#undef SEAM
#undef lo
#undef hi
#undef lane
#undef wave
#undef gw
#undef tid
#undef WSP
#undef args
}

extern "C" void kernel_launch(void* const* d_in, const int* in_sizes, int n_in, void* d_out, int out_size, void* d_ws, size_t ws_size, hipStream_t stream) {
    static int ok = 0;
    if (ok == 0) {
        if (n_in != N_IN || ws_size < WS_END) { fprintf(stderr, "kernel_launch: n_in %d (want %d), ws %zu (want >= %zu)\n", n_in, (int)N_IN, ws_size, (size_t)WS_END); return; }
        if (hipFuncSetAttribute((const void*)fwd, hipFuncAttributeMaxDynamicSharedMemorySize, LDS_BYTES) != hipSuccess) { fprintf(stderr, "kernel_launch: hipFuncSetAttribute failed\n"); return; }
        int per_cu = 0;
        if (hipOccupancyMaxActiveBlocksPerMultiprocessor(&per_cu, (const void*)fwd, 512, LDS_BYTES) != hipSuccess || per_cu < 1) fprintf(stderr, "kernel_launch: occupancy query reports %d\n", per_cu);
        ok = 1;
    }
    Args a;
    memset(&a, 0, sizeof(a));
    for (int i = 0; i < N_IN; ++i) a.in[i] = (const float*)d_in[i];
    a.out = (float*)d_out; a.ws = (unsigned char*)d_ws;
    hipMemsetAsync((char*)d_ws + WS_CTL, 0, CTL_BYTES, stream);
#if MK_ONE_LAUNCH
    a.ph_lo = 0; a.ph_hi = NPHASE;
    hipLaunchKernelGGL(fwd, dim3(256), dim3(512), LDS_BYTES, stream, a);
#else
    for (int p = 0; p < NPHASE; ++p) { a.ph_lo = p; a.ph_hi = p + 1; hipLaunchKernelGGL(fwd, dim3(256), dim3(512), LDS_BYTES, stream, a); }
#endif
    const hipError_t le = hipPeekAtLastError();
    if (le != hipSuccess) fprintf(stderr, "kernel_launch: launch failed: %s\n", hipGetErrorName(le));
}
```

```cpp
#include <hip/hip_runtime.h>
#include <cstdio>
#include <cstdint>
#include <cstring>

#define LAS __attribute__((address_space(3)))
#define GAS __attribute__((address_space(1)))
typedef unsigned short bf16_t;
typedef short bf16x8 __attribute__((ext_vector_type(8)));
typedef short s16x4 __attribute__((ext_vector_type(4)));
typedef float f32x2 __attribute__((ext_vector_type(2)));
typedef float f32x4 __attribute__((ext_vector_type(4)));
typedef float f32x16 __attribute__((ext_vector_type(16)));
typedef unsigned u32x2 __attribute__((ext_vector_type(2)));
typedef unsigned u32x4 __attribute__((ext_vector_type(4)));

#ifndef MK_ONE_LAUNCH
#define MK_ONE_LAUNCH 1
#endif

constexpr int NB = 4, LSEQ = 4096, DM = 1024, NCTX = 256, DEPTH = 4;
constexpr int TLAT = NB * LSEQ, TCTX = NB * NCTX, TT = TLAT + TCTX;
constexpr int KVR = LSEQ + NCTX;
constexpr int NEXP = 64, TOPK = 8, EDIM = 256;
constexpr int NPAIR = TT * TOPK, NSLOT = NPAIR + TT;
constexpr float DN_ALPHA = 1.681792830507429f;
constexpr float LN_EPS = 1e-6f, RMS_EPS = 1e-6f, ROUTE_SCALE = 2.5f;
constexpr float ATT_SCALE = 0.088388347648318440f;

constexpr size_t al256(size_t x) { return (x + 255) / 256 * 256; }
constexpr size_t WS_CTL = 0, CTL_BYTES = 65536;
constexpr size_t WS_MOD = WS_CTL + CTL_BYTES;
constexpr size_t WS_GAINP = WS_MOD + al256((size_t)DEPTH * 5 * 6 * DM * 4);
constexpr size_t WS_ROPE = WS_GAINP + 2048;
constexpr size_t WS_WRHI = WS_ROPE + 16384;
constexpr size_t WS_WRLO = WS_WRHI + (size_t)DEPTH * 64 * DM * 2;
constexpr size_t WS_WF = WS_WRLO + (size_t)DEPTH * 64 * DM * 2;
constexpr size_t WS_WINE = WS_WF + (size_t)2 * 512 * DM * 2;
constexpr size_t WS_WINO = WS_WINE + (size_t)2 * 1280 * DM * 2;
constexpr size_t WS_WOUT = WS_WINO + (size_t)2 * 3072 * DM * 2;
constexpr size_t WS_WGU = WS_WOUT + (size_t)DEPTH * DM * DM * 2;
constexpr size_t WS_WD = WS_WGU + (size_t)DEPTH * 65 * 512 * DM * 2;
constexpr size_t WS_TW = WS_WD + (size_t)DEPTH * 65 * DM * 256 * 2;
constexpr size_t WS_TWC = WS_TW + (size_t)4096 * 8192 * 2;
constexpr size_t WS_XS = WS_TWC + (size_t)256 * 512 * 2;
constexpr size_t WS_H = WS_XS + (size_t)TT * DM * 4;
constexpr size_t WS_TKE = WS_H + (size_t)TT * DM * 2;
constexpr size_t WS_TKW = WS_TKE + (size_t)NPAIR * 4;
constexpr size_t WS_TKP = WS_TKW + (size_t)NPAIR * 4;
constexpr size_t WS_LIST = WS_TKP + (size_t)NPAIR * 4;
constexpr size_t WS_ACT = WS_LIST + (size_t)(NEXP + 1) * TT * 4;
constexpr size_t WS_YB = WS_ACT + (size_t)(NSLOT + 256) * EDIM * 2;
constexpr size_t WS_QB = WS_YB;
constexpr size_t WS_KB = WS_QB + (size_t)TT * DM * 2;
constexpr size_t WS_VB = WS_KB + (size_t)NB * KVR * DM * 2;
constexpr size_t WS_O = WS_VB + (size_t)NB * KVR * DM * 2;
constexpr size_t WS_Y = WS_O + (size_t)TT * DM * 2;
constexpr size_t WS_ZT = WS_Y + (size_t)TT * DM * 2;
constexpr size_t WS_ZCT = WS_ZT + (size_t)1024 * 8192 * 2;
constexpr size_t WS_OVL_END = WS_ZCT + (size_t)1024 * 512 * 2;
constexpr size_t WS_HL = WS_YB + (size_t)NSLOT * DM * 2;
constexpr size_t WS_TRASH = WS_HL + (size_t)TT * DM * 2;
constexpr size_t WS_END = WS_TRASH + (size_t)256 * 16384;
static_assert(WS_OVL_END <= WS_HL, "overlay fits in YB");
static_assert(WS_END <= (size_t)1 << 30, "workspace must fit 1 GiB");
constexpr int CW_TMO = 0, CW_CNT = 64  , CW_BAR = 1024;

constexpr int LDS_BYTES = 147456;
constexpr int LDS_STAGE = 0;
constexpr int LDS_EPI = 131072;
constexpr int LDS_RIDX = 139264;
constexpr int LDS_TAB = 141312;
constexpr int LDS_MISC = 147456 - 256;

__device__ __forceinline__ unsigned cvt_pk_bf16(float lo, float hi) { unsigned r; asm volatile("v_cvt_pk_bf16_f32 %0, %1, %2" : "=v"(r) : "v"(lo), "v"(hi)); return r; }
__device__ __forceinline__ float bf_lo(unsigned u) { return __uint_as_float(u << 16); }
__device__ __forceinline__ float bf_hi(unsigned u) { return __uint_as_float(u & 0xffff0000u); }
__device__ __forceinline__ float wave_sum(float v) {
#pragma unroll
    for (int o = 1; o < 64; o <<= 1) v += __shfl_xor(v, o);
    return v;
}
__device__ __forceinline__ float wave_max(float v) {
#pragma unroll
    for (int o = 1; o < 64; o <<= 1) v = fmaxf(v, __shfl_xor(v, o));
    return v;
}
#define LDS_WAIT() asm volatile("s_waitcnt lgkmcnt(0)" ::: "memory")
#define VM_WAIT() asm volatile("s_waitcnt vmcnt(0)" ::: "memory")

#ifndef PROBE_TS
#define PROBE_TS 0
#endif
#ifndef PROBE_TS_BLK
#define PROBE_TS_BLK 0
#endif
#define TS(k) do { if (PROBE_TS && blockIdx.x == PROBE_TS_BLK && threadIdx.x == 0) { const unsigned long long now_ = __builtin_amdgcn_s_memrealtime(); volatile LAS float* ta_ = (volatile LAS float*)(lds + LDS_MISC + 64); \
    ta_[k] = ta_[k] + (float)(now_ - *(volatile LAS unsigned long long*)(lds + LDS_MISC + 192)); *(volatile LAS unsigned long long*)(lds + LDS_MISC + 192) = now_; } } while (0)

__device__ __forceinline__ int opaque_tid() { int t = threadIdx.x; asm volatile("" : "+v"(t)); return t; }
namespace pg8 {
constexpr int BM = 256, BK = 64, HALF = 128, HTB = HALF * BK * 2  , STAGE_BYTES = 8 * HTB;

__host__ __device__ __forceinline__ int lds_byte(int r, int c) { const int st = (r >> 4) * 2 + (c >> 5), rr = r & 15, cc = c & 31, ob = rr * 64 + cc * 2; return st * 1024 + (ob ^ (((ob >> 9) & 1) << 5)); }
__host__ __device__ __forceinline__ void stage_rc(int b, int& R, int& C) { const int st = b / 1024, sb = b % 1024, swz = sb ^ (((sb >> 9) & 1) << 5); R = (st >> 1) * 16 + swz / 64; C = (st & 1) * 32 + (swz % 64) / 2; }
__host__ __device__ __forceinline__ int perm32(int rho) { const int n = rho >> 4, i = rho & 15; return 8 * (i >> 2) + 4 * n + (i & 3); }

struct Unit { const char* A; const char* B; char* C; const int* rows; int ldc, nvalid, x0, x1; };

struct EpiStore {
    __device__ __forceinline__ void operator()(const f32x4 (&acc)[2][2][4][2], const Unit& u) const {
        const int tid = opaque_tid(), wid = tid >> 6, lane = tid & 63, wr = wid >> 2, wc = wid & 3, fr = lane & 15, fq = lane >> 4;
        const int row0 = wr * 64 + fr, col0 = wc * 32 + 8 * fq;
#pragma unroll
        for (int ai = 0; ai < 2; ++ai)
#pragma unroll
            for (int m = 0; m < 4; ++m) {
                const int r = row0 + ai * HALF + m * 16;
                if (r < u.nvalid) {
                    bf16_t* rowp = (bf16_t*)u.C + (size_t)r * u.ldc + col0;
#pragma unroll
                    for (int bj = 0; bj < 2; ++bj) { const f32x4 v0 = acc[ai][bj][m][0], v1 = acc[ai][bj][m][1];
                        u32x4 w; w.x = cvt_pk_bf16(v0[0], v0[1]); w.y = cvt_pk_bf16(v0[2], v0[3]); w.z = cvt_pk_bf16(v1[0], v1[1]); w.w = cvt_pk_bf16(v1[2], v1[3]);
                        *(u32x4*)(rowp + bj * HALF) = w; }
                }
            }
    }
};
constexpr float YB_SCALE = 32.0f;
struct EpiStoreF8 {
    __device__ __forceinline__ void operator()(const f32x4 (&acc)[2][2][4][2], const Unit& u) const {
        const int tid = opaque_tid(), wid = tid >> 6, lane = tid & 63, wr = wid >> 2, wc = wid & 3, fr = lane & 15, fq = lane >> 4;
        const int row0 = wr * 64 + fr, col0 = wc * 32 + 8 * fq;
#pragma unroll
        for (int ai = 0; ai < 2; ++ai)
#pragma unroll
            for (int m = 0; m < 4; ++m) {
                const int r = row0 + ai * HALF + m * 16;
                if (r < u.nvalid) {
                    unsigned char* rowp = (unsigned char*)u.C + (size_t)r * u.ldc + col0;
#pragma unroll
                    for (int bj = 0; bj < 2; ++bj) { f32x4 v0 = acc[ai][bj][m][0] * YB_SCALE, v1 = acc[ai][bj][m][1] * YB_SCALE;
#pragma unroll
                        for (int t = 0; t < 4; ++t) { v0[t] = __builtin_amdgcn_fmed3f(v0[t], -448.0f, 448.0f); v1[t] = __builtin_amdgcn_fmed3f(v1[t], -448.0f, 448.0f); }
                        int w0 = 0, w1 = 0;
                        w0 = __builtin_amdgcn_cvt_pk_fp8_f32(v0[0], v0[1], w0, false); w0 = __builtin_amdgcn_cvt_pk_fp8_f32(v0[2], v0[3], w0, true);
                        w1 = __builtin_amdgcn_cvt_pk_fp8_f32(v1[0], v1[1], w1, false); w1 = __builtin_amdgcn_cvt_pk_fp8_f32(v1[2], v1[3], w1, true);
                        *(u32x2*)(rowp + bj * HALF) = (u32x2){(unsigned)w0, (unsigned)w1}; }
                }
            }
    }
};
struct EpiSwiGLU {
    __device__ __forceinline__ void operator()(const f32x4 (&acc)[2][2][4][2], const Unit& u) const {
        const int tid = opaque_tid(), wid = tid >> 6, lane = tid & 63, wr = wid >> 2, wc = wid & 3, fr = lane & 15, fq = lane >> 4;
        const int row0 = wr * 64 + fr, col0 = wc * 32 + 8 * fq;
#pragma unroll
        for (int ai = 0; ai < 2; ++ai)
#pragma unroll
            for (int m = 0; m < 4; ++m) {
                const int r = row0 + ai * HALF + m * 16;
                if (r < u.nvalid) {
                    float o[8];
#pragma unroll
                    for (int n = 0; n < 2; ++n)
#pragma unroll
                        for (int j = 0; j < 4; ++j) { const float g = acc[ai][0][m][n][j], up = acc[ai][1][m][n][j];
                            o[n * 4 + j] = g * __builtin_amdgcn_rcpf(1.0f + __builtin_amdgcn_exp2f(-1.4426950408889634f * g)) * up; }
                    u32x4 w; w.x = cvt_pk_bf16(o[0], o[1]); w.y = cvt_pk_bf16(o[2], o[3]); w.z = cvt_pk_bf16(o[4], o[5]); w.w = cvt_pk_bf16(o[6], o[7]);
                    *(u32x4*)((bf16_t*)u.C + (size_t)r * u.ldc + col0) = w;
                }
            }
    }
};
struct EpiQKVE {
    LAS float* P;
    const float* gainp;
    const f32x2* rope;
    __device__ __forceinline__ void operator()(const f32x4 (&acc)[2][2][4][2], const Unit& u) const {
        const int tid = opaque_tid(), wid = tid >> 6, lane = tid & 63, wr = wid >> 2, wc = wid & 3, fr = lane & 15, fq = lane >> 4;
        const int row0 = wr * 64 + fr, col0 = wc * 32 + 8 * fq;
        if (u.x0 >= 2) {
            const size_t bjs = (u.x0 == 2) ? (size_t)NB * KVR * 128 : (size_t)HALF;
#pragma unroll
            for (int ai = 0; ai < 2; ++ai)
#pragma unroll
                for (int m = 0; m < 4; ++m) { bf16_t* rowp = (bf16_t*)u.C + (size_t)(row0 + ai * HALF + m * 16) * u.ldc + col0;
#pragma unroll
                    for (int bj = 0; bj < 2; ++bj) { const f32x4 v0 = acc[ai][bj][m][0], v1 = acc[ai][bj][m][1];
                        u32x4 w; w.x = cvt_pk_bf16(v0[0], v0[1]); w.y = cvt_pk_bf16(v0[2], v0[3]); w.z = cvt_pk_bf16(v1[0], v1[1]); w.w = cvt_pk_bf16(v1[2], v1[3]);
                        *(u32x4*)(rowp + bj * bjs) = w; } }
            asm volatile("" ::: "memory"); __builtin_amdgcn_s_barrier(); asm volatile("" ::: "memory");
            return;
        }
#pragma unroll
        for (int ai = 0; ai < 2; ++ai)
#pragma unroll
            for (int m = 0; m < 4; ++m)
#pragma unroll
                for (int bj = 0; bj < 2; ++bj) { const f32x4 a = acc[ai][bj][m][0], b = acc[ai][bj][m][1];
                    float s = (a[0] * a[0] + a[1] * a[1]) + (a[2] * a[2] + a[3] * a[3]) + (b[0] * b[0] + b[1] * b[1]) + (b[2] * b[2] + b[3] * b[3]);
                    s += __shfl_xor(s, 16); s += __shfl_xor(s, 32);
                    if (fq == 0) P[(bj * 256 + row0 + ai * HALF + m * 16) * 4 + wc] = s; }
        asm volatile("s_waitcnt lgkmcnt(0)" ::: "memory"); __builtin_amdgcn_s_barrier(); asm volatile("" ::: "memory");
        const f32x4 g0 = *(const f32x4*)(gainp + u.x0 * 128 + col0), g1 = *(const f32x4*)(gainp + u.x0 * 128 + col0 + 4);
        const int half = wc >> 1, fi = ((wc & 1) * 4 + fq) * 4;
#pragma unroll
        for (int ai = 0; ai < 2; ++ai)
#pragma unroll
            for (int m = 0; m < 4; ++m) {
                const int r = row0 + ai * HALF + m * 16;
                int pos = 0;
                if (u.x1 >= 0) { const int t = u.x1 + r; pos = half ? (t & 63) : (t >> 6); }
                const f32x4 cs0 = *(const f32x4*)(rope + pos * 32 + fi), cs1 = *(const f32x4*)(rope + pos * 32 + fi + 2);
                const float cc[4] = {cs0[0], cs0[2], cs1[0], cs1[2]}, ss[4] = {cs0[1], cs0[3], cs1[1], cs1[3]};
                bf16_t* rowp = (bf16_t*)u.C + (size_t)r * u.ldc + col0;
#pragma unroll
                for (int bj = 0; bj < 2; ++bj) {
                    const f32x4 pp = *(const LAS f32x4*)(P + (bj * 256 + r) * 4);
                    const float rs = __builtin_amdgcn_rsqf(((pp[0] + pp[1]) + (pp[2] + pp[3])) * (1.0f / 128.0f) + RMS_EPS);
                    float o1[4], o2[4];
#pragma unroll
                    for (int j = 0; j < 4; ++j) { const float v1 = acc[ai][bj][m][0][j] * rs * g0[j], v2 = acc[ai][bj][m][1][j] * rs * g1[j];
                        o1[j] = v1 * cc[j] - v2 * ss[j]; o2[j] = v1 * ss[j] + v2 * cc[j]; }
                    u32x4 w; w.x = cvt_pk_bf16(o1[0], o1[1]); w.y = cvt_pk_bf16(o1[2], o1[3]); w.z = cvt_pk_bf16(o2[0], o2[1]); w.w = cvt_pk_bf16(o2[2], o2[3]);
                    *(u32x4*)(rowp + bj * ((u.x0 == 0) ? (size_t)HALF : (size_t)NB * KVR * 128)) = w;
                }
            }
    }
};

template <class Epi, class Sched, bool GATHER>
__device__ __forceinline__ void gemm_phase(LAS unsigned char* lds, const int K_, Sched& S, const Epi& E) {
    const int K = K_;
    const int tid = opaque_tid(), wid = __builtin_amdgcn_readfirstlane(tid >> 6), lane = tid & 63, wr = wid >> 2, wc = wid & 3, fr = lane & 15, fq = lane >> 4;
    const int nt = K / BK;
    Unit cur, nxt; int ui = 0;
    if (!S.next(0, cur)) return;
    unsigned voffB[2], offA[2][2];
#pragma unroll
    for (int i = 0; i < 2; ++i) { int R, C; stage_rc(tid * 16 + i * 8192, R, C); const int Rb = (R & ~31) + perm32(R & 31);
        voffB[i] = (unsigned)(Rb * K + C) * 2u; }
    LAS int* ridx = (LAS int*)(lds + LDS_RIDX);
    if (GATHER) {
        if (tid < 256) ridx[tid] = (tid < cur.nvalid) ? cur.rows[tid] : 0;
        __syncthreads();
#pragma unroll
        for (int h = 0; h < 2; ++h)
#pragma unroll
            for (int i = 0; i < 2; ++i) { int R, C; stage_rc(tid * 16 + i * 8192, R, C); offA[h][i] = (unsigned)ridx[h * HALF + R] * (unsigned)(K * 2) + (unsigned)C * 2u; }
    } else {
#pragma unroll
        for (int h = 0; h < 2; ++h)
#pragma unroll
            for (int i = 0; i < 2; ++i) { int R, C; stage_rc(tid * 16 + i * 8192, R, C); offA[h][i] = (unsigned)((h * HALF + R) * K + C) * 2u; }
    }
    const size_t kstep = (size_t)(BK * 2);
    const size_t hstep = (size_t)HALF * K * 2;
    const unsigned ldsw = (unsigned)wid * 1024u;
    const int aoff = lds_byte(wr * 64 + fr, fq * 8), boff = lds_byte(wc * 32 + fr, fq * 8);
#define PG8_SA(b, h) (((b) * 2 + (h)) * HTB)
#define PG8_SB(b, h) ((4 + (b) * 2 + (h)) * HTB)
#define PG8_STAGE(bufoff, gbase, voff) do { _Pragma("unroll") for (int _i = 0; _i < 2; ++_i) \
        __builtin_amdgcn_global_load_lds((const unsigned*)((const char*)(gbase) + (voff)[_i]), (LAS unsigned*)(lds + (bufoff) + ldsw + _i * 8192), 16, 0, 0); } while (0)
#define PG8_LDA(dst, b, h) do { _Pragma("unroll") for (int m = 0; m < 4; ++m) _Pragma("unroll") for (int k = 0; k < 2; ++k) dst[m][k] = *(const LAS bf16x8*)(lds + PG8_SA(b, h) + aoff + m * 2048 + k * 1024); } while (0)
#define PG8_LDB(dst, b, h) do { _Pragma("unroll") for (int n = 0; n < 2; ++n) _Pragma("unroll") for (int k = 0; k < 2; ++k) dst[n][k] = *(const LAS bf16x8*)(lds + PG8_SB(b, h) + boff + n * 2048 + k * 1024); } while (0)
#define PG8_MMA(ai, bj, At, Bt) do { __builtin_amdgcn_s_setprio(1); _Pragma("unroll") for (int m = 0; m < 4; ++m) _Pragma("unroll") for (int n = 0; n < 2; ++n) _Pragma("unroll") for (int k = 0; k < 2; ++k) \
        acc[ai][bj][m][n] = __builtin_amdgcn_mfma_f32_16x16x32_bf16(Bt[n][k], At[m][k], acc[ai][bj][m][n], 0, 0, 0); __builtin_amdgcn_s_setprio(0); } while (0)
#define PG8_WAIT_V(n) asm volatile("s_waitcnt vmcnt(" #n ")" ::: "memory")
#define PG8_WAIT_L(n) asm volatile("s_waitcnt lgkmcnt(" #n ")" ::: "memory")
#define PG8_BAR __builtin_amdgcn_s_barrier()
#define PG8_SCHED __builtin_amdgcn_sched_barrier(0)
    f32x4 acc[2][2][4][2];
#pragma unroll
    for (int a = 0; a < 2; ++a)
#pragma unroll
        for (int b = 0; b < 2; ++b)
#pragma unroll
            for (int m = 0; m < 4; ++m)
#pragma unroll
                for (int n = 0; n < 2; ++n) acc[a][b][m][n] = (f32x4){0.f, 0.f, 0.f, 0.f};
    bf16x8 At[4][2], B0[2][2], B1[2][2];
    const char* cA = cur.A; const char* cB = cur.B;
    PG8_STAGE(PG8_SB(0, 0), cB, voffB); PG8_STAGE(PG8_SA(0, 0), cA, offA[0]); PG8_STAGE(PG8_SB(0, 1), cB + hstep, voffB); PG8_STAGE(PG8_SA(0, 1), cA, offA[1]);
    if (wr == 1) PG8_BAR;
    PG8_WAIT_V(4); PG8_BAR;
    PG8_STAGE(PG8_SB(1, 0), cB + kstep, voffB); PG8_STAGE(PG8_SA(1, 0), cA + kstep, offA[0]); PG8_STAGE(PG8_SB(1, 1), cB + hstep + kstep, voffB);
    PG8_WAIT_V(6); PG8_BAR;
    for (;;) {
        const bool has_next = S.next(ui + 1, nxt);
        const char* nA = has_next ? nxt.A : cA; const char* nB = has_next ? nxt.B : cB;
        if (GATHER && has_next && wid < 4)
            __builtin_amdgcn_global_load_lds((const unsigned*)(nxt.rows + wid * 64 + lane), (LAS unsigned*)(lds + LDS_RIDX + ((ui + 1) & 1) * 1024 + wid * 256), 4, 0, 0);
        for (int t = 0; t < nt; t += 2) {
            const bool last = (t == nt - 2);
            const char* a1 = cA + (size_t)(t + 1) * kstep;
            const char* a2 = last ? nA : cA + (size_t)(t + 2) * kstep; const char* b2 = last ? nB : cB + (size_t)(t + 2) * kstep;
            const char* a3 = a2 + kstep; const char* b3 = b2 + kstep;
            PG8_LDB(B0, 0, 0); PG8_SCHED; PG8_LDA(At, 0, 0); PG8_STAGE(PG8_SA(1, 1), a1, offA[1]);
            PG8_WAIT_L(8); PG8_BAR; PG8_WAIT_L(0); PG8_MMA(0, 0, At, B0); PG8_BAR; PG8_SCHED;
            if (GATHER && last && has_next) {
                LAS int* rn = ridx + ((ui + 1) & 1) * 256;
#pragma unroll
                for (int h = 0; h < 2; ++h)
#pragma unroll
                    for (int i = 0; i < 2; ++i) { int R, C; stage_rc(tid * 16 + i * 8192, R, C); const int rr = h * HALF + R; const int tok = (rr < nxt.nvalid) ? rn[rr] : 0; offA[h][i] = (unsigned)tok * (unsigned)(K * 2) + (unsigned)C * 2u; }
            }
            PG8_LDB(B1, 0, 1); PG8_STAGE(PG8_SB(0, 0), b2, voffB);
            PG8_BAR; PG8_WAIT_L(0); PG8_MMA(0, 1, At, B1); PG8_BAR;
            PG8_LDA(At, 0, 1); PG8_STAGE(PG8_SA(0, 0), a2, offA[0]);
            PG8_BAR; PG8_WAIT_L(0); PG8_MMA(1, 0, At, B0); PG8_BAR; PG8_SCHED;
            PG8_STAGE(PG8_SB(0, 1), b2 + hstep, voffB);
            PG8_WAIT_V(6); PG8_BAR; PG8_MMA(1, 1, At, B1); PG8_BAR;
            PG8_LDB(B0, 1, 0); PG8_SCHED; PG8_LDA(At, 1, 0); PG8_STAGE(PG8_SA(0, 1), a2, offA[1]);
            PG8_WAIT_L(8); PG8_BAR; PG8_WAIT_L(0); PG8_MMA(0, 0, At, B0); PG8_BAR; PG8_SCHED;
            PG8_LDB(B1, 1, 1); PG8_STAGE(PG8_SB(1, 0), b3, voffB);
            PG8_BAR; PG8_WAIT_L(0); PG8_MMA(0, 1, At, B1); PG8_BAR;
            PG8_LDA(At, 1, 1); PG8_STAGE(PG8_SA(1, 0), a3, offA[0]);
            PG8_BAR; PG8_WAIT_L(0); PG8_MMA(1, 0, At, B0); PG8_BAR; PG8_SCHED;
            PG8_STAGE(PG8_SB(1, 1), b3 + hstep, voffB);
            PG8_WAIT_V(6); PG8_BAR; PG8_MMA(1, 1, At, B1); PG8_BAR;
        }
        { Unit eu; S.next(ui, eu); E(acc, eu); }
        if (!has_next) break;
#pragma unroll
        for (int a = 0; a < 2; ++a)
#pragma unroll
            for (int b = 0; b < 2; ++b)
#pragma unroll
                for (int m = 0; m < 4; ++m)
#pragma unroll
                    for (int n = 0; n < 2; ++n) acc[a][b][m][n] = (f32x4){0.f, 0.f, 0.f, 0.f};
        cur = nxt; cA = nA; cB = nB; ++ui;
    }
    PG8_WAIT_V(0);
    if (wr == 0) PG8_BAR;
    PG8_BAR;
#undef PG8_SA
#undef PG8_SB
#undef PG8_STAGE
#undef PG8_LDA
#undef PG8_LDB
#undef PG8_MMA
#undef PG8_WAIT_V
#undef PG8_WAIT_L
#undef PG8_BAR
#undef PG8_SCHED
}
}

namespace att {
constexpr int D = 128, NW = 8, QBLK = 32, KVBLK = 64;
constexpr float SCALE = ATT_SCALE;
constexpr float THR = 8.f;
constexpr float NEGM = -30000.f;
constexpr size_t SHM_V = KVBLK * D * 2, SHM_K = KVBLK * D * 2, SHM_ATTN = 2 * SHM_V + 2 * SHM_K + NW * 64 * 4;
constexpr int LDS_BIAS = 69632;
#define KSWZ(row, colB) ((row) * 256 + ((colB) ^ (((row) & 7) << 4)))
#define SBAR() __builtin_amdgcn_sched_barrier(0)
__device__ __forceinline__ int crow(int r, int hi) { return (r & 3) + 8 * (r >> 2) + 4 * hi; }

__device__ __forceinline__ void partialSM(f32x16& p0, f32x16& p1, float& m_reg, float& mn, float& alpha) {
  constexpr float C = SCALE * 1.4426950408889634f;
  float pmax = p0[0];
#pragma unroll
  for (int r = 1; r < 16; ++r) pmax = fmaxf(pmax, p0[r]);
#pragma unroll
  for (int r = 0; r < 16; ++r) pmax = fmaxf(pmax, p1[r]);
  { auto rr = __builtin_amdgcn_permlane32_swap(__float_as_uint(pmax), __float_as_uint(pmax), false, false);
    pmax = fmaxf(__uint_as_float(rr[0]), __uint_as_float(rr[1])); }
  if (__builtin_expect(__all(pmax - m_reg <= THR / SCALE), 1)) { mn = m_reg; alpha = 1.f; }
  else { mn = fmaxf(m_reg, pmax); alpha = __builtin_amdgcn_exp2f((m_reg - mn) * C); m_reg = mn; }
  float mnC = -mn * C;
#pragma unroll
  for (int r = 0; r < 16; ++r) p0[r] = fmaf(p0[r], C, mnC);
#pragma unroll
  for (int r = 0; r < 16; ++r) p1[r] = fmaf(p1[r], C, mnC);
#pragma unroll
  for (int r = 0; r < 16; ++r) p0[r] = __builtin_amdgcn_exp2f(p0[r]);
}
__device__ __forceinline__ void finishSM(f32x16& p0, f32x16& p1, float alpha, float& l_reg, bf16x8& pa0, bf16x8& pa1, bf16x8& pa2, bf16x8& pa3) {
#pragma unroll
  for (int r = 0; r < 16; ++r) p1[r] = __builtin_amdgcn_exp2f(p1[r]);
  float ps = 0;
#pragma unroll
  for (int r = 0; r < 16; ++r) ps += p0[r];
#pragma unroll
  for (int r = 0; r < 16; ++r) ps += p1[r];
  { auto rr = __builtin_amdgcn_permlane32_swap(__float_as_uint(ps), __float_as_uint(ps), false, false);
    ps = __uint_as_float(rr[0]) + __uint_as_float(rr[1]); }
  l_reg = l_reg * alpha + ps;
#define PK4(P, BASE, OUT) do { unsigned a0 = cvt_pk_bf16(P[BASE + 0], P[BASE + 1]), a1 = cvt_pk_bf16(P[BASE + 2], P[BASE + 3]);   \
    unsigned b0 = cvt_pk_bf16(P[BASE + 4], P[BASE + 5]), b1 = cvt_pk_bf16(P[BASE + 6], P[BASE + 7]);                              \
    auto r0 = __builtin_amdgcn_permlane32_swap(a0, b0, false, false); auto r1 = __builtin_amdgcn_permlane32_swap(a1, b1, false, false); \
    u32x4 w = {r0[0], r1[0], r0[1], r1[1]}; OUT = *reinterpret_cast<bf16x8*>(&w); } while (0)
  PK4(p0, 0, pa0); PK4(p0, 8, pa1); PK4(p1, 0, pa2); PK4(p1, 8, pa3);
#undef PK4
}
__device__ __forceinline__ void qkt(f32x16& p0, f32x16& p1, const char* Ks, const bf16x8* qr, int r32, int hi) {
  p0 = f32x16{}; p1 = f32x16{};
#pragma unroll
  for (int d0 = 0; d0 < 8; ++d0) { int cb = (d0 * 16 + hi * 8) * 2;
    bf16x8 b0 = *reinterpret_cast<const bf16x8*>(Ks + KSWZ(r32, cb));
    bf16x8 b1 = *reinterpret_cast<const bf16x8*>(Ks + KSWZ(32 + r32, cb));
    p0 = __builtin_amdgcn_mfma_f32_32x32x16_bf16(b0, qr[d0], p0, 0, 0, 0);
    p1 = __builtin_amdgcn_mfma_f32_32x32x16_bf16(b1, qr[d0], p1, 0, 0, 0); }
}
__device__ __forceinline__ int v_st(int k, int c) { const int kk = (k & ~0xC) | ((k & 4) << 1) | ((k & 8) >> 1); return ((kk >> 3) * 4 + (c >> 5)) * 512 + ((kk & 7) * 32 + (c & 31)) * 2; }
__device__ __forceinline__ int v_rd_base(int lane) { return ((lane & 3) << 3) | (((lane >> 2) & 3) << 6) | (((lane >> 4) & 1) << 5) | (((lane >> 5) & 1) << 8); }
constexpr int v_rd_off(int d0, int ks, int half) { return d0 * 512 + ks * 4096 + half * 2048; }
template <int OFF> __device__ __forceinline__ s16x4 tr_read(int vb) {
  s16x4 r; asm volatile("ds_read_b64_tr_b16 %0, %1 offset:%2" : "=&v"(r) : "v"(vb), "i"(OFF) : "memory"); return r;
}
template <int D0> __device__ __forceinline__ void pv_one(f32x16& od, int vb, bf16x8 pa0, bf16x8 pa1, bf16x8 pa2, bf16x8 pa3) {
  const s16x4 l0 = tr_read<v_rd_off(D0, 0, 0)>(vb), h0 = tr_read<v_rd_off(D0, 0, 1)>(vb), l1 = tr_read<v_rd_off(D0, 1, 0)>(vb), h1 = tr_read<v_rd_off(D0, 1, 1)>(vb);
  const s16x4 l2 = tr_read<v_rd_off(D0, 2, 0)>(vb), h2 = tr_read<v_rd_off(D0, 2, 1)>(vb), l3 = tr_read<v_rd_off(D0, 3, 0)>(vb), h3 = tr_read<v_rd_off(D0, 3, 1)>(vb);
  asm volatile("s_waitcnt lgkmcnt(0)" ::: "memory"); SBAR();
#define PK(L, H) (bf16x8){L[0], L[1], L[2], L[3], H[0], H[1], H[2], H[3]}
  od = __builtin_amdgcn_mfma_f32_32x32x16_bf16(pa0, PK(l0, h0), od, 0, 0, 0);
  od = __builtin_amdgcn_mfma_f32_32x32x16_bf16(pa1, PK(l1, h1), od, 0, 0, 0);
  od = __builtin_amdgcn_mfma_f32_32x32x16_bf16(pa2, PK(l2, h2), od, 0, 0, 0);
  od = __builtin_amdgcn_mfma_f32_32x32x16_bf16(pa3, PK(l3, h3), od, 0, 0, 0);
#undef PK
}
__device__ __forceinline__ void pv_d0(f32x16* o, int vb, bf16x8 pa0, bf16x8 pa1, bf16x8 pa2, bf16x8 pa3) {
  pv_one<0>(o[0], vb, pa0, pa1, pa2, pa3); pv_one<1>(o[1], vb, pa0, pa1, pa2, pa3); pv_one<2>(o[2], vb, pa0, pa1, pa2, pa3); pv_one<3>(o[3], vb, pa0, pa1, pa2, pa3);
}

template <bool NA, int ldq, int ldk, int ldo>
__device__ __forceinline__ void attn_body(const bf16_t* __restrict__ Qb, const bf16_t* __restrict__ Kh, const bf16_t* __restrict__ Vh,
                                          bf16_t* __restrict__ Ob, const int NT, const int nloc, const int bs, const int q0r, char* lds) {
  const int tid = opaque_tid(), wid = tid >> 6, lane = tid & 63, r32 = lane & 31, hi = lane >> 5;
  char* V_lds = lds; char* K_lds = lds + 2 * SHM_V;
  float* ws = (float*)(lds + 2 * SHM_V + 2 * SHM_K) + wid * 64; float* li_l = ws; float* al_l = ws + 32;
  float m_reg = -1e30f, l_reg = 0; f32x16 o[4] = {}; bf16x8 qr[8];
  const bf16_t* Qw = Qb + (wid * QBLK + r32) * ldq + hi * 8;
#pragma unroll
  for (int d0 = 0; d0 < 8; ++d0) qr[d0] = *reinterpret_cast<const bf16x8*>(Qw + d0 * 16);
  const int sr = tid >> 4, sc = (tid & 15) * 8, vst0 = v_st(sr, sc), vst1 = v_st(32 + sr, sc);
  const int vb0 = (int)(uintptr_t)V_lds + v_rd_base(lane);
  const unsigned kvo = (unsigned)(sr * ldk + sc) * 2u;
  const float* btab = (const float*)(lds + LDS_BIAS) + 64;
  constexpr int SD = NA ? 1 : 2;
  struct { bf16x8 vs0, vs1, ks0, ks1; } sr_[SD];
#define KOFF(j) (NA ? ((j) < nloc ? (bs + (j)) * 64 : LSEQ + ((j) - nloc) * 64) : (j) * 64)
#define SLOAD(i, k0) do { const unsigned _ko = (unsigned)((k0) * ldk * 2) + kvo; sr_[i].vs0 = *reinterpret_cast<const bf16x8*>((const char*)Vh + _ko); sr_[i].vs1 = *reinterpret_cast<const bf16x8*>((const char*)Vh + (_ko + 64u * ldk)); \
    sr_[i].ks0 = *reinterpret_cast<const bf16x8*>((const char*)Kh + _ko); sr_[i].ks1 = *reinterpret_cast<const bf16x8*>((const char*)Kh + (_ko + 64u * ldk)); } while (0)
#define SWRITE(b, i) do { int sr_w = sr, sc_w = sc, v0_w = vst0, v1_w = vst1; \
    if (NA) { const int t_ = opaque_tid(); sr_w = t_ >> 4; sc_w = (t_ & 15) * 8; v0_w = v_st(sr_w, sc_w); v1_w = v_st(32 + sr_w, sc_w); }     \
    *(bf16x8*)(V_lds + (b) * SHM_V + v0_w) = sr_[i].vs0;          \
    *(bf16x8*)(V_lds + (b) * SHM_V + v1_w) = sr_[i].vs1; int kc = sc_w * 2;               \
    *(bf16x8*)(K_lds + (b) * SHM_K + KSWZ(sr_w, kc)) = sr_[i].ks0;                       \
    *(bf16x8*)(K_lds + (b) * SHM_K + KSWZ(32 + sr_w, kc)) = sr_[i].ks1; } while (0)
#define SWAIT() do { if (SD == 2) asm volatile("s_waitcnt vmcnt(4)" ::: "memory"); else asm volatile("s_waitcnt vmcnt(0)" ::: "memory"); } while (0)
#define RESC(a) do { if (__any((a) < 1.f)) { if (hi == 0) al_l[r32] = (a); asm volatile("s_waitcnt lgkmcnt(0)" ::: "memory"); \
    _Pragma("unroll") for (int d = 0; d < 4; ++d) _Pragma("unroll") for (int r = 0; r < 16; ++r) o[d][r] *= al_l[crow(r, hi)]; } } while (0)
#define ACT(j) (!NA || (j) >= nloc || ((bs + (j)) >= min(max(q0r + __builtin_amdgcn_readfirstlane(opaque_tid() >> 7) - 4, 0), 56) && (bs + (j)) < min(max(q0r + __builtin_amdgcn_readfirstlane(opaque_tid() >> 7) - 4, 0), 56) + 8))
#define NAMASK(P0, P1, j) do { if (NA && (j) < nloc) { const int kr = bs + (j); const int t_ = opaque_tid(); \
    const int qrow = q0r + __builtin_amdgcn_readfirstlane(t_ >> 7), qcol = ((t_ >> 6) & 1) * 32 + (t_ & 31), hi_ = (t_ >> 5) & 1; \
    const int cstart = min(max(qcol - 8, 0), 48); \
    const float* bp = btab + (kr - qrow + 7) * 31 + (4 * hi_ - qcol + 15); const int cs = cstart - 4 * hi_; \
    _Pragma("unroll") for (int r = 0; r < 16; ++r) { const int kc = (r & 3) + 8 * (r >> 2); \
        P0[r] = ((unsigned)(kc - cs) < 16u) ? P0[r] + bp[kc] : NEGM; P1[r] = ((unsigned)(kc + 32 - cs) < 16u) ? P1[r] + bp[kc + 32] : NEGM; } } } while (0)
  f32x16 pA0, pA1, pB0, pB1; float mnA, mnB, alA = 1.f, alB = 1.f; bf16x8 pa0, pa1, pa2, pa3;
  bool actA, actB;
  constexpr int SE = 0, SO = SD - 1;
  SLOAD(SE, KOFF(0)); asm volatile("s_waitcnt vmcnt(0)" ::: "memory"); SWRITE(0, SE); __syncthreads();
  actA = ACT(0);
  if (actA) { qkt(pA0, pA1, K_lds, qr, r32, hi); NAMASK(pA0, pA1, 0); partialSM(pA0, pA1, m_reg, mnA, alA); } else alA = 1.f;
  SLOAD(SO, KOFF(1)); if (SD == 2 && 2 < NT) SLOAD(SE, KOFF(2));
  SWAIT(); SWRITE(1, SO); __syncthreads();
  for (int j = 1; j + 1 < NT; j += 2) {
    SBAR(); actB = ACT(j); if (actB) { qkt(pB0, pB1, K_lds + SHM_K, qr, r32, hi); NAMASK(pB0, pB1, j); }
    if (actA) finishSM(pA0, pA1, alA, l_reg, pa0, pa1, pa2, pa3); SBAR();
    SLOAD(SO, KOFF(j + SD)); SBAR();
    if (actA) pv_d0(o, vb0, pa0, pa1, pa2, pa3); if (actB) partialSM(pB0, pB1, m_reg, mnB, alB); else alB = 1.f;
    __syncthreads(); SWAIT(); SWRITE(0, SE);
    RESC(alB); __syncthreads();
    SBAR(); actA = ACT(j + 1); if (actA) { qkt(pA0, pA1, K_lds, qr, r32, hi); NAMASK(pA0, pA1, j + 1); }
    if (actB) finishSM(pB0, pB1, alB, l_reg, pa0, pa1, pa2, pa3); SBAR();
    if (SD == 1 || j + 3 < NT) SLOAD(SE, KOFF(j + 1 + SD)); SBAR();
    if (actB) pv_d0(o, vb0 + (int)SHM_V, pa0, pa1, pa2, pa3); if (actA) partialSM(pA0, pA1, m_reg, mnA, alA); else alA = 1.f;
    __syncthreads(); SWAIT(); SWRITE(1, SO);
    RESC(alA); __syncthreads();
  }
  SBAR(); actB = ACT(NT - 1); if (actB) { qkt(pB0, pB1, K_lds + SHM_K, qr, r32, hi); NAMASK(pB0, pB1, NT - 1); }
  if (actA) finishSM(pA0, pA1, alA, l_reg, pa0, pa1, pa2, pa3); SBAR();
  if (actA) pv_d0(o, vb0, pa0, pa1, pa2, pa3); if (actB) partialSM(pB0, pB1, m_reg, mnB, alB); else alB = 1.f;
  __syncthreads(); RESC(alB);
  if (actB) { finishSM(pB0, pB1, alB, l_reg, pa0, pa1, pa2, pa3); SBAR();
    pv_d0(o, vb0 + (int)SHM_V, pa0, pa1, pa2, pa3); }
  if (hi == 0) li_l[r32] = l_reg; asm volatile("s_waitcnt lgkmcnt(0)" ::: "memory");
  float rli[16];
#pragma unroll
  for (int r = 0; r < 16; ++r) rli[r] = __builtin_amdgcn_rcpf(li_l[crow(r, hi)]);
  bf16_t* Ow = Ob + (wid * QBLK) * ldo + r32;
#pragma unroll
  for (int r = 0; r < 16; ++r) { const int orow = crow(r, hi);
#pragma unroll
    for (int d0 = 0; d0 < 4; ++d0) { const unsigned pk = cvt_pk_bf16(o[d0][r] * rli[r], 0.f); Ow[orow * ldo + d0 * 32] = (bf16_t)(pk & 0xffffu); } }
  __syncthreads();
#undef ACT
#undef KOFF
#undef SLOAD
#undef SWRITE
#undef SWAIT
#undef RESC
#undef NAMASK
}
#undef KSWZ
#undef SBAR
}

#define XB_TMO      128
#define XB_XCNT(j)  (256  + 64 * (j))
#define XB_XSUB(j)  (1280 + 64 * (j))
#define XB_XGEN(j)  (2304 + 64 * (j))
#define XB_TOP      3328
#define XB_TOPGEN   3392
#define XCD_BAR_WORDS 3456
#define XB_SPIN_CAP (1u << 22)
__device__ __forceinline__ unsigned xb_ld(unsigned* p)              { return __hip_atomic_load(p, __ATOMIC_RELAXED, __HIP_MEMORY_SCOPE_AGENT); }
__device__ __forceinline__ unsigned xb_add(unsigned* p, unsigned v) { return __hip_atomic_fetch_add(p, v, __ATOMIC_RELAXED, __HIP_MEMORY_SCOPE_AGENT); }
__device__ __forceinline__ unsigned xb_xcc_id() { return (unsigned)__builtin_amdgcn_s_getreg((3 << 11) | 20) & 0xFu; }
#define XB_SPIN(cond, bar) do { unsigned _sp = 0; while (cond) { __builtin_amdgcn_s_sleep(1); \
    if ((++_sp & 255u) == 0u) { if (xb_ld(&(bar)[XB_TMO])) break; if (_sp > XB_SPIN_CAP) { atomicAdd(&(bar)[XB_TMO], 1u); break; } } } } while (0)
struct XcdBarrier { unsigned* bar; unsigned x; volatile LAS unsigned* st; };
__device__ __forceinline__ XcdBarrier xcd_barrier_post(unsigned* bar, volatile LAS unsigned* st) {
    XcdBarrier b; b.bar = bar; b.x = xb_xcc_id(); b.st = st;
    if (threadIdx.x == 0) (void)xb_add(&bar[XB_XCNT(b.x)], 1u);
    return b;
}
__device__ __forceinline__ void xcd_barrier_complete(unsigned* bar, unsigned x, unsigned& nloc, unsigned& nx) {
    const unsigned G = gridDim.x * gridDim.y * gridDim.z;
    unsigned sum, cnt, mine, sp = 0u;
    for (;;) {
        sum = 0u; cnt = 0u; mine = 0u;
#pragma unroll
        for (unsigned j = 0; j < 16; ++j) { const unsigned c = xb_ld(&bar[XB_XCNT(j)]); sum += c; cnt += (c > 0u) ? 1u : 0u; mine = (j == x) ? c : mine; }
        if (sum == G) break;
        __builtin_amdgcn_s_sleep(1);
        if ((++sp & 255u) == 0u) { if (xb_ld(&bar[XB_TMO])) break; if (sp > XB_SPIN_CAP) { atomicAdd(&bar[XB_TMO], 1u); break; } }
    }
    nloc = mine > 0u ? mine : 1u; nx = cnt > 0u ? cnt : 1u;
}
__device__ __forceinline__ void xcd_barrier(const XcdBarrier& b) {
    asm volatile("s_waitcnt vmcnt(0)" ::: "memory");
    __syncthreads();
    if (threadIdx.x == 0) {
        unsigned* bar = b.bar;
        __builtin_amdgcn_s_waitcnt(0);
        unsigned nloc = b.st[0], nx = b.st[1];
        if (nloc == 0u) { xcd_barrier_complete(bar, b.x, nloc, nx); b.st[0] = nloc; b.st[1] = nx; }
        const unsigned old = xb_add(&bar[XB_XSUB(b.x)], 1u);
        const unsigned gen = old / nloc;
        if (old + 1u == (gen + 1u) * nloc) {
            __builtin_amdgcn_fence(__ATOMIC_RELEASE, "agent");
            asm volatile("s_waitcnt vmcnt(0)" ::: "memory");
            const unsigned og = xb_add(&bar[XB_TOP], 1u);
            const unsigned tg = og / nx;
            if (og + 1u == (tg + 1u) * nx) xb_add(&bar[XB_TOPGEN], 1u);
            else XB_SPIN(xb_ld(&bar[XB_TOPGEN]) == tg, bar);
            __builtin_amdgcn_fence(__ATOMIC_ACQUIRE, "agent");
            xb_add(&bar[XB_XGEN(b.x)], 1u);
            asm volatile("s_waitcnt vmcnt(0)" ::: "memory");
        } else {
            XB_SPIN(xb_ld(&bar[XB_XGEN(b.x)]) == gen, bar);
            __builtin_amdgcn_fence(__ATOMIC_ACQUIRE, "agent");
            asm volatile("s_waitcnt vmcnt(0)" ::: "memory");
        }
    }
    __syncthreads();
}

enum { I_X = 0, I_C, I_CTX, I_CCTX, I_WMOD, I_BMOD, I_LN1G, I_LN1B, I_LN2G, I_LN2B, I_ABWIN, I_ABWF, I_ABQN, I_ABKN, I_ABWOUT, I_NAWIN, I_NARPB, I_NAWOUT,
       I_WR, I_EBIAS, I_WG, I_WU, I_WDN, I_SG, I_SU, I_SD, N_IN };
struct Args { const float* in[N_IN]; float* out; unsigned char* ws; int ph_lo, ph_hi; };
struct KA {
    __device__ __forceinline__ const __attribute__((address_space(4))) char* base() const { const __attribute__((address_space(4))) char* p = (const __attribute__((address_space(4))) char*)__builtin_amdgcn_kernarg_segment_ptr(); asm volatile("" : "+s"(p)); return p; }
    __device__ __forceinline__ const float* in(int i) const { return *(const float* const __attribute__((address_space(4)))*)(base() + 8 * i); }
    __device__ __forceinline__ float* out() const { return *(float* const __attribute__((address_space(4)))*)(base() + 8 * N_IN); }
    __device__ __forceinline__ int ph_lo() const { return *(const int __attribute__((address_space(4)))*)(base() + 8 * N_IN + 16); }
    __device__ __forceinline__ int ph_hi() const { return *(const int __attribute__((address_space(4)))*)(base() + 8 * N_IN + 20); }
    __device__ __forceinline__ unsigned char* ws() const { return *(unsigned char* const __attribute__((address_space(4)))*)(base() + 8 * N_IN + 8); }
};

__device__ __forceinline__ int tok_batchrow(int m) { return m < TLAT ? (m >> 12) : 4; }

__host__ __device__ __forceinline__ int rope_phys(int d) { const int hf = d >> 6, dd = d & 63, i = dd & 31, second = dd >> 5; return hf * 64 + (i >> 2) * 8 + second * 4 + (i & 3); }

constexpr int CV_GU = 65 * 2 * 16, CV_DN = 65 * 16, CV_OUT = 64;
__host__ __device__ constexpr int cv_in(int l) { return (l & 1) ? 192 : 80; }
__host__ __device__ constexpr int cv_items(int l) { return CV_GU + CV_DN + cv_in(l) + CV_OUT; }
struct CvItem { const float* src; bf16_t* dst; int ldw, K, k0, n0, kind, which; };
__device__ __forceinline__ int cv_row(const CvItem& d, int n) {
    if (d.kind == 1) return (n >> 7) * 256 + d.which * 128 + (n & 127);
    if (d.kind == 2) { const int c = n - 256; return c < 1024 ? (c & ~127) + rope_phys(c & 127) : c; }
    return n;
}
__device__ __forceinline__ CvItem cv_decode(const KA& a, int l, int it) {
    CvItem d; unsigned char* ws = a.ws(); const int j = l >> 1; int r = it; d.which = 0;
    if (r < CV_GU) { const int mat = r >> 4, kb = r & 15, which = mat & 1, e = mat >> 1;
        d.src = (e < 64) ? a.in(which ? I_WU : I_WG) + ((size_t)(l * 64 + e) * DM * EDIM) : a.in(which ? I_SU : I_SG) + (size_t)l * DM * EDIM;
        d.dst = (bf16_t*)(ws + WS_WGU) + (size_t)(l * 65 + e) * 512 * DM; d.ldw = EDIM; d.K = DM; d.k0 = 64 * kb; d.n0 = 0; d.kind = 1; d.which = which; return d; }
    r -= CV_GU;
    if (r < CV_DN) { const int e = r >> 4, item = r & 15;
        d.src = (e < 64) ? a.in(I_WDN) + ((size_t)(l * 64 + e) * EDIM * DM) : a.in(I_SD) + (size_t)l * EDIM * DM;
        d.dst = (bf16_t*)(ws + WS_WD) + (size_t)(l * 65 + e) * DM * EDIM; d.ldw = DM; d.K = EDIM; d.k0 = 64 * (item >> 2); d.n0 = 256 * (item & 3); d.kind = 0; return d; }
    r -= CV_DN;
    if (r < cv_in(l)) {
        if ((l & 1) == 0) { d.src = a.in(I_ABWIN) + (size_t)j * DM * 1536; d.dst = (bf16_t*)(ws + WS_WINE) + (size_t)j * 1280 * DM; d.ldw = 1536; d.K = DM; d.k0 = 64 * (r / 5); d.n0 = 256 + 256 * (r % 5); d.kind = 2; }
        else { d.src = a.in(I_NAWIN) + (size_t)j * DM * 3072; d.dst = (bf16_t*)(ws + WS_WINO) + (size_t)j * 3072 * DM; d.ldw = 3072; d.K = DM; d.k0 = 64 * (r / 12); d.n0 = 256 * (r % 12); d.kind = 0; }
        return d; }
    r -= cv_in(l);
    d.src = ((l & 1) ? a.in(I_NAWOUT) : a.in(I_ABWOUT)) + (size_t)j * DM * DM; d.dst = (bf16_t*)(ws + WS_WOUT) + (size_t)l * DM * DM; d.ldw = DM; d.K = DM; d.k0 = 64 * (r >> 2); d.n0 = 256 * (r & 3); d.kind = 0;
    return d;
}
constexpr int CV_LS = 260;
__device__ __forceinline__ void cv_load(const CvItem& d, f32x4 (&v)[8], int t) {
    const float* p = d.src + (size_t)(d.k0 + (t >> 6)) * d.ldw + d.n0 + (t & 63) * 4;
#pragma unroll
    for (int i = 0; i < 8; ++i) v[i] = *(const f32x4*)(p + (size_t)(8 * i) * d.ldw);
}
__device__ __forceinline__ void convert_items(LAS unsigned char* lds, int l, int lo, int hi, int worker, int nworkers) {
    const KA a;
    const int t = opaque_tid();
    LAS float* img = (LAS float*)lds;
    int it = lo + worker;
    if (it >= hi) return;
    CvItem d0 = cv_decode(a, l, it); f32x4 v[8]; cv_load(d0, v, t);
    for (;;) {
        { LAS float* w = img + (t >> 6) * CV_LS + (t & 63) * 4;
#pragma unroll
          for (int i = 0; i < 8; ++i) *(LAS f32x4*)(w + i * 8 * CV_LS) = v[i]; }
        __syncthreads();
        const int itn = it + nworkers; const bool more = itn < hi;
        CvItem d1 = d0;
        if (more) { d1 = cv_decode(a, l, itn); cv_load(d1, v, t); }
        { const int n = (t >> 6) * 32 + (t & 31), qh = (t >> 5) & 1; bf16_t* orow = d0.dst + (size_t)cv_row(d0, d0.n0 + n) * d0.K + d0.k0;
#pragma unroll
          for (int p = 0; p < 4; ++p) { const int q = 2 * p + qh; const LAS float* s = img + (8 * q) * CV_LS + n;
              u32x4 o; o.x = cvt_pk_bf16(s[0 * CV_LS], s[1 * CV_LS]); o.y = cvt_pk_bf16(s[2 * CV_LS], s[3 * CV_LS]); o.z = cvt_pk_bf16(s[4 * CV_LS], s[5 * CV_LS]); o.w = cvt_pk_bf16(s[6 * CV_LS], s[7 * CV_LS]);
              *(u32x4*)(orow + 8 * q) = o; } }
        __syncthreads();
        if (!more) break;
        d0 = d1; it = itn;
    }
}
struct CvSlice { int l, i0, i1, l2, j0, j1; };
constexpr int CV_EX = CV_GU + CV_DN;
#ifndef CV_MODE
#define CV_MODE 1
#endif
__device__ __forceinline__ CvSlice cv_slice(int l, int phase  ) {
    const CvSlice none = {0, 0, 0, 0, 0, 0};
    if (CV_MODE == 0) return none;
    if (l == 0) { if (phase == 1) return {0, 0, 2000, 0, 0, 0}; if (phase == 2) return {0, 2000, 3000, 0, 0, 0};
                  if (phase == 4) return {1, CV_EX, cv_items(1), 1, 0, 744}; if (phase == 5) return {1, 744, 1144, 0, 0, 0}; }
    if (l == 1) { if (phase == 0) return {1, 1144, 2120, 0, 0, 0}; if (phase == 2) return {1, 2120, CV_EX, 0, 0, 0};
                  if (phase == 4) return {2, CV_EX, cv_items(2), 2, 0, 856}; if (phase == 5) return {2, 856, 1256, 0, 0, 0}; }
    if (l == 2) { if (phase == 1) return {2, 1256, CV_EX, 0, 0, 0}; if (phase == 2) return {3, CV_EX, cv_items(3), 3, 0, 744};
                  if (phase == 4) return {3, 744, 1744, 0, 0, 0}; if (phase == 5) return {3, 1744, 2144, 0, 0, 0}; }
    if (l == 3) { if (phase == 0) return {3, 2144, 3044, 0, 0, 0}; if (phase == 2) return {3, 3044, CV_EX, 0, 0, 0}; }
    return none;
}
__device__ __forceinline__ void cv_tail(LAS unsigned char* lds, int l, int phase, int n_units, int bid, int G) {
    const CvSlice c = cv_slice(l, phase);
    if (c.i1 <= c.i0 && c.j1 <= c.j0) return;
    const int rem = n_units % G, nw = (rem == 0) ? G : G - rem, w = (rem == 0) ? bid : bid - rem;
    if (w < 0) return;
    __syncthreads();
    if (c.i1 > c.i0) convert_items(lds, c.l, c.i0, c.i1, w, nw);
    if (c.j1 > c.j0) convert_items(lds, c.l2, c.j0, c.j1, w, nw);
}

__device__ __forceinline__ void p0_mod(const KA& a, LAS unsigned char* lds, int bid, int G, int tid, int wave, int lane) {
    LAS float* sl = (LAS float*)(lds + 69632);
    LAS float* part = (LAS float*)(lds + 69632 + 20480);
    for (int i = tid; i < 5 * DM; i += 512) { const int r = i >> 10, k = i & 1023; const float v = (r < 4) ? a.in(I_C)[r * DM + k] : a.in(I_CCTX)[k]; sl[i] = v / (1.0f + __expf(-v)); }
    __syncthreads();
    float* mod = (float*)(a.ws() + WS_MOD);
    for (int task = bid; task < DEPTH * 48; task += G) {
        const int l = task / 48, c0 = (task % 48) * 128;
        const float* w = a.in(I_WMOD) + (size_t)l * DM * 6144 + c0 + 2 * lane;
        f32x2 acc[5];
#pragma unroll
        for (int r = 0; r < 5; ++r) acc[r] = (f32x2){0.f, 0.f};
#pragma unroll 16
        for (int k = wave * 128; k < wave * 128 + 128; ++k) { const f32x2 wv = *(const f32x2*)(w + (size_t)k * 6144);
#pragma unroll
            for (int r = 0; r < 5; ++r) acc[r] += wv * sl[r * DM + k]; }
#pragma unroll
        for (int r = 0; r < 5; ++r) *(LAS f32x2*)(part + (wave * 5 + r) * 128 + 2 * lane) = acc[r];
        __syncthreads();
        for (int i = tid; i < 640; i += 512) { const int r = i >> 7, c = i & 127; float s = a.in(I_BMOD)[l * 6144 + c0 + c];
#pragma unroll
            for (int w8 = 0; w8 < 8; ++w8) s += part[(w8 * 5 + r) * 128 + c];
            mod[((size_t)l * 5 + r) * 6144 + c0 + c] = s; }
        __syncthreads();
    }
}

__device__ __forceinline__ void p0_fourier_fold(const KA& a, LAS unsigned char* lds, int task, int tid, int wave, int lane) {
    const int kq = task & 3, g = (task >> 2) & 3, q = (task >> 4) & 1, j = task >> 5;
    LAS float* M = (LAS float*)(lds + 100352);
    LAS float* trg = M + 4096;
    const float* Wf = a.in(I_ABWF) + (size_t)(j * 4 + g) * 64 * 64;
    LAS float* Wl = trg + 64;
    __syncthreads();
    if (tid < 64) { const float ang = (float)tid * (1.0f / 32.0f); trg[tid] = q ? sinpif(ang) : cospif(ang); }
    for (int i = tid; i < 1024; i += 512) *(LAS f32x4*)(Wl + 4 * i) = *(const f32x4*)(Wf + 4 * i);
    __syncthreads();
    for (int i = tid; i < 4096; i += 512) { const int c = i >> 6, d = i & 63; float s = 0.f;
#pragma unroll 8
        for (int m = 0; m < 64; ++m) s += trg[(m * c) & 63] * Wl[m * 64 + d];
        M[i] = s; }
    __syncthreads();
    float mcol[64];
#pragma unroll
    for (int c = 0; c < 64; ++c) mcol[c] = M[c * 64 + lane];
    bf16_t* dst = (bf16_t*)(a.ws() + WS_WF) + ((size_t)j * 512 + q * 256 + g * 64 + lane) * DM;
    const float* win = a.in(I_ABWIN) + (size_t)j * DM * 1536 + g * 64 + lane;
    const int kbeg = kq * 256 + wave * 32;
    float wv[32];
#pragma unroll
    for (int i = 0; i < 32; ++i) wv[i] = win[(size_t)(kbeg + i) * 1536];
#pragma unroll
    for (int i = 0; i < 32; ++i) { float s = 0.f;
#pragma unroll
        for (int c = 0; c < 64; ++c) s += __int_as_float(__builtin_amdgcn_readlane(__float_as_int(wv[i]), c)) * mcol[c];
        dst[kbeg + i] = (bf16_t)(cvt_pk_bf16(s, 0.f) & 0xffffu); }
}


__device__ __forceinline__ void p0_tables(const KA& a, LAS unsigned char* lds, int gtid, int NGT, int tid) {
    LAS float* ctab = (LAS float*)(lds + 116736);
    for (int i = tid; i < 4096; i += 512) ctab[i] = cospif((float)i * (1.0f / 2048.0f));
    __syncthreads();
    bf16_t* TW = (bf16_t*)(a.ws() + WS_TW);
    for (int it = gtid; it < 4096 * 1024; it += NGT) {
        const int k = it >> 10, c8 = (it & 1023) * 8, n0 = c8 & 4095, sh = (c8 >> 12) ? 1024 : 0; const float sg = (c8 >> 12) ? (-1.0f / 512.0f) : (1.0f / 512.0f);
        float v[8];
#pragma unroll
        for (int j = 0; j < 8; ++j) v[j] = ctab[(k * (n0 + j) - sh) & 4095] * sg;
        u32x4 o; o.x = cvt_pk_bf16(v[0], v[1]); o.y = cvt_pk_bf16(v[2], v[3]); o.z = cvt_pk_bf16(v[4], v[5]); o.w = cvt_pk_bf16(v[6], v[7]);
        *(u32x4*)(TW + (size_t)k * 8192 + c8) = o;
    }
    bf16_t* TWC = (bf16_t*)(a.ws() + WS_TWC);
    for (int it = gtid; it < 256 * 64; it += NGT) {
        const int k = it >> 6, c8 = (it & 63) * 8, n0 = c8 & 255, sh = (c8 >> 8) ? 1024 : 0; const float sg = (c8 >> 8) ? (-1.0f / 128.0f) : (1.0f / 128.0f);
        float v[8];
#pragma unroll
        for (int j = 0; j < 8; ++j) v[j] = ctab[(((k * (n0 + j)) & 255) * 16 - sh) & 4095] * sg;
        u32x4 o; o.x = cvt_pk_bf16(v[0], v[1]); o.y = cvt_pk_bf16(v[2], v[3]); o.z = cvt_pk_bf16(v[4], v[5]); o.w = cvt_pk_bf16(v[6], v[7]);
        *(u32x4*)(TWC + (size_t)k * 512 + c8) = o;
    }
    bf16_t* WH = (bf16_t*)(a.ws() + WS_WRHI); bf16_t* WL = (bf16_t*)(a.ws() + WS_WRLO);
    for (int it = gtid; it < DEPTH * 64 * DM; it += NGT) {
        const int i = it & 7, ln = (it >> 3) & 63, ks = (it >> 9) & 31, nt4 = (it >> 14) & 3, l = it >> 16, e = nt4 * 16 + (ln & 15), k = ks * 32 + (ln >> 4) * 8 + i;
        const float w = a.in(I_WR)[((size_t)l * DM + k) * 64 + e];
        const unsigned h = cvt_pk_bf16(w, 0.f) & 0xffffu; const float r = w - __uint_as_float(h << 16);
        WH[it] = (bf16_t)h; WL[it] = (bf16_t)(cvt_pk_bf16(r, 0.f) & 0xffffu);
    }
    float* gp = (float*)(a.ws() + WS_GAINP);
    for (int it = gtid; it < 2 * 2 * 128; it += NGT) { const int j = it >> 8, qk = (it >> 7) & 1, d = it & 127; gp[(j * 2 + qk) * 128 + rope_phys(d)] = a.in(qk ? I_ABKN : I_ABQN)[j * 128 + d]; }
    f32x2* rp = (f32x2*)(a.ws() + WS_ROPE);
    for (int it = gtid; it < 64 * 32; it += NGT) { const int pos = it >> 5, i = it & 31; const float inv = exp2f(-(float)i * (13.287712379549449f / 32.0f));
        const float ang = (float)pos * inv; rp[it] = (f32x2){cosf(ang), sinf(ang)}; }
}

__device__ __forceinline__ const float* xrow_in(const KA& a, int l, int m) {
    if (l == 0) return m < TLAT ? a.in(I_X) + (size_t)m * DM : a.in(I_CTX) + (size_t)(m - TLAT) * DM;
    return nullptr;
}
__device__ __forceinline__ void p0b_modulate(const KA& a, int gw, int NGW, int lane) {
    const float* mod = (const float*)(a.ws() + WS_MOD);
    bf16_t* H = (bf16_t*)(a.ws() + WS_H);
    for (int m = gw; m < TT; m += NGW) {
        const f32x4* xr = (const f32x4*)xrow_in(a, 0, m) + lane; const float* md = mod + (size_t)tok_batchrow(m) * 6144;
        u32x2* o = (u32x2*)(H + (size_t)m * DM) + lane;
#pragma unroll
        for (int j = 0; j < 4; ++j) { const f32x4 x = xr[64 * j], sh = *((const f32x4*)md + lane + 64 * j), sc = *((const f32x4*)(md + DM) + lane + 64 * j);
            const f32x4 h = x * (sc + 1.0f) + sh; o[64 * j] = (u32x2){cvt_pk_bf16(h[0], h[1]), cvt_pk_bf16(h[2], h[3])}; }
    }
}

#ifndef D_DELAY
#define D_DELAY 0
#endif
#ifndef PROBE_D
#define PROBE_D 7
#endif
__device__ __forceinline__ void phase_ln1_router(const KA& a, LAS unsigned char* lds, int l, int bid, int tid, int wave, int lane, const bool dry) {
    LAS float* lg = (LAS float*)lds;
    LAS int* hist = (LAS int*)(lds + 96 * 64 * 4);
    LAS int* pend = hist + 128;
    const float* mod = (const float*)(a.ws() + WS_MOD) + (size_t)l * 5 * 6144;
    const bf16_t* Y = (const bf16_t*)(a.ws() + WS_Y);
    bf16_t* XS = (bf16_t*)(a.ws() + (dry ? WS_ACT : WS_XS)); bf16_t* H = (bf16_t*)(a.ws() + (dry ? WS_YB + ((size_t)200 << 20) : WS_H)); bf16_t* HL = (bf16_t*)(a.ws() + (dry ? WS_YB + ((size_t)240 << 20) : WS_HL));
    if (tid < 64) hist[tid] = 0;
    const int NTOK = (l == DEPTH - 1) ? 64 : 68;
    const int tok0 = bid * NTOK;
    if (!dry || (PROBE_D & 1)) {
        f32x4 lng[4], lnb[4], g1[4], sc2[4], sh2[4];
        { const f32x4* pg = (const f32x4*)(a.in(I_LN1G) + l * DM) + lane; const f32x4* pb = (const f32x4*)(a.in(I_LN1B) + l * DM) + lane;
#pragma unroll
          for (int j = 0; j < 4; ++j) { lng[j] = pg[64 * j]; lnb[j] = pb[64 * j]; } }
        int cur_br = -1;
        f32x4 xn[4]; u32x2 xb[4]; u32x2 yn[4];
        const bf16_t* XSr = (const bf16_t*)(a.ws() + WS_XS);
#define D_LOADX(M) do { if (l == 0) { const f32x4* xr = (const f32x4*)xrow_in(a, 0, (M)) + lane; _Pragma("unroll") for (int j = 0; j < 4; ++j) xn[j] = xr[64 * j]; } \
        else { const u32x2* xr = (const u32x2*)(XSr + (size_t)(M) * DM) + lane; _Pragma("unroll") for (int j = 0; j < 4; ++j) xb[j] = xr[64 * j]; } \
        const u32x2* yr = (const u32x2*)(Y + (size_t)(M) * DM) + lane; _Pragma("unroll") for (int j = 0; j < 4; ++j) yn[j] = yr[64 * j]; } while (0)
        D_LOADX(tok0 + wave);
        for (int r = wave; r < NTOK; r += 8) {
            const int m = tok0 + r, br = tok_batchrow(m);
            if (br != cur_br) { cur_br = br; const float* md = mod + (size_t)br * 6144;
#pragma unroll
                for (int j = 0; j < 4; ++j) { g1[j] = *((const f32x4*)(md + 2 * DM) + lane + 64 * j); sh2[j] = *((const f32x4*)(md + 3 * DM) + lane + 64 * j); sc2[j] = *((const f32x4*)(md + 4 * DM) + lane + 64 * j) + 1.0f; } }
            f32x4 v[4]; float s = 0.f;
#pragma unroll
            for (int j = 0; j < 4; ++j) { const f32x4 y = {bf_lo(yn[j].x), bf_hi(yn[j].x), bf_lo(yn[j].y), bf_hi(yn[j].y)};
                const f32x4 x = (l == 0) ? xn[j] : (f32x4){bf_lo(xb[j].x), bf_hi(xb[j].x), bf_lo(xb[j].y), bf_hi(xb[j].y)};
                v[j] = x * DN_ALPHA + g1[j] * y; s += (v[j][0] + v[j][1]) + (v[j][2] + v[j][3]); }
            if (r + 8 < NTOK) D_LOADX(m + 8);
            const float mean = wave_sum(s) * (1.0f / DM); float s2 = 0.f;
#pragma unroll
            for (int j = 0; j < 4; ++j) { v[j] = v[j] - mean; s2 += (v[j][0] * v[j][0] + v[j][1] * v[j][1]) + (v[j][2] * v[j][2] + v[j][3] * v[j][3]); }
            const float rstd = __builtin_amdgcn_rsqf(wave_sum(s2) * (1.0f / DM) + LN_EPS);
            u32x2* xo = (u32x2*)(XS + (size_t)m * DM) + lane; u32x2* ho = (u32x2*)(H + (size_t)m * DM) + lane; u32x2* hl = (u32x2*)(HL + (size_t)m * DM) + lane;
#pragma unroll
            for (int j = 0; j < 4; ++j) { const f32x4 x1 = v[j] * rstd * lng[j] + lnb[j]; xo[64 * j] = (u32x2){cvt_pk_bf16(x1[0], x1[1]), cvt_pk_bf16(x1[2], x1[3])};
                const f32x4 h = x1 * sc2[j] + sh2[j];
                const unsigned h01 = cvt_pk_bf16(h[0], h[1]), h23 = cvt_pk_bf16(h[2], h[3]);
                ho[64 * j] = (u32x2){h01, h23};
                hl[64 * j] = (u32x2){cvt_pk_bf16(h[0] - bf_lo(h01), h[1] - bf_hi(h01)), cvt_pk_bf16(h[2] - bf_lo(h23), h[3] - bf_hi(h23))}; }
        }
    }
#undef D_LOADX
    VM_WAIT(); __syncthreads();
    if (D_DELAY) { const unsigned long long t0d = __builtin_amdgcn_s_memrealtime(); while (__builtin_amdgcn_s_memrealtime() - t0d < (unsigned long long)D_DELAY) __builtin_amdgcn_s_sleep(16); }
    TS(4);
    __builtin_amdgcn_fence(__ATOMIC_ACQUIRE, "agent"); VM_WAIT();
    if (!dry || (PROBE_D & 2)) {
        const bf16_t* WH = (const bf16_t*)(a.ws() + WS_WRHI) + (size_t)l * 64 * DM; const bf16_t* WL = (const bf16_t*)(a.ws() + WS_WRLO) + (size_t)l * 64 * DM;
        const int ntile = wave & 3, mt0 = wave >> 2, fr = lane & 15, fq = lane >> 4;
        constexpr int AQ = 264;
        LAS bf16_t* Ahi = (LAS bf16_t*)(lds + 32768); LAS bf16_t* Alo = Ahi + 80 * AQ;
        f32x4 acc[3];
#pragma unroll
        for (int i = 0; i < 3; ++i) acc[i] = (f32x4){0.f, 0.f, 0.f, 0.f};
        bf16x8 rh[5], rl[5];
#define D_FETCH(KQ) do { _Pragma("unroll") for (int ii = 0; ii < 5; ++ii) { const int p = tid + 512 * ii; if (p < NTOK * 32) { const size_t g = (size_t)(tok0 + (p >> 5)) * DM + (KQ) * 256 + (p & 31) * 8; \
            rh[ii] = *(const bf16x8*)(H + g); rl[ii] = *(const bf16x8*)(HL + g); } } } while (0)
        D_FETCH(0);
#pragma unroll 1
        for (int kq = 0; kq < 4; ++kq) {
            bf16x8 bh[8], bl[8];
#pragma unroll
            for (int q = 0; q < 8; ++q) { const size_t fo = (((size_t)ntile * 32 + kq * 8 + q) * 64 + lane) * 8; bh[q] = *(const bf16x8*)(WH + fo); bl[q] = *(const bf16x8*)(WL + fo); }
            __syncthreads();
#pragma unroll
            for (int ii = 0; ii < 5; ++ii) { const int p = tid + 512 * ii; if (p < NTOK * 32) { *(LAS bf16x8*)(Ahi + (p >> 5) * AQ + (p & 31) * 8) = rh[ii]; *(LAS bf16x8*)(Alo + (p >> 5) * AQ + (p & 31) * 8) = rl[ii]; } }
            __syncthreads();
            if (kq < 3) D_FETCH(kq + 1);
#pragma unroll
            for (int q = 0; q < 8; ++q)
#pragma unroll
                for (int i = 0; i < 3; ++i) if (i < 2 || mt0 == 0) {
                    const bf16x8 ahv = *(const LAS bf16x8*)(Ahi + ((mt0 + 2 * i) * 16 + fr) * AQ + q * 32 + fq * 8), alv = *(const LAS bf16x8*)(Alo + ((mt0 + 2 * i) * 16 + fr) * AQ + q * 32 + fq * 8);
                    acc[i] = __builtin_amdgcn_mfma_f32_16x16x32_bf16(ahv, bh[q], acc[i], 0, 0, 0);
                    acc[i] = __builtin_amdgcn_mfma_f32_16x16x32_bf16(ahv, bl[q], acc[i], 0, 0, 0);
                    acc[i] = __builtin_amdgcn_mfma_f32_16x16x32_bf16(alv, bh[q], acc[i], 0, 0, 0); }
        }
#undef D_FETCH
#pragma unroll
        for (int i = 0; i < 3; ++i) if (i < 2 || mt0 == 0)
#pragma unroll
            for (int q = 0; q < 4; ++q) lg[((mt0 + 2 * i) * 16 + fq * 4 + q) * 64 + ntile * 16 + fr] = acc[i][q];
    }
    __syncthreads(); TS(5);
    if (!dry || (PROBE_D & 4)) {
        int* tke = (int*)(a.ws() + WS_TKE); float* tkw = (float*)(a.ws() + WS_TKW);
        const float ebias = a.in(I_EBIAS)[l * 64 + lane];
        for (int r = wave; r < NTOK; r += 8) {
            const int m = tok0 + r;
            const float score = 1.0f / (1.0f + __expf(-lg[r * 64 + lane]));
            const float sel = score + ebias; int rank = 0;
#pragma unroll
            for (int c = 0; c < 64; ++c) { const float o = __int_as_float(__builtin_amdgcn_readlane(__float_as_int(sel), c)); rank += (o > sel || (o == sel && c < lane)) ? 1 : 0; }
            const bool mine = rank < TOPK;
            const unsigned long long taken = __ballot(mine);
            const float wsum = wave_sum(mine ? score : 0.f);
            if (mine) { const int k = __popcll(taken & ((1ull << lane) - 1ull)); const int lr = __hip_atomic_fetch_add(&hist[lane], 1, __ATOMIC_RELAXED, __HIP_MEMORY_SCOPE_WORKGROUP);
                if (!dry) { tke[m * 8 + k] = lane; tkw[m * 8 + k] = score / wsum * ROUTE_SCALE; } pend[r * 8 + k] = (lane << 16) | lr; }
        }
    }
    __syncthreads();
    if (dry) return;
    { unsigned* cnt = (unsigned*)(a.ws() + WS_CTL) + CW_CNT + l * 64;
      if (tid < 64) hist[64 + tid] = (int)atomicAdd(&cnt[tid], (unsigned)hist[tid]); }
    __syncthreads();
    { int* tkp = (int*)(a.ws() + WS_TKP); int* list = (int*)(a.ws() + WS_LIST);
      for (int i = tid; i < NTOK * 8; i += 512) { const int pe = pend[i], e = pe >> 16, p = hist[64 + e] + (pe & 0xffff); const int m = tok0 + (i >> 3);
        tkp[m * 8 + (i & 7)] = p; list[(size_t)e * TT + p] = m; } }
    __syncthreads();
}

constexpr float YB_SCALE_G = 32.0f;
__device__ __forceinline__ void phase_combine_ln2(const KA& a, LAS unsigned char* lds, int l, int gw, int NGW, int tid, int lane, const bool dry) {
    LAS int* rst = (LAS int*)(lds + LDS_TAB) + 66;
    const float* mod = (const float*)(a.ws() + WS_MOD) + (size_t)l * 5 * 6144;
    const unsigned char* YB = (const unsigned char*)(a.ws() + WS_YB);
    const bf16_t* XSi = (const bf16_t*)(a.ws() + WS_XS); bf16_t* XS = (bf16_t*)(a.ws() + (dry ? WS_ACT : WS_XS)); bf16_t* H = (bf16_t*)(a.ws() + (dry ? WS_HL : WS_H));
    const int* tke = (const int*)(a.ws() + WS_TKE); const float* tkw = (const float*)(a.ws() + WS_TKW); const int* tkp = (const int*)(a.ws() + WS_TKP);
    const int mend = (l == DEPTH - 1) ? TLAT : TT;
    const int e0 = 16 * lane;
    f32x4 lng[4], lnb[4];
    { const f32x4* pg = (const f32x4*)(a.in(I_LN2G) + l * DM + e0); const f32x4* pb = (const f32x4*)(a.in(I_LN2B) + l * DM + e0);
#pragma unroll
      for (int j = 0; j < 4; ++j) { lng[j] = pg[j]; lnb[j] = pb[j]; } }
    float* outp = dry ? (float*)(a.ws() + WS_ACT) : a.out();
#define G_SLOTS(M0, SLOT, W) do { _Pragma("unroll") for (int q = 0; q < 2; ++q) { const int mq = (q == 0 || (M0) + NGW < mend) ? (M0) + q * NGW : (M0); SLOT[q] = 0; W[q] = 1.0f / YB_SCALE_G; \
        if ((M0) < mend) { if (lane < 8) { SLOT[q] = rst[tke[mq * 8 + lane]] + tkp[mq * 8 + lane]; W[q] = tkw[mq * 8 + lane] * (1.0f / YB_SCALE_G); } if (lane == 8) SLOT[q] = rst[64] + mq; } } } while (0)
    int slotn[2]; float wn[2];
    G_SLOTS(gw, slotn, wn);
    for (int m0 = gw; m0 < mend; m0 += 2 * NGW) {
        int mm[2]; mm[0] = m0; mm[1] = (m0 + NGW < mend) ? m0 + NGW : m0;
        const bool two = (m0 + NGW < mend);
        int slot[2]; float w[2];
        slot[0] = slotn[0]; slot[1] = slotn[1]; w[0] = wn[0]; w[1] = wn[1];
        G_SLOTS(m0 + 2 * NGW, slotn, wn);
        f32x4 ff[2][4]; f32x4 xv[2][4];
#pragma unroll
        for (int q = 0; q < 2; ++q) { const u32x4* xi = (const u32x4*)(XSi + (size_t)mm[q] * DM + e0); const u32x4 xa = xi[0], xc = xi[1];
            xv[q][0] = (f32x4){bf_lo(xa[0]), bf_hi(xa[0]), bf_lo(xa[1]), bf_hi(xa[1])}; xv[q][1] = (f32x4){bf_lo(xa[2]), bf_hi(xa[2]), bf_lo(xa[3]), bf_hi(xa[3])};
            xv[q][2] = (f32x4){bf_lo(xc[0]), bf_hi(xc[0]), bf_lo(xc[1]), bf_hi(xc[1])}; xv[q][3] = (f32x4){bf_lo(xc[2]), bf_hi(xc[2]), bf_lo(xc[3]), bf_hi(xc[3])};
#pragma unroll
            for (int j = 0; j < 4; ++j) ff[q][j] = (f32x4){0.f, 0.f, 0.f, 0.f}; }
        u32x4 yy[2][9];
#pragma unroll
        for (int k = 0; k < 9; ++k)
#pragma unroll
            for (int q = 0; q < 2; ++q) { const int sk = __builtin_amdgcn_readlane(slot[q], k); yy[q][k] = *(const u32x4*)(YB + (size_t)sk * DM + e0); }
#pragma unroll
        for (int k = 0; k < 9; ++k)
#pragma unroll
            for (int q = 0; q < 2; ++q) { const float wk = __int_as_float(__builtin_amdgcn_readlane(__float_as_int(w[q]), k));
#pragma unroll
                for (int j = 0; j < 4; ++j) { const f32x2 lo2 = __builtin_amdgcn_cvt_pk_f32_fp8((int)yy[q][k][j], false), hi2 = __builtin_amdgcn_cvt_pk_f32_fp8((int)yy[q][k][j], true);
                    ff[q][j] += (f32x4){lo2.x, lo2.y, hi2.x, hi2.y} * wk; } }
#pragma unroll
        for (int q = 0; q < 2; ++q) {
            if (q == 1 && !two) break;
            const int m = mm[q]; const float* md = mod + (size_t)tok_batchrow(m) * 6144;
            f32x4 v[4]; float s = 0.f;
#pragma unroll
            for (int j = 0; j < 4; ++j) { const f32x4 g2 = *((const f32x4*)(md + 5 * DM + e0) + j);
                v[j] = xv[q][j] * DN_ALPHA + g2 * ff[q][j]; s += (v[j][0] + v[j][1]) + (v[j][2] + v[j][3]); }
            const float mean = wave_sum(s) * (1.0f / DM); float s2 = 0.f;
#pragma unroll
            for (int j = 0; j < 4; ++j) { v[j] = v[j] - mean; s2 += (v[j][0] * v[j][0] + v[j][1] * v[j][1]) + (v[j][2] * v[j][2] + v[j][3] * v[j][3]); }
            const float rstd = __builtin_amdgcn_rsqf(wave_sum(s2) * (1.0f / DM) + LN_EPS);
            if (l == DEPTH - 1) {
                f32x4* oo = (f32x4*)(outp + (size_t)m * DM + e0);
#pragma unroll
                for (int j = 0; j < 4; ++j) oo[j] = v[j] * rstd * lng[j] + lnb[j];
            } else {
                const float* mdn = md + 5 * 6144;
                u32x4* xio = (u32x4*)(XS + (size_t)m * DM + e0); u32x4* ho = (u32x4*)(H + (size_t)m * DM + e0);
                unsigned hp[8], xp[8];
#pragma unroll
                for (int j = 0; j < 4; ++j) { const f32x4 x2 = v[j] * rstd * lng[j] + lnb[j]; xp[2 * j] = cvt_pk_bf16(x2[0], x2[1]); xp[2 * j + 1] = cvt_pk_bf16(x2[2], x2[3]);
                    const f32x4 sh = *((const f32x4*)(mdn + e0) + j), sc = *((const f32x4*)(mdn + DM + e0) + j);
                    const f32x4 h = x2 * (sc + 1.0f) + sh; hp[2 * j] = cvt_pk_bf16(h[0], h[1]); hp[2 * j + 1] = cvt_pk_bf16(h[2], h[3]); }
                ho[0] = (u32x4){hp[0], hp[1], hp[2], hp[3]}; ho[1] = (u32x4){hp[4], hp[5], hp[6], hp[7]};
                xio[0] = (u32x4){xp[0], xp[1], xp[2], xp[3]}; xio[1] = (u32x4){xp[4], xp[5], xp[6], xp[7]};
            }
        }
    }
#undef G_SLOTS
}

__device__ __forceinline__ void build_expert_tables(const KA& a, LAS unsigned char* lds, int l, int tid) {
    LAS int* tst = (LAS int*)(lds + LDS_TAB); LAS int* rst = tst + 66; LAS int* cn = rst + 66;
    __syncthreads();
    if (tid < 64) {
        const unsigned* cnt = (const unsigned*)(a.ws() + WS_CTL) + CW_CNT + l * 64;
        const int c = (int)__hip_atomic_load(cnt + tid, __ATOMIC_RELAXED, __HIP_MEMORY_SCOPE_AGENT);
        int t = (c + 255) >> 8, r = c;
#pragma unroll
        for (int o = 1; o < 64; o <<= 1) { const int t2 = __shfl_up(t, o), r2 = __shfl_up(r, o); if (tid >= o) { t += t2; r += r2; } }
        tst[tid] = t - ((c + 255) >> 8); rst[tid] = r - c; cn[tid] = c;
        const int nsh = (l == DEPTH - 1) ? TLAT : TT;
        if (tid == 63) { tst[64] = t; rst[64] = r; cn[64] = nsh; tst[65] = t + (nsh >> 8); rst[65] = r + nsh; }
    }
    __syncthreads();
}

struct Seg {
    int i0, c, G, first, n;
    __device__ __forceinline__ void init(int first_, int n_, int c_, int G_) { first = first_; n = n_; c = c_; G = G_; i0 = (first_ <= c_) ? 0 : (first_ - c_ + G_ - 1) / G_; }
    __device__ __forceinline__ int idx(int i) const { const int L = (i0 + i) * G + c - first; return L < n ? L : -1; }
};
__device__ __forceinline__ int kv_row0(int pm) { return pm < 64 ? (pm >> 4) * KVR + (pm & 15) * 256 : (pm - 64) * KVR + LSEQ; }

struct SchedQKVE { Seg s; unsigned char* ws; int j;
    __device__ __forceinline__ bool next(int i, pg8::Unit& u) { const int L0 = s.idx(i); if (L0 < 0) return false;
        size_t offA, offB, offC; int ldc, x0, x1 = 0;
        if (L0 >= 340) { const int L = L0 - 340; x0 = 3;
            if (L < 128) { const int q = L >> 6, mt = L & 63, b = mt >> 4;
                offA = WS_WF + ((size_t)j * 512 + q * 256) * 2048; offB = WS_H + (size_t)mt * 256 * 2048; offC = WS_ZT + ((size_t)b * 256 * 8192 + q * 4096 + (mt & 15) * 256) * 2; ldc = 8192; }
            else { const int q = (L - 128) >> 2, b = (L - 128) & 3;
                offA = WS_WF + ((size_t)j * 512 + q * 256) * 2048; offB = WS_H + (size_t)(TLAT + b * 256) * 2048; offC = WS_ZCT + ((size_t)b * 256 * 512 + q * 256) * 2; ldc = 512; }
        } else { const int pm = L0 % 68, pn = L0 / 68;
            offA = WS_H + (size_t)pm * 256 * 2048; offB = WS_WINE + ((size_t)j * 1280 + pn * 256) * 2048; x1 = pm < 64 ? (pm & 15) * 256 : -1;
            if (pn < 3) { offC = WS_QB + ((size_t)pm * 256 * 768 + pn * 256) * 2; ldc = 768; x0 = 0; }
            else { offC = (pn == 3 ? WS_KB : WS_VB) + (size_t)kv_row0(pm) * 128 * 2; ldc = 128; x0 = pn - 2; } }
        u.A = (const char*)(ws + offA); u.B = (const char*)(ws + offB); u.C = (char*)(ws + offC); u.ldc = ldc; u.x0 = x0; u.x1 = x1; u.rows = nullptr; u.nvalid = 256;
        return true; } };
struct SchedQKVO { Seg s; unsigned char* ws; int j;
    __device__ __forceinline__ bool next(int i, pg8::Unit& u) { const int L = s.idx(i); if (L < 0) return false; const int pm = L % 68, pn = L / 68;
        u.A = (const char*)(ws + WS_H) + (size_t)pm * 256 * 2048; u.B = (const char*)(ws + WS_WINO) + ((size_t)j * 3072 + pn * 256) * 2048; u.rows = nullptr; u.nvalid = 256; u.x0 = 0; u.x1 = 0; u.ldc = 1024;
        if (pn < 4) u.C = (char*)(ws + WS_QB) + ((size_t)pm * 256 * 1024 + pn * 256) * 2;
        else u.C = (char*)(ws + (pn < 8 ? WS_KB : WS_VB)) + ((size_t)kv_row0(pm) * 1024 + (pn & 3) * 256) * 2;
        return true; } };
struct SchedDFT { Seg s; unsigned char* ws;
    __device__ __forceinline__ bool next(int i, pg8::Unit& u) { const int L = s.idx(i); if (L < 0) return false; const int pm = L & 15, b = L >> 4;
        u.A = (const char*)(ws + WS_TW) + (size_t)pm * 256 * 16384; u.B = (const char*)(ws + WS_ZT) + (size_t)b * 256 * 16384;
        u.C = (char*)(ws + WS_O) + (size_t)(b * LSEQ + pm * 256) * 1024 * 2; u.ldc = 1024; u.rows = nullptr; u.nvalid = 256; u.x0 = 0; u.x1 = 0; return true; } };
struct SchedDFTC { Seg s; unsigned char* ws;
    __device__ __forceinline__ bool next(int i, pg8::Unit& u) { const int b = s.idx(i); if (b < 0) return false;
        u.A = (const char*)(ws + WS_TWC); u.B = (const char*)(ws + WS_ZCT) + (size_t)b * 256 * 1024;
        u.C = (char*)(ws + WS_O) + (size_t)(TLAT + b * 256) * 1024 * 2; u.ldc = 1024; u.rows = nullptr; u.nvalid = 256; u.x0 = 0; u.x1 = 0; return true; } };
struct SchedOUT { Seg s; unsigned char* ws; int l, nm;
    __device__ __forceinline__ bool next(int i, pg8::Unit& u) { const int L = s.idx(i); if (L < 0) return false; const int pm = L % nm, pn = L / nm;
        u.A = (const char*)(ws + WS_O) + (size_t)pm * 256 * 2048; u.B = (const char*)(ws + WS_WOUT) + ((size_t)l * 1024 + pn * 256) * 2048;
        u.C = (char*)(ws + WS_Y) + ((size_t)pm * 256 * 1024 + pn * 256) * 2; u.ldc = 1024; u.rows = nullptr; u.nvalid = 256; u.x0 = 0; u.x1 = 0; return true; } };
struct SchedGU { Seg s; unsigned char* ws; int l; const LAS int* tab; int e; int L0, cnt; int probe;
    __device__ __forceinline__ bool next(int i, pg8::Unit& u) { const int L = cnt > 0 ? (i < cnt ? L0 + i : -1) : s.idx(i); if (L < 0) return false; const int mtg = L >> 1, nt = L & 1;
        while (tab[e + 1] <= mtg) ++e;
        while (tab[e] > mtg) --e;
        const int mt = mtg - tab[e], r0 = tab[66 + e] + mt * 256;
        u.A = (const char*)(ws + WS_H); u.rows = (const int*)(ws + WS_LIST) + (size_t)e * TT + mt * 256; u.nvalid = min(256, tab[132 + e] - mt * 256);
        u.B = (const char*)(ws + WS_WGU) + ((size_t)(l * 65 + e) * 512 + nt * 256) * 2048;
        u.C = (char*)(ws + WS_ACT) + ((size_t)r0 * 256 + nt * 128) * 2; u.ldc = 256; u.x0 = 0; u.x1 = 0;
        if (probe & 1) u.rows = (const int*)(ws + WS_LIST) + (size_t)64 * TT + (mtg & 63) * 256;
        if (probe & 2) u.nvalid = 0;
        return true; } };
struct SchedDN { Seg s; unsigned char* ws; int l; const LAS int* tab; int e; int probe; int L0, cnt;
    __device__ __forceinline__ bool next(int i, pg8::Unit& u) { const int L = cnt > 0 ? (i < cnt ? L0 + i : -1) : s.idx(i); if (L < 0) return false; const int mtg = L >> 2, nt = L & 3;
        while (tab[e + 1] <= mtg) ++e;
        while (tab[e] > mtg) --e;
        const int mt = mtg - tab[e], r0 = tab[66 + e] + mt * 256;
        u.A = (const char*)(ws + WS_ACT) + (size_t)r0 * 512; u.rows = nullptr; u.nvalid = min(256, tab[132 + e] - mt * 256);
        u.B = (const char*)(ws + WS_WD) + ((size_t)(l * 65 + e) * 1024 + nt * 256) * 512;
        u.C = (char*)(ws + WS_YB) + ((size_t)r0 * 1024 + nt * 256); u.ldc = 1024; u.x0 = 0; u.x1 = 0;
        if (probe & 1) u.nvalid = 0;
        if (probe & 2) { u.A = (const char*)(ws + WS_ACT); u.B = (const char*)(ws + WS_WD) + (size_t)(l * 65) * 1024 * 512; }
        return true; } };

constexpr int NPHASE = 2 + 7 * DEPTH;
#ifndef PHMASK
#define PHMASK 0xFFFFF
#endif
#define SITE(b) if constexpr ((PHMASK >> (b)) & 1)
#ifndef REP_A
#define REP_A 1
#endif
#ifndef REP_B
#define REP_B 1
#endif
#ifndef REP_BO
#define REP_BO 1
#endif
#ifndef REP_C
#define REP_C 1
#endif
#ifndef REP_E
#define REP_E 1
#endif
#ifndef REP_F
#define REP_F 1
#endif
#ifndef REP_D
#define REP_D 1
#endif
#ifndef REP_G
#define REP_G 1
#endif
#ifndef REP_BAR
#define REP_BAR 1
#endif
#ifndef PROBE_TS_SCALE
#define PROBE_TS_SCALE 0.0002f
#endif
#ifndef PROBE_TS_A
#define PROBE_TS_A 0
#endif
#ifndef PROBE_TS_B
#define PROBE_TS_B 1
#endif
#ifndef EF_FUSED
#define EF_FUSED 0
#endif
#ifndef E_STAGGER
#define E_STAGGER 0
#endif
#ifndef PROBE_E
#define PROBE_E 0
#endif
#ifndef PROBE_F
#define PROBE_F 0
#endif
#ifndef REP_P0
#define REP_P0 1
#endif
__global__ void __launch_bounds__(512, 2) fwd(Args args_) {
    extern __shared__ __attribute__((aligned(16))) unsigned char lds_raw[];
    LAS unsigned char* lds = (LAS unsigned char*)lds_raw;
    const int G = gridDim.x, bid = ((G & 7) == 0) ? (int)(blockIdx.x & 7) * (G >> 3) + (int)(blockIdx.x >> 3) : (int)blockIdx.x;
#define tid (opaque_tid())
#define lane (opaque_tid() & 63)
#define wave (__builtin_amdgcn_readfirstlane(opaque_tid() >> 6))
    const KA a;
#define WSP (a.ws())
#define args a
    volatile LAS unsigned* MISC = (volatile LAS unsigned*)(lds + LDS_MISC);
    { const int t0 = threadIdx.x; if (t0 < 64) MISC[t0] = 0u; }
    __syncthreads();
    if (PROBE_TS && threadIdx.x == 0) *(volatile LAS unsigned long long*)(lds + LDS_MISC + 192) = __builtin_amdgcn_s_memrealtime();
#define lo (a.ph_lo())
#define hi (a.ph_hi())
    XcdBarrier bar; bar.bar = (unsigned*)(WSP + WS_CTL) + CW_BAR; bar.x = 0; bar.st = MISC + 8;
    if (hi - lo > 1) bar = xcd_barrier_post((unsigned*)(WSP + WS_CTL) + CW_BAR, MISC + 8);
#define IN(k) (lo <= (k) && (k) < hi)
#define SEAM(k) do { if (IN(k) && IN((k) + 1)) for (int rb = 0; rb < REP_BAR; ++rb) xcd_barrier(bar); TS(((k) < 2) ? 16 : 17 + ((k) - 2) % 7); } while (0)
    const int NGW = G * 8;
#define gw (bid * 8 + wave)

    if (IN(0)) SITE(0) for (int rep = 0; rep < REP_P0; ++rep) {
        __syncthreads();
        p0_mod(args, lds, bid, G, tid, wave, lane); TS(11);
        if (bid >= G - 64) p0_fourier_fold(args, lds, G - 1 - bid, tid, wave, lane);
        TS(12); p0_tables(args, lds, bid * 512 + tid, G * 512, tid); TS(13);
        { int* ident = (int*)(WSP + WS_LIST) + (size_t)NEXP * TT; for (int i = bid * 512 + tid; i < TT; i += G * 512) ident[i] = i; }
        __syncthreads();
        if (CV_MODE == 0) convert_items(lds, 0, 0, cv_items(0), bid, G);
        else { convert_items(lds, 0, CV_EX, cv_items(0), bid, G); convert_items(lds, 0, 3000, CV_EX, bid, G); }
        if (CV_MODE == 0) { for (int lq = 1; lq < DEPTH; ++lq) convert_items(lds, lq, 0, cv_items(lq), bid, G); }
        TS(14);
    }
    TS(0); SEAM(0);
    if (IN(1)) SITE(0) p0b_modulate(args, gw, NGW, lane);
    TS(0); SEAM(1);

    for (int l = 0; l < DEPTH; ++l) {
        const int pb = 2 + 7 * l, j = l >> 1;
        if (IN(pb + 0)) for (int rep = 0; rep < REP_A; ++rep) {
            if ((l & 1) == 0) {
                SITE(1) { SchedQKVE S; S.s.init(0, 476, bid, G); S.ws = WSP; S.j = j;
                  pg8::EpiQKVE E; E.P = (LAS float*)(lds + LDS_EPI); E.gainp = (const float*)(WSP + WS_GAINP) + j * 256; E.rope = (const f32x2*)(WSP + WS_ROPE);
                  pg8::gemm_phase<pg8::EpiQKVE, SchedQKVE, false>(lds, 1024, S, E); }
            } else SITE(3) {
                SchedQKVO S; S.s.init(0, 816, bid, G); S.ws = WSP; S.j = j; pg8::EpiStore E;
                pg8::gemm_phase<pg8::EpiStore, SchedQKVO, false>(lds, 1024, S, E);
                if (rep == 0) cv_tail(lds, l, 0, 816, bid, G);
            }
        }
        TS(1); SEAM(pb + 0);
        if (IN(pb + 1)) for (int rep = 0; rep < ((l & 1) ? REP_BO : REP_B); ++rep) {
            __syncthreads();
            const bf16_t* QB = (const bf16_t*)(WSP + WS_QB); const bf16_t* KB = (const bf16_t*)(WSP + WS_KB); const bf16_t* VB = (const bf16_t*)(WSP + WS_VB); bf16_t* O = (bf16_t*)(WSP + WS_O);
            if ((l & 1) == 0) {
                SITE(4) { SchedDFT S; S.s.init(0, 64, bid, G); S.ws = WSP; pg8::EpiStore E; pg8::gemm_phase<pg8::EpiStore, SchedDFT, false>(lds, 8192, S, E); }
                SITE(5) { SchedDFTC S; S.s.init(28, 4, bid, G); S.ws = WSP; pg8::EpiStore E; pg8::gemm_phase<pg8::EpiStore, SchedDFTC, false>(lds, 512, S, E); }
                __syncthreads();
                if (bid < 64 && rep == 0) { const CvSlice c = cv_slice(l, 1); if (c.i1 > c.i0) { __syncthreads(); convert_items(lds, c.l, c.i0, c.i1, bid, 64); __syncthreads(); } }
                SITE(6) {
                    int u = (bid < 24) ? bid : (bid >= 64 ? bid - 40 : 408);
                    while (u < 408) {
                        const bf16_t *q, *k, *v; bf16_t* o; int ntile;
                        if (u < 24) { const int b = u / 6, h = u % 6; q = QB + (TLAT + b * 256) * 768 + h * 128; k = KB + ((h / 3) * NB * KVR + b * KVR + LSEQ) * 128; v = VB + ((h / 3) * NB * KVR + b * KVR + LSEQ) * 128;
                            o = O + (TLAT + b * 256) * 1024 + 256 + h * 128; ntile = 4; u = 408; }
                        else { const int uu = u - 24, bk = uu / 48, x = uu % 48, b = bk >> 1, kvh = bk & 1, h = kvh * 3 + x / 16, qb = x & 15;
                            q = QB + (b * LSEQ + qb * 256) * 768 + h * 128; k = KB + (kvh * NB * KVR + b * KVR) * 128; v = VB + (kvh * NB * KVR + b * KVR) * 128;
                            o = O + (b * LSEQ + qb * 256) * 1024 + 256 + h * 128; ntile = 68; u += 192; }
                        att::attn_body<false, 768, 128, 1024>(q, k, v, o, ntile, 0, 0, 0, (char*)lds_raw);
                    }
                }
            } else {
                const float* rpb = a.in(I_NARPB) + (size_t)j * 8 * 465;
                LAS float* bt = (LAS float*)(lds + att::LDS_BIAS);
                SITE(7) for (int u = bid; u < ((l == DEPTH - 1) ? 512 : 544); u += G) {
                    const bf16_t *q, *k, *v; bf16_t* o; int ntile, nloc, bs, q0r, h;
                    if (u < 512) { const int bh = u >> 4, blk = u & 15, b = bh >> 3; h = bh & 7; bs = min(max(4 * blk - 4, 0), 52); q0r = 4 * blk; ntile = 16; nloc = 12;
                        q = QB + (b * LSEQ + blk * 256) * 1024 + h * 128; k = KB + b * KVR * 1024 + h * 128; v = VB + b * KVR * 1024 + h * 128; o = O + (b * LSEQ + blk * 256) * 1024 + h * 128; }
                    else { const int b = (u - 512) >> 3; h = u & 7; bs = 0; q0r = 0; ntile = 4; nloc = 0;
                        q = QB + (TLAT + b * 256) * 1024 + h * 128; k = KB + b * KVR * 1024 + h * 128; v = VB + b * KVR * 1024 + h * 128; o = O + (TLAT + b * 256) * 1024 + h * 128; }
                    for (int i = tid; i < 465; i += 512) bt[64 + i] = rpb[h * 465 + i] * (1.0f / ATT_SCALE);
                    att::attn_body<true, 1024, 1024, 1024>(q, k, v, o, ntile, nloc, bs, q0r, (char*)lds_raw);
                }
            }
        }
        TS(2); SEAM(pb + 1);
        if (IN(pb + 2)) SITE(9) for (int rep = 0; rep < REP_C; ++rep) { const int nm = (l == DEPTH - 1) ? 64 : 68;
            SchedOUT S; S.s.init(0, nm * 4, bid, G); S.ws = WSP; S.l = l; S.nm = nm; pg8::EpiStore E; pg8::gemm_phase<pg8::EpiStore, SchedOUT, false>(lds, 1024, S, E);
            if (rep == 0) cv_tail(lds, l, 2, nm * 4, bid, G); }
        TS(3); SEAM(pb + 2);
        if (IN(pb + 3)) SITE(10) for (int rep = 0; rep < REP_D; ++rep) { __syncthreads(); phase_ln1_router(args, lds, l, bid, tid, wave, lane, rep + 1 < REP_D); }
        TS(6); SEAM(pb + 3);
#if EF_FUSED
        if (IN(pb + 4)) SITE(11) for (int rep = 0; rep < REP_E; ++rep) { build_expert_tables(args, lds, l, tid);
            const LAS int* tab = (const LAS int*)(lds + LDS_TAB);
            const int nsu = tab[65]; int ecur = 0;
            for (int su = bid; su < nsu; su += G) {
                { SchedGU S; S.s.init(0, 0, bid, G); S.ws = WSP; S.l = l; S.tab = tab; S.e = ecur; S.L0 = su * 2; S.cnt = 2; S.probe = 0; pg8::EpiSwiGLU E;
                  pg8::gemm_phase<pg8::EpiSwiGLU, SchedGU, true>(lds, 1024, S, E); ecur = S.e; }
                VM_WAIT(); __syncthreads();
                __builtin_amdgcn_fence(__ATOMIC_ACQUIRE, "agent"); VM_WAIT();
                { SchedDN S; S.s.init(0, 0, bid, G); S.ws = WSP; S.l = l; S.tab = tab; S.e = ecur; S.probe = 0; S.L0 = su * 4; S.cnt = 4; pg8::EpiStoreF8 E;
                  int k256 = 256; asm volatile("" : "+s"(k256));
                  pg8::gemm_phase<pg8::EpiStoreF8, SchedDN, false>(lds, k256, S, E); }
            }
            if (rep == 0) { cv_tail(lds, l, 4, nsu, bid, G); cv_tail(lds, l, 5, nsu, bid, G); } }
        TS(7); SEAM(pb + 4);
        if (IN(pb + 5) && !IN(pb + 4)) {}
#else
        if (IN(pb + 4)) SITE(11) for (int rep = 0; rep < REP_E; ++rep) { build_expert_tables(args, lds, l, tid);
            const LAS int* tab = (const LAS int*)(lds + LDS_TAB);
            if (E_STAGGER && (bid & 1) && bid >= 8) { const unsigned long long t0s = __builtin_amdgcn_s_memrealtime(); while (__builtin_amdgcn_s_memrealtime() - t0s < (unsigned long long)E_STAGGER) __builtin_amdgcn_s_sleep(16); }
            SchedGU S; S.s.init(0, tab[65] * 2, bid, G); S.ws = WSP; S.l = l; S.tab = tab; S.e = 0; S.L0 = 0; S.cnt = 0; S.probe = (rep + 1 < REP_E) ? PROBE_E : 0; pg8::EpiSwiGLU E;
            pg8::gemm_phase<pg8::EpiSwiGLU, SchedGU, true>(lds, 1024, S, E);
            if (rep == 0) cv_tail(lds, l, 4, tab[65] * 2, bid, G); }
        TS(7); SEAM(pb + 4);
        if (IN(pb + 5)) SITE(12) for (int rep = 0; rep < REP_F; ++rep) { if (!IN(pb + 4)) build_expert_tables(args, lds, l, tid);
            const LAS int* tab = (const LAS int*)(lds + LDS_TAB);
            SchedDN S; S.s.init(0, tab[65] * 4, bid, G); S.ws = WSP; S.l = l; S.tab = tab; S.e = 0; S.probe = (rep + 1 < REP_F) ? PROBE_F : 0; S.L0 = 0; S.cnt = 0; pg8::EpiStoreF8 E;
            int k256 = 256; asm volatile("" : "+s"(k256));
            pg8::gemm_phase<pg8::EpiStoreF8, SchedDN, false>(lds, k256, S, E);
            if (rep == 0) cv_tail(lds, l, 5, tab[65] * 4, bid, G); }
        TS(8); SEAM(pb + 5);
#endif
        if (IN(pb + 6)) SITE(13) for (int rep = 0; rep < REP_G; ++rep) { if (!IN(pb + 4)) build_expert_tables(args, lds, l, tid); phase_combine_ln2(args, lds, l, gw, NGW, tid, lane, rep + 1 < REP_G); }
        TS(9); SEAM(pb + 6);
    }
    if (PROBE_TS) { volatile LAS float* ta_ = (volatile LAS float*)(lds + LDS_MISC + 64);
        float* tsw = (float*)(WSP + WS_CTL) + 32;
        if (blockIdx.x == PROBE_TS_BLK && threadIdx.x == 0) __hip_atomic_store(tsw, ta_[PROBE_TS_A] * 0.01f * PROBE_TS_SCALE, __ATOMIC_RELAXED, __HIP_MEMORY_SCOPE_AGENT);
        xcd_barrier(bar);
        const float va0_unused = 0.f; (void)va0_unused; const float va = __hip_atomic_load(tsw, __ATOMIC_RELAXED, __HIP_MEMORY_SCOPE_AGENT); float* o_ = a.out();
        for (int i = blockIdx.x * 512 + threadIdx.x; i < TLAT * DM; i += G * 512) o_[i] += va; }
#undef IN
#undef SEAM
#undef lo
#undef hi
#undef lane
#undef wave
#undef gw
#undef tid
#undef WSP
#undef args
}

extern "C" void kernel_launch(void* const* d_in, const int* in_sizes, int n_in, void* d_out, int out_size, void* d_ws, size_t ws_size, hipStream_t stream) {
    static int ok = 0;
    if (ok == 0) {
        if (n_in != N_IN || ws_size < WS_END) { fprintf(stderr, "kernel_launch: n_in %d (want %d), ws %zu (want >= %zu)\n", n_in, (int)N_IN, ws_size, (size_t)WS_END); return; }
        if (hipFuncSetAttribute((const void*)fwd, hipFuncAttributeMaxDynamicSharedMemorySize, LDS_BYTES) != hipSuccess) { fprintf(stderr, "kernel_launch: hipFuncSetAttribute failed\n"); return; }
        int per_cu = 0;
        if (hipOccupancyMaxActiveBlocksPerMultiprocessor(&per_cu, (const void*)fwd, 512, LDS_BYTES) != hipSuccess || per_cu < 1) fprintf(stderr, "kernel_launch: occupancy query reports %d\n", per_cu);
        ok = 1;
    }
    Args a;
    memset(&a, 0, sizeof(a));
    for (int i = 0; i < N_IN; ++i) a.in[i] = (const float*)d_in[i];
    a.out = (float*)d_out; a.ws = (unsigned char*)d_ws;
    hipMemsetAsync((char*)d_ws + WS_CTL, 0, CTL_BYTES, stream);
#if MK_ONE_LAUNCH
    a.ph_lo = 0; a.ph_hi = NPHASE;
    hipLaunchKernelGGL(fwd, dim3(256), dim3(512), LDS_BYTES, stream, a);
#else
    for (int p = 0; p < NPHASE; ++p) { a.ph_lo = p; a.ph_hi = p + 1; hipLaunchKernelGGL(fwd, dim3(256), dim3(512), LDS_BYTES, stream, a); }
#endif
    const hipError_t le = hipPeekAtLastError();
    if (le != hipSuccess) fprintf(stderr, "kernel_launch: launch failed: %s\n", hipGetErrorName(le));
}
```

```cpp
#include <hip/hip_runtime.h>
#include <cstdio>
#include <cstdint>
#include <cstring>

#define LAS __attribute__((address_space(3)))
#define GAS __attribute__((address_space(1)))
typedef unsigned short bf16_t;
typedef short bf16x8 __attribute__((ext_vector_type(8)));
typedef short s16x4 __attribute__((ext_vector_type(4)));
typedef float f32x2 __attribute__((ext_vector_type(2)));
typedef float f32x4 __attribute__((ext_vector_type(4)));
typedef float f32x16 __attribute__((ext_vector_type(16)));
typedef unsigned u32x2 __attribute__((ext_vector_type(2)));
typedef unsigned u32x4 __attribute__((ext_vector_type(4)));

#ifndef MK_ONE_LAUNCH
#define MK_ONE_LAUNCH 1
#endif

constexpr int NB = 4, LSEQ = 4096, DM = 1024, NCTX = 256, DEPTH = 4;
constexpr int TLAT = NB * LSEQ, TCTX = NB * NCTX, TT = TLAT + TCTX;
constexpr int KVR = LSEQ + NCTX;
constexpr int NEXP = 64, TOPK = 8, EDIM = 256;
constexpr int NPAIR = TT * TOPK, NSLOT = NPAIR + TT;
constexpr float DN_ALPHA = 1.681792830507429f;
constexpr float LN_EPS = 1e-6f, RMS_EPS = 1e-6f, ROUTE_SCALE = 2.5f;
constexpr float ATT_SCALE = 0.088388347648318440f;

constexpr size_t al256(size_t x) { return (x + 255) / 256 * 256; }
constexpr size_t WS_CTL = 0, CTL_BYTES = 65536;
constexpr size_t WS_MOD = WS_CTL + CTL_BYTES;
constexpr size_t WS_GAINP = WS_MOD + al256((size_t)DEPTH * 5 * 6 * DM * 4);
constexpr size_t WS_ROPE = WS_GAINP + 2048;
constexpr size_t WS_WRHI = WS_ROPE + 16384;
constexpr size_t WS_WRLO = WS_WRHI + (size_t)DEPTH * 64 * DM * 2;
constexpr size_t WS_WF = WS_WRLO + (size_t)DEPTH * 64 * DM * 2;
constexpr size_t WS_WINE = WS_WF + (size_t)2 * 512 * DM * 2;
constexpr size_t WS_WINO = WS_WINE + (size_t)2 * 1280 * DM * 2;
constexpr size_t WS_WOUT = WS_WINO + (size_t)2 * 3072 * DM * 2;
constexpr size_t WS_WGU = WS_WOUT + (size_t)DEPTH * DM * DM * 2;
constexpr size_t WS_WD = WS_WGU + (size_t)DEPTH * 65 * 512 * DM * 2;
constexpr size_t WS_TW = WS_WD + (size_t)DEPTH * 65 * DM * 256 * 2;
constexpr size_t WS_TWC = WS_TW + (size_t)4096 * 8192 * 2;
constexpr size_t WS_XS = WS_TWC + (size_t)256 * 512 * 2;
constexpr size_t WS_H = WS_XS + (size_t)TT * DM * 4;
constexpr size_t WS_TKE = WS_H + (size_t)TT * DM * 2;
constexpr size_t WS_TKW = WS_TKE + (size_t)NPAIR * 4;
constexpr size_t WS_TKP = WS_TKW + (size_t)NPAIR * 4;
constexpr size_t WS_LIST = WS_TKP + (size_t)NPAIR * 4;
constexpr size_t WS_ACT = WS_LIST + (size_t)(NEXP + 1) * TT * 4;
constexpr size_t WS_YB = WS_ACT + (size_t)(NSLOT + 256) * EDIM * 2;
constexpr size_t WS_QB = WS_YB;
constexpr size_t WS_KB = WS_QB + (size_t)TT * DM * 2;
constexpr size_t WS_VB = WS_KB + (size_t)NB * KVR * DM * 2;
constexpr size_t WS_O = WS_VB + (size_t)NB * KVR * DM * 2;
constexpr size_t WS_Y = WS_O + (size_t)TT * DM * 2;
constexpr size_t WS_ZT = WS_Y + (size_t)TT * DM * 2;
constexpr size_t WS_ZCT = WS_ZT + (size_t)1024 * 8192 * 2;
constexpr size_t WS_OVL_END = WS_ZCT + (size_t)1024 * 512 * 2;
constexpr size_t WS_HL = WS_YB + (size_t)NSLOT * DM * 2;
constexpr size_t WS_TRASH = WS_HL + (size_t)TT * DM * 2;
constexpr size_t WS_END = WS_TRASH + (size_t)256 * 16384;
static_assert(WS_OVL_END <= WS_HL, "overlay fits in YB");
static_assert(WS_END <= (size_t)1 << 30, "workspace must fit 1 GiB");
constexpr int CW_TMO = 0, CW_CNT = 64  , CW_BAR = 1024;

constexpr int LDS_BYTES = 147456;
constexpr int LDS_STAGE = 0;
constexpr int LDS_EPI = 131072;
constexpr int LDS_RIDX = 139264;
constexpr int LDS_TAB = 141312;
constexpr int LDS_MISC = 147456 - 256;

__device__ __forceinline__ unsigned cvt_pk_bf16(float lo, float hi) { unsigned r; asm volatile("v_cvt_pk_bf16_f32 %0, %1, %2" : "=v"(r) : "v"(lo), "v"(hi)); return r; }
__device__ __forceinline__ float bf_lo(unsigned u) { return __uint_as_float(u << 16); }
__device__ __forceinline__ float bf_hi(unsigned u) { return __uint_as_float(u & 0xffff0000u); }
__device__ __forceinline__ float wave_sum(float v) {
#pragma unroll
    for (int o = 1; o < 64; o <<= 1) v += __shfl_xor(v, o);
    return v;
}
__device__ __forceinline__ float wave_sum_dpp(float v) {
#define DPPA(ctrl, rmask) v += __int_as_float(__builtin_amdgcn_update_dpp(0, __float_as_int(v), ctrl, rmask, 0xf, false))
    DPPA(0x111, 0xf); DPPA(0x112, 0xf); DPPA(0x114, 0xf); DPPA(0x118, 0xf); DPPA(0x142, 0xa); DPPA(0x143, 0xc);
#undef DPPA
    return __int_as_float(__builtin_amdgcn_readlane(__float_as_int(v), 63));
}
__device__ __forceinline__ float wave_max(float v) {
#pragma unroll
    for (int o = 1; o < 64; o <<= 1) v = fmaxf(v, __shfl_xor(v, o));
    return v;
}
#define LDS_WAIT() asm volatile("s_waitcnt lgkmcnt(0)" ::: "memory")
#define VM_WAIT() asm volatile("s_waitcnt vmcnt(0)" ::: "memory")

#ifndef PROBE_TS
#define PROBE_TS 0
#endif
#ifndef PROBE_TS_BLK
#define PROBE_TS_BLK 0
#endif
#define TS(k) do { if (PROBE_TS && blockIdx.x == PROBE_TS_BLK && threadIdx.x == 0) { const unsigned long long now_ = __builtin_amdgcn_s_memrealtime(); volatile LAS float* ta_ = (volatile LAS float*)(lds + LDS_MISC + 64); \
    ta_[k] = ta_[k] + (float)(now_ - *(volatile LAS unsigned long long*)(lds + LDS_MISC + 192)); *(volatile LAS unsigned long long*)(lds + LDS_MISC + 192) = now_; } } while (0)

__device__ __forceinline__ int opaque_tid() { int t = threadIdx.x; asm volatile("" : "+v"(t)); return t; }
namespace pg8 {
constexpr int BM = 256, BK = 64, HALF = 128, HTB = HALF * BK * 2  , STAGE_BYTES = 8 * HTB;

__host__ __device__ __forceinline__ int lds_byte(int r, int c) { const int st = (r >> 4) * 2 + (c >> 5), rr = r & 15, cc = c & 31, ob = rr * 64 + cc * 2; return st * 1024 + (ob ^ (((ob >> 9) & 1) << 5)); }
__host__ __device__ __forceinline__ void stage_rc(int b, int& R, int& C) { const int st = b / 1024, sb = b % 1024, swz = sb ^ (((sb >> 9) & 1) << 5); R = (st >> 1) * 16 + swz / 64; C = (st & 1) * 32 + (swz % 64) / 2; }
__host__ __device__ __forceinline__ int perm32(int rho) { const int n = rho >> 4, i = rho & 15; return 8 * (i >> 2) + 4 * n + (i & 3); }

struct Unit { const char* A; const char* B; char* C; const int* rows; int ldc, nvalid, x0, x1; };

struct EpiStore {
    __device__ __forceinline__ void operator()(const f32x4 (&acc)[2][2][4][2], const Unit& u) const {
        const int tid = opaque_tid(), wid = tid >> 6, lane = tid & 63, wr = wid >> 2, wc = wid & 3, fr = lane & 15, fq = lane >> 4;
        const int row0 = wr * 64 + fr, col0 = wc * 32 + 8 * fq;
#pragma unroll
        for (int ai = 0; ai < 2; ++ai)
#pragma unroll
            for (int m = 0; m < 4; ++m) {
                const int r = row0 + ai * HALF + m * 16;
                if (r < u.nvalid) {
                    bf16_t* rowp = (bf16_t*)u.C + (size_t)r * u.ldc + col0;
#pragma unroll
                    for (int bj = 0; bj < 2; ++bj) { const f32x4 v0 = acc[ai][bj][m][0], v1 = acc[ai][bj][m][1];
                        u32x4 w; w.x = cvt_pk_bf16(v0[0], v0[1]); w.y = cvt_pk_bf16(v0[2], v0[3]); w.z = cvt_pk_bf16(v1[0], v1[1]); w.w = cvt_pk_bf16(v1[2], v1[3]);
                        *(u32x4*)(rowp + bj * HALF) = w; }
                }
            }
    }
};
constexpr float YB_SCALE = 32.0f;
struct EpiStoreF8 {
    __device__ __forceinline__ void operator()(const f32x4 (&acc)[2][2][4][2], const Unit& u) const {
        const int tid = opaque_tid(), wid = tid >> 6, lane = tid & 63, wr = wid >> 2, wc = wid & 3, fr = lane & 15, fq = lane >> 4;
        const int row0 = wr * 64 + fr, col0 = wc * 32 + 8 * fq;
#pragma unroll
        for (int ai = 0; ai < 2; ++ai)
#pragma unroll
            for (int m = 0; m < 4; ++m) {
                const int r = row0 + ai * HALF + m * 16;
                if (r < u.nvalid) {
                    unsigned char* rowp = (unsigned char*)u.C + (size_t)r * u.ldc + col0;
#pragma unroll
                    for (int bj = 0; bj < 2; ++bj) { f32x4 v0 = acc[ai][bj][m][0], v1 = acc[ai][bj][m][1];
#pragma unroll
                        for (int t = 0; t < 4; ++t) { v0[t] = __builtin_amdgcn_fmed3f(v0[t], -448.0f, 448.0f); v1[t] = __builtin_amdgcn_fmed3f(v1[t], -448.0f, 448.0f); }
                        int w0 = 0, w1 = 0;
                        w0 = __builtin_amdgcn_cvt_pk_fp8_f32(v0[0], v0[1], w0, false); w0 = __builtin_amdgcn_cvt_pk_fp8_f32(v0[2], v0[3], w0, true);
                        w1 = __builtin_amdgcn_cvt_pk_fp8_f32(v1[0], v1[1], w1, false); w1 = __builtin_amdgcn_cvt_pk_fp8_f32(v1[2], v1[3], w1, true);
                        *(u32x2*)(rowp + bj * HALF) = (u32x2){(unsigned)w0, (unsigned)w1}; }
                }
            }
    }
};
struct EpiSwiGLU {
    __device__ __forceinline__ void operator()(const f32x4 (&acc)[2][2][4][2], const Unit& u) const {
        const int tid = opaque_tid(), wid = tid >> 6, lane = tid & 63, wr = wid >> 2, wc = wid & 3, fr = lane & 15, fq = lane >> 4;
        const int row0 = wr * 64 + fr, col0 = wc * 32 + 8 * fq;
#pragma unroll
        for (int ai = 0; ai < 2; ++ai)
#pragma unroll
            for (int m = 0; m < 4; ++m) {
                const int r = row0 + ai * HALF + m * 16;
                if (r < u.nvalid) {
                    float o[8];
#pragma unroll
                    for (int n = 0; n < 2; ++n)
#pragma unroll
                        for (int j = 0; j < 4; ++j) { const float g = acc[ai][0][m][n][j], up = acc[ai][1][m][n][j];
                            o[n * 4 + j] = g * __builtin_amdgcn_rcpf(1.0f + __builtin_amdgcn_exp2f(-1.4426950408889634f * g)) * up; }
                    u32x4 w; w.x = cvt_pk_bf16(o[0], o[1]); w.y = cvt_pk_bf16(o[2], o[3]); w.z = cvt_pk_bf16(o[4], o[5]); w.w = cvt_pk_bf16(o[6], o[7]);
                    *(u32x4*)((bf16_t*)u.C + (size_t)r * u.ldc + col0) = w;
                }
            }
    }
};
struct EpiQKVE {
    LAS float* P;
    const float* gainp;
    const f32x2* rope;
    __device__ __forceinline__ void operator()(const f32x4 (&acc)[2][2][4][2], const Unit& u) const {
        const int tid = opaque_tid(), wid = tid >> 6, lane = tid & 63, wr = wid >> 2, wc = wid & 3, fr = lane & 15, fq = lane >> 4;
        const int row0 = wr * 64 + fr, col0 = wc * 32 + 8 * fq;
        if (u.x0 >= 2) {
            const size_t bjs = (u.x0 == 2) ? (size_t)NB * KVR * 128 : (size_t)HALF;
#pragma unroll
            for (int ai = 0; ai < 2; ++ai)
#pragma unroll
                for (int m = 0; m < 4; ++m) { bf16_t* rowp = (bf16_t*)u.C + (size_t)(row0 + ai * HALF + m * 16) * u.ldc + col0;
#pragma unroll
                    for (int bj = 0; bj < 2; ++bj) { const f32x4 v0 = acc[ai][bj][m][0], v1 = acc[ai][bj][m][1];
                        u32x4 w; w.x = cvt_pk_bf16(v0[0], v0[1]); w.y = cvt_pk_bf16(v0[2], v0[3]); w.z = cvt_pk_bf16(v1[0], v1[1]); w.w = cvt_pk_bf16(v1[2], v1[3]);
                        *(u32x4*)(rowp + bj * bjs) = w; } }
            asm volatile("" ::: "memory"); __builtin_amdgcn_s_barrier(); asm volatile("" ::: "memory");
            return;
        }
#pragma unroll
        for (int ai = 0; ai < 2; ++ai)
#pragma unroll
            for (int m = 0; m < 4; ++m)
#pragma unroll
                for (int bj = 0; bj < 2; ++bj) { const f32x4 a = acc[ai][bj][m][0], b = acc[ai][bj][m][1];
                    float s = (a[0] * a[0] + a[1] * a[1]) + (a[2] * a[2] + a[3] * a[3]) + (b[0] * b[0] + b[1] * b[1]) + (b[2] * b[2] + b[3] * b[3]);
                    s += __shfl_xor(s, 16); s += __shfl_xor(s, 32);
                    if (fq == 0) P[(bj * 256 + row0 + ai * HALF + m * 16) * 4 + wc] = s; }
        asm volatile("s_waitcnt lgkmcnt(0)" ::: "memory"); __builtin_amdgcn_s_barrier(); asm volatile("" ::: "memory");
        const f32x4 g0 = *(const f32x4*)(gainp + u.x0 * 128 + col0), g1 = *(const f32x4*)(gainp + u.x0 * 128 + col0 + 4);
        const int half = wc >> 1, fi = ((wc & 1) * 4 + fq) * 4;
#pragma unroll
        for (int ai = 0; ai < 2; ++ai)
#pragma unroll
            for (int m = 0; m < 4; ++m) {
                const int r = row0 + ai * HALF + m * 16;
                int pos = 0;
                if (u.x1 >= 0) { const int t = u.x1 + r; pos = half ? (t & 63) : (t >> 6); }
                const f32x4 cs0 = *(const f32x4*)(rope + pos * 32 + fi), cs1 = *(const f32x4*)(rope + pos * 32 + fi + 2);
                const float cc[4] = {cs0[0], cs0[2], cs1[0], cs1[2]}, ss[4] = {cs0[1], cs0[3], cs1[1], cs1[3]};
                bf16_t* rowp = (bf16_t*)u.C + (size_t)r * u.ldc + col0;
#pragma unroll
                for (int bj = 0; bj < 2; ++bj) {
                    const f32x4 pp = *(const LAS f32x4*)(P + (bj * 256 + r) * 4);
                    const float rs = __builtin_amdgcn_rsqf(((pp[0] + pp[1]) + (pp[2] + pp[3])) * (1.0f / 128.0f) + RMS_EPS);
                    float o1[4], o2[4];
#pragma unroll
                    for (int j = 0; j < 4; ++j) { const float v1 = acc[ai][bj][m][0][j] * rs * g0[j], v2 = acc[ai][bj][m][1][j] * rs * g1[j];
                        o1[j] = v1 * cc[j] - v2 * ss[j]; o2[j] = v1 * ss[j] + v2 * cc[j]; }
                    u32x4 w; w.x = cvt_pk_bf16(o1[0], o1[1]); w.y = cvt_pk_bf16(o1[2], o1[3]); w.z = cvt_pk_bf16(o2[0], o2[1]); w.w = cvt_pk_bf16(o2[2], o2[3]);
                    *(u32x4*)(rowp + bj * ((u.x0 == 0) ? (size_t)HALF : (size_t)NB * KVR * 128)) = w;
                }
            }
    }
};

template <class Epi, class Sched, bool GATHER>
__device__ __forceinline__ void gemm_phase(LAS unsigned char* lds, const int K_, Sched& S, const Epi& E) {
    const int K = K_;
    const int tid = opaque_tid(), wid = __builtin_amdgcn_readfirstlane(tid >> 6), lane = tid & 63, wr = wid >> 2, wc = wid & 3, fr = lane & 15, fq = lane >> 4;
    const int nt = K / BK;
    Unit cur, nxt; int ui = 0;
    if (!S.next(0, cur)) return;
    unsigned voffB[2], offA[2][2];
#pragma unroll
    for (int i = 0; i < 2; ++i) { int R, C; stage_rc(tid * 16 + i * 8192, R, C); const int Rb = (R & ~31) + perm32(R & 31);
        voffB[i] = (unsigned)(Rb * K + C) * 2u; }
    LAS int* ridx = (LAS int*)(lds + LDS_RIDX);
    if (GATHER) {
        if (tid < 256) ridx[tid] = (tid < cur.nvalid) ? cur.rows[tid] : 0;
        __syncthreads();
#pragma unroll
        for (int h = 0; h < 2; ++h)
#pragma unroll
            for (int i = 0; i < 2; ++i) { int R, C; stage_rc(tid * 16 + i * 8192, R, C); offA[h][i] = (unsigned)ridx[h * HALF + R] * (unsigned)(K * 2) + (unsigned)C * 2u; }
    } else {
#pragma unroll
        for (int h = 0; h < 2; ++h)
#pragma unroll
            for (int i = 0; i < 2; ++i) { int R, C; stage_rc(tid * 16 + i * 8192, R, C); offA[h][i] = (unsigned)((h * HALF + R) * K + C) * 2u; }
    }
    const size_t kstep = (size_t)(BK * 2);
    const size_t hstep = (size_t)HALF * K * 2;
    const unsigned ldsw = (unsigned)wid * 1024u;
    const int aoff = lds_byte(wr * 64 + fr, fq * 8), boff = lds_byte(wc * 32 + fr, fq * 8);
#define PG8_SA(b, h) (((b) * 2 + (h)) * HTB)
#define PG8_SB(b, h) ((4 + (b) * 2 + (h)) * HTB)
#define PG8_STAGE(bufoff, gbase, voff) do { _Pragma("unroll") for (int _i = 0; _i < 2; ++_i) \
        __builtin_amdgcn_global_load_lds((const unsigned*)((const char*)(gbase) + (voff)[_i]), (LAS unsigned*)(lds + (bufoff) + ldsw + _i * 8192), 16, 0, 0); } while (0)
#define PG8_LDA(dst, b, h) do { _Pragma("unroll") for (int m = 0; m < 4; ++m) _Pragma("unroll") for (int k = 0; k < 2; ++k) dst[m][k] = *(const LAS bf16x8*)(lds + PG8_SA(b, h) + aoff + m * 2048 + k * 1024); } while (0)
#define PG8_LDB(dst, b, h) do { _Pragma("unroll") for (int n = 0; n < 2; ++n) _Pragma("unroll") for (int k = 0; k < 2; ++k) dst[n][k] = *(const LAS bf16x8*)(lds + PG8_SB(b, h) + boff + n * 2048 + k * 1024); } while (0)
#define PG8_MMA(ai, bj, At, Bt) do { __builtin_amdgcn_s_setprio(1); _Pragma("unroll") for (int m = 0; m < 4; ++m) _Pragma("unroll") for (int n = 0; n < 2; ++n) _Pragma("unroll") for (int k = 0; k < 2; ++k) \
        acc[ai][bj][m][n] = __builtin_amdgcn_mfma_f32_16x16x32_bf16(Bt[n][k], At[m][k], acc[ai][bj][m][n], 0, 0, 0); __builtin_amdgcn_s_setprio(0); } while (0)
#define PG8_WAIT_V(n) asm volatile("s_waitcnt vmcnt(" #n ")" ::: "memory")
#define PG8_WAIT_L(n) asm volatile("s_waitcnt lgkmcnt(" #n ")" ::: "memory")
#define PG8_BAR __builtin_amdgcn_s_barrier()
#define PG8_SCHED __builtin_amdgcn_sched_barrier(0)
    f32x4 acc[2][2][4][2];
#pragma unroll
    for (int a = 0; a < 2; ++a)
#pragma unroll
        for (int b = 0; b < 2; ++b)
#pragma unroll
            for (int m = 0; m < 4; ++m)
#pragma unroll
                for (int n = 0; n < 2; ++n) acc[a][b][m][n] = (f32x4){0.f, 0.f, 0.f, 0.f};
    bf16x8 At[4][2], B0[2][2], B1[2][2];
    const char* cA = cur.A; const char* cB = cur.B;
    PG8_STAGE(PG8_SB(0, 0), cB, voffB); PG8_STAGE(PG8_SA(0, 0), cA, offA[0]); PG8_STAGE(PG8_SB(0, 1), cB + hstep, voffB); PG8_STAGE(PG8_SA(0, 1), cA, offA[1]);
    if (wr == 1) PG8_BAR;
    PG8_WAIT_V(4); PG8_BAR;
    PG8_STAGE(PG8_SB(1, 0), cB + kstep, voffB); PG8_STAGE(PG8_SA(1, 0), cA + kstep, offA[0]); PG8_STAGE(PG8_SB(1, 1), cB + hstep + kstep, voffB);
    PG8_WAIT_V(6); PG8_BAR;
    for (;;) {
        const bool has_next = S.next(ui + 1, nxt);
        const char* nA = has_next ? nxt.A : cA; const char* nB = has_next ? nxt.B : cB;
        if (GATHER && has_next && wid < 4)
            __builtin_amdgcn_global_load_lds((const unsigned*)(nxt.rows + wid * 64 + lane), (LAS unsigned*)(lds + LDS_RIDX + ((ui + 1) & 1) * 1024 + wid * 256), 4, 0, 0);
        int t = 0;
        do {
            const bool last = (t == nt - 2);
            const char* a1 = cA + (size_t)(t + 1) * kstep;
            const char* a2 = last ? nA : cA + (size_t)(t + 2) * kstep; const char* b2 = last ? nB : cB + (size_t)(t + 2) * kstep;
            const char* a3 = a2 + kstep; const char* b3 = b2 + kstep;
            PG8_LDB(B0, 0, 0); PG8_SCHED; PG8_LDA(At, 0, 0); PG8_STAGE(PG8_SA(1, 1), a1, offA[1]);
            PG8_WAIT_L(8); PG8_BAR; PG8_WAIT_L(0); PG8_MMA(0, 0, At, B0); PG8_BAR; PG8_SCHED;
            if (GATHER && last && has_next) {
                LAS int* rn = ridx + ((ui + 1) & 1) * 256;
#pragma unroll
                for (int h = 0; h < 2; ++h)
#pragma unroll
                    for (int i = 0; i < 2; ++i) { int R, C; stage_rc(tid * 16 + i * 8192, R, C); const int rr = h * HALF + R; const int tok = (rr < nxt.nvalid) ? rn[rr] : 0; offA[h][i] = (unsigned)tok * (unsigned)(K * 2) + (unsigned)C * 2u; }
            }
            PG8_LDB(B1, 0, 1); PG8_STAGE(PG8_SB(0, 0), b2, voffB);
            PG8_BAR; PG8_WAIT_L(0); PG8_MMA(0, 1, At, B1); PG8_BAR;
            PG8_LDA(At, 0, 1); PG8_STAGE(PG8_SA(0, 0), a2, offA[0]);
            PG8_BAR; PG8_WAIT_L(0); PG8_MMA(1, 0, At, B0); PG8_BAR; PG8_SCHED;
            PG8_STAGE(PG8_SB(0, 1), b2 + hstep, voffB);
            PG8_WAIT_V(6); PG8_BAR; PG8_MMA(1, 1, At, B1); PG8_BAR;
            PG8_LDB(B0, 1, 0); PG8_SCHED; PG8_LDA(At, 1, 0); PG8_STAGE(PG8_SA(0, 1), a2, offA[1]);
            PG8_WAIT_L(8); PG8_BAR; PG8_WAIT_L(0); PG8_MMA(0, 0, At, B0); PG8_BAR; PG8_SCHED;
            PG8_LDB(B1, 1, 1); PG8_STAGE(PG8_SB(1, 0), b3, voffB);
            PG8_BAR; PG8_WAIT_L(0); PG8_MMA(0, 1, At, B1); PG8_BAR;
            PG8_LDA(At, 1, 1); PG8_STAGE(PG8_SA(1, 0), a3, offA[0]);
            PG8_BAR; PG8_WAIT_L(0); PG8_MMA(1, 0, At, B0); PG8_BAR; PG8_SCHED;
            PG8_STAGE(PG8_SB(1, 1), b3 + hstep, voffB);
            PG8_WAIT_V(6); PG8_BAR; PG8_MMA(1, 1, At, B1); PG8_BAR;
            t += 2;
        } while (t < nt);
        { Unit eu; S.next(ui, eu); E(acc, eu); }
        if (!has_next) break;
#pragma unroll
        for (int a = 0; a < 2; ++a)
#pragma unroll
            for (int b = 0; b < 2; ++b)
#pragma unroll
                for (int m = 0; m < 4; ++m)
#pragma unroll
                    for (int n = 0; n < 2; ++n) acc[a][b][m][n] = (f32x4){0.f, 0.f, 0.f, 0.f};
        cur = nxt; cA = nA; cB = nB; ++ui;
    }
    PG8_WAIT_V(0);
    if (wr == 0) PG8_BAR;
    PG8_BAR;
#undef PG8_SA
#undef PG8_SB
#undef PG8_STAGE
#undef PG8_LDA
#undef PG8_LDB
#undef PG8_MMA
#undef PG8_WAIT_V
#undef PG8_WAIT_L
#undef PG8_BAR
#undef PG8_SCHED
}
}

namespace att {
constexpr int D = 128, NW = 8, QBLK = 32, KVBLK = 64;
constexpr float SCALE = ATT_SCALE;
constexpr float THR = 8.f;
constexpr float NEGM = -30000.f;
constexpr size_t SHM_V = KVBLK * D * 2, SHM_K = KVBLK * D * 2, SHM_ATTN = 2 * SHM_V + 2 * SHM_K + NW * 64 * 4;
constexpr int LDS_BIAS = 69632;
#define KSWZ(row, colB) ((row) * 256 + ((colB) ^ (((row) & 7) << 4)))
#define SBAR() __builtin_amdgcn_sched_barrier(0)
__device__ __forceinline__ int crow(int r, int hi) { return (r & 3) + 8 * (r >> 2) + 4 * hi; }

__device__ __forceinline__ void partialSM(f32x16& p0, f32x16& p1, float& m_reg, float& mn, float& alpha) {
  constexpr float C = SCALE * 1.4426950408889634f;
  float pmax = p0[0];
#pragma unroll
  for (int r = 1; r < 16; ++r) pmax = fmaxf(pmax, p0[r]);
#pragma unroll
  for (int r = 0; r < 16; ++r) pmax = fmaxf(pmax, p1[r]);
  { auto rr = __builtin_amdgcn_permlane32_swap(__float_as_uint(pmax), __float_as_uint(pmax), false, false);
    pmax = fmaxf(__uint_as_float(rr[0]), __uint_as_float(rr[1])); }
  if (__builtin_expect(__all(pmax - m_reg <= THR / SCALE), 1)) { mn = m_reg; alpha = 1.f; }
  else { mn = fmaxf(m_reg, pmax); alpha = __builtin_amdgcn_exp2f((m_reg - mn) * C); m_reg = mn; }
  float mnC = -mn * C;
#pragma unroll
  for (int r = 0; r < 16; ++r) p0[r] = fmaf(p0[r], C, mnC);
#pragma unroll
  for (int r = 0; r < 16; ++r) p1[r] = fmaf(p1[r], C, mnC);
#pragma unroll
  for (int r = 0; r < 16; ++r) p0[r] = __builtin_amdgcn_exp2f(p0[r]);
}
__device__ __forceinline__ void finishSM(f32x16& p0, f32x16& p1, float alpha, float& l_reg, bf16x8& pa0, bf16x8& pa1, bf16x8& pa2, bf16x8& pa3) {
#pragma unroll
  for (int r = 0; r < 16; ++r) p1[r] = __builtin_amdgcn_exp2f(p1[r]);
  float ps = 0;
#pragma unroll
  for (int r = 0; r < 16; ++r) ps += p0[r];
#pragma unroll
  for (int r = 0; r < 16; ++r) ps += p1[r];
  { auto rr = __builtin_amdgcn_permlane32_swap(__float_as_uint(ps), __float_as_uint(ps), false, false);
    ps = __uint_as_float(rr[0]) + __uint_as_float(rr[1]); }
  l_reg = l_reg * alpha + ps;
#define PK4(P, BASE, OUT) do { unsigned a0 = cvt_pk_bf16(P[BASE + 0], P[BASE + 1]), a1 = cvt_pk_bf16(P[BASE + 2], P[BASE + 3]);   \
    unsigned b0 = cvt_pk_bf16(P[BASE + 4], P[BASE + 5]), b1 = cvt_pk_bf16(P[BASE + 6], P[BASE + 7]);                              \
    auto r0 = __builtin_amdgcn_permlane32_swap(a0, b0, false, false); auto r1 = __builtin_amdgcn_permlane32_swap(a1, b1, false, false); \
    u32x4 w = {r0[0], r1[0], r0[1], r1[1]}; OUT = *reinterpret_cast<bf16x8*>(&w); } while (0)
  PK4(p0, 0, pa0); PK4(p0, 8, pa1); PK4(p1, 0, pa2); PK4(p1, 8, pa3);
#undef PK4
}
__device__ __forceinline__ void qkt(f32x16& p0, f32x16& p1, const char* Ks, const bf16x8* qr, int r32, int hi) {
  p0 = f32x16{}; p1 = f32x16{};
#pragma unroll
  for (int d0 = 0; d0 < 8; ++d0) { int cb = (d0 * 16 + hi * 8) * 2;
    bf16x8 b0 = *reinterpret_cast<const bf16x8*>(Ks + KSWZ(r32, cb));
    bf16x8 b1 = *reinterpret_cast<const bf16x8*>(Ks + KSWZ(32 + r32, cb));
    p0 = __builtin_amdgcn_mfma_f32_32x32x16_bf16(b0, qr[d0], p0, 0, 0, 0);
    p1 = __builtin_amdgcn_mfma_f32_32x32x16_bf16(b1, qr[d0], p1, 0, 0, 0); }
}
__device__ __forceinline__ int v_st(int k, int c) { const int kk = (k & ~0xC) | ((k & 4) << 1) | ((k & 8) >> 1); return ((kk >> 3) * 4 + (c >> 5)) * 512 + ((kk & 7) * 32 + (c & 31)) * 2; }
__device__ __forceinline__ int v_rd_base(int lane) { return ((lane & 3) << 3) | (((lane >> 2) & 3) << 6) | (((lane >> 4) & 1) << 5) | (((lane >> 5) & 1) << 8); }
constexpr int v_rd_off(int d0, int ks, int half) { return d0 * 512 + ks * 4096 + half * 2048; }
template <int OFF> __device__ __forceinline__ s16x4 tr_read(int vb) {
  s16x4 r; asm volatile("ds_read_b64_tr_b16 %0, %1 offset:%2" : "=&v"(r) : "v"(vb), "i"(OFF) : "memory"); return r;
}
template <int D0> __device__ __forceinline__ void pv_one(f32x16& od, int vb, bf16x8 pa0, bf16x8 pa1, bf16x8 pa2, bf16x8 pa3) {
  const s16x4 l0 = tr_read<v_rd_off(D0, 0, 0)>(vb), h0 = tr_read<v_rd_off(D0, 0, 1)>(vb), l1 = tr_read<v_rd_off(D0, 1, 0)>(vb), h1 = tr_read<v_rd_off(D0, 1, 1)>(vb);
  const s16x4 l2 = tr_read<v_rd_off(D0, 2, 0)>(vb), h2 = tr_read<v_rd_off(D0, 2, 1)>(vb), l3 = tr_read<v_rd_off(D0, 3, 0)>(vb), h3 = tr_read<v_rd_off(D0, 3, 1)>(vb);
  asm volatile("s_waitcnt lgkmcnt(0)" ::: "memory"); SBAR();
#define PK(L, H) (bf16x8){L[0], L[1], L[2], L[3], H[0], H[1], H[2], H[3]}
  od = __builtin_amdgcn_mfma_f32_32x32x16_bf16(pa0, PK(l0, h0), od, 0, 0, 0);
  od = __builtin_amdgcn_mfma_f32_32x32x16_bf16(pa1, PK(l1, h1), od, 0, 0, 0);
  od = __builtin_amdgcn_mfma_f32_32x32x16_bf16(pa2, PK(l2, h2), od, 0, 0, 0);
  od = __builtin_amdgcn_mfma_f32_32x32x16_bf16(pa3, PK(l3, h3), od, 0, 0, 0);
#undef PK
}
__device__ __forceinline__ void pv_d0(f32x16* o, int vb, bf16x8 pa0, bf16x8 pa1, bf16x8 pa2, bf16x8 pa3) {
  pv_one<0>(o[0], vb, pa0, pa1, pa2, pa3); pv_one<1>(o[1], vb, pa0, pa1, pa2, pa3); pv_one<2>(o[2], vb, pa0, pa1, pa2, pa3); pv_one<3>(o[3], vb, pa0, pa1, pa2, pa3);
}

template <bool NA, int ldq, int ldk, int ldo>
__device__ __forceinline__ void attn_body(const bf16_t* __restrict__ Qb, const bf16_t* __restrict__ Kh, const bf16_t* __restrict__ Vh,
                                          bf16_t* __restrict__ Ob, const int NT, const int nloc, const int bs, const int q0r, char* lds) {
  const int tid = opaque_tid(), wid = tid >> 6, lane = tid & 63, r32 = lane & 31, hi = lane >> 5;
  char* V_lds = lds; char* K_lds = lds + 2 * SHM_V;
  float* ws = (float*)(lds + 2 * SHM_V + 2 * SHM_K) + wid * 64; float* li_l = ws; float* al_l = ws + 32;
  float m_reg = -1e30f, l_reg = 0; f32x16 o[4] = {}; bf16x8 qr[8];
  const bf16_t* Qw = Qb + (wid * QBLK + r32) * ldq + hi * 8;
#pragma unroll
  for (int d0 = 0; d0 < 8; ++d0) qr[d0] = *reinterpret_cast<const bf16x8*>(Qw + d0 * 16);
  const int sr = tid >> 4, sc = (tid & 15) * 8, vst0 = v_st(sr, sc), vst1 = v_st(32 + sr, sc);
  const int vb0 = (int)(uintptr_t)V_lds + v_rd_base(lane);
  const unsigned kvo = (unsigned)(sr * ldk + sc) * 2u;
  const float* btab = (const float*)(lds + LDS_BIAS) + 64;
  constexpr int SD = NA ? 1 : 2;
  struct { bf16x8 vs0, vs1, ks0, ks1; } sr_[SD];
#define KOFF(j) (NA ? ((j) < nloc ? (bs + (j)) * 64 : LSEQ + ((j) - nloc) * 64) : (j) * 64)
#define SLOAD(i, k0) do { const unsigned _ko = (unsigned)((k0) * ldk * 2) + kvo; sr_[i].vs0 = *reinterpret_cast<const bf16x8*>((const char*)Vh + _ko); sr_[i].vs1 = *reinterpret_cast<const bf16x8*>((const char*)Vh + (_ko + 64u * ldk)); \
    sr_[i].ks0 = *reinterpret_cast<const bf16x8*>((const char*)Kh + _ko); sr_[i].ks1 = *reinterpret_cast<const bf16x8*>((const char*)Kh + (_ko + 64u * ldk)); } while (0)
#define SWRITE(b, i) do { int sr_w = sr, sc_w = sc, v0_w = vst0, v1_w = vst1; \
    if (NA) { const int t_ = opaque_tid(); sr_w = t_ >> 4; sc_w = (t_ & 15) * 8; v0_w = v_st(sr_w, sc_w); v1_w = v_st(32 + sr_w, sc_w); }     \
    *(bf16x8*)(V_lds + (b) * SHM_V + v0_w) = sr_[i].vs0;          \
    *(bf16x8*)(V_lds + (b) * SHM_V + v1_w) = sr_[i].vs1; int kc = sc_w * 2;               \
    *(bf16x8*)(K_lds + (b) * SHM_K + KSWZ(sr_w, kc)) = sr_[i].ks0;                       \
    *(bf16x8*)(K_lds + (b) * SHM_K + KSWZ(32 + sr_w, kc)) = sr_[i].ks1; } while (0)
#define SWAIT() do { if (SD == 2) asm volatile("s_waitcnt vmcnt(4)" ::: "memory"); else asm volatile("s_waitcnt vmcnt(0)" ::: "memory"); } while (0)
#define RESC(a) do { if (__any((a) < 1.f)) { if (hi == 0) al_l[r32] = (a); asm volatile("s_waitcnt lgkmcnt(0)" ::: "memory"); \
    _Pragma("unroll") for (int d = 0; d < 4; ++d) _Pragma("unroll") for (int r = 0; r < 16; ++r) o[d][r] *= al_l[crow(r, hi)]; } } while (0)
#define ACT(j) (!NA || (j) >= nloc || ((bs + (j)) >= min(max(q0r + __builtin_amdgcn_readfirstlane(opaque_tid() >> 7) - 4, 0), 56) && (bs + (j)) < min(max(q0r + __builtin_amdgcn_readfirstlane(opaque_tid() >> 7) - 4, 0), 56) + 8))
#define NAMASK(P0, P1, j) do { if (NA && (j) < nloc) { const int kr = bs + (j); const int t_ = opaque_tid(); \
    const int qrow = q0r + __builtin_amdgcn_readfirstlane(t_ >> 7), qcol = ((t_ >> 6) & 1) * 32 + (t_ & 31), hi_ = (t_ >> 5) & 1; \
    const int cstart = min(max(qcol - 8, 0), 48); \
    const float* bp = btab + (kr - qrow + 7) * 31 + (4 * hi_ - qcol + 15); const int cs = cstart - 4 * hi_; \
    _Pragma("unroll") for (int r = 0; r < 16; ++r) { const int kc = (r & 3) + 8 * (r >> 2); \
        P0[r] = ((unsigned)(kc - cs) < 16u) ? P0[r] + bp[kc] : NEGM; P1[r] = ((unsigned)(kc + 32 - cs) < 16u) ? P1[r] + bp[kc + 32] : NEGM; } } } while (0)
  f32x16 pA0, pA1, pB0, pB1; float mnA, mnB, alA = 1.f, alB = 1.f; bf16x8 pa0, pa1, pa2, pa3;
  bool actA, actB;
  constexpr int SE = 0, SO = SD - 1;
  SLOAD(SE, KOFF(0)); asm volatile("s_waitcnt vmcnt(0)" ::: "memory"); SWRITE(0, SE); __syncthreads();
  actA = ACT(0);
  if (actA) { qkt(pA0, pA1, K_lds, qr, r32, hi); NAMASK(pA0, pA1, 0); partialSM(pA0, pA1, m_reg, mnA, alA); } else alA = 1.f;
  SLOAD(SO, KOFF(1)); if (SD == 2 && 2 < NT) SLOAD(SE, KOFF(2));
  SWAIT(); SWRITE(1, SO); __syncthreads();
  for (int j = 1; j + 1 < NT; j += 2) {
    SBAR(); actB = ACT(j); if (actB) { qkt(pB0, pB1, K_lds + SHM_K, qr, r32, hi); NAMASK(pB0, pB1, j); }
    if (actA) finishSM(pA0, pA1, alA, l_reg, pa0, pa1, pa2, pa3); SBAR();
    SLOAD(SO, KOFF(j + SD)); SBAR();
    if (actA) pv_d0(o, vb0, pa0, pa1, pa2, pa3); if (actB) partialSM(pB0, pB1, m_reg, mnB, alB); else alB = 1.f;
    __syncthreads(); SWAIT(); SWRITE(0, SE);
    RESC(alB); __syncthreads();
    SBAR(); actA = ACT(j + 1); if (actA) { qkt(pA0, pA1, K_lds, qr, r32, hi); NAMASK(pA0, pA1, j + 1); }
    if (actB) finishSM(pB0, pB1, alB, l_reg, pa0, pa1, pa2, pa3); SBAR();
    if (SD == 1 || j + 3 < NT) SLOAD(SE, KOFF(j + 1 + SD)); SBAR();
    if (actB) pv_d0(o, vb0 + (int)SHM_V, pa0, pa1, pa2, pa3); if (actA) partialSM(pA0, pA1, m_reg, mnA, alA); else alA = 1.f;
    __syncthreads(); SWAIT(); SWRITE(1, SO);
    RESC(alA); __syncthreads();
  }
  SBAR(); actB = ACT(NT - 1); if (actB) { qkt(pB0, pB1, K_lds + SHM_K, qr, r32, hi); NAMASK(pB0, pB1, NT - 1); }
  if (actA) finishSM(pA0, pA1, alA, l_reg, pa0, pa1, pa2, pa3); SBAR();
  if (actA) pv_d0(o, vb0, pa0, pa1, pa2, pa3); if (actB) partialSM(pB0, pB1, m_reg, mnB, alB); else alB = 1.f;
  __syncthreads(); RESC(alB);
  if (actB) { finishSM(pB0, pB1, alB, l_reg, pa0, pa1, pa2, pa3); SBAR();
    pv_d0(o, vb0 + (int)SHM_V, pa0, pa1, pa2, pa3); }
  if (hi == 0) li_l[r32] = l_reg; asm volatile("s_waitcnt lgkmcnt(0)" ::: "memory");
  float rli[16];
#pragma unroll
  for (int r = 0; r < 16; ++r) rli[r] = __builtin_amdgcn_rcpf(li_l[crow(r, hi)]);
  bf16_t* Ow = Ob + (wid * QBLK) * ldo + r32;
#pragma unroll
  for (int r = 0; r < 16; ++r) { const int orow = crow(r, hi);
#pragma unroll
    for (int d0 = 0; d0 < 4; ++d0) { const unsigned pk = cvt_pk_bf16(o[d0][r] * rli[r], 0.f); Ow[orow * ldo + d0 * 32] = (bf16_t)(pk & 0xffffu); } }
  __syncthreads();
#undef ACT
#undef KOFF
#undef SLOAD
#undef SWRITE
#undef SWAIT
#undef RESC
#undef NAMASK
}
#undef KSWZ
#undef SBAR
}

#define XB_TMO      128
#define XB_XCNT(j)  (256  + 64 * (j))
#define XB_XSUB(j)  (1280 + 64 * (j))
#define XB_XGEN(j)  (2304 + 64 * (j))
#define XB_TOP      3328
#define XB_TOPGEN   3392
#define XCD_BAR_WORDS 3456
#define XB_SPIN_CAP (1u << 22)
__device__ __forceinline__ unsigned xb_ld(unsigned* p)              { return __hip_atomic_load(p, __ATOMIC_RELAXED, __HIP_MEMORY_SCOPE_AGENT); }
__device__ __forceinline__ unsigned xb_add(unsigned* p, unsigned v) { return __hip_atomic_fetch_add(p, v, __ATOMIC_RELAXED, __HIP_MEMORY_SCOPE_AGENT); }
__device__ __forceinline__ unsigned xb_xcc_id() { return (unsigned)__builtin_amdgcn_s_getreg((3 << 11) | 20) & 0xFu; }
#define XB_SPIN(cond, bar) do { unsigned _sp = 0; while (cond) { __builtin_amdgcn_s_sleep(1); \
    if ((++_sp & 255u) == 0u) { if (xb_ld(&(bar)[XB_TMO])) break; if (_sp > XB_SPIN_CAP) { atomicAdd(&(bar)[XB_TMO], 1u); break; } } } } while (0)
struct XcdBarrier { unsigned* bar; unsigned x; volatile LAS unsigned* st; };
__device__ __forceinline__ XcdBarrier xcd_barrier_post(unsigned* bar, volatile LAS unsigned* st) {
    XcdBarrier b; b.bar = bar; b.x = xb_xcc_id(); b.st = st;
    if (threadIdx.x == 0) (void)xb_add(&bar[XB_XCNT(b.x)], 1u);
    return b;
}
__device__ __forceinline__ void xcd_barrier_complete(unsigned* bar, unsigned x, unsigned& nloc, unsigned& nx) {
    const unsigned G = gridDim.x * gridDim.y * gridDim.z;
    unsigned sum, cnt, mine, sp = 0u;
    for (;;) {
        sum = 0u; cnt = 0u; mine = 0u;
#pragma unroll
        for (unsigned j = 0; j < 16; ++j) { const unsigned c = xb_ld(&bar[XB_XCNT(j)]); sum += c; cnt += (c > 0u) ? 1u : 0u; mine = (j == x) ? c : mine; }
        if (sum == G) break;
        __builtin_amdgcn_s_sleep(1);
        if ((++sp & 255u) == 0u) { if (xb_ld(&bar[XB_TMO])) break; if (sp > XB_SPIN_CAP) { atomicAdd(&bar[XB_TMO], 1u); break; } }
    }
    nloc = mine > 0u ? mine : 1u; nx = cnt > 0u ? cnt : 1u;
}
__device__ __forceinline__ void xcd_barrier(const XcdBarrier& b) {
    asm volatile("s_waitcnt vmcnt(0)" ::: "memory");
    __syncthreads();
    if (threadIdx.x == 0) {
        unsigned* bar = b.bar;
        __builtin_amdgcn_s_waitcnt(0);
        unsigned nloc = b.st[0], nx = b.st[1];
        if (nloc == 0u) { xcd_barrier_complete(bar, b.x, nloc, nx); b.st[0] = nloc; b.st[1] = nx; }
        const unsigned old = xb_add(&bar[XB_XSUB(b.x)], 1u);
        const unsigned gen = old / nloc;
        if (old + 1u == (gen + 1u) * nloc) {
            __builtin_amdgcn_fence(__ATOMIC_RELEASE, "agent");
            asm volatile("s_waitcnt vmcnt(0)" ::: "memory");
            const unsigned og = xb_add(&bar[XB_TOP], 1u);
            const unsigned tg = og / nx;
            if (og + 1u == (tg + 1u) * nx) xb_add(&bar[XB_TOPGEN], 1u);
            else XB_SPIN(xb_ld(&bar[XB_TOPGEN]) == tg, bar);
            __builtin_amdgcn_fence(__ATOMIC_ACQUIRE, "agent");
            xb_add(&bar[XB_XGEN(b.x)], 1u);
            asm volatile("s_waitcnt vmcnt(0)" ::: "memory");
        } else {
            XB_SPIN(xb_ld(&bar[XB_XGEN(b.x)]) == gen, bar);
            __builtin_amdgcn_fence(__ATOMIC_ACQUIRE, "agent");
            asm volatile("s_waitcnt vmcnt(0)" ::: "memory");
        }
    }
    __syncthreads();
}

enum { I_X = 0, I_C, I_CTX, I_CCTX, I_WMOD, I_BMOD, I_LN1G, I_LN1B, I_LN2G, I_LN2B, I_ABWIN, I_ABWF, I_ABQN, I_ABKN, I_ABWOUT, I_NAWIN, I_NARPB, I_NAWOUT,
       I_WR, I_EBIAS, I_WG, I_WU, I_WDN, I_SG, I_SU, I_SD, N_IN };
struct Args { const float* in[N_IN]; float* out; unsigned char* ws; int ph_lo, ph_hi; };
struct KA {
    __device__ __forceinline__ const __attribute__((address_space(4))) char* base() const { const __attribute__((address_space(4))) char* p = (const __attribute__((address_space(4))) char*)__builtin_amdgcn_kernarg_segment_ptr(); asm volatile("" : "+s"(p)); return p; }
    __device__ __forceinline__ const float* in(int i) const { return *(const float* const __attribute__((address_space(4)))*)(base() + 8 * i); }
    __device__ __forceinline__ float* out() const { return *(float* const __attribute__((address_space(4)))*)(base() + 8 * N_IN); }
    __device__ __forceinline__ int ph_lo() const { return *(const int __attribute__((address_space(4)))*)(base() + 8 * N_IN + 16); }
    __device__ __forceinline__ int ph_hi() const { return *(const int __attribute__((address_space(4)))*)(base() + 8 * N_IN + 20); }
    __device__ __forceinline__ unsigned char* ws() const { return *(unsigned char* const __attribute__((address_space(4)))*)(base() + 8 * N_IN + 8); }
};

__device__ __forceinline__ int tok_batchrow(int m) { return m < TLAT ? (m >> 12) : 4; }

__host__ __device__ __forceinline__ int rope_phys(int d) { const int hf = d >> 6, dd = d & 63, i = dd & 31, second = dd >> 5; return hf * 64 + (i >> 2) * 8 + second * 4 + (i & 3); }

constexpr int CV_GU = 65 * 2 * 16, CV_DN = 65 * 16, CV_OUT = 64;
__host__ __device__ constexpr int cv_in(int l) { return (l & 1) ? 192 : 80; }
__host__ __device__ constexpr int cv_items(int l) { return CV_GU + CV_DN + cv_in(l) + CV_OUT; }
struct CvItem { const float* src; bf16_t* dst; int ldw, K, k0, n0, kind, which; };
__device__ __forceinline__ int cv_row(const CvItem& d, int n) {
    if (d.kind == 1) return (n >> 7) * 256 + d.which * 128 + (n & 127);
    if (d.kind == 2) { const int c = n - 256; return c < 1024 ? (c & ~127) + rope_phys(c & 127) : c; }
    return n;
}
__device__ __forceinline__ CvItem cv_decode(const KA& a, int l, int it) {
    CvItem d; unsigned char* ws = a.ws(); const int j = l >> 1; int r = it; d.which = 0;
    if (r < CV_GU) { const int mat = r >> 4, kb = r & 15, which = mat & 1, e = mat >> 1;
        d.src = (e < 64) ? a.in(which ? I_WU : I_WG) + ((size_t)(l * 64 + e) * DM * EDIM) : a.in(which ? I_SU : I_SG) + (size_t)l * DM * EDIM;
        d.dst = (bf16_t*)(ws + WS_WGU) + (size_t)(l * 65 + e) * 512 * DM; d.ldw = EDIM; d.K = DM; d.k0 = 64 * kb; d.n0 = 0; d.kind = 1; d.which = which; return d; }
    r -= CV_GU;
    if (r < CV_DN) { const int e = r >> 4, item = r & 15;
        d.src = (e < 64) ? a.in(I_WDN) + ((size_t)(l * 64 + e) * EDIM * DM) : a.in(I_SD) + (size_t)l * EDIM * DM;
        d.dst = (bf16_t*)(ws + WS_WD) + (size_t)(l * 65 + e) * DM * EDIM; d.ldw = DM; d.K = EDIM; d.k0 = 64 * (item >> 2); d.n0 = 256 * (item & 3); d.kind = 0; d.which = 2; return d; }
    r -= CV_DN;
    if (r < cv_in(l)) {
        if ((l & 1) == 0) { d.src = a.in(I_ABWIN) + (size_t)j * DM * 1536; d.dst = (bf16_t*)(ws + WS_WINE) + (size_t)j * 1280 * DM; d.ldw = 1536; d.K = DM; d.k0 = 64 * (r / 5); d.n0 = 256 + 256 * (r % 5); d.kind = 2; }
        else { d.src = a.in(I_NAWIN) + (size_t)j * DM * 3072; d.dst = (bf16_t*)(ws + WS_WINO) + (size_t)j * 3072 * DM; d.ldw = 3072; d.K = DM; d.k0 = 64 * (r / 12); d.n0 = 256 * (r % 12); d.kind = 0; }
        return d; }
    r -= cv_in(l);
    d.src = ((l & 1) ? a.in(I_NAWOUT) : a.in(I_ABWOUT)) + (size_t)j * DM * DM; d.dst = (bf16_t*)(ws + WS_WOUT) + (size_t)l * DM * DM; d.ldw = DM; d.K = DM; d.k0 = 64 * (r >> 2); d.n0 = 256 * (r & 3); d.kind = 0;
    return d;
}
constexpr int CV_LS = 260;
__device__ __forceinline__ void cv_load(const CvItem& d, f32x4 (&v)[8], int t) {
    const float* p = d.src + (size_t)(d.k0 + (t >> 6)) * d.ldw + d.n0 + (t & 63) * 4;
#pragma unroll
    for (int i = 0; i < 8; ++i) v[i] = *(const f32x4*)(p + (size_t)(8 * i) * d.ldw);
}
__device__ __forceinline__ void convert_items(LAS unsigned char* lds, int l, int lo, int hi, int worker, int nworkers) {
    const KA a;
    const int t = opaque_tid();
    LAS float* img = (LAS float*)lds;
    int it = lo + worker;
    if (it >= hi) return;
    CvItem d0 = cv_decode(a, l, it); f32x4 v[8]; cv_load(d0, v, t);
    for (;;) {
        { LAS float* w = img + (t >> 6) * CV_LS + (t & 63) * 4;
#pragma unroll
          for (int i = 0; i < 8; ++i) *(LAS f32x4*)(w + i * 8 * CV_LS) = v[i]; }
        __syncthreads();
        const int itn = it + nworkers; const bool more = itn < hi;
        CvItem d1 = d0;
        if (more) d1 = cv_decode(a, l, itn);
        { const int n = (t >> 6) * 32 + (t & 31), qh = (t >> 5) & 1; bf16_t* orow = d0.dst + (size_t)cv_row(d0, d0.n0 + n) * d0.K + d0.k0;
          const float sc = (d0.which == 2) ? 32.0f : 1.0f;
#pragma unroll
          for (int p = 0; p < 4; ++p) { const int q = 2 * p + qh; const LAS float* s = img + (8 * q) * CV_LS + n;
              u32x4 o; o.x = cvt_pk_bf16(s[0 * CV_LS] * sc, s[1 * CV_LS] * sc); o.y = cvt_pk_bf16(s[2 * CV_LS] * sc, s[3 * CV_LS] * sc); o.z = cvt_pk_bf16(s[4 * CV_LS] * sc, s[5 * CV_LS] * sc); o.w = cvt_pk_bf16(s[6 * CV_LS] * sc, s[7 * CV_LS] * sc);
              *(u32x4*)(orow + 8 * q) = o; } }
        __syncthreads();
        if (!more) break;
        d0 = d1; it = itn; cv_load(d0, v, t);
    }
}
struct CvSlice { int l, i0, i1, l2, j0, j1; };
constexpr int CV_EX = CV_GU + CV_DN;
#ifndef CV_MODE
#define CV_MODE 1
#endif
__device__ __forceinline__ CvSlice cv_slice(int l, int phase  ) {
    const CvSlice none = {0, 0, 0, 0, 0, 0};
    if (CV_MODE == 0) return none;
    if (l == 0) { if (phase == 1) return {0, 0, 2000, 0, 0, 0}; if (phase == 2) return {0, 2000, 3000, 0, 0, 0};
                  if (phase == 4) return {1, CV_EX, cv_items(1), 1, 0, 744}; if (phase == 5) return {1, 744, 1144, 0, 0, 0}; }
    if (l == 1) { if (phase == 0) return {1, 1144, 2120, 0, 0, 0}; if (phase == 2) return {1, 2120, CV_EX, 0, 0, 0};
                  if (phase == 4) return {2, CV_EX, cv_items(2), 2, 0, 856}; if (phase == 5) return {2, 856, 1256, 0, 0, 0}; }
    if (l == 2) { if (phase == 1) return {2, 1256, CV_EX, 0, 0, 0}; if (phase == 2) return {3, CV_EX, cv_items(3), 3, 0, 744};
                  if (phase == 4) return {3, 744, 1744, 0, 0, 0}; if (phase == 5) return {3, 1744, 2144, 0, 0, 0}; }
    if (l == 3) { if (phase == 0) return {3, 2144, 3044, 0, 0, 0}; if (phase == 2) return {3, 3044, CV_EX, 0, 0, 0}; }
    return none;
}
__device__ __forceinline__ void cv_tail(LAS unsigned char* lds, int l, int phase, int n_units, int bid, int G) {
    const CvSlice c = cv_slice(l, phase);
    if (c.i1 <= c.i0 && c.j1 <= c.j0) return;
    const int rem = n_units % G, nw = (rem == 0) ? G : G - rem, w = (rem == 0) ? bid : bid - rem;
    if (w < 0) return;
    __syncthreads();
    if (c.i1 > c.i0) convert_items(lds, c.l, c.i0, c.i1, w, nw);
    if (c.j1 > c.j0) convert_items(lds, c.l2, c.j0, c.j1, w, nw);
}

__device__ __forceinline__ void p0_mod(const KA& a, LAS unsigned char* lds, int bid, int G, int tid, int wave, int lane) {
    LAS float* sl = (LAS float*)(lds + 69632);
    LAS float* part = (LAS float*)(lds + 69632 + 20480);
    for (int i = tid; i < 5 * DM; i += 512) { const int r = i >> 10, k = i & 1023; const float v = (r < 4) ? a.in(I_C)[r * DM + k] : a.in(I_CCTX)[k]; sl[i] = v / (1.0f + __expf(-v)); }
    __syncthreads();
    float* mod = (float*)(a.ws() + WS_MOD);
    for (int task = bid; task < DEPTH * 48; task += G) {
        const int l = task / 48, c0 = (task % 48) * 128;
        const float* w = a.in(I_WMOD) + (size_t)l * DM * 6144 + c0 + 2 * lane;
        f32x2 acc[5];
#pragma unroll
        for (int r = 0; r < 5; ++r) acc[r] = (f32x2){0.f, 0.f};
#pragma unroll 16
        for (int k = wave * 128; k < wave * 128 + 128; ++k) { const f32x2 wv = *(const f32x2*)(w + (size_t)k * 6144);
#pragma unroll
            for (int r = 0; r < 5; ++r) acc[r] += wv * sl[r * DM + k]; }
#pragma unroll
        for (int r = 0; r < 5; ++r) *(LAS f32x2*)(part + (wave * 5 + r) * 128 + 2 * lane) = acc[r];
        __syncthreads();
        for (int i = tid; i < 640; i += 512) { const int r = i >> 7, c = i & 127; float s = a.in(I_BMOD)[l * 6144 + c0 + c];
#pragma unroll
            for (int w8 = 0; w8 < 8; ++w8) s += part[(w8 * 5 + r) * 128 + c];
            mod[((size_t)l * 5 + r) * 6144 + c0 + c] = s; }
        __syncthreads();
    }
}

__device__ __forceinline__ void p0_fourier_fold(const KA& a, LAS unsigned char* lds, int task, int tid, int wave, int lane) {
    const int kq = task & 3, g = (task >> 2) & 3, q = (task >> 4) & 1, j = task >> 5;
    LAS float* M = (LAS float*)(lds + 100352);
    LAS float* trg = M + 4096;
    const float* Wf = a.in(I_ABWF) + (size_t)(j * 4 + g) * 64 * 64;
    LAS float* Wl = trg + 64;
    __syncthreads();
    if (tid < 64) { const float ang = (float)tid * (1.0f / 32.0f); trg[tid] = q ? sinpif(ang) : cospif(ang); }
    for (int i = tid; i < 1024; i += 512) *(LAS f32x4*)(Wl + 4 * i) = *(const f32x4*)(Wf + 4 * i);
    __syncthreads();
    for (int i = tid; i < 4096; i += 512) { const int c = i >> 6, d = i & 63; float s = 0.f;
#pragma unroll 8
        for (int m = 0; m < 64; ++m) s += trg[(m * c) & 63] * Wl[m * 64 + d];
        M[i] = s; }
    __syncthreads();
    float mcol[64];
#pragma unroll
    for (int c = 0; c < 64; ++c) mcol[c] = M[c * 64 + lane];
    bf16_t* dst = (bf16_t*)(a.ws() + WS_WF) + ((size_t)j * 512 + q * 256 + g * 64 + lane) * DM;
    const float* win = a.in(I_ABWIN) + (size_t)j * DM * 1536 + g * 64 + lane;
    const int kbeg = kq * 256 + wave * 32;
    float wv[32];
#pragma unroll
    for (int i = 0; i < 32; ++i) wv[i] = win[(size_t)(kbeg + i) * 1536];
#pragma unroll
    for (int i = 0; i < 32; ++i) { float s = 0.f;
#pragma unroll
        for (int c = 0; c < 64; ++c) s += __int_as_float(__builtin_amdgcn_readlane(__float_as_int(wv[i]), c)) * mcol[c];
        dst[kbeg + i] = (bf16_t)(cvt_pk_bf16(s, 0.f) & 0xffffu); }
}


__device__ __forceinline__ void p0_tables(const KA& a, LAS unsigned char* lds, int gtid, int NGT, int tid) {
#define P0_COS(i) __builtin_amdgcn_cosf((float)(i) * (1.0f / 4096.0f))
    bf16_t* TW = (bf16_t*)(a.ws() + WS_TW);
    for (int it = gtid; it < 4096 * 1024; it += NGT) {
        const int k = it >> 10, c8 = (it & 1023) * 8, n0 = c8 & 4095, sh = (c8 >> 12) ? 1024 : 0; const float sg = (c8 >> 12) ? (-1.0f / 512.0f) : (1.0f / 512.0f);
        float v[8];
#pragma unroll
        for (int j = 0; j < 8; ++j) v[j] = P0_COS((k * (n0 + j) - sh) & 4095) * sg;
        u32x4 o; o.x = cvt_pk_bf16(v[0], v[1]); o.y = cvt_pk_bf16(v[2], v[3]); o.z = cvt_pk_bf16(v[4], v[5]); o.w = cvt_pk_bf16(v[6], v[7]);
        *(u32x4*)(TW + (size_t)k * 8192 + c8) = o;
    }
    bf16_t* TWC = (bf16_t*)(a.ws() + WS_TWC);
    for (int it = gtid; it < 256 * 64; it += NGT) {
        const int k = it >> 6, c8 = (it & 63) * 8, n0 = c8 & 255, sh = (c8 >> 8) ? 1024 : 0; const float sg = (c8 >> 8) ? (-1.0f / 128.0f) : (1.0f / 128.0f);
        float v[8];
#pragma unroll
        for (int j = 0; j < 8; ++j) v[j] = P0_COS((((k * (n0 + j)) & 255) * 16 - sh) & 4095) * sg;
        u32x4 o; o.x = cvt_pk_bf16(v[0], v[1]); o.y = cvt_pk_bf16(v[2], v[3]); o.z = cvt_pk_bf16(v[4], v[5]); o.w = cvt_pk_bf16(v[6], v[7]);
        *(u32x4*)(TWC + (size_t)k * 512 + c8) = o;
    }
#undef P0_COS
    bf16_t* WH = (bf16_t*)(a.ws() + WS_WRHI); bf16_t* WL = (bf16_t*)(a.ws() + WS_WRLO);
    for (int it = gtid; it < DEPTH * 64 * DM; it += NGT) {
        const int i = it & 7, ln = (it >> 3) & 63, ks = (it >> 9) & 31, nt4 = (it >> 14) & 3, l = it >> 16, e = nt4 * 16 + (ln & 15), k = ks * 32 + (ln >> 4) * 8 + i;
        const float w = a.in(I_WR)[((size_t)l * DM + k) * 64 + e];
        const unsigned h = cvt_pk_bf16(w, 0.f) & 0xffffu; const float r = w - __uint_as_float(h << 16);
        WH[it] = (bf16_t)h; WL[it] = (bf16_t)(cvt_pk_bf16(r, 0.f) & 0xffffu);
    }
    float* gp = (float*)(a.ws() + WS_GAINP);
    for (int it = gtid; it < 2 * 2 * 128; it += NGT) { const int j = it >> 8, qk = (it >> 7) & 1, d = it & 127; gp[(j * 2 + qk) * 128 + rope_phys(d)] = a.in(qk ? I_ABKN : I_ABQN)[j * 128 + d]; }
    f32x2* rp = (f32x2*)(a.ws() + WS_ROPE);
    for (int it = gtid; it < 64 * 32; it += NGT) { const int pos = it >> 5, i = it & 31; const float inv = exp2f(-(float)i * (13.287712379549449f / 32.0f));
        const float ang = (float)pos * inv; rp[it] = (f32x2){cosf(ang), sinf(ang)}; }
}

__device__ __forceinline__ const float* xrow_in(const KA& a, int l, int m) {
    if (l == 0) return m < TLAT ? a.in(I_X) + (size_t)m * DM : a.in(I_CTX) + (size_t)(m - TLAT) * DM;
    return nullptr;
}
__device__ __forceinline__ void p0b_modulate(const KA& a, int gw, int NGW, int lane) {
    const float* mod = (const float*)(a.ws() + WS_MOD);
    bf16_t* H = (bf16_t*)(a.ws() + WS_H);
    for (int m = gw; m < TT; m += NGW) {
        const f32x4* xr = (const f32x4*)xrow_in(a, 0, m) + lane; const float* md = mod + (size_t)tok_batchrow(m) * 6144;
        u32x2* o = (u32x2*)(H + (size_t)m * DM) + lane;
#pragma unroll
        for (int j = 0; j < 4; ++j) { const f32x4 x = xr[64 * j], sh = *((const f32x4*)md + lane + 64 * j), sc = *((const f32x4*)(md + DM) + lane + 64 * j);
            const f32x4 h = x * (sc + 1.0f) + sh; o[64 * j] = (u32x2){cvt_pk_bf16(h[0], h[1]), cvt_pk_bf16(h[2], h[3])}; }
    }
}

#ifndef D_DELAY
#define D_DELAY 0
#endif
#ifndef PROBE_D
#define PROBE_D 7
#endif
__device__ __forceinline__ void phase_ln1_router(const KA& a, LAS unsigned char* lds, int l, int bid, int tid, int wave, int lane, const bool dry) {
    LAS float* lg = (LAS float*)lds;
    LAS int* hist = (LAS int*)(lds + 96 * 64 * 4);
    LAS int* pend = hist + 128;
    const float* mod = (const float*)(a.ws() + WS_MOD) + (size_t)l * 5 * 6144;
    const bf16_t* Y = (const bf16_t*)(a.ws() + WS_Y);
    bf16_t* XS = (bf16_t*)(a.ws() + (dry ? WS_ACT : WS_XS)); bf16_t* H = (bf16_t*)(a.ws() + (dry ? WS_YB + ((size_t)200 << 20) : WS_H)); bf16_t* HL = (bf16_t*)(a.ws() + (dry ? WS_YB + ((size_t)240 << 20) : WS_HL));
    if (tid < 64) hist[tid] = 0;
    const int NTOK = (l == DEPTH - 1) ? 64 : 68;
    const int tok0 = bid * NTOK;
    if (!dry || (PROBE_D & 1)) {
        f32x4 lng[4], lnb[4], g1[4], sc2[4], sh2[4];
        { const f32x4* pg = (const f32x4*)(a.in(I_LN1G) + l * DM) + lane; const f32x4* pb = (const f32x4*)(a.in(I_LN1B) + l * DM) + lane;
#pragma unroll
          for (int j = 0; j < 4; ++j) { lng[j] = pg[64 * j]; lnb[j] = pb[64 * j]; } }
        int cur_br = -1;
        f32x4 xn[4]; u32x2 xb[4]; u32x2 yn[4];
        const bf16_t* XSr = (const bf16_t*)(a.ws() + WS_XS);
#define D_LOADX(M) do { if (l == 0) { const f32x4* xr = (const f32x4*)xrow_in(a, 0, (M)) + lane; _Pragma("unroll") for (int j = 0; j < 4; ++j) xn[j] = xr[64 * j]; } \
        else { const u32x2* xr = (const u32x2*)(XSr + (size_t)(M) * DM) + lane; _Pragma("unroll") for (int j = 0; j < 4; ++j) xb[j] = xr[64 * j]; } \
        const u32x2* yr = (const u32x2*)(Y + (size_t)(M) * DM) + lane; _Pragma("unroll") for (int j = 0; j < 4; ++j) yn[j] = yr[64 * j]; } while (0)
        D_LOADX(tok0 + wave);
        for (int r = wave; r < NTOK; r += 8) {
            const int m = tok0 + r, br = tok_batchrow(m);
            if (br != cur_br) { cur_br = br; const float* md = mod + (size_t)br * 6144;
#pragma unroll
                for (int j = 0; j < 4; ++j) { g1[j] = *((const f32x4*)(md + 2 * DM) + lane + 64 * j); sh2[j] = *((const f32x4*)(md + 3 * DM) + lane + 64 * j); sc2[j] = *((const f32x4*)(md + 4 * DM) + lane + 64 * j) + 1.0f; } }
            f32x4 v[4]; float s = 0.f;
#pragma unroll
            for (int j = 0; j < 4; ++j) { const f32x4 y = {bf_lo(yn[j].x), bf_hi(yn[j].x), bf_lo(yn[j].y), bf_hi(yn[j].y)};
                const f32x4 x = (l == 0) ? xn[j] : (f32x4){bf_lo(xb[j].x), bf_hi(xb[j].x), bf_lo(xb[j].y), bf_hi(xb[j].y)};
                v[j] = x * DN_ALPHA + g1[j] * y; s += (v[j][0] + v[j][1]) + (v[j][2] + v[j][3]); }
            if (r + 8 < NTOK) D_LOADX(m + 8);
            const float mean = wave_sum(s) * (1.0f / DM); float s2 = 0.f;
#pragma unroll
            for (int j = 0; j < 4; ++j) { v[j] = v[j] - mean; s2 += (v[j][0] * v[j][0] + v[j][1] * v[j][1]) + (v[j][2] * v[j][2] + v[j][3] * v[j][3]); }
            const float rstd = __builtin_amdgcn_rsqf(wave_sum(s2) * (1.0f / DM) + LN_EPS);
            u32x2* xo = (u32x2*)(XS + (size_t)m * DM) + lane; u32x2* ho = (u32x2*)(H + (size_t)m * DM) + lane; u32x2* hl = (u32x2*)(HL + (size_t)m * DM) + lane;
#pragma unroll
            for (int j = 0; j < 4; ++j) { const f32x4 x1 = v[j] * rstd * lng[j] + lnb[j]; xo[64 * j] = (u32x2){cvt_pk_bf16(x1[0], x1[1]), cvt_pk_bf16(x1[2], x1[3])};
                const f32x4 h = x1 * sc2[j] + sh2[j];
                const unsigned h01 = cvt_pk_bf16(h[0], h[1]), h23 = cvt_pk_bf16(h[2], h[3]);
                ho[64 * j] = (u32x2){h01, h23};
                hl[64 * j] = (u32x2){cvt_pk_bf16(h[0] - bf_lo(h01), h[1] - bf_hi(h01)), cvt_pk_bf16(h[2] - bf_lo(h23), h[3] - bf_hi(h23))}; }
        }
    }
#undef D_LOADX
    VM_WAIT(); __syncthreads();
    if (D_DELAY) { const unsigned long long t0d = __builtin_amdgcn_s_memrealtime(); while (__builtin_amdgcn_s_memrealtime() - t0d < (unsigned long long)D_DELAY) __builtin_amdgcn_s_sleep(16); }
    TS(4);
    if (!dry || (PROBE_D & 2)) {
        const bf16_t* WH = (const bf16_t*)(a.ws() + WS_WRHI) + (size_t)l * 64 * DM; const bf16_t* WL = (const bf16_t*)(a.ws() + WS_WRLO) + (size_t)l * 64 * DM;
        const int ntile = wave & 3, mt0 = wave >> 2, fr = lane & 15, fq = lane >> 4;
        constexpr int AQ = 264;
        LAS bf16_t* Ahi = (LAS bf16_t*)(lds + 32768); LAS bf16_t* Alo = Ahi + 80 * AQ;
        f32x4 acc[3];
#pragma unroll
        for (int i = 0; i < 3; ++i) acc[i] = (f32x4){0.f, 0.f, 0.f, 0.f};
        bf16x8 rh[5], rl[5];
#define D_FETCH(KQ) do { _Pragma("unroll") for (int ii = 0; ii < 5; ++ii) { const int p = tid + 512 * ii; if (p < NTOK * 32) { const size_t g = (size_t)(tok0 + (p >> 5)) * DM + (KQ) * 256 + (p & 31) * 8; \
            rh[ii] = *(const bf16x8*)(H + g); rl[ii] = *(const bf16x8*)(HL + g); } } } while (0)
        D_FETCH(0);
#pragma unroll 1
        for (int kq = 0; kq < 4; ++kq) {
            bf16x8 bh[8], bl[8];
#pragma unroll
            for (int q = 0; q < 8; ++q) { const size_t fo = (((size_t)ntile * 32 + kq * 8 + q) * 64 + lane) * 8; bh[q] = *(const bf16x8*)(WH + fo); bl[q] = *(const bf16x8*)(WL + fo); }
            __syncthreads();
#pragma unroll
            for (int ii = 0; ii < 5; ++ii) { const int p = tid + 512 * ii; if (p < NTOK * 32) { *(LAS bf16x8*)(Ahi + (p >> 5) * AQ + (p & 31) * 8) = rh[ii]; *(LAS bf16x8*)(Alo + (p >> 5) * AQ + (p & 31) * 8) = rl[ii]; } }
            __syncthreads();
            if (kq < 3) D_FETCH(kq + 1);
#pragma unroll
            for (int q = 0; q < 8; ++q)
#pragma unroll
                for (int i = 0; i < 3; ++i) if (i < 2 || mt0 == 0) {
                    const bf16x8 ahv = *(const LAS bf16x8*)(Ahi + ((mt0 + 2 * i) * 16 + fr) * AQ + q * 32 + fq * 8), alv = *(const LAS bf16x8*)(Alo + ((mt0 + 2 * i) * 16 + fr) * AQ + q * 32 + fq * 8);
                    acc[i] = __builtin_amdgcn_mfma_f32_16x16x32_bf16(ahv, bh[q], acc[i], 0, 0, 0);
                    acc[i] = __builtin_amdgcn_mfma_f32_16x16x32_bf16(ahv, bl[q], acc[i], 0, 0, 0);
                    acc[i] = __builtin_amdgcn_mfma_f32_16x16x32_bf16(alv, bh[q], acc[i], 0, 0, 0); }
        }
#undef D_FETCH
#pragma unroll
        for (int i = 0; i < 3; ++i) if (i < 2 || mt0 == 0)
#pragma unroll
            for (int q = 0; q < 4; ++q) lg[((mt0 + 2 * i) * 16 + fq * 4 + q) * 64 + ntile * 16 + fr] = acc[i][q];
    }
    __syncthreads(); TS(5);
    if (!dry || (PROBE_D & 4)) {
        int* tke = (int*)(a.ws() + WS_TKE); float* tkw = (float*)(a.ws() + WS_TKW);
        const float ebias = a.in(I_EBIAS)[l * 64 + lane];
        for (int r = wave; r < NTOK; r += 8) {
            const int m = tok0 + r;
            const float score = 1.0f / (1.0f + __expf(-lg[r * 64 + lane]));
            const float sel = score + ebias; int rank = 0;
#pragma unroll
            for (int c = 0; c < 64; ++c) { const float o = __int_as_float(__builtin_amdgcn_readlane(__float_as_int(sel), c)); rank += (o > sel || (o == sel && c < lane)) ? 1 : 0; }
            const bool mine = rank < TOPK;
            const unsigned long long taken = __ballot(mine);
            const float wsum = wave_sum_dpp(mine ? score : 0.f);
            if (mine) { const int k = __popcll(taken & ((1ull << lane) - 1ull)); const int lr = __hip_atomic_fetch_add(&hist[lane], 1, __ATOMIC_RELAXED, __HIP_MEMORY_SCOPE_WORKGROUP);
                if (!dry) { tke[m * 8 + k] = lane; tkw[m * 8 + k] = score / wsum * ROUTE_SCALE; } pend[r * 8 + k] = (lane << 16) | lr; }
        }
    }
    __syncthreads();
    if (dry) return;
    { unsigned* cnt = (unsigned*)(a.ws() + WS_CTL) + CW_CNT + l * 64;
      if (tid < 64) hist[64 + tid] = (int)atomicAdd(&cnt[tid], (unsigned)hist[tid]); }
    __syncthreads();
    { int* tkp = (int*)(a.ws() + WS_TKP); int* list = (int*)(a.ws() + WS_LIST);
      for (int i = tid; i < NTOK * 8; i += 512) { const int pe = pend[i], e = pe >> 16, p = hist[64 + e] + (pe & 0xffff); const int m = tok0 + (i >> 3);
        tkp[m * 8 + (i & 7)] = p; list[(size_t)e * TT + p] = m; } }
    __syncthreads();
}

constexpr float YB_SCALE_G = 32.0f;
__device__ __forceinline__ void phase_combine_ln2(const KA& a, LAS unsigned char* lds, int l, int gw, int NGW, int tid, int lane, const bool dry) {
    LAS int* rst = (LAS int*)(lds + LDS_TAB) + 66;
    const float* mod = (const float*)(a.ws() + WS_MOD) + (size_t)l * 5 * 6144;
    const unsigned char* YB = (const unsigned char*)(a.ws() + WS_YB);
    const bf16_t* XSi = (const bf16_t*)(a.ws() + WS_XS); bf16_t* XS = (bf16_t*)(a.ws() + (dry ? WS_ACT : WS_XS)); bf16_t* H = (bf16_t*)(a.ws() + (dry ? WS_HL : WS_H));
    const int* tke = (const int*)(a.ws() + WS_TKE); const float* tkw = (const float*)(a.ws() + WS_TKW); const int* tkp = (const int*)(a.ws() + WS_TKP);
    const int mend = (l == DEPTH - 1) ? TLAT : TT;
    const int e0 = 16 * lane;
    f32x4 lng[4], lnb[4];
    { const f32x4* pg = (const f32x4*)(a.in(I_LN2G) + l * DM + e0); const f32x4* pb = (const f32x4*)(a.in(I_LN2B) + l * DM + e0);
#pragma unroll
      for (int j = 0; j < 4; ++j) { lng[j] = pg[j]; lnb[j] = pb[j]; } }
    float* outp = dry ? (float*)(a.ws() + WS_ACT) : a.out();
#define G_SLOTS(M0, SLOT, W) do { _Pragma("unroll") for (int q = 0; q < 2; ++q) { const int mq = (q == 0 || (M0) + NGW < mend) ? (M0) + q * NGW : (M0); SLOT[q] = 0; W[q] = 1.0f / YB_SCALE_G; \
        if ((M0) < mend) { if (lane < 8) { SLOT[q] = rst[tke[mq * 8 + lane]] + tkp[mq * 8 + lane]; W[q] = tkw[mq * 8 + lane] * (1.0f / YB_SCALE_G); } if (lane == 8) SLOT[q] = rst[64] + mq; } } } while (0)
    int slotn[2]; float wn[2];
    G_SLOTS(gw, slotn, wn);
    for (int m0 = gw; m0 < mend; m0 += 2 * NGW) {
        int mm[2]; mm[0] = m0; mm[1] = (m0 + NGW < mend) ? m0 + NGW : m0;
        const bool two = (m0 + NGW < mend);
        int slot[2]; float w[2];
        slot[0] = slotn[0]; slot[1] = slotn[1]; w[0] = wn[0]; w[1] = wn[1];
        G_SLOTS(m0 + 2 * NGW, slotn, wn);
        f32x4 ff[2][4]; f32x4 xv[2][4];
#pragma unroll
        for (int q = 0; q < 2; ++q) { const u32x4* xi = (const u32x4*)(XSi + (size_t)mm[q] * DM + e0); const u32x4 xa = xi[0], xc = xi[1];
            xv[q][0] = (f32x4){bf_lo(xa[0]), bf_hi(xa[0]), bf_lo(xa[1]), bf_hi(xa[1])}; xv[q][1] = (f32x4){bf_lo(xa[2]), bf_hi(xa[2]), bf_lo(xa[3]), bf_hi(xa[3])};
            xv[q][2] = (f32x4){bf_lo(xc[0]), bf_hi(xc[0]), bf_lo(xc[1]), bf_hi(xc[1])}; xv[q][3] = (f32x4){bf_lo(xc[2]), bf_hi(xc[2]), bf_lo(xc[3]), bf_hi(xc[3])};
#pragma unroll
            for (int j = 0; j < 4; ++j) ff[q][j] = (f32x4){0.f, 0.f, 0.f, 0.f}; }
        u32x4 yy[2][9];
#pragma unroll
        for (int k = 0; k < 9; ++k)
#pragma unroll
            for (int q = 0; q < 2; ++q) { const int sk = __builtin_amdgcn_readlane(slot[q], k); yy[q][k] = *(const u32x4*)(YB + (size_t)sk * DM + e0); }
#pragma unroll
        for (int k = 0; k < 9; ++k)
#pragma unroll
            for (int q = 0; q < 2; ++q) { const float wk = __int_as_float(__builtin_amdgcn_readlane(__float_as_int(w[q]), k));
#pragma unroll
                for (int j = 0; j < 4; ++j) { const f32x2 lo2 = __builtin_amdgcn_cvt_pk_f32_fp8((int)yy[q][k][j], false), hi2 = __builtin_amdgcn_cvt_pk_f32_fp8((int)yy[q][k][j], true);
                    ff[q][j] += (f32x4){lo2.x, lo2.y, hi2.x, hi2.y} * wk; } }
#pragma unroll
        for (int q = 0; q < 2; ++q) {
            if (q == 1 && !two) break;
            const int m = mm[q]; const float* md = mod + (size_t)tok_batchrow(m) * 6144;
            f32x4 v[4]; float s = 0.f;
#pragma unroll
            for (int j = 0; j < 4; ++j) { const f32x4 g2 = *((const f32x4*)(md + 5 * DM + e0) + j);
                v[j] = xv[q][j] * DN_ALPHA + g2 * ff[q][j]; s += (v[j][0] + v[j][1]) + (v[j][2] + v[j][3]); }
            const float mean = wave_sum(s) * (1.0f / DM); float s2 = 0.f;
#pragma unroll
            for (int j = 0; j < 4; ++j) { v[j] = v[j] - mean; s2 += (v[j][0] * v[j][0] + v[j][1] * v[j][1]) + (v[j][2] * v[j][2] + v[j][3] * v[j][3]); }
            const float rstd = __builtin_amdgcn_rsqf(wave_sum(s2) * (1.0f / DM) + LN_EPS);
            if (l == DEPTH - 1) {
                f32x4* oo = (f32x4*)(outp + (size_t)m * DM + e0);
#pragma unroll
                for (int j = 0; j < 4; ++j) oo[j] = v[j] * rstd * lng[j] + lnb[j];
            } else {
                const float* mdn = md + 5 * 6144;
                u32x4* xio = (u32x4*)(XS + (size_t)m * DM + e0); u32x4* ho = (u32x4*)(H + (size_t)m * DM + e0);
                unsigned hp[8], xp[8];
#pragma unroll
                for (int j = 0; j < 4; ++j) { const f32x4 x2 = v[j] * rstd * lng[j] + lnb[j]; xp[2 * j] = cvt_pk_bf16(x2[0], x2[1]); xp[2 * j + 1] = cvt_pk_bf16(x2[2], x2[3]);
                    const f32x4 sh = *((const f32x4*)(mdn + e0) + j), sc = *((const f32x4*)(mdn + DM + e0) + j);
                    const f32x4 h = x2 * (sc + 1.0f) + sh; hp[2 * j] = cvt_pk_bf16(h[0], h[1]); hp[2 * j + 1] = cvt_pk_bf16(h[2], h[3]); }
                ho[0] = (u32x4){hp[0], hp[1], hp[2], hp[3]}; ho[1] = (u32x4){hp[4], hp[5], hp[6], hp[7]};
                xio[0] = (u32x4){xp[0], xp[1], xp[2], xp[3]}; xio[1] = (u32x4){xp[4], xp[5], xp[6], xp[7]};
            }
        }
    }
#undef G_SLOTS
}

__device__ __forceinline__ void build_expert_tables(const KA& a, LAS unsigned char* lds, int l, int tid) {
    LAS int* tst = (LAS int*)(lds + LDS_TAB); LAS int* rst = tst + 66; LAS int* cn = rst + 66;
    __syncthreads();
    if (tid < 64) {
        const unsigned* cnt = (const unsigned*)(a.ws() + WS_CTL) + CW_CNT + l * 64;
        const int c = (int)__hip_atomic_load(cnt + tid, __ATOMIC_RELAXED, __HIP_MEMORY_SCOPE_AGENT);
        int t = (c + 255) >> 8, r = c;
#pragma unroll
        for (int o = 1; o < 64; o <<= 1) { const int t2 = __shfl_up(t, o), r2 = __shfl_up(r, o); if (tid >= o) { t += t2; r += r2; } }
        tst[tid] = t - ((c + 255) >> 8); rst[tid] = r - c; cn[tid] = c;
        const int nsh = (l == DEPTH - 1) ? TLAT : TT;
        if (tid == 63) { tst[64] = t; rst[64] = r; cn[64] = nsh; tst[65] = t + (nsh >> 8); rst[65] = r + nsh; }
    }
    __syncthreads();
    LAS int* t2e = tst + 200;
    const int ntl = tst[65];
    for (int m = tid; m < ntl; m += 512) { int lo = 0, hi = 65;
#pragma unroll
        for (int it = 0; it < 7; ++it) { const int mid = (lo + hi) >> 1; if (tst[mid] <= m) lo = mid; else hi = mid; }
        t2e[m] = lo; }
    __syncthreads();
}

struct Seg {
    int i0, c, G, first, n;
    __device__ __forceinline__ void init(int first_, int n_, int c_, int G_) { first = first_; n = n_; c = c_; G = G_; i0 = (first_ <= c_) ? 0 : (first_ - c_ + G_ - 1) / G_; }
    __device__ __forceinline__ int idx(int i) const { const int L = (i0 + i) * G + c - first; return L < n ? L : -1; }
};
__device__ __forceinline__ int kv_row0(int pm) { return pm < 64 ? (pm >> 4) * KVR + (pm & 15) * 256 : (pm - 64) * KVR + LSEQ; }

struct SchedQKVE { Seg s; unsigned char* ws; int j;
    __device__ __forceinline__ bool next(int i, pg8::Unit& u) { const int L0 = s.idx(i); if (L0 < 0) return false;
        size_t offA, offB, offC; int ldc, x0, x1 = 0;
        if (L0 >= 340) { const int L = L0 - 340; x0 = 3;
            if (L < 128) { const int q = L >> 6, mt = L & 63, b = mt >> 4;
                offA = WS_WF + ((size_t)j * 512 + q * 256) * 2048; offB = WS_H + (size_t)mt * 256 * 2048; offC = WS_ZT + ((size_t)b * 256 * 8192 + q * 4096 + (mt & 15) * 256) * 2; ldc = 8192; }
            else { const int q = (L - 128) >> 2, b = (L - 128) & 3;
                offA = WS_WF + ((size_t)j * 512 + q * 256) * 2048; offB = WS_H + (size_t)(TLAT + b * 256) * 2048; offC = WS_ZCT + ((size_t)b * 256 * 512 + q * 256) * 2; ldc = 512; }
        } else { const int pm = L0 % 68, pn = L0 / 68;
            offA = WS_H + (size_t)pm * 256 * 2048; offB = WS_WINE + ((size_t)j * 1280 + pn * 256) * 2048; x1 = pm < 64 ? (pm & 15) * 256 : -1;
            if (pn < 3) { offC = WS_QB + ((size_t)pm * 256 * 768 + pn * 256) * 2; ldc = 768; x0 = 0; }
            else { offC = (pn == 3 ? WS_KB : WS_VB) + (size_t)kv_row0(pm) * 128 * 2; ldc = 128; x0 = pn - 2; } }
        u.A = (const char*)(ws + offA); u.B = (const char*)(ws + offB); u.C = (char*)(ws + offC); u.ldc = ldc; u.x0 = x0; u.x1 = x1; u.rows = nullptr; u.nvalid = 256;
        return true; } };
struct SchedQKVO { Seg s; unsigned char* ws; int j;
    __device__ __forceinline__ bool next(int i, pg8::Unit& u) { const int L = s.idx(i); if (L < 0) return false; const int pm = L % 68, pn = L / 68;
        u.A = (const char*)(ws + WS_H) + (size_t)pm * 256 * 2048; u.B = (const char*)(ws + WS_WINO) + ((size_t)j * 3072 + pn * 256) * 2048; u.rows = nullptr; u.nvalid = 256; u.x0 = 0; u.x1 = 0; u.ldc = 1024;
        if (pn < 4) u.C = (char*)(ws + WS_QB) + ((size_t)pm * 256 * 1024 + pn * 256) * 2;
        else u.C = (char*)(ws + (pn < 8 ? WS_KB : WS_VB)) + ((size_t)kv_row0(pm) * 1024 + (pn & 3) * 256) * 2;
        return true; } };
struct SchedDFT { Seg s; unsigned char* ws;
    __device__ __forceinline__ bool next(int i, pg8::Unit& u) { const int L = s.idx(i); if (L < 0) return false; const int pm = L >> 2, b = L & 3;
        u.A = (const char*)(ws + WS_TW) + (size_t)pm * 256 * 16384; u.B = (const char*)(ws + WS_ZT) + (size_t)b * 256 * 16384;
        u.C = (char*)(ws + WS_O) + (size_t)(b * LSEQ + pm * 256) * 1024 * 2; u.ldc = 1024; u.rows = nullptr; u.nvalid = 256; u.x0 = 0; u.x1 = 0; return true; } };
struct SchedDFTC { Seg s; unsigned char* ws;
    __device__ __forceinline__ bool next(int i, pg8::Unit& u) { const int b = s.idx(i); if (b < 0) return false;
        u.A = (const char*)(ws + WS_TWC); u.B = (const char*)(ws + WS_ZCT) + (size_t)b * 256 * 1024;
        u.C = (char*)(ws + WS_O) + (size_t)(TLAT + b * 256) * 1024 * 2; u.ldc = 1024; u.rows = nullptr; u.nvalid = 256; u.x0 = 0; u.x1 = 0; return true; } };
struct SchedOUT { Seg s; unsigned char* ws; int l, nm;
    __device__ __forceinline__ bool next(int i, pg8::Unit& u) { const int L = s.idx(i); if (L < 0) return false; const int pm = L % nm, pn = L / nm;
        u.A = (const char*)(ws + WS_O) + (size_t)pm * 256 * 2048; u.B = (const char*)(ws + WS_WOUT) + ((size_t)l * 1024 + pn * 256) * 2048;
        u.C = (char*)(ws + WS_Y) + ((size_t)pm * 256 * 1024 + pn * 256) * 2; u.ldc = 1024; u.rows = nullptr; u.nvalid = 256; u.x0 = 0; u.x1 = 0; return true; } };
struct SchedGU { Seg s; unsigned char* ws; int l; const LAS int* tab; int e; int L0, cnt; int probe;
    __device__ __forceinline__ bool next(int i, pg8::Unit& u) { const int L = cnt > 0 ? (i < cnt ? L0 + i : -1) : s.idx(i); if (L < 0) return false; const int mtg = L >> 1, nt = L & 1;
        e = tab[200 + mtg];
        const int mt = mtg - tab[e], r0 = tab[66 + e] + mt * 256;
        u.A = (const char*)(ws + WS_H); u.rows = (const int*)(ws + WS_LIST) + (size_t)e * TT + mt * 256; u.nvalid = min(256, tab[132 + e] - mt * 256);
        u.B = (const char*)(ws + WS_WGU) + ((size_t)(l * 65 + e) * 512 + nt * 256) * 2048;
        u.C = (char*)(ws + WS_ACT) + ((size_t)r0 * 256 + nt * 128) * 2; u.ldc = 256; u.x0 = 0; u.x1 = 0;
        if (probe & 1) u.rows = (const int*)(ws + WS_LIST) + (size_t)64 * TT + (mtg & 63) * 256;
        if (probe & 2) u.nvalid = 0;
        return true; } };
struct SchedDN { Seg s; unsigned char* ws; int l; const LAS int* tab; int e; int probe; int L0, cnt;
    __device__ __forceinline__ bool next(int i, pg8::Unit& u) { const int L = cnt > 0 ? (i < cnt ? L0 + i : -1) : s.idx(i); if (L < 0) return false; const int mtg = L >> 2, nt = L & 3;
        e = tab[200 + mtg];
        const int mt = mtg - tab[e], r0 = tab[66 + e] + mt * 256;
        u.A = (const char*)(ws + WS_ACT) + (size_t)r0 * 512; u.rows = nullptr; u.nvalid = min(256, tab[132 + e] - mt * 256);
        u.B = (const char*)(ws + WS_WD) + ((size_t)(l * 65 + e) * 1024 + nt * 256) * 512;
        u.C = (char*)(ws + WS_YB) + ((size_t)r0 * 1024 + nt * 256); u.ldc = 1024; u.x0 = 0; u.x1 = 0;
        if (probe & 1) u.nvalid = 0;
        if (probe & 2) { u.A = (const char*)(ws + WS_ACT); u.B = (const char*)(ws + WS_WD) + (size_t)(l * 65) * 1024 * 512; }
        return true; } };

constexpr int NPHASE = 2 + 7 * DEPTH;
#ifndef PHMASK
#define PHMASK 0xFFFFF
#endif
#define SITE(b) if constexpr ((PHMASK >> (b)) & 1)
#ifndef REP_A
#define REP_A 1
#endif
#ifndef REP_B
#define REP_B 1
#endif
#ifndef REP_BO
#define REP_BO 1
#endif
#ifndef REP_C
#define REP_C 1
#endif
#ifndef REP_E
#define REP_E 1
#endif
#ifndef REP_F
#define REP_F 1
#endif
#ifndef REP_D
#define REP_D 1
#endif
#ifndef REP_G
#define REP_G 1
#endif
#ifndef REP_BAR
#define REP_BAR 1
#endif
#ifndef PROBE_TS_SCALE
#define PROBE_TS_SCALE 0.0002f
#endif
#ifndef PROBE_TS_A
#define PROBE_TS_A 0
#endif
#ifndef PROBE_TS_B
#define PROBE_TS_B 1
#endif
#ifndef EF_FUSED
#define EF_FUSED 0
#endif
#ifndef E_STAGGER
#define E_STAGGER 0
#endif
#ifndef PROBE_E
#define PROBE_E 0
#endif
#ifndef PROBE_F
#define PROBE_F 0
#endif
#ifndef REP_P0
#define REP_P0 1
#endif
__global__ void __launch_bounds__(512, 2) fwd(Args args_) {
    extern __shared__ __attribute__((aligned(16))) unsigned char lds_raw[];
    LAS unsigned char* lds = (LAS unsigned char*)lds_raw;
    const int G = gridDim.x, bid = ((G & 7) == 0) ? (int)(blockIdx.x & 7) * (G >> 3) + (int)(blockIdx.x >> 3) : (int)blockIdx.x;
#define tid (opaque_tid())
#define lane (opaque_tid() & 63)
#define wave (__builtin_amdgcn_readfirstlane(opaque_tid() >> 6))
    const KA a;
#define WSP (a.ws())
#define args a
    volatile LAS unsigned* MISC = (volatile LAS unsigned*)(lds + LDS_MISC);
    { const int t0 = threadIdx.x; if (t0 < 64) MISC[t0] = 0u; }
    __syncthreads();
    if (PROBE_TS && threadIdx.x == 0) *(volatile LAS unsigned long long*)(lds + LDS_MISC + 192) = __builtin_amdgcn_s_memrealtime();
#define lo (a.ph_lo())
#define hi (a.ph_hi())
    XcdBarrier bar; bar.bar = (unsigned*)(WSP + WS_CTL) + CW_BAR; bar.x = 0; bar.st = MISC + 8;
    if (hi - lo > 1) bar = xcd_barrier_post((unsigned*)(WSP + WS_CTL) + CW_BAR, MISC + 8);
#define IN(k) (lo <= (k) && (k) < hi)
#define SEAM(k) do { if (IN(k) && IN((k) + 1)) for (int rb = 0; rb < REP_BAR; ++rb) xcd_barrier(bar); TS(((k) < 2) ? 16 : 17 + ((k) - 2) % 7); } while (0)
    const int NGW = G * 8;
#define gw (bid * 8 + wave)

    if (IN(0)) SITE(0) for (int rep = 0; rep < REP_P0; ++rep) {
        __syncthreads();
        p0_mod(args, lds, bid, G, tid, wave, lane); TS(11);
        if (bid >= G - 64) p0_fourier_fold(args, lds, G - 1 - bid, tid, wave, lane);
        TS(12); p0_tables(args, lds, bid * 512 + tid, G * 512, tid); TS(13);
        { int* ident = (int*)(WSP + WS_LIST) + (size_t)NEXP * TT; for (int i = bid * 512 + tid; i < TT; i += G * 512) ident[i] = i; }
        __syncthreads();
        if (CV_MODE == 0) convert_items(lds, 0, 0, cv_items(0), bid, G);
        else { convert_items(lds, 0, CV_EX, cv_items(0), bid, G); convert_items(lds, 0, 3000, CV_EX, bid, G); }
        if (CV_MODE == 0) { for (int lq = 1; lq < DEPTH; ++lq) convert_items(lds, lq, 0, cv_items(lq), bid, G); }
        TS(14);
    }
    TS(0); SEAM(0);
    if (IN(1)) SITE(0) p0b_modulate(args, gw, NGW, lane);
    TS(0); SEAM(1);

    for (int l = 0; l < DEPTH; ++l) {
        const int pb = 2 + 7 * l, j = l >> 1;
        if (IN(pb + 0)) for (int rep = 0; rep < REP_A; ++rep) {
            if ((l & 1) == 0) {
                SITE(1) { SchedQKVE S; S.s.init(0, 476, bid, G); S.ws = WSP; S.j = j;
                  pg8::EpiQKVE E; E.P = (LAS float*)(lds + LDS_EPI); E.gainp = (const float*)(WSP + WS_GAINP) + j * 256; E.rope = (const f32x2*)(WSP + WS_ROPE);
                  pg8::gemm_phase<pg8::EpiQKVE, SchedQKVE, false>(lds, 1024, S, E); }
            } else SITE(3) {
                SchedQKVO S; S.s.init(0, 816, bid, G); S.ws = WSP; S.j = j; pg8::EpiStore E;
                pg8::gemm_phase<pg8::EpiStore, SchedQKVO, false>(lds, 1024, S, E);
                if (rep == 0) cv_tail(lds, l, 0, 816, bid, G);
            }
        }
        TS(1); SEAM(pb + 0);
        if (IN(pb + 1)) for (int rep = 0; rep < ((l & 1) ? REP_BO : REP_B); ++rep) {
            __syncthreads();
            const bf16_t* QB = (const bf16_t*)(WSP + WS_QB); const bf16_t* KB = (const bf16_t*)(WSP + WS_KB); const bf16_t* VB = (const bf16_t*)(WSP + WS_VB); bf16_t* O = (bf16_t*)(WSP + WS_O);
            if ((l & 1) == 0) {
                SITE(4) { SchedDFT S; S.s.init(0, 64, bid, G); S.ws = WSP; pg8::EpiStore E; pg8::gemm_phase<pg8::EpiStore, SchedDFT, false>(lds, 8192, S, E); }
                SITE(5) { SchedDFTC S; S.s.init(28, 4, bid, G); S.ws = WSP; pg8::EpiStore E; pg8::gemm_phase<pg8::EpiStore, SchedDFTC, false>(lds, 512, S, E); }
                __syncthreads();
                if (bid < 64 && rep == 0) { const CvSlice c = cv_slice(l, 1); if (c.i1 > c.i0) { __syncthreads(); convert_items(lds, c.l, c.i0, c.i1, bid, 64); __syncthreads(); } }
                SITE(6) {
                    int u = (bid < 24) ? bid : (bid >= 64 ? bid - 40 : 408);
                    while (u < 408) {
                        const bf16_t *q, *k, *v; bf16_t* o; int ntile;
                        if (u < 24) { const int b = u / 6, h = u % 6; q = QB + (TLAT + b * 256) * 768 + h * 128; k = KB + ((h / 3) * NB * KVR + b * KVR + LSEQ) * 128; v = VB + ((h / 3) * NB * KVR + b * KVR + LSEQ) * 128;
                            o = O + (TLAT + b * 256) * 1024 + 256 + h * 128; ntile = 4; u = 408; }
                        else { const int uu = u - 24, bk = uu / 48, x = uu % 48, b = bk >> 1, kvh = bk & 1, h = kvh * 3 + x / 16, qb = x & 15;
                            q = QB + (b * LSEQ + qb * 256) * 768 + h * 128; k = KB + (kvh * NB * KVR + b * KVR) * 128; v = VB + (kvh * NB * KVR + b * KVR) * 128;
                            o = O + (b * LSEQ + qb * 256) * 1024 + 256 + h * 128; ntile = 68; u += 192; }
                        att::attn_body<false, 768, 128, 1024>(q, k, v, o, ntile, 0, 0, 0, (char*)lds_raw);
                    }
                }
            } else {
                const float* rpb = a.in(I_NARPB) + (size_t)j * 8 * 465;
                LAS float* bt = (LAS float*)(lds + att::LDS_BIAS);
                SITE(7) for (int u = bid; u < ((l == DEPTH - 1) ? 512 : 544); u += G) {
                    const bf16_t *q, *k, *v; bf16_t* o; int ntile, nloc, bs, q0r, h;
                    if (u < 512) { const int bh = u >> 4, blk = u & 15, b = bh >> 3; h = bh & 7; bs = min(max(4 * blk - 4, 0), 52); q0r = 4 * blk; ntile = 16; nloc = 12;
                        q = QB + (b * LSEQ + blk * 256) * 1024 + h * 128; k = KB + b * KVR * 1024 + h * 128; v = VB + b * KVR * 1024 + h * 128; o = O + (b * LSEQ + blk * 256) * 1024 + h * 128; }
                    else { const int b = (u - 512) >> 3; h = u & 7; bs = 0; q0r = 0; ntile = 4; nloc = 0;
                        q = QB + (TLAT + b * 256) * 1024 + h * 128; k = KB + b * KVR * 1024 + h * 128; v = VB + b * KVR * 1024 + h * 128; o = O + (TLAT + b * 256) * 1024 + h * 128; }
                    for (int i = tid; i < 465; i += 512) bt[64 + i] = rpb[h * 465 + i] * (1.0f / ATT_SCALE);
                    att::attn_body<true, 1024, 1024, 1024>(q, k, v, o, ntile, nloc, bs, q0r, (char*)lds_raw);
                }
            }
        }
        TS(2); SEAM(pb + 1);
        if (IN(pb + 2)) SITE(9) for (int rep = 0; rep < REP_C; ++rep) { const int nm = (l == DEPTH - 1) ? 64 : 68;
            SchedOUT S; S.s.init(0, nm * 4, bid, G); S.ws = WSP; S.l = l; S.nm = nm; pg8::EpiStore E; pg8::gemm_phase<pg8::EpiStore, SchedOUT, false>(lds, 1024, S, E);
            if (rep == 0) cv_tail(lds, l, 2, nm * 4, bid, G); }
        TS(3); SEAM(pb + 2);
        if (IN(pb + 3)) SITE(10) for (int rep = 0; rep < REP_D; ++rep) { __syncthreads(); phase_ln1_router(args, lds, l, bid, tid, wave, lane, rep + 1 < REP_D); }
        TS(6); SEAM(pb + 3);
#if EF_FUSED
        if (IN(pb + 4)) SITE(11) for (int rep = 0; rep < REP_E; ++rep) { build_expert_tables(args, lds, l, tid);
            const LAS int* tab = (const LAS int*)(lds + LDS_TAB);
            const int nsu = tab[65]; int ecur = 0;
            for (int su = bid; su < nsu; su += G) {
                { SchedGU S; S.s.init(0, 0, bid, G); S.ws = WSP; S.l = l; S.tab = tab; S.e = ecur; S.L0 = su * 2; S.cnt = 2; S.probe = 0; pg8::EpiSwiGLU E;
                  pg8::gemm_phase<pg8::EpiSwiGLU, SchedGU, true>(lds, 1024, S, E); ecur = S.e; }
                VM_WAIT(); __syncthreads();
                __builtin_amdgcn_fence(__ATOMIC_ACQUIRE, "agent"); VM_WAIT();
                { SchedDN S; S.s.init(0, 0, bid, G); S.ws = WSP; S.l = l; S.tab = tab; S.e = ecur; S.probe = 0; S.L0 = su * 4; S.cnt = 4; pg8::EpiStoreF8 E;
                  int k256 = 256; asm volatile("" : "+s"(k256));
                  pg8::gemm_phase<pg8::EpiStoreF8, SchedDN, false>(lds, k256, S, E); }
            }
            if (rep == 0) { cv_tail(lds, l, 4, nsu, bid, G); cv_tail(lds, l, 5, nsu, bid, G); } }
        TS(7); SEAM(pb + 4);
        if (IN(pb + 5) && !IN(pb + 4)) {}
#else
        if (IN(pb + 4)) SITE(11) for (int rep = 0; rep < REP_E; ++rep) { build_expert_tables(args, lds, l, tid);
            const LAS int* tab = (const LAS int*)(lds + LDS_TAB);
            if (E_STAGGER && (bid & 1) && bid >= 8) { const unsigned long long t0s = __builtin_amdgcn_s_memrealtime(); while (__builtin_amdgcn_s_memrealtime() - t0s < (unsigned long long)E_STAGGER) __builtin_amdgcn_s_sleep(16); }
            SchedGU S; S.s.init(0, tab[65] * 2, bid, G); S.ws = WSP; S.l = l; S.tab = tab; S.e = 0; S.L0 = 0; S.cnt = 0; S.probe = (rep + 1 < REP_E) ? PROBE_E : 0; pg8::EpiSwiGLU E;
            pg8::gemm_phase<pg8::EpiSwiGLU, SchedGU, true>(lds, 1024, S, E);
            if (rep == 0) cv_tail(lds, l, 4, tab[65] * 2, bid, G); }
        TS(7); SEAM(pb + 4);
        if (IN(pb + 5)) SITE(12) for (int rep = 0; rep < REP_F; ++rep) { if (!IN(pb + 4)) build_expert_tables(args, lds, l, tid);
            const LAS int* tab = (const LAS int*)(lds + LDS_TAB);
            SchedDN S; S.s.init(0, tab[65] * 4, bid, G); S.ws = WSP; S.l = l; S.tab = tab; S.e = 0; S.probe = (rep + 1 < REP_F) ? PROBE_F : 0; S.L0 = 0; S.cnt = 0; pg8::EpiStoreF8 E;
            int k256 = 256; asm volatile("" : "+s"(k256));
            pg8::gemm_phase<pg8::EpiStoreF8, SchedDN, false>(lds, k256, S, E);
            if (rep == 0) cv_tail(lds, l, 5, tab[65] * 4, bid, G); }
        TS(8); SEAM(pb + 5);
#endif
        if (IN(pb + 6)) SITE(13) for (int rep = 0; rep < REP_G; ++rep) { if (!IN(pb + 4)) build_expert_tables(args, lds, l, tid); phase_combine_ln2(args, lds, l, gw, NGW, tid, lane, rep + 1 < REP_G); }
        TS(9); SEAM(pb + 6);
    }
    if (PROBE_TS) { volatile LAS float* ta_ = (volatile LAS float*)(lds + LDS_MISC + 64);
        float* tsw = (float*)(WSP + WS_CTL) + 32;
        if (blockIdx.x == PROBE_TS_BLK && threadIdx.x == 0) __hip_atomic_store(tsw, ta_[PROBE_TS_A] * 0.01f * PROBE_TS_SCALE, __ATOMIC_RELAXED, __HIP_MEMORY_SCOPE_AGENT);
        xcd_barrier(bar);
        const float va0_unused = 0.f; (void)va0_unused; const float va = __hip_atomic_load(tsw, __ATOMIC_RELAXED, __HIP_MEMORY_SCOPE_AGENT); float* o_ = a.out();
        for (int i = blockIdx.x * 512 + threadIdx.x; i < TLAT * DM; i += G * 512) o_[i] += va; }
#undef IN
#undef SEAM
#undef lo
#undef hi
#undef lane
#undef wave
#undef gw
#undef tid
#undef WSP
#undef args
}

extern "C" void kernel_launch(void* const* d_in, const int* in_sizes, int n_in, void* d_out, int out_size, void* d_ws, size_t ws_size, hipStream_t stream) {
    static int ok = 0;
    if (ok == 0) {
        if (n_in != N_IN || ws_size < WS_END) { fprintf(stderr, "kernel_launch: n_in %d (want %d), ws %zu (want >= %zu)\n", n_in, (int)N_IN, ws_size, (size_t)WS_END); return; }
        if (hipFuncSetAttribute((const void*)fwd, hipFuncAttributeMaxDynamicSharedMemorySize, LDS_BYTES) != hipSuccess) { fprintf(stderr, "kernel_launch: hipFuncSetAttribute failed\n"); return; }
        int per_cu = 0;
        if (hipOccupancyMaxActiveBlocksPerMultiprocessor(&per_cu, (const void*)fwd, 512, LDS_BYTES) != hipSuccess || per_cu < 1) fprintf(stderr, "kernel_launch: occupancy query reports %d\n", per_cu);
        ok = 1;
    }
    Args a;
    memset(&a, 0, sizeof(a));
    for (int i = 0; i < N_IN; ++i) a.in[i] = (const float*)d_in[i];
    a.out = (float*)d_out; a.ws = (unsigned char*)d_ws;
    hipMemsetAsync((char*)d_ws + WS_CTL, 0, CTL_BYTES, stream);
#if MK_ONE_LAUNCH
    a.ph_lo = 0; a.ph_hi = NPHASE;
    hipLaunchKernelGGL(fwd, dim3(256), dim3(512), LDS_BYTES, stream, a);
#else
    for (int p = 0; p < NPHASE; ++p) { a.ph_lo = p; a.ph_hi = p + 1; hipLaunchKernelGGL(fwd, dim3(256), dim3(512), LDS_BYTES, stream, a); }
#endif
    const hipError_t le = hipPeekAtLastError();
    if (le != hipSuccess) fprintf(stderr, "kernel_launch: launch failed: %s\n", hipGetErrorName(le));
}
```
